# Optimizing an MI355X kernel written in HIP

```python
import jax, jax.numpy as jnp
from jax import lax
import numpy as np


D_MODEL = 1024
BATCH = 8
SEQ = 2048
DEPTH = 2

N_MEM = 256
RWKV_HEADS = 8
RWKV_HEAD_DIM = 64
RWKV_W = RWKV_HEADS * RWKV_HEAD_DIM
W_LORA = 64
A_LORA = 64
G_LORA = 128
RWKV_IN = 3 * RWKV_W + W_LORA + A_LORA + G_LORA
RWKV_LN_EPS = RWKV_HEAD_DIM * 1e-5
LRU_BLOCKS = 8
LRU_W = 512
LRU_BLOCK_DIM = LRU_W // LRU_BLOCKS
CONV_WIDTH = 4
LRU_C = 8.0
MLA_HEADS = 8
MLA_NOPE = 64
MLA_ROPE = 32
MLA_QK = MLA_NOPE + MLA_ROPE
MLA_V = 64
Q_RANK = 256
KV_RANK = 128
ROPE_THETA = 10000.0
Q_BLOCK = 128
N_BRANCH = 3
BRANCH_W = 512
XA_HEADS = 4
XA_HEAD_DIM = 128
XA_W = XA_HEADS * XA_HEAD_DIM
D_FF = -(-8 * D_MODEL // (3 * 256)) * 256
LRU_OFF = RWKV_IN
MLA_OFF = LRU_OFF + 2 * LRU_W
GATE_OFF = MLA_OFF + Q_RANK + KV_RANK + MLA_ROPE
D_IN = GATE_OFF + N_BRANCH * D_MODEL

kernel_name = 'hybrid_rwkv7_rglru_mla_gated_block'


def rms_norm(x, g, eps=1e-6):
    xf = x.astype(jnp.float32)
    y = xf * lax.rsqrt(jnp.mean(xf * xf, axis=-1, keepdims=True) + eps)
    return (y * g.astype(jnp.float32)).astype(x.dtype)


def rope(x, cos, sin):
    x1, x2 = jnp.split(x, 2, axis=-1)
    return jnp.concatenate([x1 * cos - x2 * sin, x2 * cos + x1 * sin], axis=-1)


def token_shift(p):
    return jnp.pad(p, ((0, 0), (1, 0), (0, 0)))[:, :-1]


def rwkv7_scan(r, w, k, v, kk, kka):
    B, S, H, N = r.shape

    def step(state, inp):
        r_t, w_t, k_t, v_t, kk_t, kka_t = inp
        sa = jnp.einsum('bhvk,bhk->bhv', state, kk_t)
        state = (state * w_t[:, :, None, :] - sa[..., None] * kka_t[:, :, None, :]
                 + v_t[..., None] * k_t[:, :, None, :])
        return state, jnp.einsum('bhvk,bhk->bhv', state, r_t)

    xs = tuple(jnp.swapaxes(t, 0, 1) for t in (r, w, k, v, kk, kka))
    s0 = jnp.zeros((B, H, N, N), jnp.float32)
    _, ys = lax.scan(step, s0, xs)
    return jnp.swapaxes(ys, 0, 1)


def rwkv7_mix(p, mu, w0, w_up, a0, a_up, g_up, k_k, k_a, r_k, ln_g, ln_b):
    B, S, _ = p.shape
    p = p + (token_shift(p) - p) * mu
    o1, o2, o3 = RWKV_W, 2 * RWKV_W, 3 * RWKV_W
    r, k, v, wd, ad, gd = jnp.split(p, [o1, o2, o3, o3 + W_LORA, o3 + W_LORA + A_LORA], axis=-1)
    w_raw = -jax.nn.softplus(-(w0 + jnp.tanh(wd) @ w_up).astype(jnp.float32)) - 0.5
    decay = jnp.exp(-jnp.exp(w_raw))
    a = jax.nn.sigmoid(a0 + ad @ a_up)
    g = jax.nn.sigmoid(gd) @ g_up
    heads = lambda t: t.reshape(B, S, RWKV_HEADS, RWKV_HEAD_DIM)
    kk = heads(k * k_k).astype(jnp.float32)
    kk = kk / jnp.maximum(jnp.sqrt(jnp.sum(kk * kk, axis=-1, keepdims=True)), 1e-12)
    k = k * (1.0 + (a - 1.0) * k_a)
    r, k, v, decay, a = heads(r), heads(k), heads(v), heads(decay), heads(a)
    y = rwkv7_scan(r, decay, k, v, kk, kk * a)
    mean = jnp.mean(y, axis=-1, keepdims=True)
    var = jnp.mean(jnp.square(y - mean), axis=-1, keepdims=True)
    y = ((y - mean) * lax.rsqrt(var + RWKV_LN_EPS)).reshape(B, S, RWKV_W) * ln_g + ln_b
    bonus = jnp.sum(r * k * r_k, axis=-1, keepdims=True) * v
    y = y + bonus.reshape(B, S, RWKV_W)
    return (y * g).astype(p.dtype)


def _lin_combine(e1, e2):
    a1, b1 = e1
    a2, b2 = e2
    return a1 * a2, a2 * b1 + b2


def rglru_mix(xb, gb, conv_w, conv_b, wa, ba, wx, bx, lam):
    B, S, _ = xb.shape
    xc = lax.conv_general_dilated(xb, conv_w[:, None, :].astype(xb.dtype), window_strides=(1,),
                                  padding=[(CONV_WIDTH - 1, 0)],
                                  dimension_numbers=('NWC', 'WIO', 'NWC'),
                                  feature_group_count=LRU_W) + conv_b
    xh = xc.reshape(B, S, LRU_BLOCKS, LRU_BLOCK_DIM)
    r = jax.nn.sigmoid(jnp.einsum('bsni,nij->bsnj', xh, wa).reshape(B, S, LRU_W) + ba)
    i = jax.nn.sigmoid(jnp.einsum('bsni,nij->bsnj', xh, wx).reshape(B, S, LRU_W) + bx)
    log_a = -LRU_C * r.astype(jnp.float32) * jax.nn.softplus(-lam.astype(jnp.float32))
    a = jnp.exp(log_a)
    u = jnp.sqrt(-jnp.expm1(2.0 * log_a)) * (i * xc)
    _, h = lax.associative_scan(_lin_combine, (a, u), axis=1)
    return (h * jax.nn.gelu(gb)).astype(xb.dtype)


def causal_attention(q, k, v):
    B, S, H, Dk = q.shape
    nb = S // Q_BLOCK
    scale = Dk ** -0.5
    qb = q.reshape(B, nb, Q_BLOCK, H, Dk).transpose(1, 0, 2, 3, 4)
    kpos = jnp.arange(S)

    def block(args):
        qi, bi = args
        qpos = bi * Q_BLOCK + jnp.arange(Q_BLOCK)
        s = jnp.einsum('bqhd,bkhd->bhqk', qi, k, preferred_element_type=jnp.float32) * scale
        s = jnp.where(kpos[None, :] <= qpos[:, None], s, -jnp.inf)
        pr = jax.nn.softmax(s, axis=-1)
        return jnp.einsum('bhqk,bkhd->bqhd', pr.astype(v.dtype), v)

    o = lax.map(block, (qb, jnp.arange(nb)))
    return o.transpose(1, 0, 2, 3, 4).reshape(B, S, H, v.shape[-1])


def mla_mix(cq, ckv, kr, cos, sin, q_norm, w_uq, kv_norm, w_ukv, q_gain, k_gain):
    B, S, _ = cq.shape
    q = (rms_norm(cq, q_norm) @ w_uq).reshape(B, S, MLA_HEADS, MLA_QK)
    kv = (rms_norm(ckv, kv_norm) @ w_ukv).reshape(B, S, MLA_HEADS, MLA_NOPE + MLA_V)
    k_nope, v = jnp.split(kv, [MLA_NOPE], axis=-1)
    k = jnp.concatenate([k_nope, jnp.broadcast_to(kr[:, :, None, :], (B, S, MLA_HEADS, MLA_ROPE))], axis=-1)
    q = rms_norm(q, q_gain)
    k = rms_norm(k, k_gain)
    q = jnp.concatenate([q[..., :MLA_NOPE], rope(q[..., MLA_NOPE:], cos, sin).astype(q.dtype)], axis=-1)
    k = jnp.concatenate([k[..., :MLA_NOPE], rope(k[..., MLA_NOPE:], cos, sin).astype(k.dtype)], axis=-1)
    return causal_attention(q, k, v).reshape(B, S, MLA_HEADS * MLA_V)


def memory_xattn(h, m, w_q, w_kv, q_gain, k_gain, w_o):
    B, S, _ = h.shape
    M = m.shape[1]
    q = rms_norm((h @ w_q).reshape(B, S, XA_HEADS, XA_HEAD_DIM), q_gain)
    kv = (m @ w_kv).reshape(B, M, XA_HEADS, 2 * XA_HEAD_DIM)
    k, v = jnp.split(kv, 2, axis=-1)
    k = rms_norm(k, k_gain)
    s = jnp.einsum('bqhd,bkhd->bhqk', q, k, preferred_element_type=jnp.float32) * XA_HEAD_DIM ** -0.5
    pr = jax.nn.softmax(s, axis=-1)
    o = jnp.einsum('bhqk,bkhd->bqhd', pr.astype(v.dtype), v).reshape(B, S, XA_W)
    return o @ w_o


def swiglu(h, w1, w3, w2):
    return (jax.nn.silu(h @ w1) * (h @ w3)) @ w2


def setup_inputs(seed: int = 0) -> dict:
    key = jax.random.key(seed)
    ks = iter(jax.random.split(key, 64))

    def nrm(shape, scale):
        return jax.random.normal(next(ks), shape, jnp.float32) * scale

    def gain(shape):
        return 1.0 + nrm(shape, 0.1)

    L, D = DEPTH, D_MODEL
    x = nrm((BATCH, SEQ, D), 1.0)
    mem = nrm((BATCH, N_MEM, D), 1.0)
    positions = (jnp.arange(SEQ, dtype=jnp.int32)[None, :]
                 + jax.random.randint(next(ks), (BATCH, 1), 0, 4096, dtype=jnp.int32))
    a_c = jax.random.uniform(next(ks), (L, LRU_W), jnp.float32, 0.9, 0.999)
    a_base = a_c ** (1.0 / LRU_C)
    lru_lambda = jnp.log(a_base) - jnp.log1p(-a_base)
    return {
        'x': x,
        'mem': mem,
        'positions': positions,
        'norm_mix': gain((L, D)),
        'norm_xattn': gain((L, D)),
        'norm_mem': gain((L, D)),
        'norm_ffn': gain((L, D)),
        'w_in': nrm((L, D, D_IN), D ** -0.5),
        'b_gate': nrm((L, N_BRANCH * D), 0.1),
        'rwkv_mu': jax.random.uniform(next(ks), (L, RWKV_IN), jnp.float32),
        'rwkv_w0': nrm((L, RWKV_W), 0.5) - 0.5,
        'rwkv_w_up': nrm((L, W_LORA, RWKV_W), 0.1),
        'rwkv_a0': nrm((L, RWKV_W), 0.5),
        'rwkv_a_up': nrm((L, A_LORA, RWKV_W), A_LORA ** -0.5),
        'rwkv_g_up': nrm((L, G_LORA, RWKV_W), G_LORA ** -0.5),
        'rwkv_k_k': gain((L, RWKV_W)),
        'rwkv_k_a': gain((L, RWKV_W)),
        'rwkv_r_k': nrm((L, RWKV_HEADS, RWKV_HEAD_DIM), 0.1),
        'rwkv_ln_g': gain((L, RWKV_W)),
        'rwkv_ln_b': nrm((L, RWKV_W), 0.01),
        'lru_conv_w': nrm((L, CONV_WIDTH, LRU_W), CONV_WIDTH ** -0.5),
        'lru_conv_b': nrm((L, LRU_W), 0.01),
        'lru_wa': nrm((L, LRU_BLOCKS, LRU_BLOCK_DIM, LRU_BLOCK_DIM), LRU_BLOCK_DIM ** -0.5),
        'lru_ba': nrm((L, LRU_W), 0.01),
        'lru_wx': nrm((L, LRU_BLOCKS, LRU_BLOCK_DIM, LRU_BLOCK_DIM), LRU_BLOCK_DIM ** -0.5),
        'lru_bx': nrm((L, LRU_W), 0.01),
        'lru_lambda': lru_lambda,
        'mla_q_norm': gain((L, Q_RANK)),
        'mla_w_uq': nrm((L, Q_RANK, MLA_HEADS * MLA_QK), Q_RANK ** -0.5),
        'mla_kv_norm': gain((L, KV_RANK)),
        'mla_w_ukv': nrm((L, KV_RANK, MLA_HEADS * (MLA_NOPE + MLA_V)), KV_RANK ** -0.5),
        'mla_q_gain': gain((L, MLA_QK)),
        'mla_k_gain': gain((L, MLA_QK)),
        'w_branch': nrm((L, N_BRANCH, BRANCH_W, D), BRANCH_W ** -0.5),
        'w_out': nrm((L, D, D), D ** -0.5),
        'xa_w_q': nrm((L, D, XA_W), D ** -0.5),
        'xa_w_kv': nrm((L, D, 2 * XA_W), D ** -0.5),
        'xa_q_gain': gain((L, XA_HEAD_DIM)),
        'xa_k_gain': gain((L, XA_HEAD_DIM)),
        'xa_w_o': nrm((L, XA_W, D), XA_W ** -0.5),
        'ffn_w1': nrm((L, D, D_FF), D ** -0.5),
        'ffn_w3': nrm((L, D, D_FF), D ** -0.5),
        'ffn_w2': nrm((L, D_FF, D), D_FF ** -0.5),
    }


def reference(x, mem, positions, norm_mix, norm_xattn, norm_mem, norm_ffn, w_in, b_gate,
              rwkv_mu, rwkv_w0, rwkv_w_up, rwkv_a0, rwkv_a_up, rwkv_g_up, rwkv_k_k, rwkv_k_a,
              rwkv_r_k, rwkv_ln_g, rwkv_ln_b, lru_conv_w, lru_conv_b, lru_wa, lru_ba, lru_wx,
              lru_bx, lru_lambda, mla_q_norm, mla_w_uq, mla_kv_norm, mla_w_ukv, mla_q_gain,
              mla_k_gain, w_branch, w_out, xa_w_q, xa_w_kv, xa_q_gain, xa_k_gain, xa_w_o,
              ffn_w1, ffn_w3, ffn_w2):
    B, S, _ = x.shape
    inv_freq = ROPE_THETA ** (-jnp.arange(0, MLA_ROPE, 2, dtype=jnp.float32) / MLA_ROPE)
    ang = positions.astype(jnp.float32)[..., None] * inv_freq
    cos = jnp.cos(ang)[:, :, None, :]
    sin = jnp.sin(ang)[:, :, None, :]
    for l in range(DEPTH):
        h = rms_norm(x, norm_mix[l])
        p = h @ w_in[l]
        y_a = rwkv7_mix(p[..., :RWKV_IN], rwkv_mu[l], rwkv_w0[l], rwkv_w_up[l], rwkv_a0[l],
                        rwkv_a_up[l], rwkv_g_up[l], rwkv_k_k[l], rwkv_k_a[l], rwkv_r_k[l],
                        rwkv_ln_g[l], rwkv_ln_b[l])
        y_b = rglru_mix(p[..., LRU_OFF:LRU_OFF + LRU_W], p[..., LRU_OFF + LRU_W:MLA_OFF],
                        lru_conv_w[l], lru_conv_b[l], lru_wa[l], lru_ba[l], lru_wx[l], lru_bx[l],
                        lru_lambda[l])
        y_c = mla_mix(p[..., MLA_OFF:MLA_OFF + Q_RANK],
                      p[..., MLA_OFF + Q_RANK:MLA_OFF + Q_RANK + KV_RANK],
                      p[..., MLA_OFF + Q_RANK + KV_RANK:GATE_OFF], cos, sin,
                      mla_q_norm[l], mla_w_uq[l], mla_kv_norm[l], mla_w_ukv[l],
                      mla_q_gain[l], mla_k_gain[l])
        gates = jax.nn.sigmoid(p[..., GATE_OFF:] + b_gate[l]).reshape(B, S, N_BRANCH, D_MODEL)
        branches = jnp.stack([y_a, y_b, y_c], axis=2)
        proj = jnp.einsum('bsnc,ncd->bsnd', branches, w_branch[l])
        merged = jnp.sum(gates * proj, axis=2)
        x = x + merged @ w_out[l]
        x = x + memory_xattn(rms_norm(x, norm_xattn[l]), rms_norm(mem, norm_mem[l]),
                             xa_w_q[l], xa_w_kv[l], xa_q_gain[l], xa_k_gain[l], xa_w_o[l])
        x = x + swiglu(rms_norm(x, norm_ffn[l]), ffn_w1[l], ffn_w3[l], ffn_w2[l])
    return x
```

```cpp
#include <hip/hip_runtime.h>
#include <cstdio>
#include <cstdint>

#define LAS __attribute__((address_space(3)))
typedef unsigned short bf16;
typedef short bf16x8 __attribute__((ext_vector_type(8)));
typedef float f32x4 __attribute__((ext_vector_type(4)));
typedef float f32x2 __attribute__((ext_vector_type(2)));
typedef unsigned u32x4 __attribute__((ext_vector_type(4)));
typedef unsigned u32x2 __attribute__((ext_vector_type(2)));

__device__ __forceinline__ unsigned f2bf(float f) { unsigned u = __builtin_bit_cast(unsigned, f); return (u + 0x7fffu + ((u >> 16) & 1u)) >> 16; }
__device__ __forceinline__ unsigned pk2(float lo, float hi) { return f2bf(lo) | (f2bf(hi) << 16); }
__device__ __forceinline__ float bf2f(bf16 b) { return __builtin_bit_cast(float, (unsigned)b << 16); }
__device__ __forceinline__ float bflo(unsigned u) { return __builtin_bit_cast(float, u << 16); }
__device__ __forceinline__ float bfhi(unsigned u) { return __builtin_bit_cast(float, u & 0xffff0000u); }
__device__ __forceinline__ u32x4 pk8(f32x4 a, f32x4 b) { u32x4 w; w.x = pk2(a.x, a.y); w.y = pk2(a.z, a.w); w.z = pk2(b.x, b.y); w.w = pk2(b.z, b.w); return w; }
__device__ __forceinline__ float sigmoidf_(float x) { return 1.f / (1.f + __expf(-x)); }
__device__ __forceinline__ int mk_tid(int wid_s) { int t = wid_s * 64 + (int)__builtin_amdgcn_mbcnt_hi(~0u, __builtin_amdgcn_mbcnt_lo(~0u, 0u)); asm volatile("" : "+v"(t)); return t; }
__device__ __forceinline__ float wave_sum(float v) {
#pragma unroll
    for (int o = 1; o < 64; o <<= 1) v += __shfl_xor(v, o);
    return v;
}

namespace pg8 {
#define PG8_LAS __attribute__((address_space(3)))
typedef unsigned short bf16_t;
constexpr int BM = 256, BK = 64, HALF = 128, HTB = HALF * BK * 2, STAGE_BYTES = 8 * HTB, NXCD = 8, WGM = 8;
__host__ __device__ __forceinline__ int lds_byte(int r, int c) { const int st = (r >> 4) * 2 + (c >> 5), rr = r & 15, cc = c & 31, ob = rr * 64 + cc * 2; return st * 1024 + (ob ^ (((ob >> 9) & 1) << 5)); }
__host__ __device__ __forceinline__ void stage_rc(int b, int& R, int& C) { const int st = b / 1024, sb = b % 1024, swz = sb ^ (((sb >> 9) & 1) << 5); R = (st >> 1) * 16 + swz / 64; C = (st & 1) * 32 + (swz % 64) / 2; }
__host__ __device__ __forceinline__ int perm32(int rho) { const int n = rho >> 4, i = rho & 15; return 8 * (i >> 2) + 4 * n + (i & 3); }
struct Unit { int pm, pn; };
struct Gemm { const bf16_t* A; const bf16_t* Bt; int M, N, K, lda; };
struct StaticOrder {
    int nM, nN, nwg, G, c;
    __host__ __device__ void init(int M, int N, int G_, int c_) { nM = M / BM; nN = N / BM; nwg = nM * nN; G = G_; c = c_; }
    __host__ __device__ bool next(int i, Unit& u) const {
        const long L = (long)i * G + c; if (L >= nwg) return false;
        int wgid = (int)L; { const int q = nwg / NXCD, r = nwg % NXCD, xcd = wgid % NXCD, off = wgid / NXCD; wgid = (xcd < r ? xcd * (q + 1) : r * (q + 1) + (xcd - r) * q) + off; }
        const int nig = WGM * nN, gid = wgid / nig, fm = gid * WGM, gsz = (nM - fm) < WGM ? (nM - fm) : WGM;
        u.pm = fm + ((wgid % nig) % gsz); u.pn = (wgid % nig) / gsz; return true;
    }
};
template <class Epi, class Sched>
__device__ __forceinline__ void gemm_phase(int wid_s, PG8_LAS unsigned char* lds, const Gemm g, const Sched& S, const Epi& E) {
    const int tid_ = mk_tid(wid_s);
    const int tid = tid_, wid = __builtin_amdgcn_readfirstlane(tid >> 6), lane = tid & 63, wr = wid >> 2, wc = wid & 3, fr = lane & 15, fq = lane >> 4;
    const int K = g.K, nt = K / BK, lda = g.lda;
    unsigned voffA[2], voffB[2];
#pragma unroll
    for (int i = 0; i < 2; ++i) { int R, C; stage_rc(tid * 16 + i * 8192, R, C); const int Rb = (R & ~31) + perm32(R & 31);
        voffA[i] = (unsigned)(R * lda + C) * 2u; voffB[i] = (unsigned)(Rb * K + C) * 2u; }
    const size_t kstep = (size_t)(BK * 2);
    const size_t hstepA = (size_t)HALF * lda * 2, hstepB = (size_t)HALF * K * 2;
    const size_t tstepA = 2 * hstepA, tstepB = 2 * hstepB;
    const unsigned ldsw = (unsigned)wid * 1024u;
    const int aoff = lds_byte(wr * 64 + fr, fq * 8), boff = lds_byte(wc * 32 + fr, fq * 8);
#define PG8_SA(b, h) (((b) * 2 + (h)) * HTB)
#define PG8_SB(b, h) ((4 + (b) * 2 + (h)) * HTB)
#define PG8_STAGE(bufoff, gbase, voff) do { _Pragma("unroll") for (int _i = 0; _i < 2; ++_i) \
        __builtin_amdgcn_global_load_lds((const unsigned*)((const char*)(gbase) + (voff)[_i]), (PG8_LAS unsigned*)(lds + (bufoff) + ldsw + _i * 8192), 16, 0, 0); } while (0)
#define PG8_LDA(dst, b, h) do { _Pragma("unroll") for (int m = 0; m < 4; ++m) _Pragma("unroll") for (int k = 0; k < 2; ++k) dst[m][k] = *(const PG8_LAS bf16x8*)(lds + PG8_SA(b, h) + aoff + m * 2048 + k * 1024); } while (0)
#define PG8_LDB(dst, b, h) do { _Pragma("unroll") for (int n = 0; n < 2; ++n) _Pragma("unroll") for (int k = 0; k < 2; ++k) dst[n][k] = *(const PG8_LAS bf16x8*)(lds + PG8_SB(b, h) + boff + n * 2048 + k * 1024); } while (0)
#define PG8_MMA(ai, bj, At, Bt) do { __builtin_amdgcn_s_setprio(1); _Pragma("unroll") for (int m = 0; m < 4; ++m) _Pragma("unroll") for (int n = 0; n < 2; ++n) _Pragma("unroll") for (int k = 0; k < 2; ++k) \
        acc[ai][bj][m][n] = __builtin_amdgcn_mfma_f32_16x16x32_bf16(Bt[n][k], At[m][k], acc[ai][bj][m][n], 0, 0, 0); __builtin_amdgcn_s_setprio(0); } while (0)
#define PG8_WAIT_V(n) asm volatile("s_waitcnt vmcnt(" #n ")" ::: "memory")
#define PG8_WAIT_L(n) asm volatile("s_waitcnt lgkmcnt(" #n ")" ::: "memory")
#define PG8_BAR __builtin_amdgcn_s_barrier()
#define PG8_SCHED __builtin_amdgcn_sched_barrier(0)
    Unit cur, nxt; int ui = 0;
    if (!S.next(0, cur)) return;
    f32x4 acc[2][2][4][2];
#pragma unroll
    for (int a = 0; a < 2; ++a)
#pragma unroll
        for (int b = 0; b < 2; ++b)
#pragma unroll
            for (int m = 0; m < 4; ++m)
#pragma unroll
                for (int n = 0; n < 2; ++n) acc[a][b][m][n] = (f32x4){0.f, 0.f, 0.f, 0.f};
    bf16x8 At[4][2], B0[2][2], B1[2][2];
    const char* cA = (const char*)g.A + (size_t)cur.pm * tstepA; const char* cB = (const char*)g.Bt + (size_t)cur.pn * tstepB;
    PG8_STAGE(PG8_SB(0, 0), cB, voffB); PG8_STAGE(PG8_SB(0, 1), cB + hstepB, voffB); PG8_STAGE(PG8_SA(0, 0), cA, voffA); PG8_STAGE(PG8_SA(0, 1), cA + hstepA, voffA);
    if (wr == 1) PG8_BAR;
    PG8_WAIT_V(2); PG8_BAR;
    PG8_STAGE(PG8_SB(1, 0), cB + kstep, voffB); PG8_STAGE(PG8_SA(1, 0), cA + kstep, voffA); PG8_STAGE(PG8_SB(1, 1), cB + hstepB + kstep, voffB);
    PG8_WAIT_V(6); PG8_BAR;
    for (;;) {
        const bool has_next = S.next(ui + 1, nxt);
        const char* nA = has_next ? (const char*)g.A + (size_t)nxt.pm * tstepA : cA; const char* nB = has_next ? (const char*)g.Bt + (size_t)nxt.pn * tstepB : cB;
#pragma unroll 1
        for (int t = 0; t < nt; t += 2) {
            const bool last = (t == nt - 2);
            const char* a1 = cA + (size_t)(t + 1) * kstep;
            const char* a2 = last ? nA : cA + (size_t)(t + 2) * kstep; const char* b2 = last ? nB : cB + (size_t)(t + 2) * kstep;
            const char* a3 = a2 + kstep; const char* b3 = b2 + kstep;
            PG8_LDB(B0, 0, 0); PG8_LDB(B1, 0, 1); PG8_SCHED; PG8_LDA(At, 0, 0); PG8_STAGE(PG8_SA(1, 1), a1 + hstepA, voffA);
            PG8_WAIT_V(8); PG8_WAIT_L(0); PG8_BAR; PG8_MMA(0, 0, At, B0); PG8_MMA(0, 1, At, B1); PG8_BAR; PG8_SCHED;
            PG8_LDA(At, 0, 1); PG8_STAGE(PG8_SB(0, 0), b2, voffB); PG8_STAGE(PG8_SB(0, 1), b2 + hstepB, voffB); PG8_STAGE(PG8_SA(0, 0), a2, voffA);
            PG8_WAIT_V(8); PG8_WAIT_L(0); PG8_BAR; PG8_MMA(1, 0, At, B0); PG8_MMA(1, 1, At, B1); PG8_BAR; PG8_SCHED;
            PG8_LDB(B0, 1, 0); PG8_LDB(B1, 1, 1); PG8_SCHED; PG8_LDA(At, 1, 0); PG8_STAGE(PG8_SA(0, 1), a2 + hstepA, voffA);
            PG8_WAIT_V(8); PG8_WAIT_L(0); PG8_BAR; PG8_MMA(0, 0, At, B0); PG8_MMA(0, 1, At, B1); PG8_BAR; PG8_SCHED;
            PG8_LDA(At, 1, 1); PG8_STAGE(PG8_SB(1, 0), b3, voffB); PG8_STAGE(PG8_SB(1, 1), b3 + hstepB, voffB); PG8_STAGE(PG8_SA(1, 0), a3, voffA);
            PG8_WAIT_V(8); PG8_WAIT_L(0); PG8_BAR; PG8_MMA(1, 0, At, B0); PG8_MMA(1, 1, At, B1); PG8_BAR; PG8_SCHED;
        }
        if (wr == 0) PG8_BAR;
        E(acc, cur, wr, wc, fr, fq);
        if (!has_next) break;
#pragma unroll
        for (int a = 0; a < 2; ++a)
#pragma unroll
            for (int b = 0; b < 2; ++b)
#pragma unroll
                for (int m = 0; m < 4; ++m)
#pragma unroll
                    for (int n = 0; n < 2; ++n) acc[a][b][m][n] = (f32x4){0.f, 0.f, 0.f, 0.f};
        cur = nxt; cA = nA; cB = nB; ++ui;
        if (wr == 1) PG8_BAR;
    }
    PG8_WAIT_V(0);
    PG8_BAR;
#undef PG8_SA
#undef PG8_SB
#undef PG8_STAGE
#undef PG8_LDA
#undef PG8_LDB
#undef PG8_MMA
#undef PG8_WAIT_V
#undef PG8_WAIT_L
#undef PG8_BAR
#undef PG8_SCHED
}
}

#ifndef EN
#define EN 0xFFFF
#endif
#define ON(b) ((EN >> (b)) & 1)
constexpr int T = 16384, TH = 8192, SEQ = 2048, DM = 1024, DIN = 6304, NP = 3328, DFF = 2816;
constexpr int LDS_BYTES = 147456, QIDX_OFF = 140000;
constexpr size_t MiB = 1u << 20;
constexpr size_t WS_CTL = 0;
constexpr size_t WS_WT = 1 * MiB;
constexpr size_t W_IN = WS_WT, W_GATE = W_IN + (size_t)NP * 1024 * 2, W_BR = W_GATE + (size_t)3072 * 1024 * 2, W_OUT = W_BR + (size_t)3 * 1024 * 512 * 2,
                 W_MQ = W_OUT + (size_t)1024 * 1024 * 2, W_MKV = W_MQ + (size_t)768 * 256 * 2, W_XQ = W_MKV + (size_t)1024 * 128 * 2, W_XKV = W_XQ + (size_t)512 * 1024 * 2,
                 W_XO = W_XKV + (size_t)1024 * 1024 * 2, W_13 = W_XO + (size_t)1024 * 512 * 2, W_2 = W_13 + (size_t)5632 * 1024 * 2, W_END = W_2 + (size_t)1024 * 2816 * 2;
static_assert(W_END <= 40 * MiB, "weights");
constexpr size_t WS_XB = 40 * MiB, WS_PART = 72 * MiB, WS_PQ = 73 * MiB, WS_PKV = WS_PQ + 256 * 1024, WS_Y = 74 * MiB, WS_R = 122 * MiB;
constexpr size_t R_P = WS_R, R_SI = WS_R + 52 * MiB, R_Q = WS_R + 100 * MiB, R_KM = WS_R + 112 * MiB, R_VT = WS_R + 124 * MiB;
constexpr size_t R_GS = WS_R, R_MS = WS_R + 32 * MiB, R_MG = WS_R + 96 * MiB, R_MEMB = WS_R + 128 * MiB;
constexpr size_t R_MK = WS_R, R_MVT = WS_R + 2 * MiB, R_XQ = WS_R + 32 * MiB, R_XO = WS_R + 48 * MiB, R_H = WS_R;
constexpr size_t WS_END = WS_R + 132 * MiB;
static_assert(WS_END <= 256 * MiB, "ws");

struct Params { const float* in[43]; float* out; unsigned char* ws; };
typedef const __attribute__((address_space(4))) Params* KP;
enum { I_X = 0, I_MEM, I_POS, I_NMIX, I_NXA, I_NMEM, I_NFFN, I_WIN, I_BGATE, I_MU, I_W0, I_WUP, I_A0, I_AUP, I_GUP, I_KK, I_KA, I_RK, I_LNG, I_LNB,
       I_CW, I_CB, I_WA, I_BA, I_WX, I_BX, I_LAM, I_QN, I_WUQ, I_KVN, I_WUKV, I_QG, I_KG, I_WBR, I_WOUT, I_XWQ, I_XWKV, I_XQG, I_XKG, I_XWO, I_W1, I_W3, I_W2 };

__device__ __forceinline__ float rstd16(const float* part, int row) {
    const f32x4* p = (const f32x4*)(part + (size_t)row * 16); const f32x4 a = p[0], b = p[1], c = p[2], d = p[3];
    const float s = ((a.x + a.y) + (a.z + a.w)) + ((b.x + b.y) + (b.z + b.w)) + ((c.x + c.y) + (c.z + c.w)) + ((d.x + d.y) + (d.z + d.w));
    return rsqrtf(s * (1.f / 1024.f) + 1e-6f);
}
__device__ __forceinline__ float rstd4(const float* pp, int row, float invn) { const f32x4 a = *(const f32x4*)(pp + (size_t)row * 4); return rsqrtf(((a.x + a.y) + (a.z + a.w)) * invn + 1e-6f); }
__device__ __forceinline__ float sumsq8(f32x4 a, f32x4 b) { return (a.x * a.x + a.y * a.y) + (a.z * a.z + a.w * a.w) + (b.x * b.x + b.y * b.y) + (b.z * b.z + b.w * b.w); }
#define EPI_HEAD static constexpr bool PERM = true; \
    __device__ __forceinline__ void operator()(const f32x4 (&acc)[2][2][4][2], const pg8::Unit& u, int wr, int wc, int fr, int fq) const
#define EPI_ROWS _Pragma("unroll") for (int ai = 0; ai < 2; ++ai) _Pragma("unroll") for (int m = 0; m < 4; ++m) if ((__builtin_amdgcn_sched_barrier(0), true))
#define EPI_ROW (u.pm * 256 + ai * 128 + wr * 64 + m * 16 + fr)

struct EpiP {
    bf16* P; const float* part; float* pq; float* pkv;
    EPI_HEAD {
        const int col0 = u.pn * 256 + wc * 32 + 8 * fq;
        EPI_ROWS { const int row = EPI_ROW; const float rs = rstd16(part, row); float ss = 0.f;
#pragma unroll
            for (int bj = 0; bj < 2; ++bj) { const f32x4 v0 = acc[ai][bj][m][0] * rs, v1 = acc[ai][bj][m][1] * rs;
                *(u32x4*)(P + (size_t)row * NP + col0 + bj * 128) = pk8(v0, v1);
                if (u.pn == 11 || bj == 0) ss += sumsq8(v0, v1); }
            if (u.pn == 11 || u.pn == 12) { ss += __shfl_xor(ss, 16); ss += __shfl_xor(ss, 32); if (fq == 0) (u.pn == 11 ? pq : pkv)[(size_t)row * 4 + wc] = ss; } }
    }
};
struct EpiQ {
    bf16* Q; const float* pq;
    EPI_HEAD {
        const int col0 = u.pn * 256 + wc * 32 + 8 * fq;
        EPI_ROWS { const int row = EPI_ROW; const float rs = rstd4(pq, row, 1.f / 256.f);
#pragma unroll
            for (int bj = 0; bj < 2; ++bj) *(u32x4*)(Q + (size_t)row * 768 + col0 + bj * 128) = pk8(acc[ai][bj][m][0] * rs, acc[ai][bj][m][1] * rs); }
    }
};
struct EpiKV {
    bf16* Km; bf16* Vt; const float* pkv;
    EPI_HEAD {
        const int j0 = wc * 32 + 8 * fq;
        EPI_ROWS { const int row = EPI_ROW; const float rs = rstd4(pkv, row, 1.f / 128.f);
#pragma unroll
            for (int bj = 0; bj < 2; ++bj) { const int h = 2 * u.pn + bj; const f32x4 v0 = acc[ai][bj][m][0] * rs, v1 = acc[ai][bj][m][1] * rs;
                if (wc < 2) *(u32x4*)(Km + (size_t)row * 768 + h * 96 + j0) = pk8(v0, v1);
                else { const int bl = row >> 11, t = row & 2047; bf16* vp = Vt + ((size_t)(bl * 8 + h) * 64 + (j0 - 64)) * 2048 + t;
                    vp[0 * 2048] = (bf16)f2bf(v0.x); vp[1 * 2048] = (bf16)f2bf(v0.y); vp[2 * 2048] = (bf16)f2bf(v0.z); vp[3 * 2048] = (bf16)f2bf(v0.w);
                    vp[4 * 2048] = (bf16)f2bf(v1.x); vp[5 * 2048] = (bf16)f2bf(v1.y); vp[6 * 2048] = (bf16)f2bf(v1.z); vp[7 * 2048] = (bf16)f2bf(v1.w); } } }
    }
};
struct EpiGate {
    bf16* GS; const float* part; const float* bg;
    EPI_HEAD {
        const int col0 = u.pn * 256 + wc * 32 + 8 * fq;
        f32x4 b0[2], b1[2];
#pragma unroll
        for (int bj = 0; bj < 2; ++bj) { b0[bj] = *(const f32x4*)(bg + col0 + bj * 128); b1[bj] = *(const f32x4*)(bg + col0 + bj * 128 + 4); }
        EPI_ROWS { const int row = EPI_ROW; const float rs = rstd16(part, row);
#pragma unroll
            for (int bj = 0; bj < 2; ++bj) { f32x4 v0 = acc[ai][bj][m][0] * rs + b0[bj], v1 = acc[ai][bj][m][1] * rs + b1[bj];
#pragma unroll
                for (int e = 0; e < 4; ++e) { v0[e] = sigmoidf_(v0[e]); v1[e] = sigmoidf_(v1[e]); }
                *(u32x4*)(GS + (size_t)row * 1024 + col0 + bj * 128) = pk8(v0, v1); } }
    }
};
struct EpiProj {
    const bf16* GS; float* MS; bf16* MG; int n;
    EPI_HEAD {
        const int col0 = u.pn * 256 + wc * 32 + 8 * fq;
        EPI_ROWS { const int row = EPI_ROW;
#pragma unroll
            for (int bj = 0; bj < 2; ++bj) { const size_t o = (size_t)row * 1024 + col0 + bj * 128; const u32x4 gw = *(const u32x4*)(GS + o);
                f32x4 v0 = acc[ai][bj][m][0], v1 = acc[ai][bj][m][1];
                v0.x *= bflo(gw.x); v0.y *= bfhi(gw.x); v0.z *= bflo(gw.y); v0.w *= bfhi(gw.y); v1.x *= bflo(gw.z); v1.y *= bfhi(gw.z); v1.z *= bflo(gw.w); v1.w *= bfhi(gw.w);
                if (n > 0) { v0 += *(const f32x4*)(MS + o); v1 += *(const f32x4*)(MS + o + 4); }
                if (n < 2) { *(f32x4*)(MS + o) = v0; *(f32x4*)(MS + o + 4) = v1; } else *(u32x4*)(MG + o) = pk8(v0, v1); } }
    }
};
struct EpiRes {
    const float* xold; float* xout; bf16* xb; float* part;
    EPI_HEAD {
        const int col0 = u.pn * 256 + wc * 32 + 8 * fq;
        EPI_ROWS { const int row = EPI_ROW; float ss = 0.f;
#pragma unroll
            for (int bj = 0; bj < 2; ++bj) { const size_t o = (size_t)row * 1024 + col0 + bj * 128;
                const f32x4 v0 = acc[ai][bj][m][0] + *(const f32x4*)(xold + o), v1 = acc[ai][bj][m][1] + *(const f32x4*)(xold + o + 4);
                *(f32x4*)(xout + o) = v0; *(f32x4*)(xout + o + 4) = v1; *(u32x4*)(xb + o) = pk8(v0, v1); ss += sumsq8(v0, v1); }
            ss += __shfl_xor(ss, 16); ss += __shfl_xor(ss, 32); if (fq == 0) part[(size_t)row * 16 + u.pn * 4 + wc] = ss; }
    }
};
struct EpiXQ {
    bf16* Q; const float* part;
    EPI_HEAD {
        const int col0 = u.pn * 256 + wc * 32 + 8 * fq;
        EPI_ROWS { const int row = EPI_ROW; const float rs = rstd16(part, row);
#pragma unroll
            for (int bj = 0; bj < 2; ++bj) *(u32x4*)(Q + (size_t)row * 512 + col0 + bj * 128) = pk8(acc[ai][bj][m][0] * rs, acc[ai][bj][m][1] * rs); }
    }
};
struct EpiMemKV {
    bf16* mk; bf16* mVt;
    EPI_HEAD {
        const int j0 = wc * 32 + 8 * fq, h = u.pn;
        EPI_ROWS { const int row = EPI_ROW;
            *(u32x4*)(mk + (size_t)row * 512 + h * 128 + j0) = pk8(acc[ai][0][m][0], acc[ai][0][m][1]);
            const f32x4 v0 = acc[ai][1][m][0], v1 = acc[ai][1][m][1]; const int b = row >> 8, key = row & 255;
            bf16* vp = mVt + ((size_t)(b * 4 + h) * 128 + j0) * 256 + key;
            vp[0 * 256] = (bf16)f2bf(v0.x); vp[1 * 256] = (bf16)f2bf(v0.y); vp[2 * 256] = (bf16)f2bf(v0.z); vp[3 * 256] = (bf16)f2bf(v0.w);
            vp[4 * 256] = (bf16)f2bf(v1.x); vp[5 * 256] = (bf16)f2bf(v1.y); vp[6 * 256] = (bf16)f2bf(v1.z); vp[7 * 256] = (bf16)f2bf(v1.w); }
    }
};
struct EpiFFN1 {
    bf16* H; const float* part;
    EPI_HEAD {
        const int hc0 = (u.pn * 256 + wc * 32 + 8 * fq) >> 1;
        EPI_ROWS { const int row = EPI_ROW; const float rs = rstd16(part, row);
#pragma unroll
            for (int bj = 0; bj < 2; ++bj) { const f32x4 a1 = acc[ai][bj][m][0] * rs, a3 = acc[ai][bj][m][1] * rs; f32x4 hv;
#pragma unroll
                for (int e = 0; e < 4; ++e) hv[e] = a1[e] * sigmoidf_(a1[e]) * a3[e];
                u32x2 w; w.x = pk2(hv.x, hv.y); w.y = pk2(hv.z, hv.w);
                *(u32x2*)(H + (size_t)row * DFF + hc0 + bj * 64) = w; } }
    }
};

__device__ __forceinline__ void conv_job(const float* W, int ldw, int c0, int nblk, int kblk, const float* gain, bf16* WT, int K, int mode, float* scr, int gw, int NGW, int lane) {
    const int nitems = nblk * kblk;
    for (int it = gw; it < nitems; it += NGW) {
        const int kb = it / nblk, nb = it % nblk, k0 = 64 * kb, n0 = 32 * nb;
#pragma unroll 8
        for (int i = 0; i < 32; ++i) { const int kk = 2 * i + (lane >> 5); float v = W[(size_t)(k0 + kk) * ldw + c0 + n0 + (lane & 31)]; if (gain) v *= gain[k0 + kk]; scr[kk * 33 + (lane & 31)] = v; }
        __builtin_amdgcn_wave_barrier();
        const int c = lane & 7;
#pragma unroll
        for (int j = 0; j < 4; ++j) { const int n = n0 + (lane >> 3) + 8 * j; const float* s = scr + (8 * c) * 33 + (n - n0);
            u32x4 o; o.x = pk2(s[0 * 33], s[1 * 33]); o.y = pk2(s[2 * 33], s[3 * 33]); o.z = pk2(s[4 * 33], s[5 * 33]); o.w = pk2(s[6 * 33], s[7 * 33]);
            const int dr = mode == 0 ? n : (8 * (n >> 2) + (n & 3) + (mode == 2 ? 4 : 0));
            *(u32x4*)(WT + (size_t)dr * K + k0 + 8 * c) = o; }
        __builtin_amdgcn_wave_barrier();
    }
}

__device__ __forceinline__ void phase_convert(int wid_s, KP p_, int l, float* ldsf) {
    KP p = p_; asm volatile("" : "+s"(p));
    unsigned char* ws = p->ws;
    const int tid_ = mk_tid(wid_s);
    const int tid = tid_, lane = tid & 63, wv = tid >> 6;
    const int gw = blockIdx.x * 8 + wv, NGW = gridDim.x * 8;
    float* scr = ldsf + wv * (64 * 33);
    const float* nmix = p->in[I_NMIX] + l * 1024;
    conv_job(p->in[I_WIN] + (size_t)l * 1024 * DIN, DIN, 0, 101, 16, nmix, (bf16*)(ws + W_IN), 1024, 0, scr, gw, NGW, lane);
    conv_job(p->in[I_WIN] + (size_t)l * 1024 * DIN, DIN, 3232, 96, 16, nmix, (bf16*)(ws + W_GATE), 1024, 0, scr, gw, NGW, lane);
    for (int n = 0; n < 3; ++n) conv_job(p->in[I_WBR] + ((size_t)l * 3 + n) * 512 * 1024, 1024, 0, 32, 8, nullptr, (bf16*)(ws + W_BR) + (size_t)n * 1024 * 512, 512, 0, scr, gw, NGW, lane);
    conv_job(p->in[I_WOUT] + (size_t)l * 1024 * 1024, 1024, 0, 32, 16, nullptr, (bf16*)(ws + W_OUT), 1024, 0, scr, gw, NGW, lane);
    conv_job(p->in[I_WUQ] + (size_t)l * 256 * 768, 768, 0, 24, 4, p->in[I_QN] + l * 256, (bf16*)(ws + W_MQ), 256, 0, scr, gw, NGW, lane);
    conv_job(p->in[I_WUKV] + (size_t)l * 128 * 1024, 1024, 0, 32, 2, p->in[I_KVN] + l * 128, (bf16*)(ws + W_MKV), 128, 0, scr, gw, NGW, lane);
    conv_job(p->in[I_XWQ] + (size_t)l * 1024 * 512, 512, 0, 16, 16, p->in[I_NXA] + l * 1024, (bf16*)(ws + W_XQ), 1024, 0, scr, gw, NGW, lane);
    conv_job(p->in[I_XWKV] + (size_t)l * 1024 * 1024, 1024, 0, 32, 16, p->in[I_NMEM] + l * 1024, (bf16*)(ws + W_XKV), 1024, 0, scr, gw, NGW, lane);
    conv_job(p->in[I_XWO] + (size_t)l * 512 * 1024, 1024, 0, 32, 8, nullptr, (bf16*)(ws + W_XO), 512, 0, scr, gw, NGW, lane);
    conv_job(p->in[I_W1] + (size_t)l * 1024 * DFF, DFF, 0, 88, 16, p->in[I_NFFN] + l * 1024, (bf16*)(ws + W_13), 1024, 1, scr, gw, NGW, lane);
    conv_job(p->in[I_W3] + (size_t)l * 1024 * DFF, DFF, 0, 88, 16, p->in[I_NFFN] + l * 1024, (bf16*)(ws + W_13), 1024, 2, scr, gw, NGW, lane);
    conv_job(p->in[I_W2] + (size_t)l * DFF * 1024, 1024, 0, 32, 44, nullptr, (bf16*)(ws + W_2), DFF, 0, scr, gw, NGW, lane);
    { u32x4* z = (u32x4*)((bf16*)(ws + W_IN) + (size_t)3232 * 1024); const int n16 = 96 * 1024 * 2 / 16;
      unsigned zz = 0u; asm volatile("" : "+v"(zz)); const u32x4 zv = {zz, zz, zz, zz};
      for (int i = blockIdx.x * 512 + tid; i < n16; i += gridDim.x * 512) z[i] = zv; }
    if (l == 0) {
        const float* x = p->in[I_X]; bf16* xb = (bf16*)(ws + WS_XB); float* part = (float*)(ws + WS_PART);
        for (int row = gw; row < T; row += NGW) {
            const f32x4* xr = (const f32x4*)(x + (size_t)row * 1024) + lane; float s = 0.f;
#pragma unroll
            for (int j = 0; j < 4; ++j) { const f32x4 v = xr[64 * j]; s += (v.x * v.x + v.y * v.y) + (v.z * v.z + v.w * v.w);
                u32x2 w; w.x = pk2(v.x, v.y); w.y = pk2(v.z, v.w); *((u32x2*)(xb + (size_t)row * 1024) + lane + 64 * j) = w; }
            s = wave_sum(s);
            if (lane < 16) part[(size_t)row * 16 + lane] = lane == 0 ? s : 0.f;
        }
    }
}

__device__ __forceinline__ void rope_cs(int pos, int i, float& c, float& s) {
    const float invf = exp2f(-(float)i * 0.8304820237218406f);
    const float ang = (float)pos * invf;
    const double x = (double)ang * 0.15915494309189535; const float f = (float)(x - rint(x));
    c = __builtin_amdgcn_cosf(f); s = __builtin_amdgcn_sinf(f);
}
template <int DQK, int DV, bool CAUSAL, bool MLA>
__device__ __forceinline__ void attn_unit(int wid_s, unsigned char* lds, const bf16* Qb, int ldq, const bf16* Kb, int ldk, const bf16* Vtb, int ldv, bf16* Ob, int ldo,
                                          int q0, int nkt, const float* qgain, const int* pos, float qscale) {
    constexpr int KS = DQK * 2 + 16, VS = 144, NKS = DQK / 32, NDT = DV / 16, KCH = DQK / 8, NKC = (64 * KCH + 511) / 512, NVC = DV * 8 / 512;
    unsigned char* Ks = lds; unsigned char* Vs = lds + 64 * KS;
    const int tid_ = mk_tid(wid_s);
    const int tid = tid_, lane = tid & 63, wv = tid >> 6, g = lane >> 4, j = lane & 15;
    const int qrow = q0 + wv * 16 + j;
    bf16x8 qf[NKS];
    {
        float qv[NKS][8]; float ss = 0.f;
#pragma unroll
        for (int ks = 0; ks < NKS; ++ks) { const u32x4 w = *(const u32x4*)(Qb + (size_t)qrow * ldq + 32 * ks + 8 * g);
            qv[ks][0] = bflo(w.x); qv[ks][1] = bfhi(w.x); qv[ks][2] = bflo(w.y); qv[ks][3] = bfhi(w.y); qv[ks][4] = bflo(w.z); qv[ks][5] = bfhi(w.z); qv[ks][6] = bflo(w.w); qv[ks][7] = bfhi(w.w);
#pragma unroll
            for (int e = 0; e < 8; ++e) ss += qv[ks][e] * qv[ks][e]; }
        ss += __shfl_xor(ss, 16); ss += __shfl_xor(ss, 32);
        const float rs = rsqrtf(ss * (1.f / DQK) + 1e-6f);
#pragma unroll
        for (int ks = 0; ks < NKS; ++ks)
#pragma unroll
            for (int e = 0; e < 8; ++e) qv[ks][e] *= rs * qgain[32 * ks + 8 * g + e];
        if (MLA) {
            const int ps = pos[qrow];
#pragma unroll
            for (int e = 0; e < 8; ++e) { const float mine = qv[2][e], other = __shfl_xor(mine, 32); float c, s; rope_cs(ps, 8 * (g & 1) + e, c, s);
                qv[2][e] = (g < 2) ? (mine * c - other * s) : (mine * c + other * s); }
        }
#pragma unroll
        for (int ks = 0; ks < NKS; ++ks) { u32x4 w; w.x = pk2(qv[ks][0] * qscale, qv[ks][1] * qscale); w.y = pk2(qv[ks][2] * qscale, qv[ks][3] * qscale);
            w.z = pk2(qv[ks][4] * qscale, qv[ks][5] * qscale); w.w = pk2(qv[ks][6] * qscale, qv[ks][7] * qscale); qf[ks] = __builtin_bit_cast(bf16x8, w); }
    }
    f32x4 oT[NDT];
#pragma unroll
    for (int d = 0; d < NDT; ++d) oT[d] = (f32x4){0.f, 0.f, 0.f, 0.f};
    float mrun = -INFINITY, lsum = 0.f;
    u32x4 kreg[NKC], vreg[NVC];
#define ATT_PREFETCH(kt) do { _Pragma("unroll") for (int i = 0; i < NKC; ++i) { const int idx = tid + 512 * i; if (idx < 64 * KCH) { const int key = idx / KCH, ch = idx % KCH; \
            kreg[i] = *(const u32x4*)(Kb + (size_t)(64 * (kt) + key) * ldk + ch * 8); } } \
        _Pragma("unroll") for (int i = 0; i < NVC; ++i) { const int idx = tid + 512 * i; const int dv = idx >> 3, ch = idx & 7; vreg[i] = *(const u32x4*)(Vtb + (size_t)dv * ldv + 64 * (kt) + ch * 8); } } while (0)
    ATT_PREFETCH(0);
    for (int kt = 0; kt < nkt; ++kt) {
        __syncthreads();
#pragma unroll
        for (int i = 0; i < NKC; ++i) { const int idx = tid + 512 * i; if (idx < 64 * KCH) { const int key = idx / KCH, ch = idx % KCH; *(u32x4*)(Ks + key * KS + ch * 16) = kreg[i]; } }
#pragma unroll
        for (int i = 0; i < NVC; ++i) { const int idx = tid + 512 * i; const int dv = idx >> 3, ch = idx & 7; *(u32x4*)(Vs + dv * VS + ch * 16) = vreg[i]; }
        __syncthreads();
        if (kt + 1 < nkt) ATT_PREFETCH(kt + 1);
        const int qw0 = q0 + wv * 16;
        if (CAUSAL && 64 * kt > qw0 + 15) continue;
        f32x4 sT[4];
#pragma unroll
        for (int k4 = 0; k4 < 4; ++k4) { sT[k4] = (f32x4){0.f, 0.f, 0.f, 0.f};
#pragma unroll
            for (int ks = 0; ks < NKS; ++ks) { const bf16x8 a = *(const bf16x8*)(Ks + (16 * k4 + j) * KS + (32 * ks + 8 * g) * 2);
                sT[k4] = __builtin_amdgcn_mfma_f32_16x16x32_bf16(a, qf[ks], sT[k4], 0, 0, 0); } }
        if (CAUSAL && 64 * kt + 63 > qw0) {
#pragma unroll
            for (int k4 = 0; k4 < 4; ++k4)
#pragma unroll
                for (int r = 0; r < 4; ++r) if (64 * kt + 16 * k4 + 4 * g + r > qrow) sT[k4][r] = -INFINITY;
        }
        float mx = -INFINITY;
#pragma unroll
        for (int k4 = 0; k4 < 4; ++k4) mx = fmaxf(mx, fmaxf(fmaxf(sT[k4][0], sT[k4][1]), fmaxf(sT[k4][2], sT[k4][3])));
        mx = fmaxf(mx, __shfl_xor(mx, 16)); mx = fmaxf(mx, __shfl_xor(mx, 32));
        const float mnew = fmaxf(mrun, mx); const float alpha = __builtin_amdgcn_exp2f(mrun - mnew); mrun = mnew;
        float psum = 0.f;
#pragma unroll
        for (int k4 = 0; k4 < 4; ++k4)
#pragma unroll
            for (int r = 0; r < 4; ++r) { const float pv = __builtin_amdgcn_exp2f(sT[k4][r] - mnew); sT[k4][r] = pv; psum += pv; }
        lsum = lsum * alpha + psum;
#pragma unroll
        for (int d = 0; d < NDT; ++d) oT[d] *= alpha;
#pragma unroll
        for (int kc = 0; kc < 2; ++kc) {
            const bf16x8 pb = __builtin_bit_cast(bf16x8, pk8(sT[2 * kc], sT[2 * kc + 1]));
#pragma unroll
            for (int d = 0; d < NDT; ++d) { const unsigned char* vp = Vs + (16 * d + j) * VS + (32 * kc + 4 * g) * 2;
                const u32x2 lo = *(const u32x2*)vp, hi = *(const u32x2*)(vp + 32); u32x4 w; w.x = lo.x; w.y = lo.y; w.z = hi.x; w.w = hi.y;
                oT[d] = __builtin_amdgcn_mfma_f32_16x16x32_bf16(__builtin_bit_cast(bf16x8, w), pb, oT[d], 0, 0, 0); }
        }
    }
#undef ATT_PREFETCH
    lsum += __shfl_xor(lsum, 16); lsum += __shfl_xor(lsum, 32);
    const float inv = 1.f / lsum;
#pragma unroll
    for (int d = 0; d < NDT; ++d) { u32x2 w; w.x = pk2(oT[d][0] * inv, oT[d][1] * inv); w.y = pk2(oT[d][2] * inv, oT[d][3] * inv);
        *(u32x2*)(Ob + (size_t)qrow * ldo + 16 * d + 4 * g) = w; }
}

__device__ __forceinline__ void rwkv_prep_tile(int wid_s, KP p_, int l, int tile, float* ldsf) {
    KP p = p_; asm volatile("" : "+s"(p));
    unsigned char* ws = p->ws;
    const int tid_ = mk_tid(wid_s);
    const int tid = tid_, lane = tid & 63, wv = tid >> 6;
    const bf16* P = (const bf16*)(ws + R_P); bf16* SI = (bf16*)(ws + R_SI);
    const float* mu = p->in[I_MU] + l * 1792;
    const int row0 = tile * 32;
    float* s_w = ldsf; float* s_a = ldsf + 32 * 64;
    __syncthreads();
    for (int e = tid; e < 32 * 128; e += 512) { const int t = e >> 7, jj = e & 127, row = row0 + t, col = 1536 + jj;
        const float cur = bf2f(P[(size_t)row * NP + col]); const float prev = ((row & 2047) == 0) ? 0.f : bf2f(P[(size_t)(row - 1) * NP + col]);
        const float mm = cur + (prev - cur) * mu[col];
        if (jj < 64) s_w[t * 64 + jj] = tanhf(mm); else s_a[t * 64 + (jj - 64)] = mm; }
    __syncthreads();
    float aw[32], aa[32];
#pragma unroll
    for (int t = 0; t < 32; ++t) { aw[t] = 0.f; aa[t] = 0.f; }
    const float* wup = p->in[I_WUP] + (size_t)l * 64 * 512 + tid; const float* aup = p->in[I_AUP] + (size_t)l * 64 * 512 + tid;
    for (int jj = 0; jj < 64; jj += 4) {
        const float w0 = wup[(jj + 0) * 512], w1 = wup[(jj + 1) * 512], w2 = wup[(jj + 2) * 512], w3 = wup[(jj + 3) * 512];
        const float a0 = aup[(jj + 0) * 512], a1 = aup[(jj + 1) * 512], a2 = aup[(jj + 2) * 512], a3 = aup[(jj + 3) * 512];
#pragma unroll
        for (int t = 0; t < 32; ++t) { const f32x4 sw = *(const f32x4*)(s_w + t * 64 + jj), sa = *(const f32x4*)(s_a + t * 64 + jj);
            aw[t] += (sw.x * w0 + sw.y * w1) + (sw.z * w2 + sw.w * w3); aa[t] += (sa.x * a0 + sa.y * a1) + (sa.z * a2 + sa.w * a3); }
    }
    const int c = tid, h = wv;
    const float w0c = p->in[I_W0][l * 512 + c], a0c = p->in[I_A0][l * 512 + c], kkc = p->in[I_KK][l * 512 + c], kac = p->in[I_KA][l * 512 + c];
    const float mur = mu[c], muk = mu[512 + c], muv = mu[1024 + c];
#pragma unroll
    for (int t = 0; t < 32; ++t) {
        const int row = row0 + t; const bool first = (row & 2047) == 0;
        const bf16* pr = P + (size_t)row * NP; const bf16* pp = pr - NP;
        const float rc = bf2f(pr[c]), kc = bf2f(pr[512 + c]), vc = bf2f(pr[1024 + c]);
        const float rp = first ? 0.f : bf2f(pp[c]), kp = first ? 0.f : bf2f(pp[512 + c]), vp = first ? 0.f : bf2f(pp[1024 + c]);
        const float r = rc + (rp - rc) * mur, k = kc + (kp - kc) * muk, v = vc + (vp - vc) * muv;
        const float z = w0c + aw[t]; const float om = 1.f - __expf(-0.6065306597126334f * sigmoidf_(z));
        const float a = sigmoidf_(a0c + aa[t]);
        const float kkr = k * kkc; const float ss = wave_sum(kkr * kkr); const float kk = kkr / fmaxf(sqrtf(ss), 1e-12f);
        const float k2 = k * (1.f + (a - 1.f) * kac);
        bf16* o = SI + ((size_t)((row >> 11) * 8 + h) * 2048 + (row & 2047)) * 384 + lane;
        o[0] = (bf16)f2bf(r); o[64] = (bf16)f2bf(om); o[128] = (bf16)f2bf(k2); o[192] = (bf16)f2bf(kk); o[256] = (bf16)f2bf(kk * a); o[320] = (bf16)f2bf(v);
    }
}

template <int CTRL> __device__ __forceinline__ float dppf(float x) { return __builtin_bit_cast(float, __builtin_amdgcn_update_dpp(0, __builtin_bit_cast(int, x), CTRL, 0xF, 0xF, true)); }
__device__ __forceinline__ float allreduce16(float x) { x += dppf<0xB1>(x); x += dppf<0x4E>(x); x += dppf<0x141>(x); x += dppf<0x140>(x); return x; }
__device__ __forceinline__ void rwkv_scan_unit(int wid_s, const bf16* SIbh, bf16* Yb, int quarter, float* ldsf) {
    const int tid_ = mk_tid(wid_s);
    const int tid = tid_, lane = tid & 63, wv = tid >> 6;
    u32x4 pre[3];
#pragma unroll
    for (int i = 0; i < 3; ++i) pre[i] = *(const u32x4*)(SIbh + (size_t)(tid + 512 * i) * 8);
    float S0 = 0.f, S1 = 0.f, S2 = 0.f, S3 = 0.f;
    const int rowl = quarter * 16 + (wv & 3) * 4 + (lane >> 4), c4 = (lane & 15) * 4;
    __syncthreads();
    for (int ch = 0; ch < 64; ++ch) {
        float* B = ldsf + (ch & 1) * (32 * 384);
#pragma unroll
        for (int i = 0; i < 3; ++i) { float* d = B + (tid + 512 * i) * 8; const u32x4 w = pre[i];
            *(f32x4*)d = (f32x4){bflo(w.x), bfhi(w.x), bflo(w.y), bfhi(w.y)}; *(f32x4*)(d + 4) = (f32x4){bflo(w.z), bfhi(w.z), bflo(w.w), bfhi(w.w)}; }
        if (ch + 1 < 64) {
#pragma unroll
            for (int i = 0; i < 3; ++i) pre[i] = *(const u32x4*)(SIbh + (size_t)(ch + 1) * (32 * 384) + (size_t)(tid + 512 * i) * 8);
        }
        __syncthreads();
        if (wv < 4) {
#pragma unroll 4
            for (int s = 0; s < 32; ++s) {
                const float* q = B + s * 384;
                const f32x4 r4 = *(const f32x4*)(q + c4), om4 = *(const f32x4*)(q + 64 + c4), k4 = *(const f32x4*)(q + 128 + c4), kk4 = *(const f32x4*)(q + 192 + c4), ka4 = *(const f32x4*)(q + 256 + c4);
                const float v = q[320 + rowl];
                float sa = (S0 * kk4.x + S1 * kk4.y) + (S2 * kk4.z + S3 * kk4.w);
                sa = allreduce16(sa);
                S0 = fmaf(-S0, om4.x, S0); S1 = fmaf(-S1, om4.y, S1); S2 = fmaf(-S2, om4.z, S2); S3 = fmaf(-S3, om4.w, S3);
                S0 = fmaf(-sa, ka4.x, S0); S1 = fmaf(-sa, ka4.y, S1); S2 = fmaf(-sa, ka4.z, S2); S3 = fmaf(-sa, ka4.w, S3);
                S0 = fmaf(v, k4.x, S0); S1 = fmaf(v, k4.y, S1); S2 = fmaf(v, k4.z, S2); S3 = fmaf(v, k4.w, S3);
                float y = (S0 * r4.x + S1 * r4.y) + (S2 * r4.z + S3 * r4.w);
                y = allreduce16(y);
                if ((lane & 15) == 0) Yb[(size_t)(ch * 32 + s) * 1536 + rowl] = (bf16)f2bf(y);
            }
        }
    }
    __syncthreads();
}

__device__ __forceinline__ void rwkv_post_tile(int wid_s, KP p_, int l, int r, int tile, float* ldsf) {
    KP p = p_; asm volatile("" : "+s"(p));
    unsigned char* ws = p->ws;
    const int tid_ = mk_tid(wid_s);
    const int tid = tid_, lane = tid & 63, wv = tid >> 6;
    const bf16* P = (const bf16*)(ws + R_P); const bf16* SI = (const bf16*)(ws + R_SI); bf16* Y = (bf16*)(ws + WS_Y) + (size_t)r * TH * 1536;
    const float* mu = p->in[I_MU] + l * 1792;
    const int row0 = tile * 32;
    float* s_g = ldsf;
    __syncthreads();
    for (int e = tid; e < 32 * 128; e += 512) { const int t = e >> 7, jj = e & 127, row = row0 + t, col = 1664 + jj;
        const float cur = bf2f(P[(size_t)row * NP + col]); const float prev = ((row & 2047) == 0) ? 0.f : bf2f(P[(size_t)(row - 1) * NP + col]);
        s_g[e] = sigmoidf_(cur + (prev - cur) * mu[col]); }
    __syncthreads();
    float ag[32];
#pragma unroll
    for (int t = 0; t < 32; ++t) ag[t] = 0.f;
    const float* gup = p->in[I_GUP] + (size_t)l * 128 * 512 + tid;
    for (int jj = 0; jj < 128; jj += 4) {
        const float g0 = gup[(jj + 0) * 512], g1 = gup[(jj + 1) * 512], g2 = gup[(jj + 2) * 512], g3 = gup[(jj + 3) * 512];
#pragma unroll
        for (int t = 0; t < 32; ++t) { const f32x4 sg = *(const f32x4*)(s_g + t * 128 + jj); ag[t] += (sg.x * g0 + sg.y * g1) + (sg.z * g2 + sg.w * g3); }
    }
    const int c = tid, h = wv;
    const float rkc = p->in[I_RK][l * 512 + c], lng = p->in[I_LNG][l * 512 + c], lnb = p->in[I_LNB][l * 512 + c];
#pragma unroll
    for (int t = 0; t < 32; ++t) {
        const int row = row0 + t;
        const bf16* si = SI + ((size_t)((row >> 11) * 8 + h) * 2048 + (row & 2047)) * 384 + lane;
        const float rr = bf2f(si[0]), k2 = bf2f(si[128]), v = bf2f(si[320]);
        bf16* yp = Y + (size_t)row * 1536 + c;
        const float y = bf2f(*yp);
        const float mean = wave_sum(y) * (1.f / 64.f); const float d = y - mean; const float var = wave_sum(d * d) * (1.f / 64.f);
        const float yn = d * rsqrtf(var + 64e-5f) * lng + lnb;
        const float bonus = wave_sum(rr * k2 * rkc) * v;
        *yp = (bf16)f2bf((yn + bonus) * ag[t]);
    }
}

__device__ __forceinline__ float gelu_tanh(float x) { const float u = 0.7978845608028654f * (x + 0.044715f * x * x * x); return 0.5f * x * (1.f + tanhf(u)); }
__device__ __forceinline__ void lru_unit(int wid_s, KP p_, int l, int r, int bl, int n, float* ldsf) {
    KP p = p_; asm volatile("" : "+s"(p));
    unsigned char* ws = p->ws;
    const int tid_ = mk_tid(wid_s);
    const int tid = tid_, lane = tid & 63, wv = tid >> 6;
    const bf16* P = (const bf16*)(ws + R_P) + (size_t)bl * 2048 * NP; bf16* Yb = (bf16*)(ws + WS_Y) + ((size_t)(r * 4 + bl) * 2048) * 1536 + 512;
    const int cg_ = n * 64 + lane;
    float* s_wa = ldsf;
    float* s_wx = ldsf + 4096;
    float* s_xc = ldsf + 8192;
    float* s_AH = ldsf + 8192 + 8192;
    __syncthreads();
    for (int e = tid; e < 4096; e += 512) { s_wa[e] = p->in[I_WA][((size_t)l * 8 + n) * 4096 + e]; s_wx[e] = p->in[I_WX][((size_t)l * 8 + n) * 4096 + e]; }
    const float cw0 = p->in[I_CW][(l * 4 + 0) * 512 + cg_], cw1 = p->in[I_CW][(l * 4 + 1) * 512 + cg_], cw2 = p->in[I_CW][(l * 4 + 2) * 512 + cg_], cw3 = p->in[I_CW][(l * 4 + 3) * 512 + cg_];
    const float cb = p->in[I_CB][l * 512 + cg_], ba = p->in[I_BA][l * 512 + cg_], bx = p->in[I_BX][l * 512 + cg_];
    const float lam = p->in[I_LAM][l * 512 + cg_]; const float sp8 = -8.f * log1pf(__expf(-lam));
    float hcar = 0.f;
    for (int tile = 0; tile < 16; ++tile) {
        const int t0 = tile * 128 + wv * 16;
        float xc[16];
        {
            float x3 = (t0 >= 3) ? bf2f(P[(size_t)(t0 - 3) * NP + 1792 + cg_]) : 0.f, x2 = (t0 >= 2) ? bf2f(P[(size_t)(t0 - 2) * NP + 1792 + cg_]) : 0.f, x1 = (t0 >= 1) ? bf2f(P[(size_t)(t0 - 1) * NP + 1792 + cg_]) : 0.f;
#pragma unroll
            for (int i = 0; i < 16; ++i) { const float x0 = bf2f(P[(size_t)(t0 + i) * NP + 1792 + cg_]);
                xc[i] = cw0 * x3 + cw1 * x2 + cw2 * x1 + cw3 * x0 + cb; x3 = x2; x2 = x1; x1 = x0; }
        }
        __syncthreads();
#pragma unroll
        for (int i = 0; i < 16; ++i) s_xc[(wv * 16 + i) * 64 + lane] = xc[i];
        __syncthreads();
        f32x2 acc[16];
#pragma unroll
        for (int i = 0; i < 16; ++i) acc[i] = (f32x2){0.f, 0.f};
        for (int ii = 0; ii < 64; ii += 4) {
            const f32x2 w0 = {s_wa[(ii + 0) * 64 + lane], s_wx[(ii + 0) * 64 + lane]}, w1 = {s_wa[(ii + 1) * 64 + lane], s_wx[(ii + 1) * 64 + lane]},
                        w2 = {s_wa[(ii + 2) * 64 + lane], s_wx[(ii + 2) * 64 + lane]}, w3 = {s_wa[(ii + 3) * 64 + lane], s_wx[(ii + 3) * 64 + lane]};
#pragma unroll
            for (int i = 0; i < 16; ++i) { const f32x4 xv = *(const f32x4*)(s_xc + (wv * 16 + i) * 64 + ii);
                acc[i] += w0 * xv.x; acc[i] += w1 * xv.y; acc[i] += w2 * xv.z; acc[i] += w3 * xv.w; }
        }
        float av[16], uv[16]; float A = 1.f, H = 0.f;
#pragma unroll
        for (int i = 0; i < 16; ++i) { const float rg = sigmoidf_(acc[i].x + ba), ig = sigmoidf_(acc[i].y + bx);
            const float la = sp8 * rg; av[i] = __expf(la); uv[i] = sqrtf(-expm1f(2.f * la)) * (ig * xc[i]);
            A *= av[i]; H = av[i] * H + uv[i]; }
        s_AH[(wv * 64 + lane) * 2] = A; s_AH[(wv * 64 + lane) * 2 + 1] = H;
        __syncthreads();
        float hin = hcar, hall = hcar;
#pragma unroll
        for (int w = 0; w < 8; ++w) { const float Aw = s_AH[(w * 64 + lane) * 2], Hw = s_AH[(w * 64 + lane) * 2 + 1]; hall = Aw * hall + Hw; if (w < wv) hin = hall; }
        hcar = hall;
        float hh = hin;
#pragma unroll
        for (int i = 0; i < 16; ++i) { hh = av[i] * hh + uv[i];
            const float gb = bf2f(P[(size_t)(t0 + i) * NP + 2304 + cg_]);
            Yb[(size_t)(t0 + i) * 1536 + cg_] = (bf16)f2bf(hh * gelu_tanh(gb)); }
    }
    __syncthreads();
}

__device__ __forceinline__ void kfix_rows(int wid_s, KP p_, int l, int r) {
    KP p = p_; asm volatile("" : "+s"(p));
    unsigned char* ws = p->ws;
    const int tid_ = mk_tid(wid_s);
    const int tid = tid_, lane = tid & 63, wv = tid >> 6, h = lane >> 3, sub = lane & 7;
    const bf16* P = (const bf16*)(ws + R_P); bf16* Km = (bf16*)(ws + R_KM);
    const float* kg = p->in[I_KG] + l * 96; const int* pos = (const int*)p->in[I_POS] + r * TH;
    for (int row = blockIdx.x * 8 + wv; row < TH; row += gridDim.x * 8) {
        bf16* kp = Km + (size_t)row * 768 + h * 96;
        const u32x4 w = *(const u32x4*)(kp + 8 * sub);
        float nv[8] = {bflo(w.x), bfhi(w.x), bflo(w.y), bfhi(w.y), bflo(w.z), bfhi(w.z), bflo(w.w), bfhi(w.w)};
        const unsigned k1 = *(const unsigned*)(P + (size_t)row * NP + 3200 + 2 * sub), k2 = *(const unsigned*)(P + (size_t)row * NP + 3216 + 2 * sub);
        float x1a = bflo(k1), x1b = bfhi(k1), x2a = bflo(k2), x2b = bfhi(k2);
        float ss = x1a * x1a + x1b * x1b + x2a * x2a + x2b * x2b;
#pragma unroll
        for (int e = 0; e < 8; ++e) ss += nv[e] * nv[e];
        ss += __shfl_xor(ss, 1); ss += __shfl_xor(ss, 2); ss += __shfl_xor(ss, 4);
        const float rs = rsqrtf(ss * (1.f / 96.f) + 1e-6f);
#pragma unroll
        for (int e = 0; e < 8; ++e) nv[e] *= rs * kg[8 * sub + e];
        x1a *= rs * kg[64 + 2 * sub]; x1b *= rs * kg[65 + 2 * sub]; x2a *= rs * kg[80 + 2 * sub]; x2b *= rs * kg[81 + 2 * sub];
        const int ps = pos[row]; float ca, sa, cb, sb; rope_cs(ps, 2 * sub, ca, sa); rope_cs(ps, 2 * sub + 1, cb, sb);
        u32x4 o; o.x = pk2(nv[0], nv[1]); o.y = pk2(nv[2], nv[3]); o.z = pk2(nv[4], nv[5]); o.w = pk2(nv[6], nv[7]);
        *(u32x4*)(kp + 8 * sub) = o;
        *(unsigned*)(kp + 64 + 2 * sub) = pk2(x1a * ca - x2a * sa, x1b * cb - x2b * sb);
        *(unsigned*)(kp + 80 + 2 * sub) = pk2(x2a * ca + x1a * sa, x2b * cb + x1b * sb);
    }
}
__device__ __forceinline__ void mkfix_rows(int wid_s, KP p_, int l) {
    KP p = p_; asm volatile("" : "+s"(p));
    unsigned char* ws = p->ws;
    const int tid_ = mk_tid(wid_s);
    const int tid = tid_, lane = tid & 63, wv = tid >> 6, h = lane >> 4, sub = lane & 15;
    bf16* mk = (bf16*)(ws + R_MK); const float* kg = p->in[I_XKG] + l * 128;
    for (int row = blockIdx.x * 8 + wv; row < 2048; row += gridDim.x * 8) {
        bf16* kp = mk + (size_t)row * 512 + h * 128 + 8 * sub;
        const u32x4 w = *(const u32x4*)kp;
        float nv[8] = {bflo(w.x), bfhi(w.x), bflo(w.y), bfhi(w.y), bflo(w.z), bfhi(w.z), bflo(w.w), bfhi(w.w)};
        float ss = 0.f;
#pragma unroll
        for (int e = 0; e < 8; ++e) ss += nv[e] * nv[e];
        ss += __shfl_xor(ss, 1); ss += __shfl_xor(ss, 2); ss += __shfl_xor(ss, 4); ss += __shfl_xor(ss, 8);
        const float rs = rsqrtf(ss * (1.f / 128.f) + 1e-6f);
#pragma unroll
        for (int e = 0; e < 8; ++e) nv[e] *= rs * kg[8 * sub + e];
        u32x4 o; o.x = pk2(nv[0], nv[1]); o.y = pk2(nv[2], nv[3]); o.z = pk2(nv[4], nv[5]); o.w = pk2(nv[6], nv[7]);
        *(u32x4*)kp = o;
    }
}
__device__ __forceinline__ void memb_rows(int wid_s, KP p_) {
    KP p = p_; asm volatile("" : "+s"(p));
    unsigned char* ws = p->ws;
    const int tid_ = mk_tid(wid_s);
    const int tid = tid_, lane = tid & 63, wv = tid >> 6;
    const float* mem = p->in[I_MEM]; bf16* memb = (bf16*)(ws + R_MEMB);
    for (int row = blockIdx.x * 8 + wv; row < 2048; row += gridDim.x * 8) {
        const f32x4* xr = (const f32x4*)(mem + (size_t)row * 1024) + lane; f32x4 v[4]; float s = 0.f;
#pragma unroll
        for (int jq = 0; jq < 4; ++jq) { v[jq] = xr[64 * jq]; s += (v[jq].x * v[jq].x + v[jq].y * v[jq].y) + (v[jq].z * v[jq].z + v[jq].w * v[jq].w); }
        const float rs = rsqrtf(wave_sum(s) * (1.f / 1024.f) + 1e-6f);
#pragma unroll
        for (int jq = 0; jq < 4; ++jq) { u32x2 w; w.x = pk2(v[jq].x * rs, v[jq].y * rs); w.y = pk2(v[jq].z * rs, v[jq].w * rs); *((u32x2*)(memb + (size_t)row * 1024) + lane + 64 * jq) = w; }
    }
}

__device__ __forceinline__ void grid_barrier(int wid_s, unsigned* bar, unsigned& gen) {
    __threadfence();
    __syncthreads();
    gen += 1;
    if (mk_tid(wid_s) == 0) {
        const unsigned target = gen * gridDim.x;
        __hip_atomic_fetch_add(bar, 1u, __ATOMIC_RELEASE, __HIP_MEMORY_SCOPE_AGENT);
        unsigned spins = 0;
        while (__hip_atomic_load(bar, __ATOMIC_ACQUIRE, __HIP_MEMORY_SCOPE_AGENT) < target) { __builtin_amdgcn_s_sleep(2); if (++spins > (1u << 27)) break; }
    }
    __syncthreads();
    __threadfence();
}
template <class Epi>
__device__ __forceinline__ void run_gemm(int wid_s, LAS unsigned char* lds, const bf16* A, int lda, const bf16* Bt, int M, int N, int K, const Epi& E) {
    int bx_ = blockIdx.x, gx_ = gridDim.x; asm volatile("" : "+s"(bx_), "+s"(gx_), "+s"(K), "+s"(lda));
    pg8::Gemm g{A, Bt, M, N, K, lda}; pg8::StaticOrder S; S.init(M, N, gx_, bx_);
    if (ON(1)) pg8::gemm_phase<Epi, pg8::StaticOrder>(wid_s, lds, g, S, E);
}

__device__ __forceinline__ unsigned char* wsl_(KP p) { unsigned char* w = p->ws; asm volatile("" : "+s"(w)); return w; }
__global__ void __launch_bounds__(512, 2) fwd_kernel(Params parg) {
    KP p = (KP)__builtin_amdgcn_kernarg_segment_ptr();
    extern __shared__ __attribute__((aligned(16))) unsigned char lds_raw[];
    const int wid_s = __builtin_amdgcn_readfirstlane((int)threadIdx.x >> 6);
    unsigned bar_gen = 0;
    LAS unsigned char* lds3 = (LAS unsigned char*)lds_raw;
    unsigned char* lds = lds_raw; float* ldsf = (float*)lds_raw;
    unsigned char* ws = p->ws;
    const int bid = blockIdx.x;
    unsigned* ctl = (unsigned*)(wsl_(p) + WS_CTL);
    bf16* xb = (bf16*)(wsl_(p) + WS_XB); float* part = (float*)(wsl_(p) + WS_PART); float* pq = (float*)(wsl_(p) + WS_PQ); float* pkv = (float*)(wsl_(p) + WS_PKV);
    bf16* Y = (bf16*)(wsl_(p) + WS_Y);
    float* xcur = p->out;

    for (int l_ = 0; l_ < 2; ++l_) {
        int l = l_; asm volatile("" : "+s"(l));
        if (ON(0)) phase_convert(wid_s, p, l, ldsf);
        grid_barrier(wid_s, ctl + 32, bar_gen);
        for (int r_ = 0; r_ < 2; ++r_) {
            int r = r_; asm volatile("" : "+s"(r));
            { EpiP E{(bf16*)(wsl_(p) + R_P), part + (size_t)r * TH * 16, pq, pkv};
              run_gemm(wid_s, lds3, xb + (size_t)r * TH * 1024, 1024, (const bf16*)(wsl_(p) + W_IN), TH, NP, 1024, E); }
            grid_barrier(wid_s, ctl + 32, bar_gen);
            if (ON(2)) for (int tile = bid; tile < TH / 32; tile += gridDim.x) rwkv_prep_tile(wid_s, p, l, tile, ldsf);
            __syncthreads();
            { EpiQ E{(bf16*)(wsl_(p) + R_Q), pq}; run_gemm(wid_s, lds3, (const bf16*)(wsl_(p) + R_P) + 2816, NP, (const bf16*)(wsl_(p) + W_MQ), TH, 768, 256, E); }
            { EpiKV E{(bf16*)(wsl_(p) + R_KM), (bf16*)(wsl_(p) + R_VT), pkv}; run_gemm(wid_s, lds3, (const bf16*)(wsl_(p) + R_P) + 3072, NP, (const bf16*)(wsl_(p) + W_MKV), TH, 1024, 128, E); }
            grid_barrier(wid_s, ctl + 32, bar_gen);
            if (ON(7)) kfix_rows(wid_s, p, l, r);
            grid_barrier(wid_s, ctl + 32, bar_gen);
            if (ON(3) && bid < 128) { const int xcd = bid & 7, idx = bid >> 3, hh = xcd * 4 + (idx >> 2), quarter = idx & 3;
                rwkv_scan_unit(wid_s, (const bf16*)(wsl_(p) + R_SI) + (size_t)hh * 2048 * 384, Y + ((size_t)(r * 4 + (hh >> 3)) * 2048) * 1536 + (hh & 7) * 64, quarter, ldsf); }
            else if (ON(4) && bid < 160) { const int uu = bid - 128; lru_unit(wid_s, p, l, r, uu >> 3, uu & 7, ldsf); }
            {
                unsigned* ctr = ctl + l * 2 + r; volatile int* qidx = (volatile int*)(lds + QIDX_OFF);
                for (;;) {
                    __syncthreads();
                    if (mk_tid(wid_s) == 0) *qidx = (int)atomicAdd(ctr, 1u);
                    __syncthreads();
                    const int u = *qidx;
                    if (u >= 512 || !ON(5)) break;
                    const int qb = 15 - (u >> 5), bh = u & 31, bl = bh >> 3, h = bh & 7;
                    attn_unit<96, 64, true, true>(wid_s, lds, (const bf16*)(wsl_(p) + R_Q) + (size_t)bl * 2048 * 768 + h * 96, 768, (const bf16*)(wsl_(p) + R_KM) + (size_t)bl * 2048 * 768 + h * 96, 768,
                        (const bf16*)(wsl_(p) + R_VT) + (size_t)(bl * 8 + h) * 64 * 2048, 2048, Y + ((size_t)(r * 4 + bl) * 2048) * 1536 + 1024 + h * 64, 1536,
                        qb * 128, 2 * qb + 2, p->in[I_QG] + l * 96, (const int*)p->in[I_POS] + (r * 4 + bl) * 2048, 0.14724444527f  );
                }
            }
            grid_barrier(wid_s, ctl + 32, bar_gen);
            if (ON(6)) for (int tile = bid; tile < TH / 32; tile += gridDim.x) rwkv_post_tile(wid_s, p, l, r, tile, ldsf);
            grid_barrier(wid_s, ctl + 32, bar_gen);
        }
        if (ON(7)) memb_rows(wid_s, p);
        for (int n = 0; n < 3; ++n) {
            { EpiGate E{(bf16*)(wsl_(p) + R_GS), part, p->in[I_BGATE] + l * 3072 + n * 1024}; run_gemm(wid_s, lds3, xb, 1024, (const bf16*)(wsl_(p) + W_GATE) + (size_t)n * 1024 * 1024, T, 1024, 1024, E); }
            { EpiProj E{(const bf16*)(wsl_(p) + R_GS), (float*)(wsl_(p) + R_MS), (bf16*)(wsl_(p) + R_MG), n}; run_gemm(wid_s, lds3, Y + n * 512, 1536, (const bf16*)(wsl_(p) + W_BR) + (size_t)n * 1024 * 512, T, 1024, 512, E); }
        }
        grid_barrier(wid_s, ctl + 32, bar_gen);
        { EpiRes E{l == 0 ? p->in[I_X] : xcur, xcur, xb, part}; run_gemm(wid_s, lds3, (const bf16*)(wsl_(p) + R_MG), 1024, (const bf16*)(wsl_(p) + W_OUT), T, 1024, 1024, E); }
        { EpiMemKV E{(bf16*)(wsl_(p) + R_MK), (bf16*)(wsl_(p) + R_MVT)}; run_gemm(wid_s, lds3, (const bf16*)(wsl_(p) + R_MEMB), 1024, (const bf16*)(wsl_(p) + W_XKV), 2048, 1024, 1024, E); }
        grid_barrier(wid_s, ctl + 32, bar_gen);
        if (ON(7)) mkfix_rows(wid_s, p, l);
        { EpiXQ E{(bf16*)(wsl_(p) + R_XQ), part}; run_gemm(wid_s, lds3, xb, 1024, (const bf16*)(wsl_(p) + W_XQ), T, 512, 1024, E); }
        grid_barrier(wid_s, ctl + 32, bar_gen);
        if (ON(8)) for (int u = bid; u < 512; u += gridDim.x) { const int qb = u & 15, bh = u >> 4, b = bh >> 2, h = bh & 3;
            attn_unit<128, 128, false, false>(wid_s, lds, (const bf16*)(wsl_(p) + R_XQ) + (size_t)b * 2048 * 512 + h * 128, 512, (const bf16*)(wsl_(p) + R_MK) + (size_t)b * 256 * 512 + h * 128, 512,
                (const bf16*)(wsl_(p) + R_MVT) + (size_t)(b * 4 + h) * 128 * 256, 256, (bf16*)(wsl_(p) + R_XO) + (size_t)b * 2048 * 512 + h * 128, 512,
                qb * 128, 4, p->in[I_XQG] + l * 128, nullptr, 0.12751743082f  ); }
        grid_barrier(wid_s, ctl + 32, bar_gen);
        { EpiRes E{xcur, xcur, xb, part}; run_gemm(wid_s, lds3, (const bf16*)(wsl_(p) + R_XO), 512, (const bf16*)(wsl_(p) + W_XO), T, 1024, 512, E); }
        grid_barrier(wid_s, ctl + 32, bar_gen);
        { EpiFFN1 E{(bf16*)(wsl_(p) + R_H), part}; run_gemm(wid_s, lds3, xb, 1024, (const bf16*)(wsl_(p) + W_13), T, 5632, 1024, E); }
        grid_barrier(wid_s, ctl + 32, bar_gen);
        { EpiRes E{xcur, xcur, xb, part}; run_gemm(wid_s, lds3, (const bf16*)(wsl_(p) + R_H), DFF, (const bf16*)(wsl_(p) + W_2), T, 1024, DFF, E); }
        grid_barrier(wid_s, ctl + 32, bar_gen);
    }
}

extern "C" void kernel_launch(void* const* d_in, const int* in_sizes, int n_in, void* d_out, int out_size, void* d_ws, size_t ws_size, hipStream_t stream) {
    static int grid = 0;
    if (grid == 0) {
        int dev = 0, cus = 0, per_cu = 0;
        if (n_in != 43 || ws_size < WS_END) { fprintf(stderr, "kernel_launch: unexpected n_in %d / ws %zu\n", n_in, ws_size); grid = -1; return; }
        (void)hipGetDevice(&dev);
        (void)hipDeviceGetAttribute(&cus, hipDeviceAttributeMultiprocessorCount, dev);
        (void)hipFuncSetAttribute((const void*)fwd_kernel, hipFuncAttributeMaxDynamicSharedMemorySize, LDS_BYTES);
        (void)hipOccupancyMaxActiveBlocksPerMultiprocessor(&per_cu, (const void*)fwd_kernel, 512, LDS_BYTES);
        fprintf(stderr, "cus %d per_cu %d ws %zu\n", cus, per_cu, ws_size);
        grid = cus * (per_cu >= 1 ? 1 : 0);
        if (grid <= 0) { grid = -1; return; }
    }
    if (grid < 0) return;
    Params p{};
    for (int i = 0; i < 43; ++i) p.in[i] = (const float*)d_in[i];
    p.out = (float*)d_out; p.ws = (unsigned char*)d_ws;
    (void)hipMemsetAsync((char*)d_ws + WS_CTL, 0, 4096, stream);
    void* args[] = {&p};
    hipError_t e = hipLaunchCooperativeKernel((const void*)fwd_kernel, dim3(grid), dim3(512), args, LDS_BYTES, stream);
    if (e != hipSuccess) fprintf(stderr, "cooperative launch failed: %s (grid %d)\n", hipGetErrorString(e), grid);
}
```

```cpp
#include <hip/hip_runtime.h>
#include <cstdio>
#include <cstdint>

#define LAS __attribute__((address_space(3)))
typedef unsigned short bf16;
typedef short bf16x8 __attribute__((ext_vector_type(8)));
typedef float f32x4 __attribute__((ext_vector_type(4)));
typedef float f32x2 __attribute__((ext_vector_type(2)));
typedef unsigned u32x4 __attribute__((ext_vector_type(4)));
typedef unsigned u32x2 __attribute__((ext_vector_type(2)));

__device__ __forceinline__ unsigned f2bf(float f) { unsigned u = __builtin_bit_cast(unsigned, f); return (u + 0x7fffu + ((u >> 16) & 1u)) >> 16; }
__device__ __forceinline__ unsigned pk2(float lo, float hi) { return f2bf(lo) | (f2bf(hi) << 16); }
__device__ __forceinline__ float bf2f(bf16 b) { return __builtin_bit_cast(float, (unsigned)b << 16); }
__device__ __forceinline__ float bflo(unsigned u) { return __builtin_bit_cast(float, u << 16); }
__device__ __forceinline__ float bfhi(unsigned u) { return __builtin_bit_cast(float, u & 0xffff0000u); }
__device__ __forceinline__ u32x4 pk8(f32x4 a, f32x4 b) { u32x4 w; w.x = pk2(a.x, a.y); w.y = pk2(a.z, a.w); w.z = pk2(b.x, b.y); w.w = pk2(b.z, b.w); return w; }
__device__ __forceinline__ float sigmoidf_(float x) { return 1.f / (1.f + __expf(-x)); }
__device__ __forceinline__ int mk_tid(int wid_s) { int t = wid_s * 64 + (int)__builtin_amdgcn_mbcnt_hi(~0u, __builtin_amdgcn_mbcnt_lo(~0u, 0u)); asm volatile("" : "+v"(t)); return t; }
__device__ __forceinline__ float wave_sum(float v) {
#pragma unroll
    for (int o = 1; o < 64; o <<= 1) v += __shfl_xor(v, o);
    return v;
}

namespace pg8 {
#define PG8_LAS __attribute__((address_space(3)))
typedef unsigned short bf16_t;
constexpr int BM = 256, BK = 64, HALF = 128, HTB = HALF * BK * 2, STAGE_BYTES = 8 * HTB, NXCD = 8, WGM = 8;
__host__ __device__ __forceinline__ int lds_byte(int r, int c) { const int st = (r >> 4) * 2 + (c >> 5), rr = r & 15, cc = c & 31, ob = rr * 64 + cc * 2; return st * 1024 + (ob ^ (((ob >> 9) & 1) << 5)); }
__host__ __device__ __forceinline__ void stage_rc(int b, int& R, int& C) { const int st = b / 1024, sb = b % 1024, swz = sb ^ (((sb >> 9) & 1) << 5); R = (st >> 1) * 16 + swz / 64; C = (st & 1) * 32 + (swz % 64) / 2; }
__host__ __device__ __forceinline__ int perm32(int rho) { const int n = rho >> 4, i = rho & 15; return 8 * (i >> 2) + 4 * n + (i & 3); }
struct Unit { int pm, pn; };
struct Gemm { const bf16_t* A; const bf16_t* Bt; int M, N, K, lda; };
struct StaticOrder {
    int nM, nN, nwg, G, c;
    __host__ __device__ void init(int M, int N, int G_, int c_) { nM = M / BM; nN = N / BM; nwg = nM * nN; G = G_; c = c_; }
    __host__ __device__ bool next(int i, Unit& u) const {
        const long L = (long)i * G + c; if (L >= nwg) return false;
        int wgid = (int)L; { const int q = nwg / NXCD, r = nwg % NXCD, xcd = wgid % NXCD, off = wgid / NXCD; wgid = (xcd < r ? xcd * (q + 1) : r * (q + 1) + (xcd - r) * q) + off; }
        const int nig = WGM * nN, gid = wgid / nig, fm = gid * WGM, gsz = (nM - fm) < WGM ? (nM - fm) : WGM;
        u.pm = fm + ((wgid % nig) % gsz); u.pn = (wgid % nig) / gsz; return true;
    }
};
template <class Epi, class Sched>
__device__ __forceinline__ void gemm_phase(int wid_s, PG8_LAS unsigned char* lds, const Gemm g, const Sched& S, const Epi& E) {
    const int tid_ = mk_tid(wid_s);
    const int tid = tid_, wid = __builtin_amdgcn_readfirstlane(tid >> 6), lane = tid & 63, wr = wid >> 2, wc = wid & 3, fr = lane & 15, fq = lane >> 4;
    const int K = g.K, nt = K / BK, lda = g.lda;
    unsigned voffA[2], voffB[2];
#pragma unroll
    for (int i = 0; i < 2; ++i) { int R, C; stage_rc(tid * 16 + i * 8192, R, C); const int Rb = (R & ~31) + perm32(R & 31);
        voffA[i] = (unsigned)(R * lda + C) * 2u; voffB[i] = (unsigned)(Rb * K + C) * 2u; }
    const size_t kstep = (size_t)(BK * 2);
    const size_t hstepA = (size_t)HALF * lda * 2, hstepB = (size_t)HALF * K * 2;
    const size_t tstepA = 2 * hstepA, tstepB = 2 * hstepB;
    const unsigned ldsw = (unsigned)wid * 1024u;
    const int aoff = lds_byte(wr * 64 + fr, fq * 8), boff = lds_byte(wc * 32 + fr, fq * 8);
#define PG8_SA(b, h) (((b) * 2 + (h)) * HTB)
#define PG8_SB(b, h) ((4 + (b) * 2 + (h)) * HTB)
#define PG8_STAGE(bufoff, gbase, voff) do { _Pragma("unroll") for (int _i = 0; _i < 2; ++_i) \
        __builtin_amdgcn_global_load_lds((const unsigned*)((const char*)(gbase) + (voff)[_i]), (PG8_LAS unsigned*)(lds + (bufoff) + ldsw + _i * 8192), 16, 0, 0); } while (0)
#define PG8_LDA(dst, b, h) do { _Pragma("unroll") for (int m = 0; m < 4; ++m) _Pragma("unroll") for (int k = 0; k < 2; ++k) dst[m][k] = *(const PG8_LAS bf16x8*)(lds + PG8_SA(b, h) + aoff + m * 2048 + k * 1024); } while (0)
#define PG8_LDB(dst, b, h) do { _Pragma("unroll") for (int n = 0; n < 2; ++n) _Pragma("unroll") for (int k = 0; k < 2; ++k) dst[n][k] = *(const PG8_LAS bf16x8*)(lds + PG8_SB(b, h) + boff + n * 2048 + k * 1024); } while (0)
#define PG8_MMA(ai, bj, At, Bt) do { __builtin_amdgcn_s_setprio(1); _Pragma("unroll") for (int m = 0; m < 4; ++m) _Pragma("unroll") for (int n = 0; n < 2; ++n) _Pragma("unroll") for (int k = 0; k < 2; ++k) \
        acc[ai][bj][m][n] = __builtin_amdgcn_mfma_f32_16x16x32_bf16(Bt[n][k], At[m][k], acc[ai][bj][m][n], 0, 0, 0); __builtin_amdgcn_s_setprio(0); } while (0)
#define PG8_WAIT_V(n) asm volatile("s_waitcnt vmcnt(" #n ")" ::: "memory")
#define PG8_WAIT_L(n) asm volatile("s_waitcnt lgkmcnt(" #n ")" ::: "memory")
#define PG8_BAR __builtin_amdgcn_s_barrier()
#define PG8_SCHED __builtin_amdgcn_sched_barrier(0)
    Unit cur, nxt; int ui = 0;
    if (!S.next(0, cur)) return;
    f32x4 acc[2][2][4][2];
#pragma unroll
    for (int a = 0; a < 2; ++a)
#pragma unroll
        for (int b = 0; b < 2; ++b)
#pragma unroll
            for (int m = 0; m < 4; ++m)
#pragma unroll
                for (int n = 0; n < 2; ++n) acc[a][b][m][n] = (f32x4){0.f, 0.f, 0.f, 0.f};
    bf16x8 At[4][2], B0[2][2], B1[2][2];
    const char* cA = (const char*)g.A + (size_t)cur.pm * tstepA; const char* cB = (const char*)g.Bt + (size_t)cur.pn * tstepB;
    PG8_STAGE(PG8_SB(0, 0), cB, voffB); PG8_STAGE(PG8_SB(0, 1), cB + hstepB, voffB); PG8_STAGE(PG8_SA(0, 0), cA, voffA); PG8_STAGE(PG8_SA(0, 1), cA + hstepA, voffA);
    if (wr == 1) PG8_BAR;
    PG8_WAIT_V(2); PG8_BAR;
    PG8_STAGE(PG8_SB(1, 0), cB + kstep, voffB); PG8_STAGE(PG8_SA(1, 0), cA + kstep, voffA); PG8_STAGE(PG8_SB(1, 1), cB + hstepB + kstep, voffB);
    PG8_WAIT_V(6); PG8_BAR;
    for (;;) {
        const bool has_next = S.next(ui + 1, nxt);
        const char* nA = has_next ? (const char*)g.A + (size_t)nxt.pm * tstepA : cA; const char* nB = has_next ? (const char*)g.Bt + (size_t)nxt.pn * tstepB : cB;
#pragma unroll 1
        for (int t = 0; t < nt; t += 2) {
            const bool last = (t == nt - 2);
            const char* a1 = cA + (size_t)(t + 1) * kstep;
            const char* a2 = last ? nA : cA + (size_t)(t + 2) * kstep; const char* b2 = last ? nB : cB + (size_t)(t + 2) * kstep;
            const char* a3 = a2 + kstep; const char* b3 = b2 + kstep;
            PG8_LDB(B0, 0, 0); PG8_LDB(B1, 0, 1); PG8_SCHED; PG8_LDA(At, 0, 0); PG8_STAGE(PG8_SA(1, 1), a1 + hstepA, voffA);
            PG8_WAIT_V(8); PG8_WAIT_L(0); PG8_BAR; PG8_MMA(0, 0, At, B0); PG8_MMA(0, 1, At, B1); PG8_BAR; PG8_SCHED;
            PG8_LDA(At, 0, 1); PG8_STAGE(PG8_SB(0, 0), b2, voffB); PG8_STAGE(PG8_SB(0, 1), b2 + hstepB, voffB); PG8_STAGE(PG8_SA(0, 0), a2, voffA);
            PG8_WAIT_V(8); PG8_WAIT_L(0); PG8_BAR; PG8_MMA(1, 0, At, B0); PG8_MMA(1, 1, At, B1); PG8_BAR; PG8_SCHED;
            PG8_LDB(B0, 1, 0); PG8_LDB(B1, 1, 1); PG8_SCHED; PG8_LDA(At, 1, 0); PG8_STAGE(PG8_SA(0, 1), a2 + hstepA, voffA);
            PG8_WAIT_V(8); PG8_WAIT_L(0); PG8_BAR; PG8_MMA(0, 0, At, B0); PG8_MMA(0, 1, At, B1); PG8_BAR; PG8_SCHED;
            PG8_LDA(At, 1, 1); PG8_STAGE(PG8_SB(1, 0), b3, voffB); PG8_STAGE(PG8_SB(1, 1), b3 + hstepB, voffB); PG8_STAGE(PG8_SA(1, 0), a3, voffA);
            PG8_WAIT_V(8); PG8_WAIT_L(0); PG8_BAR; PG8_MMA(1, 0, At, B0); PG8_MMA(1, 1, At, B1); PG8_BAR; PG8_SCHED;
        }
        if (wr == 0) PG8_BAR;
        E(acc, cur, wr, wc, fr, fq);
        if (!has_next) break;
#pragma unroll
        for (int a = 0; a < 2; ++a)
#pragma unroll
            for (int b = 0; b < 2; ++b)
#pragma unroll
                for (int m = 0; m < 4; ++m)
#pragma unroll
                    for (int n = 0; n < 2; ++n) acc[a][b][m][n] = (f32x4){0.f, 0.f, 0.f, 0.f};
        cur = nxt; cA = nA; cB = nB; ++ui;
        if (wr == 1) PG8_BAR;
    }
    PG8_WAIT_V(0);
    PG8_BAR;
#undef PG8_SA
#undef PG8_SB
#undef PG8_STAGE
#undef PG8_LDA
#undef PG8_LDB
#undef PG8_MMA
#undef PG8_WAIT_V
#undef PG8_WAIT_L
#undef PG8_BAR
#undef PG8_SCHED
}
}

#ifndef EN
#define EN 0xFFFF
#endif
#define ON(b) ((EN >> (b)) & 1)
#ifndef REP
#define REP 0
#endif
#define RB(b) ((REP >> (b)) & 1)
#define REPLOOP(b) int nrep##b = 1 + RB(b); asm volatile("" : "+s"(nrep##b)); for (int q = 0; q < nrep##b; ++q)
constexpr int T = 16384, TH = 8192, SEQ = 2048, DM = 1024, DIN = 6304, NP = 3328, DFF = 2816;
constexpr int LDS_BYTES = 147456, QIDX_OFF = 140000;
constexpr size_t MiB = 1u << 20;
constexpr size_t WS_CTL = 0;
constexpr size_t WS_WT = 1 * MiB;
constexpr size_t W_IN = WS_WT, W_GATE = W_IN + (size_t)NP * 1024 * 2, W_BR = W_GATE + (size_t)3072 * 1024 * 2, W_OUT = W_BR + (size_t)3 * 1024 * 512 * 2,
                 W_MQ = W_OUT + (size_t)1024 * 1024 * 2, W_MKV = W_MQ + (size_t)768 * 256 * 2, W_XQ = W_MKV + (size_t)1024 * 128 * 2, W_XKV = W_XQ + (size_t)512 * 1024 * 2,
                 W_XO = W_XKV + (size_t)1024 * 1024 * 2, W_13 = W_XO + (size_t)1024 * 512 * 2, W_2 = W_13 + (size_t)5632 * 1024 * 2, W_END = W_2 + (size_t)1024 * 2816 * 2;
static_assert(W_END <= 40 * MiB, "weights");
constexpr size_t WS_XB = 40 * MiB, WS_PART = 72 * MiB, WS_PQ = 73 * MiB, WS_PKV = WS_PQ + 256 * 1024, WS_Y = 74 * MiB, WS_R = 122 * MiB;
constexpr size_t R_P = WS_R, R_SI = WS_R + 52 * MiB, R_Q = WS_R + 100 * MiB, R_KM = WS_R + 112 * MiB, R_VT = WS_R + 124 * MiB;
constexpr size_t R_GS = WS_R, R_MS = WS_R + 32 * MiB, R_MG = WS_R + 96 * MiB, R_MEMB = WS_R + 128 * MiB;
constexpr size_t R_MK = WS_R, R_MVT = WS_R + 2 * MiB, R_XQ = WS_R + 32 * MiB, R_XO = WS_R + 48 * MiB, R_H = WS_R;
constexpr size_t WS_END = WS_R + 132 * MiB;
static_assert(WS_END <= 256 * MiB, "ws");

struct Params { const float* in[43]; float* out; unsigned char* ws; };
typedef const __attribute__((address_space(4))) Params* KP;
enum { I_X = 0, I_MEM, I_POS, I_NMIX, I_NXA, I_NMEM, I_NFFN, I_WIN, I_BGATE, I_MU, I_W0, I_WUP, I_A0, I_AUP, I_GUP, I_KK, I_KA, I_RK, I_LNG, I_LNB,
       I_CW, I_CB, I_WA, I_BA, I_WX, I_BX, I_LAM, I_QN, I_WUQ, I_KVN, I_WUKV, I_QG, I_KG, I_WBR, I_WOUT, I_XWQ, I_XWKV, I_XQG, I_XKG, I_XWO, I_W1, I_W3, I_W2 };

__device__ __forceinline__ float rstd16(const float* part, int row) {
    const f32x4* p = (const f32x4*)(part + (size_t)row * 16); const f32x4 a = p[0], b = p[1], c = p[2], d = p[3];
    const float s = ((a.x + a.y) + (a.z + a.w)) + ((b.x + b.y) + (b.z + b.w)) + ((c.x + c.y) + (c.z + c.w)) + ((d.x + d.y) + (d.z + d.w));
    return rsqrtf(s * (1.f / 1024.f) + 1e-6f);
}
__device__ __forceinline__ float rstd4(const float* pp, int row, float invn) { const f32x4 a = *(const f32x4*)(pp + (size_t)row * 4); return rsqrtf(((a.x + a.y) + (a.z + a.w)) * invn + 1e-6f); }
__device__ __forceinline__ float sumsq8(f32x4 a, f32x4 b) { return (a.x * a.x + a.y * a.y) + (a.z * a.z + a.w * a.w) + (b.x * b.x + b.y * b.y) + (b.z * b.z + b.w * b.w); }
#define EPI_HEAD static constexpr bool PERM = true; \
    __device__ __forceinline__ void operator()(const f32x4 (&acc)[2][2][4][2], const pg8::Unit& u, int wr, int wc, int fr, int fq) const
#define EPI_ROWS _Pragma("unroll") for (int ai = 0; ai < 2; ++ai) _Pragma("unroll") for (int m = 0; m < 4; ++m) if ((__builtin_amdgcn_sched_barrier(0), true))
#define EPI_ROW (u.pm * 256 + ai * 128 + wr * 64 + m * 16 + fr)

struct EpiP {
    bf16* P; const float* part; float* pq; float* pkv;
    EPI_HEAD {
        const int col0 = u.pn * 256 + wc * 32 + 8 * fq;
        EPI_ROWS { const int row = EPI_ROW; const float rs = rstd16(part, row); float ss = 0.f;
#pragma unroll
            for (int bj = 0; bj < 2; ++bj) { const f32x4 v0 = acc[ai][bj][m][0] * rs, v1 = acc[ai][bj][m][1] * rs;
                *(u32x4*)(P + (size_t)row * NP + col0 + bj * 128) = pk8(v0, v1);
                if (u.pn == 11 || bj == 0) ss += sumsq8(v0, v1); }
            if (u.pn == 11 || u.pn == 12) { ss += __shfl_xor(ss, 16); ss += __shfl_xor(ss, 32); if (fq == 0) (u.pn == 11 ? pq : pkv)[(size_t)row * 4 + wc] = ss; } }
    }
};
struct EpiQ {
    bf16* Q; const float* pq;
    EPI_HEAD {
        const int col0 = u.pn * 256 + wc * 32 + 8 * fq;
        EPI_ROWS { const int row = EPI_ROW; const float rs = rstd4(pq, row, 1.f / 256.f);
#pragma unroll
            for (int bj = 0; bj < 2; ++bj) *(u32x4*)(Q + (size_t)row * 768 + col0 + bj * 128) = pk8(acc[ai][bj][m][0] * rs, acc[ai][bj][m][1] * rs); }
    }
};
struct EpiKV {
    bf16* Km; bf16* Vt; const float* pkv;
    EPI_HEAD {
        const int j0 = wc * 32 + 8 * fq;
        EPI_ROWS { const int row = EPI_ROW; const float rs = rstd4(pkv, row, 1.f / 128.f);
#pragma unroll
            for (int bj = 0; bj < 2; ++bj) { const int h = 2 * u.pn + bj; const f32x4 v0 = acc[ai][bj][m][0] * rs, v1 = acc[ai][bj][m][1] * rs;
                if (wc < 2) *(u32x4*)(Km + (size_t)row * 768 + h * 96 + j0) = pk8(v0, v1);
                else { const int bl = row >> 11, t = row & 2047; bf16* vp = Vt + ((size_t)(bl * 8 + h) * 64 + (j0 - 64)) * 2048 + t;
                    vp[0 * 2048] = (bf16)f2bf(v0.x); vp[1 * 2048] = (bf16)f2bf(v0.y); vp[2 * 2048] = (bf16)f2bf(v0.z); vp[3 * 2048] = (bf16)f2bf(v0.w);
                    vp[4 * 2048] = (bf16)f2bf(v1.x); vp[5 * 2048] = (bf16)f2bf(v1.y); vp[6 * 2048] = (bf16)f2bf(v1.z); vp[7 * 2048] = (bf16)f2bf(v1.w); } } }
    }
};
struct EpiGate {
    bf16* GS; const float* part; const float* bg;
    EPI_HEAD {
        const int col0 = u.pn * 256 + wc * 32 + 8 * fq;
        f32x4 b0[2], b1[2];
#pragma unroll
        for (int bj = 0; bj < 2; ++bj) { b0[bj] = *(const f32x4*)(bg + col0 + bj * 128); b1[bj] = *(const f32x4*)(bg + col0 + bj * 128 + 4); }
        EPI_ROWS { const int row = EPI_ROW; const float rs = rstd16(part, row);
#pragma unroll
            for (int bj = 0; bj < 2; ++bj) { f32x4 v0 = acc[ai][bj][m][0] * rs + b0[bj], v1 = acc[ai][bj][m][1] * rs + b1[bj];
#pragma unroll
                for (int e = 0; e < 4; ++e) { v0[e] = sigmoidf_(v0[e]); v1[e] = sigmoidf_(v1[e]); }
                *(u32x4*)(GS + (size_t)row * 1024 + col0 + bj * 128) = pk8(v0, v1); } }
    }
};
struct EpiProj {
    const bf16* GS; float* MS; bf16* MG; int n;
    EPI_HEAD {
        const int col0 = u.pn * 256 + wc * 32 + 8 * fq;
        EPI_ROWS { const int row = EPI_ROW;
#pragma unroll
            for (int bj = 0; bj < 2; ++bj) { const size_t o = (size_t)row * 1024 + col0 + bj * 128; const u32x4 gw = *(const u32x4*)(GS + o);
                f32x4 v0 = acc[ai][bj][m][0], v1 = acc[ai][bj][m][1];
                v0.x *= bflo(gw.x); v0.y *= bfhi(gw.x); v0.z *= bflo(gw.y); v0.w *= bfhi(gw.y); v1.x *= bflo(gw.z); v1.y *= bfhi(gw.z); v1.z *= bflo(gw.w); v1.w *= bfhi(gw.w);
                if (n > 0) { v0 += *(const f32x4*)(MS + o); v1 += *(const f32x4*)(MS + o + 4); }
                if (n < 2) { *(f32x4*)(MS + o) = v0; *(f32x4*)(MS + o + 4) = v1; } else *(u32x4*)(MG + o) = pk8(v0, v1); } }
    }
};
struct EpiRes {
    const float* xold; float* xout; bf16* xb; float* part;
    EPI_HEAD {
        const int col0 = u.pn * 256 + wc * 32 + 8 * fq;
        EPI_ROWS { const int row = EPI_ROW; float ss = 0.f;
#pragma unroll
            for (int bj = 0; bj < 2; ++bj) { const size_t o = (size_t)row * 1024 + col0 + bj * 128;
                const f32x4 v0 = acc[ai][bj][m][0] + *(const f32x4*)(xold + o), v1 = acc[ai][bj][m][1] + *(const f32x4*)(xold + o + 4);
                *(f32x4*)(xout + o) = v0; *(f32x4*)(xout + o + 4) = v1; *(u32x4*)(xb + o) = pk8(v0, v1); ss += sumsq8(v0, v1); }
            ss += __shfl_xor(ss, 16); ss += __shfl_xor(ss, 32); if (fq == 0) part[(size_t)row * 16 + u.pn * 4 + wc] = ss; }
    }
};
struct EpiXQ {
    bf16* Q; const float* part;
    EPI_HEAD {
        const int col0 = u.pn * 256 + wc * 32 + 8 * fq;
        EPI_ROWS { const int row = EPI_ROW; const float rs = rstd16(part, row);
#pragma unroll
            for (int bj = 0; bj < 2; ++bj) *(u32x4*)(Q + (size_t)row * 512 + col0 + bj * 128) = pk8(acc[ai][bj][m][0] * rs, acc[ai][bj][m][1] * rs); }
    }
};
struct EpiMemKV {
    bf16* mk; bf16* mVt;
    EPI_HEAD {
        const int j0 = wc * 32 + 8 * fq, h = u.pn;
        EPI_ROWS { const int row = EPI_ROW;
            *(u32x4*)(mk + (size_t)row * 512 + h * 128 + j0) = pk8(acc[ai][0][m][0], acc[ai][0][m][1]);
            const f32x4 v0 = acc[ai][1][m][0], v1 = acc[ai][1][m][1]; const int b = row >> 8, key = row & 255;
            bf16* vp = mVt + ((size_t)(b * 4 + h) * 128 + j0) * 256 + key;
            vp[0 * 256] = (bf16)f2bf(v0.x); vp[1 * 256] = (bf16)f2bf(v0.y); vp[2 * 256] = (bf16)f2bf(v0.z); vp[3 * 256] = (bf16)f2bf(v0.w);
            vp[4 * 256] = (bf16)f2bf(v1.x); vp[5 * 256] = (bf16)f2bf(v1.y); vp[6 * 256] = (bf16)f2bf(v1.z); vp[7 * 256] = (bf16)f2bf(v1.w); }
    }
};
struct EpiFFN1 {
    bf16* H; const float* part;
    EPI_HEAD {
        const int hc0 = (u.pn * 256 + wc * 32 + 8 * fq) >> 1;
        EPI_ROWS { const int row = EPI_ROW; const float rs = rstd16(part, row);
#pragma unroll
            for (int bj = 0; bj < 2; ++bj) { const f32x4 a1 = acc[ai][bj][m][0] * rs, a3 = acc[ai][bj][m][1] * rs; f32x4 hv;
#pragma unroll
                for (int e = 0; e < 4; ++e) hv[e] = a1[e] * sigmoidf_(a1[e]) * a3[e];
                u32x2 w; w.x = pk2(hv.x, hv.y); w.y = pk2(hv.z, hv.w);
                *(u32x2*)(H + (size_t)row * DFF + hc0 + bj * 64) = w; } }
    }
};

__device__ __forceinline__ void conv_job(const float* W, int ldw, int c0, int nblk, int kblk, const float* gain, bf16* WT, int K, int mode, float* scr, int gw, int NGW, int lane) {
    const int nitems = nblk * kblk;
    for (int it = gw; it < nitems; it += NGW) {
        const int kb = it / nblk, nb = it % nblk, k0 = 64 * kb, n0 = 32 * nb;
#pragma unroll 8
        for (int i = 0; i < 32; ++i) { const int kk = 2 * i + (lane >> 5); float v = W[(size_t)(k0 + kk) * ldw + c0 + n0 + (lane & 31)]; if (gain) v *= gain[k0 + kk]; scr[kk * 33 + (lane & 31)] = v; }
        __builtin_amdgcn_wave_barrier();
        const int c = lane & 7;
#pragma unroll
        for (int j = 0; j < 4; ++j) { const int n = n0 + (lane >> 3) + 8 * j; const float* s = scr + (8 * c) * 33 + (n - n0);
            u32x4 o; o.x = pk2(s[0 * 33], s[1 * 33]); o.y = pk2(s[2 * 33], s[3 * 33]); o.z = pk2(s[4 * 33], s[5 * 33]); o.w = pk2(s[6 * 33], s[7 * 33]);
            const int dr = mode == 0 ? n : (8 * (n >> 2) + (n & 3) + (mode == 2 ? 4 : 0));
            *(u32x4*)(WT + (size_t)dr * K + k0 + 8 * c) = o; }
        __builtin_amdgcn_wave_barrier();
    }
}

__device__ __forceinline__ void phase_convert(int wid_s, KP p_, int l, float* ldsf) {
    KP p = p_; asm volatile("" : "+s"(p));
    unsigned char* ws = p->ws;
    const int tid_ = mk_tid(wid_s);
    const int tid = tid_, lane = tid & 63, wv = tid >> 6;
    const int gw = blockIdx.x * 8 + wv, NGW = gridDim.x * 8;
    float* scr = ldsf + wv * (64 * 33);
    const float* nmix = p->in[I_NMIX] + l * 1024;
    conv_job(p->in[I_WIN] + (size_t)l * 1024 * DIN, DIN, 0, 101, 16, nmix, (bf16*)(ws + W_IN), 1024, 0, scr, gw, NGW, lane);
    conv_job(p->in[I_WIN] + (size_t)l * 1024 * DIN, DIN, 3232, 96, 16, nmix, (bf16*)(ws + W_GATE), 1024, 0, scr, gw, NGW, lane);
    for (int n = 0; n < 3; ++n) conv_job(p->in[I_WBR] + ((size_t)l * 3 + n) * 512 * 1024, 1024, 0, 32, 8, nullptr, (bf16*)(ws + W_BR) + (size_t)n * 1024 * 512, 512, 0, scr, gw, NGW, lane);
    conv_job(p->in[I_WOUT] + (size_t)l * 1024 * 1024, 1024, 0, 32, 16, nullptr, (bf16*)(ws + W_OUT), 1024, 0, scr, gw, NGW, lane);
    conv_job(p->in[I_WUQ] + (size_t)l * 256 * 768, 768, 0, 24, 4, p->in[I_QN] + l * 256, (bf16*)(ws + W_MQ), 256, 0, scr, gw, NGW, lane);
    conv_job(p->in[I_WUKV] + (size_t)l * 128 * 1024, 1024, 0, 32, 2, p->in[I_KVN] + l * 128, (bf16*)(ws + W_MKV), 128, 0, scr, gw, NGW, lane);
    conv_job(p->in[I_XWQ] + (size_t)l * 1024 * 512, 512, 0, 16, 16, p->in[I_NXA] + l * 1024, (bf16*)(ws + W_XQ), 1024, 0, scr, gw, NGW, lane);
    conv_job(p->in[I_XWKV] + (size_t)l * 1024 * 1024, 1024, 0, 32, 16, p->in[I_NMEM] + l * 1024, (bf16*)(ws + W_XKV), 1024, 0, scr, gw, NGW, lane);
    conv_job(p->in[I_XWO] + (size_t)l * 512 * 1024, 1024, 0, 32, 8, nullptr, (bf16*)(ws + W_XO), 512, 0, scr, gw, NGW, lane);
    conv_job(p->in[I_W1] + (size_t)l * 1024 * DFF, DFF, 0, 88, 16, p->in[I_NFFN] + l * 1024, (bf16*)(ws + W_13), 1024, 1, scr, gw, NGW, lane);
    conv_job(p->in[I_W3] + (size_t)l * 1024 * DFF, DFF, 0, 88, 16, p->in[I_NFFN] + l * 1024, (bf16*)(ws + W_13), 1024, 2, scr, gw, NGW, lane);
    conv_job(p->in[I_W2] + (size_t)l * DFF * 1024, 1024, 0, 32, 44, nullptr, (bf16*)(ws + W_2), DFF, 0, scr, gw, NGW, lane);
    { u32x4* z = (u32x4*)((bf16*)(ws + W_IN) + (size_t)3232 * 1024); const int n16 = 96 * 1024 * 2 / 16;
      unsigned zz = 0u; asm volatile("" : "+v"(zz)); const u32x4 zv = {zz, zz, zz, zz};
      for (int i = blockIdx.x * 512 + tid; i < n16; i += gridDim.x * 512) z[i] = zv; }
    if (l == 0) {
        const float* x = p->in[I_X]; bf16* xb = (bf16*)(ws + WS_XB); float* part = (float*)(ws + WS_PART);
        for (int row = gw; row < T; row += NGW) {
            const f32x4* xr = (const f32x4*)(x + (size_t)row * 1024) + lane; float s = 0.f;
#pragma unroll
            for (int j = 0; j < 4; ++j) { const f32x4 v = xr[64 * j]; s += (v.x * v.x + v.y * v.y) + (v.z * v.z + v.w * v.w);
                u32x2 w; w.x = pk2(v.x, v.y); w.y = pk2(v.z, v.w); *((u32x2*)(xb + (size_t)row * 1024) + lane + 64 * j) = w; }
            s = wave_sum(s);
            if (lane < 16) part[(size_t)row * 16 + lane] = lane == 0 ? s : 0.f;
        }
    }
}

__device__ __forceinline__ void rope_cs(int pos, int i, float& c, float& s) {
    const float invf = exp2f(-(float)i * 0.8304820237218406f);
    const float ang = (float)pos * invf;
    const double x = (double)ang * 0.15915494309189535; const float f = (float)(x - rint(x));
    c = __builtin_amdgcn_cosf(f); s = __builtin_amdgcn_sinf(f);
}
template <int DQK, int DV, bool CAUSAL, bool MLA>
__device__ __forceinline__ void attn_unit(int wid_s, unsigned char* lds, const bf16* Qb, int ldq, const bf16* Kb, int ldk, const bf16* Vtb, int ldv, bf16* Ob, int ldo,
                                          int q0, int nkt, const float* qgain, const int* pos, float qscale) {
    constexpr int KS = DQK * 2 + 16, VS = 144, NKS = DQK / 32, NDT = DV / 16, KCH = DQK / 8, NKC = (64 * KCH + 511) / 512, NVC = DV * 8 / 512;
    unsigned char* Ks = lds; unsigned char* Vs = lds + 64 * KS;
    const int tid_ = mk_tid(wid_s);
    const int tid = tid_, lane = tid & 63, wv = tid >> 6, g = lane >> 4, j = lane & 15;
    const int qrow = q0 + wv * 16 + j;
    bf16x8 qf[NKS];
    {
        float qv[NKS][8]; float ss = 0.f;
#pragma unroll
        for (int ks = 0; ks < NKS; ++ks) { const u32x4 w = *(const u32x4*)(Qb + (size_t)qrow * ldq + 32 * ks + 8 * g);
            qv[ks][0] = bflo(w.x); qv[ks][1] = bfhi(w.x); qv[ks][2] = bflo(w.y); qv[ks][3] = bfhi(w.y); qv[ks][4] = bflo(w.z); qv[ks][5] = bfhi(w.z); qv[ks][6] = bflo(w.w); qv[ks][7] = bfhi(w.w);
#pragma unroll
            for (int e = 0; e < 8; ++e) ss += qv[ks][e] * qv[ks][e]; }
        ss += __shfl_xor(ss, 16); ss += __shfl_xor(ss, 32);
        const float rs = rsqrtf(ss * (1.f / DQK) + 1e-6f);
#pragma unroll
        for (int ks = 0; ks < NKS; ++ks)
#pragma unroll
            for (int e = 0; e < 8; ++e) qv[ks][e] *= rs * qgain[32 * ks + 8 * g + e];
        if (MLA) {
            const int ps = pos[qrow];
#pragma unroll
            for (int e = 0; e < 8; ++e) { const float mine = qv[2][e], other = __shfl_xor(mine, 32); float c, s; rope_cs(ps, 8 * (g & 1) + e, c, s);
                qv[2][e] = (g < 2) ? (mine * c - other * s) : (mine * c + other * s); }
        }
#pragma unroll
        for (int ks = 0; ks < NKS; ++ks) { u32x4 w; w.x = pk2(qv[ks][0] * qscale, qv[ks][1] * qscale); w.y = pk2(qv[ks][2] * qscale, qv[ks][3] * qscale);
            w.z = pk2(qv[ks][4] * qscale, qv[ks][5] * qscale); w.w = pk2(qv[ks][6] * qscale, qv[ks][7] * qscale); qf[ks] = __builtin_bit_cast(bf16x8, w); }
    }
    f32x4 oT[NDT];
#pragma unroll
    for (int d = 0; d < NDT; ++d) oT[d] = (f32x4){0.f, 0.f, 0.f, 0.f};
    float mrun = -INFINITY, lsum = 0.f;
    u32x4 kreg[NKC], vreg[NVC];
#define ATT_PREFETCH(kt) do { _Pragma("unroll") for (int i = 0; i < NKC; ++i) { const int idx = tid + 512 * i; if (idx < 64 * KCH) { const int key = idx / KCH, ch = idx % KCH; \
            kreg[i] = *(const u32x4*)(Kb + (size_t)(64 * (kt) + key) * ldk + ch * 8); } } \
        _Pragma("unroll") for (int i = 0; i < NVC; ++i) { const int idx = tid + 512 * i; const int dv = idx >> 3, ch = idx & 7; vreg[i] = *(const u32x4*)(Vtb + (size_t)dv * ldv + 64 * (kt) + ch * 8); } } while (0)
    ATT_PREFETCH(0);
    for (int kt = 0; kt < nkt; ++kt) {
        __syncthreads();
#pragma unroll
        for (int i = 0; i < NKC; ++i) { const int idx = tid + 512 * i; if (idx < 64 * KCH) { const int key = idx / KCH, ch = idx % KCH; *(u32x4*)(Ks + key * KS + ch * 16) = kreg[i]; } }
#pragma unroll
        for (int i = 0; i < NVC; ++i) { const int idx = tid + 512 * i; const int dv = idx >> 3, ch = idx & 7; *(u32x4*)(Vs + dv * VS + ch * 16) = vreg[i]; }
        __syncthreads();
        if (kt + 1 < nkt) ATT_PREFETCH(kt + 1);
        const int qw0 = q0 + wv * 16;
        if (CAUSAL && 64 * kt > qw0 + 15) continue;
        f32x4 sT[4];
#pragma unroll
        for (int k4 = 0; k4 < 4; ++k4) { sT[k4] = (f32x4){0.f, 0.f, 0.f, 0.f};
#pragma unroll
            for (int ks = 0; ks < NKS; ++ks) { const bf16x8 a = *(const bf16x8*)(Ks + (16 * k4 + j) * KS + (32 * ks + 8 * g) * 2);
                sT[k4] = __builtin_amdgcn_mfma_f32_16x16x32_bf16(a, qf[ks], sT[k4], 0, 0, 0); } }
        if (CAUSAL && 64 * kt + 63 > qw0) {
#pragma unroll
            for (int k4 = 0; k4 < 4; ++k4)
#pragma unroll
                for (int r = 0; r < 4; ++r) if (64 * kt + 16 * k4 + 4 * g + r > qrow) sT[k4][r] = -INFINITY;
        }
        float mx = -INFINITY;
#pragma unroll
        for (int k4 = 0; k4 < 4; ++k4) mx = fmaxf(mx, fmaxf(fmaxf(sT[k4][0], sT[k4][1]), fmaxf(sT[k4][2], sT[k4][3])));
        mx = fmaxf(mx, __shfl_xor(mx, 16)); mx = fmaxf(mx, __shfl_xor(mx, 32));
        const float mnew = fmaxf(mrun, mx); const float alpha = __builtin_amdgcn_exp2f(mrun - mnew); mrun = mnew;
        float psum = 0.f;
#pragma unroll
        for (int k4 = 0; k4 < 4; ++k4)
#pragma unroll
            for (int r = 0; r < 4; ++r) { const float pv = __builtin_amdgcn_exp2f(sT[k4][r] - mnew); sT[k4][r] = pv; psum += pv; }
        lsum = lsum * alpha + psum;
#pragma unroll
        for (int d = 0; d < NDT; ++d) oT[d] *= alpha;
#pragma unroll
        for (int kc = 0; kc < 2; ++kc) {
            const bf16x8 pb = __builtin_bit_cast(bf16x8, pk8(sT[2 * kc], sT[2 * kc + 1]));
#pragma unroll
            for (int d = 0; d < NDT; ++d) { const unsigned char* vp = Vs + (16 * d + j) * VS + (32 * kc + 4 * g) * 2;
                const u32x2 lo = *(const u32x2*)vp, hi = *(const u32x2*)(vp + 32); u32x4 w; w.x = lo.x; w.y = lo.y; w.z = hi.x; w.w = hi.y;
                oT[d] = __builtin_amdgcn_mfma_f32_16x16x32_bf16(__builtin_bit_cast(bf16x8, w), pb, oT[d], 0, 0, 0); }
        }
    }
#undef ATT_PREFETCH
    lsum += __shfl_xor(lsum, 16); lsum += __shfl_xor(lsum, 32);
    const float inv = 1.f / lsum;
#pragma unroll
    for (int d = 0; d < NDT; ++d) { u32x2 w; w.x = pk2(oT[d][0] * inv, oT[d][1] * inv); w.y = pk2(oT[d][2] * inv, oT[d][3] * inv);
        *(u32x2*)(Ob + (size_t)qrow * ldo + 16 * d + 4 * g) = w; }
}

__device__ __forceinline__ void rwkv_prep_tile(int wid_s, KP p_, int l, int tile, float* ldsf) {
    KP p = p_; asm volatile("" : "+s"(p));
    unsigned char* ws = p->ws;
    const int tid_ = mk_tid(wid_s);
    const int tid = tid_, lane = tid & 63, wv = tid >> 6;
    const bf16* P = (const bf16*)(ws + R_P); bf16* SI = (bf16*)(ws + R_SI);
    const float* mu = p->in[I_MU] + l * 1792;
    const int row0 = tile * 32;
    float* s_w = ldsf; float* s_a = ldsf + 32 * 64;
    __syncthreads();
    for (int e = tid; e < 32 * 128; e += 512) { const int t = e >> 7, jj = e & 127, row = row0 + t, col = 1536 + jj;
        const float cur = bf2f(P[(size_t)row * NP + col]); const float prev = ((row & 2047) == 0) ? 0.f : bf2f(P[(size_t)(row - 1) * NP + col]);
        const float mm = cur + (prev - cur) * mu[col];
        if (jj < 64) s_w[t * 64 + jj] = tanhf(mm); else s_a[t * 64 + (jj - 64)] = mm; }
    __syncthreads();
    float aw[32], aa[32];
#pragma unroll
    for (int t = 0; t < 32; ++t) { aw[t] = 0.f; aa[t] = 0.f; }
    const float* wup = p->in[I_WUP] + (size_t)l * 64 * 512 + tid; const float* aup = p->in[I_AUP] + (size_t)l * 64 * 512 + tid;
    for (int jj = 0; jj < 64; jj += 4) {
        const float w0 = wup[(jj + 0) * 512], w1 = wup[(jj + 1) * 512], w2 = wup[(jj + 2) * 512], w3 = wup[(jj + 3) * 512];
        const float a0 = aup[(jj + 0) * 512], a1 = aup[(jj + 1) * 512], a2 = aup[(jj + 2) * 512], a3 = aup[(jj + 3) * 512];
#pragma unroll
        for (int t = 0; t < 32; ++t) { const f32x4 sw = *(const f32x4*)(s_w + t * 64 + jj), sa = *(const f32x4*)(s_a + t * 64 + jj);
            aw[t] += (sw.x * w0 + sw.y * w1) + (sw.z * w2 + sw.w * w3); aa[t] += (sa.x * a0 + sa.y * a1) + (sa.z * a2 + sa.w * a3); }
    }
    const int c = tid, h = wv;
    const float w0c = p->in[I_W0][l * 512 + c], a0c = p->in[I_A0][l * 512 + c], kkc = p->in[I_KK][l * 512 + c], kac = p->in[I_KA][l * 512 + c];
    const float mur = mu[c], muk = mu[512 + c], muv = mu[1024 + c];
#pragma unroll
    for (int t = 0; t < 32; ++t) {
        const int row = row0 + t; const bool first = (row & 2047) == 0;
        const bf16* pr = P + (size_t)row * NP; const bf16* pp = pr - NP;
        const float rc = bf2f(pr[c]), kc = bf2f(pr[512 + c]), vc = bf2f(pr[1024 + c]);
        const float rp = first ? 0.f : bf2f(pp[c]), kp = first ? 0.f : bf2f(pp[512 + c]), vp = first ? 0.f : bf2f(pp[1024 + c]);
        const float r = rc + (rp - rc) * mur, k = kc + (kp - kc) * muk, v = vc + (vp - vc) * muv;
        const float z = w0c + aw[t]; const float om = 1.f - __expf(-0.6065306597126334f * sigmoidf_(z));
        const float a = sigmoidf_(a0c + aa[t]);
        const float kkr = k * kkc; const float ss = wave_sum(kkr * kkr); const float kk = kkr / fmaxf(sqrtf(ss), 1e-12f);
        const float k2 = k * (1.f + (a - 1.f) * kac);
        bf16* o = SI + ((size_t)((row >> 11) * 8 + h) * 2048 + (row & 2047)) * 384 + lane;
        o[0] = (bf16)f2bf(r); o[64] = (bf16)f2bf(om); o[128] = (bf16)f2bf(k2); o[192] = (bf16)f2bf(kk); o[256] = (bf16)f2bf(kk * a); o[320] = (bf16)f2bf(v);
    }
}

template <int CTRL> __device__ __forceinline__ float dppf(float x) { return __builtin_bit_cast(float, __builtin_amdgcn_update_dpp(0, __builtin_bit_cast(int, x), CTRL, 0xF, 0xF, true)); }
__device__ __forceinline__ float allreduce16(float x) { x += dppf<0xB1>(x); x += dppf<0x4E>(x); x += dppf<0x141>(x); x += dppf<0x140>(x); return x; }
__device__ __forceinline__ void rwkv_scan_unit(int wid_s, const bf16* SIbh, bf16* Yb, int quarter, float* ldsf) {
    const int tid_ = mk_tid(wid_s);
    const int tid = tid_, lane = tid & 63, wv = tid >> 6;
    u32x4 pre[3];
#pragma unroll
    for (int i = 0; i < 3; ++i) pre[i] = *(const u32x4*)(SIbh + (size_t)(tid + 512 * i) * 8);
    float S0 = 0.f, S1 = 0.f, S2 = 0.f, S3 = 0.f;
    const int rowl = quarter * 16 + (wv & 3) * 4 + (lane >> 4), c4 = (lane & 15) * 4;
    __syncthreads();
    for (int ch = 0; ch < 64; ++ch) {
        float* B = ldsf + (ch & 1) * (32 * 384);
#pragma unroll
        for (int i = 0; i < 3; ++i) { float* d = B + (tid + 512 * i) * 8; const u32x4 w = pre[i];
            *(f32x4*)d = (f32x4){bflo(w.x), bfhi(w.x), bflo(w.y), bfhi(w.y)}; *(f32x4*)(d + 4) = (f32x4){bflo(w.z), bfhi(w.z), bflo(w.w), bfhi(w.w)}; }
        if (ch + 1 < 64) {
#pragma unroll
            for (int i = 0; i < 3; ++i) pre[i] = *(const u32x4*)(SIbh + (size_t)(ch + 1) * (32 * 384) + (size_t)(tid + 512 * i) * 8);
        }
        __syncthreads();
        if (wv < 4) {
#pragma unroll 4
            for (int s = 0; s < 32; ++s) {
                const float* q = B + s * 384;
                const f32x4 r4 = *(const f32x4*)(q + c4), om4 = *(const f32x4*)(q + 64 + c4), k4 = *(const f32x4*)(q + 128 + c4), kk4 = *(const f32x4*)(q + 192 + c4), ka4 = *(const f32x4*)(q + 256 + c4);
                const float v = q[320 + rowl];
                float sa = (S0 * kk4.x + S1 * kk4.y) + (S2 * kk4.z + S3 * kk4.w);
                sa = allreduce16(sa);
                S0 = fmaf(-S0, om4.x, S0); S1 = fmaf(-S1, om4.y, S1); S2 = fmaf(-S2, om4.z, S2); S3 = fmaf(-S3, om4.w, S3);
                S0 = fmaf(-sa, ka4.x, S0); S1 = fmaf(-sa, ka4.y, S1); S2 = fmaf(-sa, ka4.z, S2); S3 = fmaf(-sa, ka4.w, S3);
                S0 = fmaf(v, k4.x, S0); S1 = fmaf(v, k4.y, S1); S2 = fmaf(v, k4.z, S2); S3 = fmaf(v, k4.w, S3);
                float y = (S0 * r4.x + S1 * r4.y) + (S2 * r4.z + S3 * r4.w);
                y = allreduce16(y);
                if ((lane & 15) == 0) Yb[(size_t)(ch * 32 + s) * 1536 + rowl] = (bf16)f2bf(y);
            }
        }
    }
    __syncthreads();
}

__device__ __forceinline__ void rwkv_post_tile(int wid_s, KP p_, int l, int r, int tile, float* ldsf) {
    KP p = p_; asm volatile("" : "+s"(p));
    unsigned char* ws = p->ws;
    const int tid_ = mk_tid(wid_s);
    const int tid = tid_, lane = tid & 63, wv = tid >> 6;
    const bf16* P = (const bf16*)(ws + R_P); const bf16* SI = (const bf16*)(ws + R_SI); bf16* Y = (bf16*)(ws + WS_Y) + (size_t)r * TH * 1536;
    const float* mu = p->in[I_MU] + l * 1792;
    const int row0 = tile * 32;
    float* s_g = ldsf;
    __syncthreads();
    for (int e = tid; e < 32 * 128; e += 512) { const int t = e >> 7, jj = e & 127, row = row0 + t, col = 1664 + jj;
        const float cur = bf2f(P[(size_t)row * NP + col]); const float prev = ((row & 2047) == 0) ? 0.f : bf2f(P[(size_t)(row - 1) * NP + col]);
        s_g[e] = sigmoidf_(cur + (prev - cur) * mu[col]); }
    __syncthreads();
    float ag[32];
#pragma unroll
    for (int t = 0; t < 32; ++t) ag[t] = 0.f;
    const float* gup = p->in[I_GUP] + (size_t)l * 128 * 512 + tid;
    for (int jj = 0; jj < 128; jj += 4) {
        const float g0 = gup[(jj + 0) * 512], g1 = gup[(jj + 1) * 512], g2 = gup[(jj + 2) * 512], g3 = gup[(jj + 3) * 512];
#pragma unroll
        for (int t = 0; t < 32; ++t) { const f32x4 sg = *(const f32x4*)(s_g + t * 128 + jj); ag[t] += (sg.x * g0 + sg.y * g1) + (sg.z * g2 + sg.w * g3); }
    }
    const int c = tid, h = wv;
    const float rkc = p->in[I_RK][l * 512 + c], lng = p->in[I_LNG][l * 512 + c], lnb = p->in[I_LNB][l * 512 + c];
#pragma unroll
    for (int t = 0; t < 32; ++t) {
        const int row = row0 + t;
        const bf16* si = SI + ((size_t)((row >> 11) * 8 + h) * 2048 + (row & 2047)) * 384 + lane;
        const float rr = bf2f(si[0]), k2 = bf2f(si[128]), v = bf2f(si[320]);
        bf16* yp = Y + (size_t)row * 1536 + c;
        const float y = bf2f(*yp);
        const float mean = wave_sum(y) * (1.f / 64.f); const float d = y - mean; const float var = wave_sum(d * d) * (1.f / 64.f);
        const float yn = d * rsqrtf(var + 64e-5f) * lng + lnb;
        const float bonus = wave_sum(rr * k2 * rkc) * v;
        *yp = (bf16)f2bf((yn + bonus) * ag[t]);
    }
}

__device__ __forceinline__ float gelu_tanh(float x) { const float u = 0.7978845608028654f * (x + 0.044715f * x * x * x); return 0.5f * x * (1.f + tanhf(u)); }
__device__ __forceinline__ void lru_unit(int wid_s, KP p_, int l, int r, int bl, int n, float* ldsf) {
    KP p = p_; asm volatile("" : "+s"(p));
    unsigned char* ws = p->ws;
    const int tid_ = mk_tid(wid_s);
    const int tid = tid_, lane = tid & 63, wv = tid >> 6;
    const bf16* P = (const bf16*)(ws + R_P) + (size_t)bl * 2048 * NP; bf16* Yb = (bf16*)(ws + WS_Y) + ((size_t)(r * 4 + bl) * 2048) * 1536 + 512;
    const int cg_ = n * 64 + lane;
    float* s_wa = ldsf;
    float* s_wx = ldsf + 4096;
    float* s_xc = ldsf + 8192;
    float* s_AH = ldsf + 8192 + 8192;
    __syncthreads();
    for (int e = tid; e < 4096; e += 512) { s_wa[e] = p->in[I_WA][((size_t)l * 8 + n) * 4096 + e]; s_wx[e] = p->in[I_WX][((size_t)l * 8 + n) * 4096 + e]; }
    const float cw0 = p->in[I_CW][(l * 4 + 0) * 512 + cg_], cw1 = p->in[I_CW][(l * 4 + 1) * 512 + cg_], cw2 = p->in[I_CW][(l * 4 + 2) * 512 + cg_], cw3 = p->in[I_CW][(l * 4 + 3) * 512 + cg_];
    const float cb = p->in[I_CB][l * 512 + cg_], ba = p->in[I_BA][l * 512 + cg_], bx = p->in[I_BX][l * 512 + cg_];
    const float lam = p->in[I_LAM][l * 512 + cg_]; const float sp8 = -8.f * log1pf(__expf(-lam));
    float hcar = 0.f;
    for (int tile = 0; tile < 16; ++tile) {
        const int t0 = tile * 128 + wv * 16;
        float xc[16];
        {
            float x3 = (t0 >= 3) ? bf2f(P[(size_t)(t0 - 3) * NP + 1792 + cg_]) : 0.f, x2 = (t0 >= 2) ? bf2f(P[(size_t)(t0 - 2) * NP + 1792 + cg_]) : 0.f, x1 = (t0 >= 1) ? bf2f(P[(size_t)(t0 - 1) * NP + 1792 + cg_]) : 0.f;
#pragma unroll
            for (int i = 0; i < 16; ++i) { const float x0 = bf2f(P[(size_t)(t0 + i) * NP + 1792 + cg_]);
                xc[i] = cw0 * x3 + cw1 * x2 + cw2 * x1 + cw3 * x0 + cb; x3 = x2; x2 = x1; x1 = x0; }
        }
        __syncthreads();
#pragma unroll
        for (int i = 0; i < 16; ++i) s_xc[(wv * 16 + i) * 64 + lane] = xc[i];
        __syncthreads();
        f32x2 acc[16];
#pragma unroll
        for (int i = 0; i < 16; ++i) acc[i] = (f32x2){0.f, 0.f};
        for (int ii = 0; ii < 64; ii += 4) {
            const f32x2 w0 = {s_wa[(ii + 0) * 64 + lane], s_wx[(ii + 0) * 64 + lane]}, w1 = {s_wa[(ii + 1) * 64 + lane], s_wx[(ii + 1) * 64 + lane]},
                        w2 = {s_wa[(ii + 2) * 64 + lane], s_wx[(ii + 2) * 64 + lane]}, w3 = {s_wa[(ii + 3) * 64 + lane], s_wx[(ii + 3) * 64 + lane]};
#pragma unroll
            for (int i = 0; i < 16; ++i) { const f32x4 xv = *(const f32x4*)(s_xc + (wv * 16 + i) * 64 + ii);
                acc[i] += w0 * xv.x; acc[i] += w1 * xv.y; acc[i] += w2 * xv.z; acc[i] += w3 * xv.w; }
        }
        float av[16], uv[16]; float A = 1.f, H = 0.f;
#pragma unroll
        for (int i = 0; i < 16; ++i) { const float rg = sigmoidf_(acc[i].x + ba), ig = sigmoidf_(acc[i].y + bx);
            const float la = sp8 * rg; av[i] = __expf(la); uv[i] = sqrtf(-expm1f(2.f * la)) * (ig * xc[i]);
            A *= av[i]; H = av[i] * H + uv[i]; }
        s_AH[(wv * 64 + lane) * 2] = A; s_AH[(wv * 64 + lane) * 2 + 1] = H;
        __syncthreads();
        float hin = hcar, hall = hcar;
#pragma unroll
        for (int w = 0; w < 8; ++w) { const float Aw = s_AH[(w * 64 + lane) * 2], Hw = s_AH[(w * 64 + lane) * 2 + 1]; hall = Aw * hall + Hw; if (w < wv) hin = hall; }
        hcar = hall;
        float hh = hin;
#pragma unroll
        for (int i = 0; i < 16; ++i) { hh = av[i] * hh + uv[i];
            const float gb = bf2f(P[(size_t)(t0 + i) * NP + 2304 + cg_]);
            Yb[(size_t)(t0 + i) * 1536 + cg_] = (bf16)f2bf(hh * gelu_tanh(gb)); }
    }
    __syncthreads();
}

__device__ __forceinline__ void kfix_rows(int wid_s, KP p_, int l, int r) {
    KP p = p_; asm volatile("" : "+s"(p));
    unsigned char* ws = p->ws;
    const int tid_ = mk_tid(wid_s);
    const int tid = tid_, lane = tid & 63, wv = tid >> 6, h = lane >> 3, sub = lane & 7;
    const bf16* P = (const bf16*)(ws + R_P); bf16* Km = (bf16*)(ws + R_KM);
    const float* kg = p->in[I_KG] + l * 96; const int* pos = (const int*)p->in[I_POS] + r * TH;
    for (int row = blockIdx.x * 8 + wv; row < TH; row += gridDim.x * 8) {
        bf16* kp = Km + (size_t)row * 768 + h * 96;
        const u32x4 w = *(const u32x4*)(kp + 8 * sub);
        float nv[8] = {bflo(w.x), bfhi(w.x), bflo(w.y), bfhi(w.y), bflo(w.z), bfhi(w.z), bflo(w.w), bfhi(w.w)};
        const unsigned k1 = *(const unsigned*)(P + (size_t)row * NP + 3200 + 2 * sub), k2 = *(const unsigned*)(P + (size_t)row * NP + 3216 + 2 * sub);
        float x1a = bflo(k1), x1b = bfhi(k1), x2a = bflo(k2), x2b = bfhi(k2);
        float ss = x1a * x1a + x1b * x1b + x2a * x2a + x2b * x2b;
#pragma unroll
        for (int e = 0; e < 8; ++e) ss += nv[e] * nv[e];
        ss += __shfl_xor(ss, 1); ss += __shfl_xor(ss, 2); ss += __shfl_xor(ss, 4);
        const float rs = rsqrtf(ss * (1.f / 96.f) + 1e-6f);
#pragma unroll
        for (int e = 0; e < 8; ++e) nv[e] *= rs * kg[8 * sub + e];
        x1a *= rs * kg[64 + 2 * sub]; x1b *= rs * kg[65 + 2 * sub]; x2a *= rs * kg[80 + 2 * sub]; x2b *= rs * kg[81 + 2 * sub];
        const int ps = pos[row]; float ca, sa, cb, sb; rope_cs(ps, 2 * sub, ca, sa); rope_cs(ps, 2 * sub + 1, cb, sb);
        u32x4 o; o.x = pk2(nv[0], nv[1]); o.y = pk2(nv[2], nv[3]); o.z = pk2(nv[4], nv[5]); o.w = pk2(nv[6], nv[7]);
        *(u32x4*)(kp + 8 * sub) = o;
        *(unsigned*)(kp + 64 + 2 * sub) = pk2(x1a * ca - x2a * sa, x1b * cb - x2b * sb);
        *(unsigned*)(kp + 80 + 2 * sub) = pk2(x2a * ca + x1a * sa, x2b * cb + x1b * sb);
    }
}
__device__ __forceinline__ void mkfix_rows(int wid_s, KP p_, int l) {
    KP p = p_; asm volatile("" : "+s"(p));
    unsigned char* ws = p->ws;
    const int tid_ = mk_tid(wid_s);
    const int tid = tid_, lane = tid & 63, wv = tid >> 6, h = lane >> 4, sub = lane & 15;
    bf16* mk = (bf16*)(ws + R_MK); const float* kg = p->in[I_XKG] + l * 128;
    for (int row = blockIdx.x * 8 + wv; row < 2048; row += gridDim.x * 8) {
        bf16* kp = mk + (size_t)row * 512 + h * 128 + 8 * sub;
        const u32x4 w = *(const u32x4*)kp;
        float nv[8] = {bflo(w.x), bfhi(w.x), bflo(w.y), bfhi(w.y), bflo(w.z), bfhi(w.z), bflo(w.w), bfhi(w.w)};
        float ss = 0.f;
#pragma unroll
        for (int e = 0; e < 8; ++e) ss += nv[e] * nv[e];
        ss += __shfl_xor(ss, 1); ss += __shfl_xor(ss, 2); ss += __shfl_xor(ss, 4); ss += __shfl_xor(ss, 8);
        const float rs = rsqrtf(ss * (1.f / 128.f) + 1e-6f);
#pragma unroll
        for (int e = 0; e < 8; ++e) nv[e] *= rs * kg[8 * sub + e];
        u32x4 o; o.x = pk2(nv[0], nv[1]); o.y = pk2(nv[2], nv[3]); o.z = pk2(nv[4], nv[5]); o.w = pk2(nv[6], nv[7]);
        *(u32x4*)kp = o;
    }
}
__device__ __forceinline__ void memb_rows(int wid_s, KP p_) {
    KP p = p_; asm volatile("" : "+s"(p));
    unsigned char* ws = p->ws;
    const int tid_ = mk_tid(wid_s);
    const int tid = tid_, lane = tid & 63, wv = tid >> 6;
    const float* mem = p->in[I_MEM]; bf16* memb = (bf16*)(ws + R_MEMB);
    for (int row = blockIdx.x * 8 + wv; row < 2048; row += gridDim.x * 8) {
        const f32x4* xr = (const f32x4*)(mem + (size_t)row * 1024) + lane; f32x4 v[4]; float s = 0.f;
#pragma unroll
        for (int jq = 0; jq < 4; ++jq) { v[jq] = xr[64 * jq]; s += (v[jq].x * v[jq].x + v[jq].y * v[jq].y) + (v[jq].z * v[jq].z + v[jq].w * v[jq].w); }
        const float rs = rsqrtf(wave_sum(s) * (1.f / 1024.f) + 1e-6f);
#pragma unroll
        for (int jq = 0; jq < 4; ++jq) { u32x2 w; w.x = pk2(v[jq].x * rs, v[jq].y * rs); w.y = pk2(v[jq].z * rs, v[jq].w * rs); *((u32x2*)(memb + (size_t)row * 1024) + lane + 64 * jq) = w; }
    }
}

#define XB_TMO      128
#define XB_XCNT(j)  (256  + 64 * (j))
#define XB_XSUB(j)  (1280 + 64 * (j))
#define XB_XGEN(j)  (2304 + 64 * (j))
#define XB_TOP      3328
#define XB_TOPGEN   3392
#define XCD_BAR_WORDS 3456
#define XB_SPIN_CAP (1u << 22)
__device__ __forceinline__ unsigned xb_ld(unsigned* p)              { return __hip_atomic_load(p, __ATOMIC_RELAXED, __HIP_MEMORY_SCOPE_AGENT); }
__device__ __forceinline__ unsigned xb_add(unsigned* p, unsigned v) { return __hip_atomic_fetch_add(p, v, __ATOMIC_RELAXED, __HIP_MEMORY_SCOPE_AGENT); }
__device__ __forceinline__ unsigned xb_xcc_id() { return (unsigned)__builtin_amdgcn_s_getreg((3 << 11) | 20) & 0xFu; }
#define XB_SPIN(cond, bar) do { unsigned _sp = 0; while (cond) { __builtin_amdgcn_s_sleep(1); \
    if ((++_sp & 255u) == 0u) { if (xb_ld(&(bar)[XB_TMO])) break; if (_sp > XB_SPIN_CAP) { atomicAdd(&(bar)[XB_TMO], 1u); break; } } } } while (0)
__device__ __forceinline__ void xcd_barrier_complete(unsigned* bar, unsigned x, unsigned& nloc, unsigned& nx) {
    const unsigned G = gridDim.x;
    unsigned sum, cnt, mine, sp = 0u;
    for (;;) {
        sum = 0u; cnt = 0u; mine = 0u;
#pragma unroll
        for (unsigned j = 0; j < 16; ++j) { const unsigned c = xb_ld(&bar[XB_XCNT(j)]); sum += c; cnt += (c > 0u) ? 1u : 0u; mine = (j == x) ? c : mine; }
        if (sum == G) break;
        __builtin_amdgcn_s_sleep(1);
        if ((++sp & 255u) == 0u) { if (xb_ld(&bar[XB_TMO])) break; if (sp > XB_SPIN_CAP) { atomicAdd(&bar[XB_TMO], 1u); break; } }
    }
    nloc = mine > 0u ? mine : 1u; nx = cnt > 0u ? cnt : 1u;
}
__device__ __forceinline__ void grid_barrier1(int wid_s, unsigned* bar, volatile unsigned* st) {
    asm volatile("s_waitcnt vmcnt(0)" ::: "memory");
    __syncthreads();
    if (mk_tid(wid_s) == 0) {
        const unsigned x = xb_xcc_id();
        __builtin_amdgcn_s_waitcnt(0);
        unsigned nloc = st[0], nx = st[1];
        if (nloc == 0u) { xcd_barrier_complete(bar, x, nloc, nx); st[0] = nloc; st[1] = nx; }
        const unsigned old = xb_add(&bar[XB_XSUB(x)], 1u);
        const unsigned gen = old / nloc;
        if (old + 1u == (gen + 1u) * nloc) {
            __builtin_amdgcn_fence(__ATOMIC_RELEASE, "agent");
            asm volatile("s_waitcnt vmcnt(0)" ::: "memory");
            const unsigned og = xb_add(&bar[XB_TOP], 1u);
            const unsigned tg = og / nx;
            if (og + 1u == (tg + 1u) * nx) xb_add(&bar[XB_TOPGEN], 1u);
            else XB_SPIN(xb_ld(&bar[XB_TOPGEN]) == tg, bar);
            __builtin_amdgcn_fence(__ATOMIC_ACQUIRE, "agent");
            xb_add(&bar[XB_XGEN(x)], 1u);
            asm volatile("s_waitcnt vmcnt(0)" ::: "memory");
        } else {
            XB_SPIN(xb_ld(&bar[XB_XGEN(x)]) == gen, bar);
            __builtin_amdgcn_fence(__ATOMIC_ACQUIRE, "agent");
            asm volatile("s_waitcnt vmcnt(0)" ::: "memory");
        }
    }
    __syncthreads();
}
__device__ __forceinline__ void grid_barrier(int wid_s, unsigned* bar, volatile unsigned* st) { int nb = 1 + RB(8); asm volatile("" : "+s"(nb)); for (int q = 0; q < nb; ++q) grid_barrier1(wid_s, bar, st); }
template <class Epi>
__device__ __forceinline__ void run_gemm(int wid_s, LAS unsigned char* lds, const bf16* A, int lda, const bf16* Bt, int M, int N, int K, const Epi& E) {
    int bx_ = blockIdx.x, gx_ = gridDim.x; asm volatile("" : "+s"(bx_), "+s"(gx_), "+s"(K), "+s"(lda));
    pg8::Gemm g{A, Bt, M, N, K, lda}; pg8::StaticOrder S; S.init(M, N, gx_, bx_);
    if (ON(1)) pg8::gemm_phase<Epi, pg8::StaticOrder>(wid_s, lds, g, S, E);
}

__device__ __forceinline__ unsigned char* wsl_(KP p) { unsigned char* w = p->ws; asm volatile("" : "+s"(w)); return w; }
__global__ void __launch_bounds__(512, 2) fwd_kernel(Params parg) {
    KP p = (KP)__builtin_amdgcn_kernarg_segment_ptr();
    extern __shared__ __attribute__((aligned(16))) unsigned char lds_raw[];
    const int wid_s = __builtin_amdgcn_readfirstlane((int)threadIdx.x >> 6);
    LAS unsigned char* lds3 = (LAS unsigned char*)lds_raw;
    unsigned char* lds = lds_raw; float* ldsf = (float*)lds_raw;
    unsigned char* ws = p->ws;
    const int bid = blockIdx.x;
    unsigned* ctl = (unsigned*)(wsl_(p) + WS_CTL);
    bf16* xb = (bf16*)(wsl_(p) + WS_XB); float* part = (float*)(wsl_(p) + WS_PART); float* pq = (float*)(wsl_(p) + WS_PQ); float* pkv = (float*)(wsl_(p) + WS_PKV);
    bf16* Y = (bf16*)(wsl_(p) + WS_Y);
    float* xcur = p->out;
    volatile unsigned* bst = (volatile unsigned*)(lds + QIDX_OFF + 16);
    if (threadIdx.x == 0) { bst[0] = 0u; bst[1] = 0u; (void)xb_add(&ctl[1024 + XB_XCNT(xb_xcc_id())], 1u); }
    __syncthreads();

    for (int l_ = 0; l_ < 2; ++l_) {
        int l = l_; asm volatile("" : "+s"(l));
        { REPLOOP(0) { if (ON(0)) phase_convert(wid_s, p, l, ldsf);
        grid_barrier(wid_s, ctl + 1024, bst); } }
        for (int r_ = 0; r_ < 2; ++r_) {
            int r = r_; asm volatile("" : "+s"(r));
            { REPLOOP(1) { EpiP E{(bf16*)(wsl_(p) + R_P), part + (size_t)r * TH * 16, pq, pkv};
              run_gemm(wid_s, lds3, xb + (size_t)r * TH * 1024, 1024, (const bf16*)(wsl_(p) + W_IN), TH, NP, 1024, E);
            grid_barrier(wid_s, ctl + 1024, bst); } }
            { REPLOOP(2) {
            if (ON(2)) for (int tile = bid; tile < TH / 32; tile += gridDim.x) rwkv_prep_tile(wid_s, p, l, tile, ldsf);
            __syncthreads();
            { EpiQ E{(bf16*)(wsl_(p) + R_Q), pq}; run_gemm(wid_s, lds3, (const bf16*)(wsl_(p) + R_P) + 2816, NP, (const bf16*)(wsl_(p) + W_MQ), TH, 768, 256, E); }
            { EpiKV E{(bf16*)(wsl_(p) + R_KM), (bf16*)(wsl_(p) + R_VT), pkv}; run_gemm(wid_s, lds3, (const bf16*)(wsl_(p) + R_P) + 3072, NP, (const bf16*)(wsl_(p) + W_MKV), TH, 1024, 128, E); }
            grid_barrier(wid_s, ctl + 1024, bst); } }
            if (ON(7)) kfix_rows(wid_s, p, l, r);
            grid_barrier(wid_s, ctl + 1024, bst);
            { REPLOOP(3) {
            if (ON(3) && !(q && RB(10)) && bid < 128) { const int xcd = bid & 7, idx = bid >> 3, hh = xcd * 4 + (idx >> 2), quarter = idx & 3;
                rwkv_scan_unit(wid_s, (const bf16*)(wsl_(p) + R_SI) + (size_t)hh * 2048 * 384, Y + ((size_t)(r * 4 + (hh >> 3)) * 2048) * 1536 + (hh & 7) * 64, quarter, ldsf); }
            else if (ON(4) && !(q && RB(11)) && bid >= 128 && bid < 160) { const int uu = bid - 128; lru_unit(wid_s, p, l, r, uu >> 3, uu & 7, ldsf); }
            {
                unsigned* ctr = ctl + q * 4 + l * 2 + r; volatile int* qidx = (volatile int*)(lds + QIDX_OFF);
                for (;;) {
                    __syncthreads();
                    if (mk_tid(wid_s) == 0) *qidx = (int)atomicAdd(ctr, 1u);
                    __syncthreads();
                    const int u = *qidx;
                    if (u >= 512 || !ON(5) || (q && RB(12))) break;
                    const int qb = 15 - (u >> 5), bh = u & 31, bl = bh >> 3, h = bh & 7;
                    attn_unit<96, 64, true, true>(wid_s, lds, (const bf16*)(wsl_(p) + R_Q) + (size_t)bl * 2048 * 768 + h * 96, 768, (const bf16*)(wsl_(p) + R_KM) + (size_t)bl * 2048 * 768 + h * 96, 768,
                        (const bf16*)(wsl_(p) + R_VT) + (size_t)(bl * 8 + h) * 64 * 2048, 2048, Y + ((size_t)(r * 4 + bl) * 2048) * 1536 + 1024 + h * 64, 1536,
                        qb * 128, 2 * qb + 2, p->in[I_QG] + l * 96, (const int*)p->in[I_POS] + (r * 4 + bl) * 2048, 0.14724444527f  );
                }
            }
            grid_barrier(wid_s, ctl + 1024, bst); } }
            if (ON(6)) for (int tile = bid; tile < TH / 32; tile += gridDim.x) rwkv_post_tile(wid_s, p, l, r, tile, ldsf);
            grid_barrier(wid_s, ctl + 1024, bst);
        }
        if (ON(7)) memb_rows(wid_s, p);
        { REPLOOP(4) {
        for (int n = 0; n < 3; ++n) {
            { EpiGate E{(bf16*)(wsl_(p) + R_GS), part, p->in[I_BGATE] + l * 3072 + n * 1024}; run_gemm(wid_s, lds3, xb, 1024, (const bf16*)(wsl_(p) + W_GATE) + (size_t)n * 1024 * 1024, T, 1024, 1024, E); }
            { EpiProj E{(const bf16*)(wsl_(p) + R_GS), (float*)(wsl_(p) + R_MS), (bf16*)(wsl_(p) + R_MG), n}; run_gemm(wid_s, lds3, Y + n * 512, 1536, (const bf16*)(wsl_(p) + W_BR) + (size_t)n * 1024 * 512, T, 1024, 512, E); }
        }
        grid_barrier(wid_s, ctl + 1024, bst); } }
        { EpiRes E{l == 0 ? p->in[I_X] : xcur, xcur, xb, part}; run_gemm(wid_s, lds3, (const bf16*)(wsl_(p) + R_MG), 1024, (const bf16*)(wsl_(p) + W_OUT), T, 1024, 1024, E); }
        { EpiMemKV E{(bf16*)(wsl_(p) + R_MK), (bf16*)(wsl_(p) + R_MVT)}; run_gemm(wid_s, lds3, (const bf16*)(wsl_(p) + R_MEMB), 1024, (const bf16*)(wsl_(p) + W_XKV), 2048, 1024, 1024, E); }
        grid_barrier(wid_s, ctl + 1024, bst);
        if (ON(7)) mkfix_rows(wid_s, p, l);
        { REPLOOP(5) { EpiXQ E{(bf16*)(wsl_(p) + R_XQ), part}; run_gemm(wid_s, lds3, xb, 1024, (const bf16*)(wsl_(p) + W_XQ), T, 512, 1024, E);
        grid_barrier(wid_s, ctl + 1024, bst); } }
        { REPLOOP(6) {
        if (ON(8)) for (int u = bid; u < 512; u += gridDim.x) { const int qb = u & 15, bh = u >> 4, b = bh >> 2, h = bh & 3;
            attn_unit<128, 128, false, false>(wid_s, lds, (const bf16*)(wsl_(p) + R_XQ) + (size_t)b * 2048 * 512 + h * 128, 512, (const bf16*)(wsl_(p) + R_MK) + (size_t)b * 256 * 512 + h * 128, 512,
                (const bf16*)(wsl_(p) + R_MVT) + (size_t)(b * 4 + h) * 128 * 256, 256, (bf16*)(wsl_(p) + R_XO) + (size_t)b * 2048 * 512 + h * 128, 512,
                qb * 128, 4, p->in[I_XQG] + l * 128, nullptr, 0.12751743082f  ); }
        grid_barrier(wid_s, ctl + 1024, bst); } }
        { EpiRes E{xcur, xcur, xb, part}; run_gemm(wid_s, lds3, (const bf16*)(wsl_(p) + R_XO), 512, (const bf16*)(wsl_(p) + W_XO), T, 1024, 512, E); }
        grid_barrier(wid_s, ctl + 1024, bst);
        { REPLOOP(7) { EpiFFN1 E{(bf16*)(wsl_(p) + R_H), part}; run_gemm(wid_s, lds3, xb, 1024, (const bf16*)(wsl_(p) + W_13), T, 5632, 1024, E);
        grid_barrier(wid_s, ctl + 1024, bst); } }
        { EpiRes E{xcur, xcur, xb, part}; run_gemm(wid_s, lds3, (const bf16*)(wsl_(p) + R_H), DFF, (const bf16*)(wsl_(p) + W_2), T, 1024, DFF, E); }
        grid_barrier(wid_s, ctl + 1024, bst);
    }
}

extern "C" void kernel_launch(void* const* d_in, const int* in_sizes, int n_in, void* d_out, int out_size, void* d_ws, size_t ws_size, hipStream_t stream) {
    static int grid = 0;
    if (grid == 0) {
        int dev = 0, cus = 0, per_cu = 0;
        if (n_in != 43 || ws_size < WS_END) { fprintf(stderr, "kernel_launch: unexpected n_in %d / ws %zu\n", n_in, ws_size); grid = -1; return; }
        (void)hipGetDevice(&dev);
        (void)hipDeviceGetAttribute(&cus, hipDeviceAttributeMultiprocessorCount, dev);
        (void)hipFuncSetAttribute((const void*)fwd_kernel, hipFuncAttributeMaxDynamicSharedMemorySize, LDS_BYTES);
        (void)hipOccupancyMaxActiveBlocksPerMultiprocessor(&per_cu, (const void*)fwd_kernel, 512, LDS_BYTES);
        fprintf(stderr, "cus %d per_cu %d ws %zu\n", cus, per_cu, ws_size);
        grid = cus * (per_cu >= 1 ? 1 : 0);
        if (grid <= 0) { grid = -1; return; }
    }
    if (grid < 0) return;
    Params p{};
    for (int i = 0; i < 43; ++i) p.in[i] = (const float*)d_in[i];
    p.out = (float*)d_out; p.ws = (unsigned char*)d_ws;
    (void)hipMemsetAsync((char*)d_ws + WS_CTL, 0, 32768, stream);
    void* args[] = {&p};
    hipError_t e = hipLaunchCooperativeKernel((const void*)fwd_kernel, dim3(grid), dim3(512), args, LDS_BYTES, stream);
    if (e != hipSuccess) fprintf(stderr, "cooperative launch failed: %s (grid %d)\n", hipGetErrorString(e), grid);
}
```

```cpp
#include <hip/hip_runtime.h>
#include <cstdio>
#include <cstdint>

#define LAS __attribute__((address_space(3)))
typedef unsigned short bf16;
typedef short bf16x8 __attribute__((ext_vector_type(8)));
typedef float f32x4 __attribute__((ext_vector_type(4)));
typedef float f32x2 __attribute__((ext_vector_type(2)));
typedef unsigned u32x4 __attribute__((ext_vector_type(4)));
typedef unsigned u32x2 __attribute__((ext_vector_type(2)));

__device__ __forceinline__ unsigned f2bf(float f) { unsigned u = __builtin_bit_cast(unsigned, f); return (u + 0x7fffu + ((u >> 16) & 1u)) >> 16; }
__device__ __forceinline__ unsigned pk2(float lo, float hi) { return f2bf(lo) | (f2bf(hi) << 16); }
__device__ __forceinline__ float bf2f(bf16 b) { return __builtin_bit_cast(float, (unsigned)b << 16); }
__device__ __forceinline__ float bflo(unsigned u) { return __builtin_bit_cast(float, u << 16); }
__device__ __forceinline__ float bfhi(unsigned u) { return __builtin_bit_cast(float, u & 0xffff0000u); }
__device__ __forceinline__ u32x4 pk8(f32x4 a, f32x4 b) { u32x4 w; w.x = pk2(a.x, a.y); w.y = pk2(a.z, a.w); w.z = pk2(b.x, b.y); w.w = pk2(b.z, b.w); return w; }
__device__ __forceinline__ float sigmoidf_(float x) { return 1.f / (1.f + __expf(-x)); }
__device__ __forceinline__ int mk_tid(int wid_s) { int t = wid_s * 64 + (int)__builtin_amdgcn_mbcnt_hi(~0u, __builtin_amdgcn_mbcnt_lo(~0u, 0u)); asm volatile("" : "+v"(t)); return t; }
__device__ __forceinline__ float wave_sum(float v) {
#pragma unroll
    for (int o = 1; o < 64; o <<= 1) v += __shfl_xor(v, o);
    return v;
}

namespace pg8 {
#define PG8_LAS __attribute__((address_space(3)))
typedef unsigned short bf16_t;
constexpr int BM = 256, BK = 64, HALF = 128, HTB = HALF * BK * 2, STAGE_BYTES = 8 * HTB, NXCD = 8, WGM = 8;
__host__ __device__ __forceinline__ int lds_byte(int r, int c) { const int st = (r >> 4) * 2 + (c >> 5), rr = r & 15, cc = c & 31, ob = rr * 64 + cc * 2; return st * 1024 + (ob ^ (((ob >> 9) & 1) << 5)); }
__host__ __device__ __forceinline__ void stage_rc(int b, int& R, int& C) { const int st = b / 1024, sb = b % 1024, swz = sb ^ (((sb >> 9) & 1) << 5); R = (st >> 1) * 16 + swz / 64; C = (st & 1) * 32 + (swz % 64) / 2; }
__host__ __device__ __forceinline__ int perm32(int rho) { const int n = rho >> 4, i = rho & 15; return 8 * (i >> 2) + 4 * n + (i & 3); }
struct Unit { int pm, pn; };
struct Gemm { const bf16_t* A; const bf16_t* Bt; int M, N, K, lda; };
struct StaticOrder {
    int nM, nN, nwg, G, c;
    __host__ __device__ void init(int M, int N, int G_, int c_) { nM = M / BM; nN = N / BM; nwg = nM * nN; G = G_; c = c_; }
    __host__ __device__ bool next(int i, Unit& u) const {
        const long L = (long)i * G + c; if (L >= nwg) return false;
        int wgid = (int)L; { const int q = nwg / NXCD, r = nwg % NXCD, xcd = wgid % NXCD, off = wgid / NXCD; wgid = (xcd < r ? xcd * (q + 1) : r * (q + 1) + (xcd - r) * q) + off; }
        const int nig = WGM * nN, gid = wgid / nig, fm = gid * WGM, gsz = (nM - fm) < WGM ? (nM - fm) : WGM;
        u.pm = fm + ((wgid % nig) % gsz); u.pn = (wgid % nig) / gsz; return true;
    }
};
template <class Epi, class Sched>
__device__ __forceinline__ void gemm_phase(int wid_s, PG8_LAS unsigned char* lds, const Gemm g, const Sched& S, const Epi& E) {
    const int tid_ = mk_tid(wid_s);
    const int tid = tid_, wid = __builtin_amdgcn_readfirstlane(tid >> 6), lane = tid & 63, wr = wid >> 2, wc = wid & 3, fr = lane & 15, fq = lane >> 4;
    const int K = g.K, nt = K / BK, lda = g.lda;
    unsigned voffA[2], voffB[2];
#pragma unroll
    for (int i = 0; i < 2; ++i) { int R, C; stage_rc(tid * 16 + i * 8192, R, C); const int Rb = (R & ~31) + perm32(R & 31);
        voffA[i] = (unsigned)(R * lda + C) * 2u; voffB[i] = (unsigned)(Rb * K + C) * 2u; }
    const size_t kstep = (size_t)(BK * 2);
    const size_t hstepA = (size_t)HALF * lda * 2, hstepB = (size_t)HALF * K * 2;
    const size_t tstepA = 2 * hstepA, tstepB = 2 * hstepB;
    const unsigned ldsw = (unsigned)wid * 1024u;
    const int aoff = lds_byte(wr * 64 + fr, fq * 8), boff = lds_byte(wc * 32 + fr, fq * 8);
#define PG8_SA(b, h) (((b) * 2 + (h)) * HTB)
#define PG8_SB(b, h) ((4 + (b) * 2 + (h)) * HTB)
#define PG8_STAGE(bufoff, gbase, voff) do { _Pragma("unroll") for (int _i = 0; _i < 2; ++_i) \
        __builtin_amdgcn_global_load_lds((const unsigned*)((const char*)(gbase) + (voff)[_i]), (PG8_LAS unsigned*)(lds + (bufoff) + ldsw + _i * 8192), 16, 0, 0); } while (0)
#define PG8_LDA(dst, b, h) do { _Pragma("unroll") for (int m = 0; m < 4; ++m) _Pragma("unroll") for (int k = 0; k < 2; ++k) dst[m][k] = *(const PG8_LAS bf16x8*)(lds + PG8_SA(b, h) + aoff + m * 2048 + k * 1024); } while (0)
#define PG8_LDB(dst, b, h) do { _Pragma("unroll") for (int n = 0; n < 2; ++n) _Pragma("unroll") for (int k = 0; k < 2; ++k) dst[n][k] = *(const PG8_LAS bf16x8*)(lds + PG8_SB(b, h) + boff + n * 2048 + k * 1024); } while (0)
#define PG8_MMA(ai, bj, At, Bt) do { __builtin_amdgcn_s_setprio(1); _Pragma("unroll") for (int m = 0; m < 4; ++m) _Pragma("unroll") for (int n = 0; n < 2; ++n) _Pragma("unroll") for (int k = 0; k < 2; ++k) \
        acc[ai][bj][m][n] = __builtin_amdgcn_mfma_f32_16x16x32_bf16(Bt[n][k], At[m][k], acc[ai][bj][m][n], 0, 0, 0); __builtin_amdgcn_s_setprio(0); } while (0)
#define PG8_WAIT_V(n) asm volatile("s_waitcnt vmcnt(" #n ")" ::: "memory")
#define PG8_WAIT_L(n) asm volatile("s_waitcnt lgkmcnt(" #n ")" ::: "memory")
#define PG8_BAR __builtin_amdgcn_s_barrier()
#define PG8_SCHED __builtin_amdgcn_sched_barrier(0)
    Unit cur, nxt; int ui = 0;
    if (!S.next(0, cur)) return;
    f32x4 acc[2][2][4][2];
#pragma unroll
    for (int a = 0; a < 2; ++a)
#pragma unroll
        for (int b = 0; b < 2; ++b)
#pragma unroll
            for (int m = 0; m < 4; ++m)
#pragma unroll
                for (int n = 0; n < 2; ++n) acc[a][b][m][n] = (f32x4){0.f, 0.f, 0.f, 0.f};
    bf16x8 At[4][2], B0[2][2], B1[2][2];
    const char* cA = (const char*)g.A + (size_t)cur.pm * tstepA; const char* cB = (const char*)g.Bt + (size_t)cur.pn * tstepB;
    PG8_STAGE(PG8_SB(0, 0), cB, voffB); PG8_STAGE(PG8_SB(0, 1), cB + hstepB, voffB); PG8_STAGE(PG8_SA(0, 0), cA, voffA); PG8_STAGE(PG8_SA(0, 1), cA + hstepA, voffA);
    if (wr == 1) PG8_BAR;
    PG8_WAIT_V(2); PG8_BAR;
    PG8_STAGE(PG8_SB(1, 0), cB + kstep, voffB); PG8_STAGE(PG8_SA(1, 0), cA + kstep, voffA); PG8_STAGE(PG8_SB(1, 1), cB + hstepB + kstep, voffB);
    PG8_WAIT_V(6); PG8_BAR;
    for (;;) {
        const bool has_next = S.next(ui + 1, nxt);
        const char* nA = has_next ? (const char*)g.A + (size_t)nxt.pm * tstepA : cA; const char* nB = has_next ? (const char*)g.Bt + (size_t)nxt.pn * tstepB : cB;
#pragma unroll 1
        for (int t = 0; t < nt; t += 2) {
            const bool last = (t == nt - 2);
            const char* a1 = cA + (size_t)(t + 1) * kstep;
            const char* a2 = last ? nA : cA + (size_t)(t + 2) * kstep; const char* b2 = last ? nB : cB + (size_t)(t + 2) * kstep;
            const char* a3 = a2 + kstep; const char* b3 = b2 + kstep;
            PG8_LDB(B0, 0, 0); PG8_LDB(B1, 0, 1); PG8_SCHED; PG8_LDA(At, 0, 0); PG8_STAGE(PG8_SA(1, 1), a1 + hstepA, voffA);
            PG8_WAIT_V(8); PG8_WAIT_L(0); PG8_BAR; PG8_MMA(0, 0, At, B0); PG8_MMA(0, 1, At, B1); PG8_BAR; PG8_SCHED;
            PG8_LDA(At, 0, 1); PG8_STAGE(PG8_SB(0, 0), b2, voffB); PG8_STAGE(PG8_SB(0, 1), b2 + hstepB, voffB); PG8_STAGE(PG8_SA(0, 0), a2, voffA);
            PG8_WAIT_V(8); PG8_WAIT_L(0); PG8_BAR; PG8_MMA(1, 0, At, B0); PG8_MMA(1, 1, At, B1); PG8_BAR; PG8_SCHED;
            PG8_LDB(B0, 1, 0); PG8_LDB(B1, 1, 1); PG8_SCHED; PG8_LDA(At, 1, 0); PG8_STAGE(PG8_SA(0, 1), a2 + hstepA, voffA);
            PG8_WAIT_V(8); PG8_WAIT_L(0); PG8_BAR; PG8_MMA(0, 0, At, B0); PG8_MMA(0, 1, At, B1); PG8_BAR; PG8_SCHED;
            PG8_LDA(At, 1, 1); PG8_STAGE(PG8_SB(1, 0), b3, voffB); PG8_STAGE(PG8_SB(1, 1), b3 + hstepB, voffB); PG8_STAGE(PG8_SA(1, 0), a3, voffA);
            PG8_WAIT_V(8); PG8_WAIT_L(0); PG8_BAR; PG8_MMA(1, 0, At, B0); PG8_MMA(1, 1, At, B1); PG8_BAR; PG8_SCHED;
        }
        if (wr == 0) PG8_BAR;
        E(acc, cur, wr, wc, fr, fq);
        if (!has_next) break;
#pragma unroll
        for (int a = 0; a < 2; ++a)
#pragma unroll
            for (int b = 0; b < 2; ++b)
#pragma unroll
                for (int m = 0; m < 4; ++m)
#pragma unroll
                    for (int n = 0; n < 2; ++n) acc[a][b][m][n] = (f32x4){0.f, 0.f, 0.f, 0.f};
        cur = nxt; cA = nA; cB = nB; ++ui;
        if (wr == 1) PG8_BAR;
    }
    PG8_WAIT_V(0);
    PG8_BAR;
#undef PG8_SA
#undef PG8_SB
#undef PG8_STAGE
#undef PG8_LDA
#undef PG8_LDB
#undef PG8_MMA
#undef PG8_WAIT_V
#undef PG8_WAIT_L
#undef PG8_BAR
#undef PG8_SCHED
}
}

#ifndef EN
#define EN 0xFFFF
#endif
#define ON(b) ((EN >> (b)) & 1)
#ifndef REP
#define REP 0
#endif
#define RB(b) ((REP >> (b)) & 1)
#define REPLOOP(b) int nrep##b = 1 + RB(b); asm volatile("" : "+s"(nrep##b)); for (int q = 0; q < nrep##b; ++q)
constexpr int T = 16384, TH = 8192, SEQ = 2048, DM = 1024, DIN = 6304, NP = 3328, DFF = 2816;
constexpr int LDS_BYTES = 147456, QIDX_OFF = 140000;
constexpr size_t MiB = 1u << 20;
constexpr size_t WS_CTL = 0;
constexpr size_t WS_WT = 1 * MiB;
constexpr size_t W_IN = WS_WT, W_GATE = W_IN + (size_t)NP * 1024 * 2, W_BR = W_GATE + (size_t)3072 * 1024 * 2, W_OUT = W_BR + (size_t)3 * 1024 * 512 * 2,
                 W_MQ = W_OUT + (size_t)1024 * 1024 * 2, W_MKV = W_MQ + (size_t)768 * 256 * 2, W_XQ = W_MKV + (size_t)1024 * 128 * 2, W_XKV = W_XQ + (size_t)512 * 1024 * 2,
                 W_XO = W_XKV + (size_t)1024 * 1024 * 2, W_13 = W_XO + (size_t)1024 * 512 * 2, W_2 = W_13 + (size_t)5632 * 1024 * 2, W_END = W_2 + (size_t)1024 * 2816 * 2;
static_assert(W_END <= 40 * MiB, "weights");
constexpr size_t WS_XB = 40 * MiB, WS_PART = 72 * MiB, WS_PQ = 73 * MiB, WS_PKV = WS_PQ + 256 * 1024, WS_Y = 74 * MiB, WS_R = 122 * MiB;
constexpr size_t R_P = WS_R, R_SI = WS_R + 52 * MiB, R_Q = WS_R + 100 * MiB, R_KM = WS_R + 112 * MiB, R_VT = WS_R + 124 * MiB;
constexpr size_t R_GS = WS_R, R_MS = WS_R + 32 * MiB, R_MG = WS_R + 96 * MiB, R_MEMB = WS_R + 128 * MiB;
constexpr size_t R_MK = WS_R, R_MVT = WS_R + 2 * MiB, R_XQ = WS_R + 32 * MiB, R_XO = WS_R + 48 * MiB, R_H = WS_R;
constexpr size_t WS_END = WS_R + 132 * MiB;
static_assert(WS_END <= 256 * MiB, "ws");

struct Params { const float* in[43]; float* out; unsigned char* ws; };
typedef const __attribute__((address_space(4))) Params* KP;
enum { I_X = 0, I_MEM, I_POS, I_NMIX, I_NXA, I_NMEM, I_NFFN, I_WIN, I_BGATE, I_MU, I_W0, I_WUP, I_A0, I_AUP, I_GUP, I_KK, I_KA, I_RK, I_LNG, I_LNB,
       I_CW, I_CB, I_WA, I_BA, I_WX, I_BX, I_LAM, I_QN, I_WUQ, I_KVN, I_WUKV, I_QG, I_KG, I_WBR, I_WOUT, I_XWQ, I_XWKV, I_XQG, I_XKG, I_XWO, I_W1, I_W3, I_W2 };

__device__ __forceinline__ float rstd16(const float* part, int row) {
    const f32x4* p = (const f32x4*)(part + (size_t)row * 16); const f32x4 a = p[0], b = p[1], c = p[2], d = p[3];
    const float s = ((a.x + a.y) + (a.z + a.w)) + ((b.x + b.y) + (b.z + b.w)) + ((c.x + c.y) + (c.z + c.w)) + ((d.x + d.y) + (d.z + d.w));
    return rsqrtf(s * (1.f / 1024.f) + 1e-6f);
}
__device__ __forceinline__ float rstd4(const float* pp, int row, float invn) { const f32x4 a = *(const f32x4*)(pp + (size_t)row * 4); return rsqrtf(((a.x + a.y) + (a.z + a.w)) * invn + 1e-6f); }
__device__ __forceinline__ float sumsq8(f32x4 a, f32x4 b) { return (a.x * a.x + a.y * a.y) + (a.z * a.z + a.w * a.w) + (b.x * b.x + b.y * b.y) + (b.z * b.z + b.w * b.w); }
#define EPI_HEAD static constexpr bool PERM = true; \
    __device__ __forceinline__ void operator()(const f32x4 (&acc)[2][2][4][2], const pg8::Unit& u, int wr, int wc, int fr, int fq) const
#define EPI_ROWS _Pragma("unroll") for (int ai = 0; ai < 2; ++ai) _Pragma("unroll") for (int m = 0; m < 4; ++m) if ((__builtin_amdgcn_sched_barrier(0), true))
#define EPI_ROW (u.pm * 256 + ai * 128 + wr * 64 + m * 16 + fr)

struct EpiP {
    bf16* P; const float* part; float* pq; float* pkv;
    EPI_HEAD {
        const int col0 = u.pn * 256 + wc * 32 + 8 * fq;
        EPI_ROWS { const int row = EPI_ROW; const float rs = rstd16(part, row); float ss = 0.f;
#pragma unroll
            for (int bj = 0; bj < 2; ++bj) { const f32x4 v0 = acc[ai][bj][m][0] * rs, v1 = acc[ai][bj][m][1] * rs;
                *(u32x4*)(P + (size_t)row * NP + col0 + bj * 128) = pk8(v0, v1);
                if (u.pn == 11 || bj == 0) ss += sumsq8(v0, v1); }
            if (u.pn == 11 || u.pn == 12) { ss += __shfl_xor(ss, 16); ss += __shfl_xor(ss, 32); if (fq == 0) (u.pn == 11 ? pq : pkv)[(size_t)row * 4 + wc] = ss; } }
    }
};
struct EpiQ {
    bf16* Q; const float* pq;
    EPI_HEAD {
        const int col0 = u.pn * 256 + wc * 32 + 8 * fq;
        EPI_ROWS { const int row = EPI_ROW; const float rs = rstd4(pq, row, 1.f / 256.f);
#pragma unroll
            for (int bj = 0; bj < 2; ++bj) *(u32x4*)(Q + (size_t)row * 768 + col0 + bj * 128) = pk8(acc[ai][bj][m][0] * rs, acc[ai][bj][m][1] * rs); }
    }
};
struct EpiKV {
    bf16* Km; bf16* Vt; const float* pkv;
    EPI_HEAD {
        const int j0 = wc * 32 + 8 * fq;
        EPI_ROWS { const int row = EPI_ROW; const float rs = rstd4(pkv, row, 1.f / 128.f);
#pragma unroll
            for (int bj = 0; bj < 2; ++bj) { const int h = 2 * u.pn + bj; const f32x4 v0 = acc[ai][bj][m][0] * rs, v1 = acc[ai][bj][m][1] * rs;
                if (wc < 2) *(u32x4*)(Km + (size_t)row * 768 + h * 96 + j0) = pk8(v0, v1);
                else { const int bl = row >> 11, t = row & 2047; bf16* vp = Vt + ((size_t)(bl * 8 + h) * 64 + (j0 - 64)) * 2048 + t;
                    vp[0 * 2048] = (bf16)f2bf(v0.x); vp[1 * 2048] = (bf16)f2bf(v0.y); vp[2 * 2048] = (bf16)f2bf(v0.z); vp[3 * 2048] = (bf16)f2bf(v0.w);
                    vp[4 * 2048] = (bf16)f2bf(v1.x); vp[5 * 2048] = (bf16)f2bf(v1.y); vp[6 * 2048] = (bf16)f2bf(v1.z); vp[7 * 2048] = (bf16)f2bf(v1.w); } } }
    }
};
struct EpiGate {
    bf16* GS; const float* part; const float* bg;
    EPI_HEAD {
        const int col0 = u.pn * 256 + wc * 32 + 8 * fq;
        f32x4 b0[2], b1[2];
#pragma unroll
        for (int bj = 0; bj < 2; ++bj) { b0[bj] = *(const f32x4*)(bg + col0 + bj * 128); b1[bj] = *(const f32x4*)(bg + col0 + bj * 128 + 4); }
        EPI_ROWS { const int row = EPI_ROW; const float rs = rstd16(part, row);
#pragma unroll
            for (int bj = 0; bj < 2; ++bj) { f32x4 v0 = acc[ai][bj][m][0] * rs + b0[bj], v1 = acc[ai][bj][m][1] * rs + b1[bj];
#pragma unroll
                for (int e = 0; e < 4; ++e) { v0[e] = sigmoidf_(v0[e]); v1[e] = sigmoidf_(v1[e]); }
                *(u32x4*)(GS + (size_t)row * 1024 + col0 + bj * 128) = pk8(v0, v1); } }
    }
};
struct EpiProj {
    const bf16* GS; float* MS; bf16* MG; int n;
    EPI_HEAD {
        const int col0 = u.pn * 256 + wc * 32 + 8 * fq;
        EPI_ROWS { const int row = EPI_ROW;
#pragma unroll
            for (int bj = 0; bj < 2; ++bj) { const size_t o = (size_t)row * 1024 + col0 + bj * 128; const u32x4 gw = *(const u32x4*)(GS + o);
                f32x4 v0 = acc[ai][bj][m][0], v1 = acc[ai][bj][m][1];
                v0.x *= bflo(gw.x); v0.y *= bfhi(gw.x); v0.z *= bflo(gw.y); v0.w *= bfhi(gw.y); v1.x *= bflo(gw.z); v1.y *= bfhi(gw.z); v1.z *= bflo(gw.w); v1.w *= bfhi(gw.w);
                if (n > 0) { v0 += *(const f32x4*)(MS + o); v1 += *(const f32x4*)(MS + o + 4); }
                if (n < 2) { *(f32x4*)(MS + o) = v0; *(f32x4*)(MS + o + 4) = v1; } else *(u32x4*)(MG + o) = pk8(v0, v1); } }
    }
};
struct EpiRes {
    const float* xold; float* xout; bf16* xb; float* part;
    EPI_HEAD {
        const int col0 = u.pn * 256 + wc * 32 + 8 * fq;
        EPI_ROWS { const int row = EPI_ROW; float ss = 0.f;
#pragma unroll
            for (int bj = 0; bj < 2; ++bj) { const size_t o = (size_t)row * 1024 + col0 + bj * 128;
                const f32x4 v0 = acc[ai][bj][m][0] + *(const f32x4*)(xold + o), v1 = acc[ai][bj][m][1] + *(const f32x4*)(xold + o + 4);
                *(f32x4*)(xout + o) = v0; *(f32x4*)(xout + o + 4) = v1; *(u32x4*)(xb + o) = pk8(v0, v1); ss += sumsq8(v0, v1); }
            ss += __shfl_xor(ss, 16); ss += __shfl_xor(ss, 32); if (fq == 0) part[(size_t)row * 16 + u.pn * 4 + wc] = ss; }
    }
};
struct EpiXQ {
    bf16* Q; const float* part;
    EPI_HEAD {
        const int col0 = u.pn * 256 + wc * 32 + 8 * fq;
        EPI_ROWS { const int row = EPI_ROW; const float rs = rstd16(part, row);
#pragma unroll
            for (int bj = 0; bj < 2; ++bj) *(u32x4*)(Q + (size_t)row * 512 + col0 + bj * 128) = pk8(acc[ai][bj][m][0] * rs, acc[ai][bj][m][1] * rs); }
    }
};
struct EpiMemKV {
    bf16* mk; bf16* mVt;
    EPI_HEAD {
        const int j0 = wc * 32 + 8 * fq, h = u.pn;
        EPI_ROWS { const int row = EPI_ROW;
            *(u32x4*)(mk + (size_t)row * 512 + h * 128 + j0) = pk8(acc[ai][0][m][0], acc[ai][0][m][1]);
            const f32x4 v0 = acc[ai][1][m][0], v1 = acc[ai][1][m][1]; const int b = row >> 8, key = row & 255;
            bf16* vp = mVt + ((size_t)(b * 4 + h) * 128 + j0) * 256 + key;
            vp[0 * 256] = (bf16)f2bf(v0.x); vp[1 * 256] = (bf16)f2bf(v0.y); vp[2 * 256] = (bf16)f2bf(v0.z); vp[3 * 256] = (bf16)f2bf(v0.w);
            vp[4 * 256] = (bf16)f2bf(v1.x); vp[5 * 256] = (bf16)f2bf(v1.y); vp[6 * 256] = (bf16)f2bf(v1.z); vp[7 * 256] = (bf16)f2bf(v1.w); }
    }
};
struct EpiFFN1 {
    bf16* H; const float* part;
    EPI_HEAD {
        const int hc0 = (u.pn * 256 + wc * 32 + 8 * fq) >> 1;
        EPI_ROWS { const int row = EPI_ROW; const float rs = rstd16(part, row);
#pragma unroll
            for (int bj = 0; bj < 2; ++bj) { const f32x4 a1 = acc[ai][bj][m][0] * rs, a3 = acc[ai][bj][m][1] * rs; f32x4 hv;
#pragma unroll
                for (int e = 0; e < 4; ++e) hv[e] = a1[e] * sigmoidf_(a1[e]) * a3[e];
                u32x2 w; w.x = pk2(hv.x, hv.y); w.y = pk2(hv.z, hv.w);
                *(u32x2*)(H + (size_t)row * DFF + hc0 + bj * 64) = w; } }
    }
};

__device__ __forceinline__ void conv_job(const float* W, int ldw, int c0, int nblk, int kblk, const float* gain, bf16* WT, int K, int mode, float* scr, int gw, int NGW, int lane) {
    const int nitems = nblk * kblk;
    for (int it = gw; it < nitems; it += NGW) {
        const int kb = it / nblk, nb = it % nblk, k0 = 64 * kb, n0 = 32 * nb;
#pragma unroll 8
        for (int i = 0; i < 32; ++i) { const int kk = 2 * i + (lane >> 5); float v = W[(size_t)(k0 + kk) * ldw + c0 + n0 + (lane & 31)]; if (gain) v *= gain[k0 + kk]; scr[kk * 33 + (lane & 31)] = v; }
        __builtin_amdgcn_wave_barrier();
        const int c = lane & 7;
#pragma unroll
        for (int j = 0; j < 4; ++j) { const int n = n0 + (lane >> 3) + 8 * j; const float* s = scr + (8 * c) * 33 + (n - n0);
            u32x4 o; o.x = pk2(s[0 * 33], s[1 * 33]); o.y = pk2(s[2 * 33], s[3 * 33]); o.z = pk2(s[4 * 33], s[5 * 33]); o.w = pk2(s[6 * 33], s[7 * 33]);
            const int dr = mode == 0 ? n : (8 * (n >> 2) + (n & 3) + (mode == 2 ? 4 : 0));
            *(u32x4*)(WT + (size_t)dr * K + k0 + 8 * c) = o; }
        __builtin_amdgcn_wave_barrier();
    }
}

__device__ __forceinline__ void phase_convert(int wid_s, KP p_, int l, float* ldsf) {
    KP p = p_; asm volatile("" : "+s"(p));
    unsigned char* ws = p->ws;
    const int tid_ = mk_tid(wid_s);
    const int tid = tid_, lane = tid & 63, wv = tid >> 6;
    const int gw = blockIdx.x * 8 + wv, NGW = gridDim.x * 8;
    float* scr = ldsf + wv * (64 * 33);
    const float* nmix = p->in[I_NMIX] + l * 1024;
    conv_job(p->in[I_WIN] + (size_t)l * 1024 * DIN, DIN, 0, 101, 16, nmix, (bf16*)(ws + W_IN), 1024, 0, scr, gw, NGW, lane);
    conv_job(p->in[I_WIN] + (size_t)l * 1024 * DIN, DIN, 3232, 96, 16, nmix, (bf16*)(ws + W_GATE), 1024, 0, scr, gw, NGW, lane);
    for (int n = 0; n < 3; ++n) conv_job(p->in[I_WBR] + ((size_t)l * 3 + n) * 512 * 1024, 1024, 0, 32, 8, nullptr, (bf16*)(ws + W_BR) + (size_t)n * 1024 * 512, 512, 0, scr, gw, NGW, lane);
    conv_job(p->in[I_WOUT] + (size_t)l * 1024 * 1024, 1024, 0, 32, 16, nullptr, (bf16*)(ws + W_OUT), 1024, 0, scr, gw, NGW, lane);
    conv_job(p->in[I_WUQ] + (size_t)l * 256 * 768, 768, 0, 24, 4, p->in[I_QN] + l * 256, (bf16*)(ws + W_MQ), 256, 0, scr, gw, NGW, lane);
    conv_job(p->in[I_WUKV] + (size_t)l * 128 * 1024, 1024, 0, 32, 2, p->in[I_KVN] + l * 128, (bf16*)(ws + W_MKV), 128, 0, scr, gw, NGW, lane);
    conv_job(p->in[I_XWQ] + (size_t)l * 1024 * 512, 512, 0, 16, 16, p->in[I_NXA] + l * 1024, (bf16*)(ws + W_XQ), 1024, 0, scr, gw, NGW, lane);
    conv_job(p->in[I_XWKV] + (size_t)l * 1024 * 1024, 1024, 0, 32, 16, p->in[I_NMEM] + l * 1024, (bf16*)(ws + W_XKV), 1024, 0, scr, gw, NGW, lane);
    conv_job(p->in[I_XWO] + (size_t)l * 512 * 1024, 1024, 0, 32, 8, nullptr, (bf16*)(ws + W_XO), 512, 0, scr, gw, NGW, lane);
    conv_job(p->in[I_W1] + (size_t)l * 1024 * DFF, DFF, 0, 88, 16, p->in[I_NFFN] + l * 1024, (bf16*)(ws + W_13), 1024, 1, scr, gw, NGW, lane);
    conv_job(p->in[I_W3] + (size_t)l * 1024 * DFF, DFF, 0, 88, 16, p->in[I_NFFN] + l * 1024, (bf16*)(ws + W_13), 1024, 2, scr, gw, NGW, lane);
    conv_job(p->in[I_W2] + (size_t)l * DFF * 1024, 1024, 0, 32, 44, nullptr, (bf16*)(ws + W_2), DFF, 0, scr, gw, NGW, lane);
    { u32x4* z = (u32x4*)((bf16*)(ws + W_IN) + (size_t)3232 * 1024); const int n16 = 96 * 1024 * 2 / 16;
      unsigned zz = 0u; asm volatile("" : "+v"(zz)); const u32x4 zv = {zz, zz, zz, zz};
      for (int i = blockIdx.x * 512 + tid; i < n16; i += gridDim.x * 512) z[i] = zv; }
    if (l == 0) {
        const float* x = p->in[I_X]; bf16* xb = (bf16*)(ws + WS_XB); float* part = (float*)(ws + WS_PART);
        for (int row = gw; row < T; row += NGW) {
            const f32x4* xr = (const f32x4*)(x + (size_t)row * 1024) + lane; float s = 0.f;
#pragma unroll
            for (int j = 0; j < 4; ++j) { const f32x4 v = xr[64 * j]; s += (v.x * v.x + v.y * v.y) + (v.z * v.z + v.w * v.w);
                u32x2 w; w.x = pk2(v.x, v.y); w.y = pk2(v.z, v.w); *((u32x2*)(xb + (size_t)row * 1024) + lane + 64 * j) = w; }
            s = wave_sum(s);
            if (lane < 16) part[(size_t)row * 16 + lane] = lane == 0 ? s : 0.f;
        }
    }
}

__device__ __forceinline__ void rope_cs(int pos, int i, float& c, float& s) {
    const float invf = exp2f(-(float)i * 0.8304820237218406f);
    const float ang = (float)pos * invf;
    const double x = (double)ang * 0.15915494309189535; const float f = (float)(x - rint(x));
    c = __builtin_amdgcn_cosf(f); s = __builtin_amdgcn_sinf(f);
}
template <int DQK, int DV, bool CAUSAL, bool MLA>
__device__ __forceinline__ void attn_unit(int wid_s, unsigned char* lds, const bf16* Qb, int ldq, const bf16* Kb, int ldk, const bf16* Vtb, int ldv, bf16* Ob, int ldo,
                                          int q0, int nkt, const float* qgain, const int* pos, float qscale) {
    constexpr int KS = DQK * 2 + 16, VS = 144, NKS = DQK / 32, NDT = DV / 16, KCH = DQK / 8, NKC = (64 * KCH + 511) / 512, NVC = DV * 8 / 512;
    unsigned char* Ks = lds; unsigned char* Vs = lds + 64 * KS;
    const int tid_ = mk_tid(wid_s);
    const int tid = tid_, lane = tid & 63, wv = tid >> 6, g = lane >> 4, j = lane & 15;
    const int qrow = q0 + wv * 16 + j;
    bf16x8 qf[NKS];
    {
        float qv[NKS][8]; float ss = 0.f;
#pragma unroll
        for (int ks = 0; ks < NKS; ++ks) { const u32x4 w = *(const u32x4*)(Qb + (size_t)qrow * ldq + 32 * ks + 8 * g);
            qv[ks][0] = bflo(w.x); qv[ks][1] = bfhi(w.x); qv[ks][2] = bflo(w.y); qv[ks][3] = bfhi(w.y); qv[ks][4] = bflo(w.z); qv[ks][5] = bfhi(w.z); qv[ks][6] = bflo(w.w); qv[ks][7] = bfhi(w.w);
#pragma unroll
            for (int e = 0; e < 8; ++e) ss += qv[ks][e] * qv[ks][e]; }
        ss += __shfl_xor(ss, 16); ss += __shfl_xor(ss, 32);
        const float rs = rsqrtf(ss * (1.f / DQK) + 1e-6f);
#pragma unroll
        for (int ks = 0; ks < NKS; ++ks)
#pragma unroll
            for (int e = 0; e < 8; ++e) qv[ks][e] *= rs * qgain[32 * ks + 8 * g + e];
        if (MLA) {
            const int ps = pos[qrow];
#pragma unroll
            for (int e = 0; e < 8; ++e) { const float mine = qv[2][e], other = __shfl_xor(mine, 32); float c, s; rope_cs(ps, 8 * (g & 1) + e, c, s);
                qv[2][e] = (g < 2) ? (mine * c - other * s) : (mine * c + other * s); }
        }
#pragma unroll
        for (int ks = 0; ks < NKS; ++ks) { u32x4 w; w.x = pk2(qv[ks][0] * qscale, qv[ks][1] * qscale); w.y = pk2(qv[ks][2] * qscale, qv[ks][3] * qscale);
            w.z = pk2(qv[ks][4] * qscale, qv[ks][5] * qscale); w.w = pk2(qv[ks][6] * qscale, qv[ks][7] * qscale); qf[ks] = __builtin_bit_cast(bf16x8, w); }
    }
    f32x4 oT[NDT];
#pragma unroll
    for (int d = 0; d < NDT; ++d) oT[d] = (f32x4){0.f, 0.f, 0.f, 0.f};
    float mrun = -INFINITY, lsum = 0.f;
    u32x4 kreg[NKC], vreg[NVC];
#define ATT_PREFETCH(kt) do { _Pragma("unroll") for (int i = 0; i < NKC; ++i) { const int idx = tid + 512 * i; if (idx < 64 * KCH) { const int key = idx / KCH, ch = idx % KCH; \
            kreg[i] = *(const u32x4*)(Kb + (size_t)(64 * (kt) + key) * ldk + ch * 8); } } \
        _Pragma("unroll") for (int i = 0; i < NVC; ++i) { const int idx = tid + 512 * i; const int dv = idx >> 3, ch = idx & 7; vreg[i] = *(const u32x4*)(Vtb + (size_t)dv * ldv + 64 * (kt) + ch * 8); } } while (0)
    ATT_PREFETCH(0);
    for (int kt = 0; kt < nkt; ++kt) {
        __syncthreads();
#pragma unroll
        for (int i = 0; i < NKC; ++i) { const int idx = tid + 512 * i; if (idx < 64 * KCH) { const int key = idx / KCH, ch = idx % KCH; *(u32x4*)(Ks + key * KS + ch * 16) = kreg[i]; } }
#pragma unroll
        for (int i = 0; i < NVC; ++i) { const int idx = tid + 512 * i; const int dv = idx >> 3, ch = idx & 7; *(u32x4*)(Vs + dv * VS + ch * 16) = vreg[i]; }
        __syncthreads();
        if (kt + 1 < nkt) ATT_PREFETCH(kt + 1);
        const int qw0 = q0 + wv * 16;
        if (CAUSAL && 64 * kt > qw0 + 15) continue;
        f32x4 sT[4];
#pragma unroll
        for (int k4 = 0; k4 < 4; ++k4) { sT[k4] = (f32x4){0.f, 0.f, 0.f, 0.f};
#pragma unroll
            for (int ks = 0; ks < NKS; ++ks) { const bf16x8 a = *(const bf16x8*)(Ks + (16 * k4 + j) * KS + (32 * ks + 8 * g) * 2);
                sT[k4] = __builtin_amdgcn_mfma_f32_16x16x32_bf16(a, qf[ks], sT[k4], 0, 0, 0); } }
        if (CAUSAL && 64 * kt + 63 > qw0) {
#pragma unroll
            for (int k4 = 0; k4 < 4; ++k4)
#pragma unroll
                for (int r = 0; r < 4; ++r) if (64 * kt + 16 * k4 + 4 * g + r > qrow) sT[k4][r] = -INFINITY;
        }
        float mx = -INFINITY;
#pragma unroll
        for (int k4 = 0; k4 < 4; ++k4) mx = fmaxf(mx, fmaxf(fmaxf(sT[k4][0], sT[k4][1]), fmaxf(sT[k4][2], sT[k4][3])));
        mx = fmaxf(mx, __shfl_xor(mx, 16)); mx = fmaxf(mx, __shfl_xor(mx, 32));
        const float mnew = fmaxf(mrun, mx); const float alpha = __builtin_amdgcn_exp2f(mrun - mnew); mrun = mnew;
        float psum = 0.f;
#pragma unroll
        for (int k4 = 0; k4 < 4; ++k4)
#pragma unroll
            for (int r = 0; r < 4; ++r) { const float pv = __builtin_amdgcn_exp2f(sT[k4][r] - mnew); sT[k4][r] = pv; psum += pv; }
        lsum = lsum * alpha + psum;
#pragma unroll
        for (int d = 0; d < NDT; ++d) oT[d] *= alpha;
#pragma unroll
        for (int kc = 0; kc < 2; ++kc) {
            const bf16x8 pb = __builtin_bit_cast(bf16x8, pk8(sT[2 * kc], sT[2 * kc + 1]));
#pragma unroll
            for (int d = 0; d < NDT; ++d) { const unsigned char* vp = Vs + (16 * d + j) * VS + (32 * kc + 4 * g) * 2;
                const u32x2 lo = *(const u32x2*)vp, hi = *(const u32x2*)(vp + 32); u32x4 w; w.x = lo.x; w.y = lo.y; w.z = hi.x; w.w = hi.y;
                oT[d] = __builtin_amdgcn_mfma_f32_16x16x32_bf16(__builtin_bit_cast(bf16x8, w), pb, oT[d], 0, 0, 0); }
        }
    }
#undef ATT_PREFETCH
    lsum += __shfl_xor(lsum, 16); lsum += __shfl_xor(lsum, 32);
    const float inv = 1.f / lsum;
#pragma unroll
    for (int d = 0; d < NDT; ++d) { u32x2 w; w.x = pk2(oT[d][0] * inv, oT[d][1] * inv); w.y = pk2(oT[d][2] * inv, oT[d][3] * inv);
        *(u32x2*)(Ob + (size_t)qrow * ldo + 16 * d + 4 * g) = w; }
}

__device__ __forceinline__ void rwkv_prep_tile(int wid_s, KP p_, int l, int tile, float* ldsf) {
    KP p = p_; asm volatile("" : "+s"(p));
    unsigned char* ws = p->ws;
    const int tid_ = mk_tid(wid_s);
    const int tid = tid_, lane = tid & 63, wv = tid >> 6;
    const bf16* P = (const bf16*)(ws + R_P); bf16* SI = (bf16*)(ws + R_SI);
    const float* mu = p->in[I_MU] + l * 1792;
    const int row0 = tile * 32;
    float* s_w = ldsf; float* s_a = ldsf + 32 * 64;
    __syncthreads();
    for (int e = tid; e < 32 * 128; e += 512) { const int t = e >> 7, jj = e & 127, row = row0 + t, col = 1536 + jj;
        const float cur = bf2f(P[(size_t)row * NP + col]); const float prev = ((row & 2047) == 0) ? 0.f : bf2f(P[(size_t)(row - 1) * NP + col]);
        const float mm = cur + (prev - cur) * mu[col];
        if (jj < 64) s_w[t * 64 + jj] = tanhf(mm); else s_a[t * 64 + (jj - 64)] = mm; }
    __syncthreads();
    float aw[32], aa[32];
#pragma unroll
    for (int t = 0; t < 32; ++t) { aw[t] = 0.f; aa[t] = 0.f; }
    const float* wup = p->in[I_WUP] + (size_t)l * 64 * 512 + tid; const float* aup = p->in[I_AUP] + (size_t)l * 64 * 512 + tid;
    for (int jj = 0; jj < 64; jj += 4) {
        const float w0 = wup[(jj + 0) * 512], w1 = wup[(jj + 1) * 512], w2 = wup[(jj + 2) * 512], w3 = wup[(jj + 3) * 512];
        const float a0 = aup[(jj + 0) * 512], a1 = aup[(jj + 1) * 512], a2 = aup[(jj + 2) * 512], a3 = aup[(jj + 3) * 512];
#pragma unroll
        for (int t = 0; t < 32; ++t) { const f32x4 sw = *(const f32x4*)(s_w + t * 64 + jj), sa = *(const f32x4*)(s_a + t * 64 + jj);
            aw[t] += (sw.x * w0 + sw.y * w1) + (sw.z * w2 + sw.w * w3); aa[t] += (sa.x * a0 + sa.y * a1) + (sa.z * a2 + sa.w * a3); }
    }
    const int c = tid, h = wv;
    const float w0c = p->in[I_W0][l * 512 + c], a0c = p->in[I_A0][l * 512 + c], kkc = p->in[I_KK][l * 512 + c], kac = p->in[I_KA][l * 512 + c];
    const float mur = mu[c], muk = mu[512 + c], muv = mu[1024 + c];
#pragma unroll
    for (int t = 0; t < 32; ++t) {
        const int row = row0 + t; const bool first = (row & 2047) == 0;
        const bf16* pr = P + (size_t)row * NP; const bf16* pp = pr - NP;
        const float rc = bf2f(pr[c]), kc = bf2f(pr[512 + c]), vc = bf2f(pr[1024 + c]);
        const float rp = first ? 0.f : bf2f(pp[c]), kp = first ? 0.f : bf2f(pp[512 + c]), vp = first ? 0.f : bf2f(pp[1024 + c]);
        const float r = rc + (rp - rc) * mur, k = kc + (kp - kc) * muk, v = vc + (vp - vc) * muv;
        const float z = w0c + aw[t]; const float om = 1.f - __expf(-0.6065306597126334f * sigmoidf_(z));
        const float a = sigmoidf_(a0c + aa[t]);
        const float kkr = k * kkc; const float ss = wave_sum(kkr * kkr); const float kk = kkr / fmaxf(sqrtf(ss), 1e-12f);
        const float k2 = k * (1.f + (a - 1.f) * kac);
        bf16* o = SI + ((size_t)((row >> 11) * 8 + h) * 2048 + (row & 2047)) * 384 + lane;
        o[0] = (bf16)f2bf(r); o[64] = (bf16)f2bf(om); o[128] = (bf16)f2bf(k2); o[192] = (bf16)f2bf(kk); o[256] = (bf16)f2bf(kk * a); o[320] = (bf16)f2bf(v);
    }
}

template <int CTRL> __device__ __forceinline__ float dppf(float x) { return __builtin_bit_cast(float, __builtin_amdgcn_update_dpp(0, __builtin_bit_cast(int, x), CTRL, 0xF, 0xF, true)); }
__device__ __forceinline__ float allreduce16(float x) { x += dppf<0xB1>(x); x += dppf<0x4E>(x); x += dppf<0x141>(x); x += dppf<0x140>(x); return x; }
__device__ __forceinline__ void rwkv_scan_unit(int wid_s, const bf16* SIbh, bf16* Yb, int quarter, float* ldsf) {
    const int tid_ = mk_tid(wid_s);
    const int tid = tid_, lane = tid & 63, wv = tid >> 6;
    u32x4 pre[3];
#pragma unroll
    for (int i = 0; i < 3; ++i) pre[i] = *(const u32x4*)(SIbh + (size_t)(tid + 512 * i) * 8);
    f32x2 Sa = {0.f, 0.f}, Sb = {0.f, 0.f};
    const int rowl = quarter * 16 + (wv & 3) * 4 + (lane >> 4), c4 = (lane & 15) * 4;
    __syncthreads();
    for (int ch = 0; ch < 64; ++ch) {
        float* B = ldsf + (ch & 1) * (32 * 384);
#pragma unroll
        for (int i = 0; i < 3; ++i) { float* d = B + (tid + 512 * i) * 8; const u32x4 w = pre[i];
            *(f32x4*)d = (f32x4){bflo(w.x), bfhi(w.x), bflo(w.y), bfhi(w.y)}; *(f32x4*)(d + 4) = (f32x4){bflo(w.z), bfhi(w.z), bflo(w.w), bfhi(w.w)}; }
        if (ch + 1 < 64) {
#pragma unroll
            for (int i = 0; i < 3; ++i) pre[i] = *(const u32x4*)(SIbh + (size_t)(ch + 1) * (32 * 384) + (size_t)(tid + 512 * i) * 8);
        }
        __syncthreads();
        if (wv < 4) {
            const float* q = B;
            f32x4 r4 = *(const f32x4*)(q + c4), om4 = *(const f32x4*)(q + 64 + c4), k4 = *(const f32x4*)(q + 128 + c4), kk4 = *(const f32x4*)(q + 192 + c4), ka4 = *(const f32x4*)(q + 256 + c4);
            float v = q[320 + rowl];
            float ykeep = 0.f;
#pragma unroll
            for (int s = 0; s < 32; ++s) {
                const float* qn = B + ((s + 1) & 31) * 384;
                const f32x4 nr4 = *(const f32x4*)(qn + c4), nom4 = *(const f32x4*)(qn + 64 + c4), nk4 = *(const f32x4*)(qn + 128 + c4), nkk4 = *(const f32x4*)(qn + 192 + c4), nka4 = *(const f32x4*)(qn + 256 + c4);
                const float nv = qn[320 + rowl];
                const f32x2 pa = Sa * (f32x2){kk4.x, kk4.y} + Sb * (f32x2){kk4.z, kk4.w};
                float sa = allreduce16(pa.x + pa.y);
                Sa = Sa - Sa * (f32x2){om4.x, om4.y} + (f32x2){k4.x, k4.y} * v; Sb = Sb - Sb * (f32x2){om4.z, om4.w} + (f32x2){k4.z, k4.w} * v;
                Sa = Sa - (f32x2){ka4.x, ka4.y} * sa; Sb = Sb - (f32x2){ka4.z, ka4.w} * sa;
                const f32x2 py = Sa * (f32x2){r4.x, r4.y} + Sb * (f32x2){r4.z, r4.w};
                const float y = allreduce16(py.x + py.y);
                ykeep = ((lane & 15) == (s & 15)) ? y : ykeep;
                if ((s & 15) == 15) Yb[(size_t)(ch * 32 + (s & 16) + (lane & 15)) * 1536 + rowl] = (bf16)f2bf(ykeep);
                r4 = nr4; om4 = nom4; k4 = nk4; kk4 = nkk4; ka4 = nka4; v = nv;
            }
        }
    }
    __syncthreads();
}

__device__ __forceinline__ void rwkv_post_tile(int wid_s, KP p_, int l, int r, int tile, float* ldsf) {
    KP p = p_; asm volatile("" : "+s"(p));
    unsigned char* ws = p->ws;
    const int tid_ = mk_tid(wid_s);
    const int tid = tid_, lane = tid & 63, wv = tid >> 6;
    const bf16* P = (const bf16*)(ws + R_P); const bf16* SI = (const bf16*)(ws + R_SI); bf16* Y = (bf16*)(ws + WS_Y) + (size_t)r * TH * 1536;
    const float* mu = p->in[I_MU] + l * 1792;
    const int row0 = tile * 32;
    float* s_g = ldsf;
    __syncthreads();
    for (int e = tid; e < 32 * 128; e += 512) { const int t = e >> 7, jj = e & 127, row = row0 + t, col = 1664 + jj;
        const float cur = bf2f(P[(size_t)row * NP + col]); const float prev = ((row & 2047) == 0) ? 0.f : bf2f(P[(size_t)(row - 1) * NP + col]);
        s_g[e] = sigmoidf_(cur + (prev - cur) * mu[col]); }
    __syncthreads();
    float ag[32];
#pragma unroll
    for (int t = 0; t < 32; ++t) ag[t] = 0.f;
    const float* gup = p->in[I_GUP] + (size_t)l * 128 * 512 + tid;
    for (int jj = 0; jj < 128; jj += 4) {
        const float g0 = gup[(jj + 0) * 512], g1 = gup[(jj + 1) * 512], g2 = gup[(jj + 2) * 512], g3 = gup[(jj + 3) * 512];
#pragma unroll
        for (int t = 0; t < 32; ++t) { const f32x4 sg = *(const f32x4*)(s_g + t * 128 + jj); ag[t] += (sg.x * g0 + sg.y * g1) + (sg.z * g2 + sg.w * g3); }
    }
    const int c = tid, h = wv;
    const float rkc = p->in[I_RK][l * 512 + c], lng = p->in[I_LNG][l * 512 + c], lnb = p->in[I_LNB][l * 512 + c];
#pragma unroll
    for (int t = 0; t < 32; ++t) {
        const int row = row0 + t;
        const bf16* si = SI + ((size_t)((row >> 11) * 8 + h) * 2048 + (row & 2047)) * 384 + lane;
        const float rr = bf2f(si[0]), k2 = bf2f(si[128]), v = bf2f(si[320]);
        bf16* yp = Y + (size_t)row * 1536 + c;
        const float y = bf2f(*yp);
        const float mean = wave_sum(y) * (1.f / 64.f); const float d = y - mean; const float var = wave_sum(d * d) * (1.f / 64.f);
        const float yn = d * rsqrtf(var + 64e-5f) * lng + lnb;
        const float bonus = wave_sum(rr * k2 * rkc) * v;
        *yp = (bf16)f2bf((yn + bonus) * ag[t]);
    }
}

__device__ __forceinline__ float fsig(float x) { return __builtin_amdgcn_rcpf(1.f + __builtin_amdgcn_exp2f(-1.4426950408889634f * x)); }
__device__ __forceinline__ float gelu_tanh(float x) { const float u = 0.7978845608028654f * (x + 0.044715f * x * x * x); return x * fsig(2.f * u); }
__device__ __forceinline__ void lru_unit(int wid_s, KP p_, int l, int r, int bl, int n, float* ldsf) {
    KP p = p_; asm volatile("" : "+s"(p));
    unsigned char* ws = p->ws;
    const int tid_ = mk_tid(wid_s);
    const int tid = tid_, lane = tid & 63, wv = tid >> 6, g = lane >> 4, j = lane & 15;
    const bf16* P = (const bf16*)(ws + R_P) + (size_t)bl * 2048 * NP; bf16* Yb = (bf16*)(ws + WS_Y) + ((size_t)(r * 4 + bl) * 2048) * 1536 + 512;
    const int cg_ = n * 64 + lane;
    float* s_xc = ldsf;
    float* s_a = ldsf + 8192;
    float* s_u = ldsf + 16384;
    float* s_AH = ldsf + 24576;
    unsigned char* s_xb16 = (unsigned char*)ldsf + 102400;
    unsigned char* s_wt16 = (unsigned char*)ldsf + 120832;
    __syncthreads();
    for (int e = tid; e < 8192; e += 512) { const int jj = e >> 6, ii = e & 63;
        const float w = (jj < 64) ? p->in[I_WA][((size_t)l * 8 + n) * 4096 + ii * 64 + jj] : p->in[I_WX][((size_t)l * 8 + n) * 4096 + ii * 64 + (jj - 64)];
        *(bf16*)(s_wt16 + (jj * 72 + ii) * 2) = (bf16)f2bf(w); }
    const float cw0 = p->in[I_CW][(l * 4 + 0) * 512 + cg_], cw1 = p->in[I_CW][(l * 4 + 1) * 512 + cg_], cw2 = p->in[I_CW][(l * 4 + 2) * 512 + cg_], cw3 = p->in[I_CW][(l * 4 + 3) * 512 + cg_];
    const float cb = p->in[I_CB][l * 512 + cg_];
    float ba4[4], bx4[4], sp4[4];
#pragma unroll
    for (int n4 = 0; n4 < 4; ++n4) { const int c = n * 64 + 16 * n4 + j; ba4[n4] = p->in[I_BA][l * 512 + c]; bx4[n4] = p->in[I_BX][l * 512 + c];
        sp4[n4] = -8.f * 1.4426950408889634f * log1pf(__expf(-p->in[I_LAM][l * 512 + c])); }
    float hcar = 0.f;
    for (int tile = 0; tile < 16; ++tile) {
        const int t0 = tile * 128 + wv * 16;
        float xc[16]; unsigned short gbr[16];
        {
            float x3 = (t0 >= 3) ? bf2f(P[(size_t)(t0 - 3) * NP + 1792 + cg_]) : 0.f, x2 = (t0 >= 2) ? bf2f(P[(size_t)(t0 - 2) * NP + 1792 + cg_]) : 0.f, x1 = (t0 >= 1) ? bf2f(P[(size_t)(t0 - 1) * NP + 1792 + cg_]) : 0.f;
#pragma unroll
            for (int i = 0; i < 16; ++i) { const float x0 = bf2f(P[(size_t)(t0 + i) * NP + 1792 + cg_]);
                xc[i] = cw0 * x3 + cw1 * x2 + cw2 * x1 + cw3 * x0 + cb; x3 = x2; x2 = x1; x1 = x0; }
#pragma unroll
            for (int i = 0; i < 16; ++i) gbr[i] = P[(size_t)(t0 + i) * NP + 2304 + cg_];
        }
        __syncthreads();
#pragma unroll
        for (int i = 0; i < 16; ++i) { s_xc[(wv * 16 + i) * 64 + lane] = xc[i]; *(bf16*)(s_xb16 + ((wv * 16 + i) * 72 + lane) * 2) = (bf16)f2bf(xc[i]); }
        __syncthreads();
        {
            f32x4 acc[8];
            const bf16x8 a0 = *(const bf16x8*)(s_xb16 + ((16 * wv + j) * 72 + 8 * g) * 2), a1 = *(const bf16x8*)(s_xb16 + ((16 * wv + j) * 72 + 32 + 8 * g) * 2);
#pragma unroll
            for (int nn = 0; nn < 8; ++nn) { acc[nn] = (f32x4){0.f, 0.f, 0.f, 0.f};
                const bf16x8 b0 = *(const bf16x8*)(s_wt16 + ((16 * nn + j) * 72 + 8 * g) * 2), b1 = *(const bf16x8*)(s_wt16 + ((16 * nn + j) * 72 + 32 + 8 * g) * 2);
                acc[nn] = __builtin_amdgcn_mfma_f32_16x16x32_bf16(a0, b0, acc[nn], 0, 0, 0); acc[nn] = __builtin_amdgcn_mfma_f32_16x16x32_bf16(a1, b1, acc[nn], 0, 0, 0); }
#pragma unroll
            for (int n4 = 0; n4 < 4; ++n4)
#pragma unroll
                for (int rr = 0; rr < 4; ++rr) { const int tk = 16 * wv + 4 * g + rr, c = 16 * n4 + j;
                    const float rg = fsig(acc[n4][rr] + ba4[n4]), ig = fsig(acc[n4 + 4][rr] + bx4[n4]);
                    const float a = __builtin_amdgcn_exp2f(sp4[n4] * rg);
                    const float uu = __builtin_amdgcn_sqrtf(fmaxf(1.f - a * a, 0.f)) * (ig * s_xc[tk * 64 + c]);
                    s_a[tk * 64 + c] = a; s_u[tk * 64 + c] = uu; }
        }
        __syncthreads();
        float av[16], uv[16]; float A = 1.f, H = 0.f;
#pragma unroll
        for (int i = 0; i < 16; ++i) { av[i] = s_a[(wv * 16 + i) * 64 + lane]; uv[i] = s_u[(wv * 16 + i) * 64 + lane]; A *= av[i]; H = av[i] * H + uv[i]; }
        s_AH[(wv * 64 + lane) * 2] = A; s_AH[(wv * 64 + lane) * 2 + 1] = H;
        __syncthreads();
        float hin = hcar, hall = hcar;
#pragma unroll
        for (int w = 0; w < 8; ++w) { const float Aw = s_AH[(w * 64 + lane) * 2], Hw = s_AH[(w * 64 + lane) * 2 + 1]; hall = Aw * hall + Hw; if (w < wv) hin = hall; }
        hcar = hall;
        float hh = hin;
#pragma unroll
        for (int i = 0; i < 16; ++i) { hh = av[i] * hh + uv[i];
            Yb[(size_t)(t0 + i) * 1536 + cg_] = (bf16)f2bf(hh * gelu_tanh(bf2f(gbr[i]))); }
    }
    __syncthreads();
}

__device__ __forceinline__ void kfix_rows(int wid_s, KP p_, int l, int r) {
    KP p = p_; asm volatile("" : "+s"(p));
    unsigned char* ws = p->ws;
    const int tid_ = mk_tid(wid_s);
    const int tid = tid_, lane = tid & 63, wv = tid >> 6, h = lane >> 3, sub = lane & 7;
    const bf16* P = (const bf16*)(ws + R_P); bf16* Km = (bf16*)(ws + R_KM);
    const float* kg = p->in[I_KG] + l * 96; const int* pos = (const int*)p->in[I_POS] + r * TH;
    for (int row = blockIdx.x * 8 + wv; row < TH; row += gridDim.x * 8) {
        bf16* kp = Km + (size_t)row * 768 + h * 96;
        const u32x4 w = *(const u32x4*)(kp + 8 * sub);
        float nv[8] = {bflo(w.x), bfhi(w.x), bflo(w.y), bfhi(w.y), bflo(w.z), bfhi(w.z), bflo(w.w), bfhi(w.w)};
        const unsigned k1 = *(const unsigned*)(P + (size_t)row * NP + 3200 + 2 * sub), k2 = *(const unsigned*)(P + (size_t)row * NP + 3216 + 2 * sub);
        float x1a = bflo(k1), x1b = bfhi(k1), x2a = bflo(k2), x2b = bfhi(k2);
        float ss = x1a * x1a + x1b * x1b + x2a * x2a + x2b * x2b;
#pragma unroll
        for (int e = 0; e < 8; ++e) ss += nv[e] * nv[e];
        ss += __shfl_xor(ss, 1); ss += __shfl_xor(ss, 2); ss += __shfl_xor(ss, 4);
        const float rs = rsqrtf(ss * (1.f / 96.f) + 1e-6f);
#pragma unroll
        for (int e = 0; e < 8; ++e) nv[e] *= rs * kg[8 * sub + e];
        x1a *= rs * kg[64 + 2 * sub]; x1b *= rs * kg[65 + 2 * sub]; x2a *= rs * kg[80 + 2 * sub]; x2b *= rs * kg[81 + 2 * sub];
        const int ps = pos[row]; float ca, sa, cb, sb; rope_cs(ps, 2 * sub, ca, sa); rope_cs(ps, 2 * sub + 1, cb, sb);
        u32x4 o; o.x = pk2(nv[0], nv[1]); o.y = pk2(nv[2], nv[3]); o.z = pk2(nv[4], nv[5]); o.w = pk2(nv[6], nv[7]);
        *(u32x4*)(kp + 8 * sub) = o;
        *(unsigned*)(kp + 64 + 2 * sub) = pk2(x1a * ca - x2a * sa, x1b * cb - x2b * sb);
        *(unsigned*)(kp + 80 + 2 * sub) = pk2(x2a * ca + x1a * sa, x2b * cb + x1b * sb);
    }
}
__device__ __forceinline__ void mkfix_rows(int wid_s, KP p_, int l) {
    KP p = p_; asm volatile("" : "+s"(p));
    unsigned char* ws = p->ws;
    const int tid_ = mk_tid(wid_s);
    const int tid = tid_, lane = tid & 63, wv = tid >> 6, h = lane >> 4, sub = lane & 15;
    bf16* mk = (bf16*)(ws + R_MK); const float* kg = p->in[I_XKG] + l * 128;
    for (int row = blockIdx.x * 8 + wv; row < 2048; row += gridDim.x * 8) {
        bf16* kp = mk + (size_t)row * 512 + h * 128 + 8 * sub;
        const u32x4 w = *(const u32x4*)kp;
        float nv[8] = {bflo(w.x), bfhi(w.x), bflo(w.y), bfhi(w.y), bflo(w.z), bfhi(w.z), bflo(w.w), bfhi(w.w)};
        float ss = 0.f;
#pragma unroll
        for (int e = 0; e < 8; ++e) ss += nv[e] * nv[e];
        ss += __shfl_xor(ss, 1); ss += __shfl_xor(ss, 2); ss += __shfl_xor(ss, 4); ss += __shfl_xor(ss, 8);
        const float rs = rsqrtf(ss * (1.f / 128.f) + 1e-6f);
#pragma unroll
        for (int e = 0; e < 8; ++e) nv[e] *= rs * kg[8 * sub + e];
        u32x4 o; o.x = pk2(nv[0], nv[1]); o.y = pk2(nv[2], nv[3]); o.z = pk2(nv[4], nv[5]); o.w = pk2(nv[6], nv[7]);
        *(u32x4*)kp = o;
    }
}
__device__ __forceinline__ void memb_rows(int wid_s, KP p_) {
    KP p = p_; asm volatile("" : "+s"(p));
    unsigned char* ws = p->ws;
    const int tid_ = mk_tid(wid_s);
    const int tid = tid_, lane = tid & 63, wv = tid >> 6;
    const float* mem = p->in[I_MEM]; bf16* memb = (bf16*)(ws + R_MEMB);
    for (int row = blockIdx.x * 8 + wv; row < 2048; row += gridDim.x * 8) {
        const f32x4* xr = (const f32x4*)(mem + (size_t)row * 1024) + lane; f32x4 v[4]; float s = 0.f;
#pragma unroll
        for (int jq = 0; jq < 4; ++jq) { v[jq] = xr[64 * jq]; s += (v[jq].x * v[jq].x + v[jq].y * v[jq].y) + (v[jq].z * v[jq].z + v[jq].w * v[jq].w); }
        const float rs = rsqrtf(wave_sum(s) * (1.f / 1024.f) + 1e-6f);
#pragma unroll
        for (int jq = 0; jq < 4; ++jq) { u32x2 w; w.x = pk2(v[jq].x * rs, v[jq].y * rs); w.y = pk2(v[jq].z * rs, v[jq].w * rs); *((u32x2*)(memb + (size_t)row * 1024) + lane + 64 * jq) = w; }
    }
}

#define XB_TMO      128
#define XB_XCNT(j)  (256  + 64 * (j))
#define XB_XSUB(j)  (1280 + 64 * (j))
#define XB_XGEN(j)  (2304 + 64 * (j))
#define XB_TOP      3328
#define XB_TOPGEN   3392
#define XCD_BAR_WORDS 3456
#define XB_SPIN_CAP (1u << 22)
__device__ __forceinline__ unsigned xb_ld(unsigned* p)              { return __hip_atomic_load(p, __ATOMIC_RELAXED, __HIP_MEMORY_SCOPE_AGENT); }
__device__ __forceinline__ unsigned xb_add(unsigned* p, unsigned v) { return __hip_atomic_fetch_add(p, v, __ATOMIC_RELAXED, __HIP_MEMORY_SCOPE_AGENT); }
__device__ __forceinline__ unsigned xb_xcc_id() { return (unsigned)__builtin_amdgcn_s_getreg((3 << 11) | 20) & 0xFu; }
#define XB_SPIN(cond, bar) do { unsigned _sp = 0; while (cond) { __builtin_amdgcn_s_sleep(1); \
    if ((++_sp & 255u) == 0u) { if (xb_ld(&(bar)[XB_TMO])) break; if (_sp > XB_SPIN_CAP) { atomicAdd(&(bar)[XB_TMO], 1u); break; } } } } while (0)
__device__ __forceinline__ void xcd_barrier_complete(unsigned* bar, unsigned x, unsigned& nloc, unsigned& nx) {
    const unsigned G = gridDim.x;
    unsigned sum, cnt, mine, sp = 0u;
    for (;;) {
        sum = 0u; cnt = 0u; mine = 0u;
#pragma unroll
        for (unsigned j = 0; j < 16; ++j) { const unsigned c = xb_ld(&bar[XB_XCNT(j)]); sum += c; cnt += (c > 0u) ? 1u : 0u; mine = (j == x) ? c : mine; }
        if (sum == G) break;
        __builtin_amdgcn_s_sleep(1);
        if ((++sp & 255u) == 0u) { if (xb_ld(&bar[XB_TMO])) break; if (sp > XB_SPIN_CAP) { atomicAdd(&bar[XB_TMO], 1u); break; } }
    }
    nloc = mine > 0u ? mine : 1u; nx = cnt > 0u ? cnt : 1u;
}
__device__ __forceinline__ void grid_barrier1(int wid_s, unsigned* bar, volatile unsigned* st) {
    asm volatile("s_waitcnt vmcnt(0)" ::: "memory");
    __syncthreads();
    if (mk_tid(wid_s) == 0) {
        const unsigned x = xb_xcc_id();
        __builtin_amdgcn_s_waitcnt(0);
        unsigned nloc = st[0], nx = st[1];
        if (nloc == 0u) { xcd_barrier_complete(bar, x, nloc, nx); st[0] = nloc; st[1] = nx; }
        const unsigned old = xb_add(&bar[XB_XSUB(x)], 1u);
        const unsigned gen = old / nloc;
        if (old + 1u == (gen + 1u) * nloc) {
            __builtin_amdgcn_fence(__ATOMIC_RELEASE, "agent");
            asm volatile("s_waitcnt vmcnt(0)" ::: "memory");
            const unsigned og = xb_add(&bar[XB_TOP], 1u);
            const unsigned tg = og / nx;
            if (og + 1u == (tg + 1u) * nx) xb_add(&bar[XB_TOPGEN], 1u);
            else XB_SPIN(xb_ld(&bar[XB_TOPGEN]) == tg, bar);
            __builtin_amdgcn_fence(__ATOMIC_ACQUIRE, "agent");
            xb_add(&bar[XB_XGEN(x)], 1u);
            asm volatile("s_waitcnt vmcnt(0)" ::: "memory");
        } else {
            XB_SPIN(xb_ld(&bar[XB_XGEN(x)]) == gen, bar);
            __builtin_amdgcn_fence(__ATOMIC_ACQUIRE, "agent");
            asm volatile("s_waitcnt vmcnt(0)" ::: "memory");
        }
    }
    __syncthreads();
}
__device__ __forceinline__ void grid_barrier(int wid_s, unsigned* bar, volatile unsigned* st) { int nb = 1 + RB(8); asm volatile("" : "+s"(nb)); for (int q = 0; q < nb; ++q) grid_barrier1(wid_s, bar, st); }
template <class Epi>
__device__ __forceinline__ void run_gemm(int wid_s, LAS unsigned char* lds, const bf16* A, int lda, const bf16* Bt, int M, int N, int K, const Epi& E) {
    int bx_ = blockIdx.x, gx_ = gridDim.x; asm volatile("" : "+s"(bx_), "+s"(gx_), "+s"(K), "+s"(lda));
    pg8::Gemm g{A, Bt, M, N, K, lda}; pg8::StaticOrder S; S.init(M, N, gx_, bx_);
    if (ON(1)) pg8::gemm_phase<Epi, pg8::StaticOrder>(wid_s, lds, g, S, E);
}

__device__ __forceinline__ unsigned char* wsl_(KP p) { unsigned char* w = p->ws; asm volatile("" : "+s"(w)); return w; }
__global__ void __launch_bounds__(512, 2) fwd_kernel(Params parg) {
    KP p = (KP)__builtin_amdgcn_kernarg_segment_ptr();
    extern __shared__ __attribute__((aligned(16))) unsigned char lds_raw[];
    const int wid_s = __builtin_amdgcn_readfirstlane((int)threadIdx.x >> 6);
    LAS unsigned char* lds3 = (LAS unsigned char*)lds_raw;
    unsigned char* lds = lds_raw; float* ldsf = (float*)lds_raw;
    unsigned char* ws = p->ws;
    const int bid = blockIdx.x;
    unsigned* ctl = (unsigned*)(wsl_(p) + WS_CTL);
    bf16* xb = (bf16*)(wsl_(p) + WS_XB); float* part = (float*)(wsl_(p) + WS_PART); float* pq = (float*)(wsl_(p) + WS_PQ); float* pkv = (float*)(wsl_(p) + WS_PKV);
    bf16* Y = (bf16*)(wsl_(p) + WS_Y);
    float* xcur = p->out;
    volatile unsigned* bst = (volatile unsigned*)(lds + QIDX_OFF + 16);
    if (threadIdx.x == 0) { bst[0] = 0u; bst[1] = 0u; (void)xb_add(&ctl[1024 + XB_XCNT(xb_xcc_id())], 1u); }
    __syncthreads();

    for (int l_ = 0; l_ < 2; ++l_) {
        int l = l_; asm volatile("" : "+s"(l));
        { REPLOOP(0) { if (ON(0)) phase_convert(wid_s, p, l, ldsf);
        grid_barrier(wid_s, ctl + 1024, bst); } }
        for (int r_ = 0; r_ < 2; ++r_) {
            int r = r_; asm volatile("" : "+s"(r));
            { REPLOOP(1) { EpiP E{(bf16*)(wsl_(p) + R_P), part + (size_t)r * TH * 16, pq, pkv};
              run_gemm(wid_s, lds3, xb + (size_t)r * TH * 1024, 1024, (const bf16*)(wsl_(p) + W_IN), TH, NP, 1024, E);
            grid_barrier(wid_s, ctl + 1024, bst); } }
            { REPLOOP(2) {
            if (ON(2)) for (int tile = bid; tile < TH / 32; tile += gridDim.x) rwkv_prep_tile(wid_s, p, l, tile, ldsf);
            __syncthreads();
            { EpiQ E{(bf16*)(wsl_(p) + R_Q), pq}; run_gemm(wid_s, lds3, (const bf16*)(wsl_(p) + R_P) + 2816, NP, (const bf16*)(wsl_(p) + W_MQ), TH, 768, 256, E); }
            { EpiKV E{(bf16*)(wsl_(p) + R_KM), (bf16*)(wsl_(p) + R_VT), pkv}; run_gemm(wid_s, lds3, (const bf16*)(wsl_(p) + R_P) + 3072, NP, (const bf16*)(wsl_(p) + W_MKV), TH, 1024, 128, E); }
            grid_barrier(wid_s, ctl + 1024, bst); } }
            if (ON(7)) kfix_rows(wid_s, p, l, r);
            grid_barrier(wid_s, ctl + 1024, bst);
            { REPLOOP(3) {
            if (ON(3) && !(q && RB(10)) && bid < 128) { const int xcd = bid & 7, idx = bid >> 3, hh = xcd * 4 + (idx >> 2), quarter = idx & 3;
                rwkv_scan_unit(wid_s, (const bf16*)(wsl_(p) + R_SI) + (size_t)hh * 2048 * 384, Y + ((size_t)(r * 4 + (hh >> 3)) * 2048) * 1536 + (hh & 7) * 64, quarter, ldsf); }
            else if (ON(4) && !(q && RB(11)) && bid >= 128 && bid < 160) { const int uu = bid - 128; lru_unit(wid_s, p, l, r, uu >> 3, uu & 7, ldsf); }
            {
                unsigned* ctr = ctl + q * 4 + l * 2 + r; volatile int* qidx = (volatile int*)(lds + QIDX_OFF);
                for (;;) {
                    __syncthreads();
                    if (mk_tid(wid_s) == 0) *qidx = (int)atomicAdd(ctr, 1u);
                    __syncthreads();
                    const int u = *qidx;
                    if (u >= 512 || !ON(5) || (q && RB(12))) break;
                    const int qb = 15 - (u >> 5), bh = u & 31, bl = bh >> 3, h = bh & 7;
                    attn_unit<96, 64, true, true>(wid_s, lds, (const bf16*)(wsl_(p) + R_Q) + (size_t)bl * 2048 * 768 + h * 96, 768, (const bf16*)(wsl_(p) + R_KM) + (size_t)bl * 2048 * 768 + h * 96, 768,
                        (const bf16*)(wsl_(p) + R_VT) + (size_t)(bl * 8 + h) * 64 * 2048, 2048, Y + ((size_t)(r * 4 + bl) * 2048) * 1536 + 1024 + h * 64, 1536,
                        qb * 128, 2 * qb + 2, p->in[I_QG] + l * 96, (const int*)p->in[I_POS] + (r * 4 + bl) * 2048, 0.14724444527f  );
                }
            }
            grid_barrier(wid_s, ctl + 1024, bst); } }
            if (ON(6)) for (int tile = bid; tile < TH / 32; tile += gridDim.x) rwkv_post_tile(wid_s, p, l, r, tile, ldsf);
            grid_barrier(wid_s, ctl + 1024, bst);
        }
        if (ON(7)) memb_rows(wid_s, p);
        { REPLOOP(4) {
        for (int n = 0; n < 3; ++n) {
            { EpiGate E{(bf16*)(wsl_(p) + R_GS), part, p->in[I_BGATE] + l * 3072 + n * 1024}; run_gemm(wid_s, lds3, xb, 1024, (const bf16*)(wsl_(p) + W_GATE) + (size_t)n * 1024 * 1024, T, 1024, 1024, E); }
            { EpiProj E{(const bf16*)(wsl_(p) + R_GS), (float*)(wsl_(p) + R_MS), (bf16*)(wsl_(p) + R_MG), n}; run_gemm(wid_s, lds3, Y + n * 512, 1536, (const bf16*)(wsl_(p) + W_BR) + (size_t)n * 1024 * 512, T, 1024, 512, E); }
        }
        grid_barrier(wid_s, ctl + 1024, bst); } }
        { EpiRes E{l == 0 ? p->in[I_X] : xcur, xcur, xb, part}; run_gemm(wid_s, lds3, (const bf16*)(wsl_(p) + R_MG), 1024, (const bf16*)(wsl_(p) + W_OUT), T, 1024, 1024, E); }
        { EpiMemKV E{(bf16*)(wsl_(p) + R_MK), (bf16*)(wsl_(p) + R_MVT)}; run_gemm(wid_s, lds3, (const bf16*)(wsl_(p) + R_MEMB), 1024, (const bf16*)(wsl_(p) + W_XKV), 2048, 1024, 1024, E); }
        grid_barrier(wid_s, ctl + 1024, bst);
        if (ON(7)) mkfix_rows(wid_s, p, l);
        { REPLOOP(5) { EpiXQ E{(bf16*)(wsl_(p) + R_XQ), part}; run_gemm(wid_s, lds3, xb, 1024, (const bf16*)(wsl_(p) + W_XQ), T, 512, 1024, E);
        grid_barrier(wid_s, ctl + 1024, bst); } }
        { REPLOOP(6) {
        if (ON(8)) for (int u = bid; u < 512; u += gridDim.x) { const int qb = u & 15, bh = u >> 4, b = bh >> 2, h = bh & 3;
            attn_unit<128, 128, false, false>(wid_s, lds, (const bf16*)(wsl_(p) + R_XQ) + (size_t)b * 2048 * 512 + h * 128, 512, (const bf16*)(wsl_(p) + R_MK) + (size_t)b * 256 * 512 + h * 128, 512,
                (const bf16*)(wsl_(p) + R_MVT) + (size_t)(b * 4 + h) * 128 * 256, 256, (bf16*)(wsl_(p) + R_XO) + (size_t)b * 2048 * 512 + h * 128, 512,
                qb * 128, 4, p->in[I_XQG] + l * 128, nullptr, 0.12751743082f  ); }
        grid_barrier(wid_s, ctl + 1024, bst); } }
        { EpiRes E{xcur, xcur, xb, part}; run_gemm(wid_s, lds3, (const bf16*)(wsl_(p) + R_XO), 512, (const bf16*)(wsl_(p) + W_XO), T, 1024, 512, E); }
        grid_barrier(wid_s, ctl + 1024, bst);
        { REPLOOP(7) { EpiFFN1 E{(bf16*)(wsl_(p) + R_H), part}; run_gemm(wid_s, lds3, xb, 1024, (const bf16*)(wsl_(p) + W_13), T, 5632, 1024, E);
        grid_barrier(wid_s, ctl + 1024, bst); } }
        { EpiRes E{xcur, xcur, xb, part}; run_gemm(wid_s, lds3, (const bf16*)(wsl_(p) + R_H), DFF, (const bf16*)(wsl_(p) + W_2), T, 1024, DFF, E); }
        grid_barrier(wid_s, ctl + 1024, bst);
    }
}

extern "C" void kernel_launch(void* const* d_in, const int* in_sizes, int n_in, void* d_out, int out_size, void* d_ws, size_t ws_size, hipStream_t stream) {
    static int grid = 0;
    if (grid == 0) {
        int dev = 0, cus = 0, per_cu = 0;
        if (n_in != 43 || ws_size < WS_END) { fprintf(stderr, "kernel_launch: unexpected n_in %d / ws %zu\n", n_in, ws_size); grid = -1; return; }
        (void)hipGetDevice(&dev);
        (void)hipDeviceGetAttribute(&cus, hipDeviceAttributeMultiprocessorCount, dev);
        (void)hipFuncSetAttribute((const void*)fwd_kernel, hipFuncAttributeMaxDynamicSharedMemorySize, LDS_BYTES);
        (void)hipOccupancyMaxActiveBlocksPerMultiprocessor(&per_cu, (const void*)fwd_kernel, 512, LDS_BYTES);
        fprintf(stderr, "cus %d per_cu %d ws %zu\n", cus, per_cu, ws_size);
        grid = cus * (per_cu >= 1 ? 1 : 0);
        if (grid <= 0) { grid = -1; return; }
    }
    if (grid < 0) return;
    Params p{};
    for (int i = 0; i < 43; ++i) p.in[i] = (const float*)d_in[i];
    p.out = (float*)d_out; p.ws = (unsigned char*)d_ws;
    (void)hipMemsetAsync((char*)d_ws + WS_CTL, 0, 32768, stream);
    void* args[] = {&p};
    hipError_t e = hipLaunchCooperativeKernel((const void*)fwd_kernel, dim3(grid), dim3(512), args, LDS_BYTES, stream);
    if (e != hipSuccess) fprintf(stderr, "cooperative launch failed: %s (grid %d)\n", hipGetErrorString(e), grid);
}
```

```cpp
#include <hip/hip_runtime.h>
#include <cstdio>
#include <cstdint>

#define LAS __attribute__((address_space(3)))
typedef unsigned short bf16;
typedef short bf16x8 __attribute__((ext_vector_type(8)));
typedef float f32x4 __attribute__((ext_vector_type(4)));
typedef float f32x2 __attribute__((ext_vector_type(2)));
typedef unsigned u32x4 __attribute__((ext_vector_type(4)));
typedef unsigned u32x2 __attribute__((ext_vector_type(2)));

__device__ __forceinline__ unsigned f2bf(float f) { unsigned u = __builtin_bit_cast(unsigned, f); return (u + 0x7fffu + ((u >> 16) & 1u)) >> 16; }
__device__ __forceinline__ unsigned pk2(float lo, float hi) { return f2bf(lo) | (f2bf(hi) << 16); }
__device__ __forceinline__ float bf2f(bf16 b) { return __builtin_bit_cast(float, (unsigned)b << 16); }
__device__ __forceinline__ float bflo(unsigned u) { return __builtin_bit_cast(float, u << 16); }
__device__ __forceinline__ float bfhi(unsigned u) { return __builtin_bit_cast(float, u & 0xffff0000u); }
__device__ __forceinline__ u32x4 pk8(f32x4 a, f32x4 b) { u32x4 w; w.x = pk2(a.x, a.y); w.y = pk2(a.z, a.w); w.z = pk2(b.x, b.y); w.w = pk2(b.z, b.w); return w; }
__device__ __forceinline__ float sigmoidf_(float x) { return 1.f / (1.f + __expf(-x)); }
__device__ __forceinline__ float fsig(float x) { return __builtin_amdgcn_rcpf(1.f + __builtin_amdgcn_exp2f(-1.4426950408889634f * x)); }
__device__ __forceinline__ int mk_tid(int wid_s) { int t = wid_s * 64 + (int)__builtin_amdgcn_mbcnt_hi(~0u, __builtin_amdgcn_mbcnt_lo(~0u, 0u)); asm volatile("" : "+v"(t)); return t; }
__device__ __forceinline__ float wave_sum(float v) {
#pragma unroll
    for (int o = 1; o < 64; o <<= 1) v += __shfl_xor(v, o);
    return v;
}

namespace pg8 {
#define PG8_LAS __attribute__((address_space(3)))
typedef unsigned short bf16_t;
constexpr int BM = 256, BK = 64, HALF = 128, HTB = HALF * BK * 2, STAGE_BYTES = 8 * HTB, NXCD = 8, WGM = 8;
__host__ __device__ __forceinline__ int lds_byte(int r, int c) { const int st = (r >> 4) * 2 + (c >> 5), rr = r & 15, cc = c & 31, ob = rr * 64 + cc * 2; return st * 1024 + (ob ^ (((ob >> 9) & 1) << 5)); }
__host__ __device__ __forceinline__ void stage_rc(int b, int& R, int& C) { const int st = b / 1024, sb = b % 1024, swz = sb ^ (((sb >> 9) & 1) << 5); R = (st >> 1) * 16 + swz / 64; C = (st & 1) * 32 + (swz % 64) / 2; }
__host__ __device__ __forceinline__ int perm32(int rho) { const int n = rho >> 4, i = rho & 15; return 8 * (i >> 2) + 4 * n + (i & 3); }
struct Unit { int pm, pn; };
struct Gemm { const bf16_t* A; const bf16_t* Bt; int M, N, K, lda; };
struct StaticOrder {
    int nM, nN, nwg, G, c;
    __host__ __device__ void init(int M, int N, int G_, int c_) { nM = M / BM; nN = N / BM; nwg = nM * nN; G = G_; c = c_; }
    __host__ __device__ bool next(int i, Unit& u) const {
        const long L = (long)i * G + c; if (L >= nwg) return false;
        int wgid = (int)L; { const int q = nwg / NXCD, r = nwg % NXCD, xcd = wgid % NXCD, off = wgid / NXCD; wgid = (xcd < r ? xcd * (q + 1) : r * (q + 1) + (xcd - r) * q) + off; }
        const int nig = WGM * nN, gid = wgid / nig, fm = gid * WGM, gsz = (nM - fm) < WGM ? (nM - fm) : WGM;
        u.pm = fm + ((wgid % nig) % gsz); u.pn = (wgid % nig) / gsz; return true;
    }
};
template <class Epi, class Sched>
__device__ __forceinline__ void gemm_phase(int wid_s, PG8_LAS unsigned char* lds, const Gemm g, const Sched& S, const Epi& E) {
    const int tid_ = mk_tid(wid_s);
    const int tid = tid_, wid = __builtin_amdgcn_readfirstlane(tid >> 6), lane = tid & 63, wr = wid >> 2, wc = wid & 3, fr = lane & 15, fq = lane >> 4;
    const int K = g.K, nt = K / BK, lda = g.lda;
    unsigned voffA[2], voffB[2];
#pragma unroll
    for (int i = 0; i < 2; ++i) { int R, C; stage_rc(tid * 16 + i * 8192, R, C); const int Rb = (R & ~31) + perm32(R & 31);
        voffA[i] = (unsigned)(R * lda + C) * 2u; voffB[i] = (unsigned)(Rb * K + C) * 2u; }
    const size_t kstep = (size_t)(BK * 2);
    const size_t hstepA = (size_t)HALF * lda * 2, hstepB = (size_t)HALF * K * 2;
    const size_t tstepA = 2 * hstepA, tstepB = 2 * hstepB;
    const unsigned ldsw = (unsigned)wid * 1024u;
    const int aoff = lds_byte(wr * 64 + fr, fq * 8), boff = lds_byte(wc * 32 + fr, fq * 8);
#define PG8_SA(b, h) (((b) * 2 + (h)) * HTB)
#define PG8_SB(b, h) ((4 + (b) * 2 + (h)) * HTB)
#define PG8_STAGE(bufoff, gbase, voff) do { _Pragma("unroll") for (int _i = 0; _i < 2; ++_i) \
        __builtin_amdgcn_global_load_lds((const unsigned*)((const char*)(gbase) + (voff)[_i]), (PG8_LAS unsigned*)(lds + (bufoff) + ldsw + _i * 8192), 16, 0, 0); } while (0)
#define PG8_LDA(dst, b, h) do { _Pragma("unroll") for (int m = 0; m < 4; ++m) _Pragma("unroll") for (int k = 0; k < 2; ++k) dst[m][k] = *(const PG8_LAS bf16x8*)(lds + PG8_SA(b, h) + aoff + m * 2048 + k * 1024); } while (0)
#define PG8_LDB(dst, b, h) do { _Pragma("unroll") for (int n = 0; n < 2; ++n) _Pragma("unroll") for (int k = 0; k < 2; ++k) dst[n][k] = *(const PG8_LAS bf16x8*)(lds + PG8_SB(b, h) + boff + n * 2048 + k * 1024); } while (0)
#define PG8_MMA(ai, bj, At, Bt) do { __builtin_amdgcn_s_setprio(1); _Pragma("unroll") for (int m = 0; m < 4; ++m) _Pragma("unroll") for (int n = 0; n < 2; ++n) _Pragma("unroll") for (int k = 0; k < 2; ++k) \
        acc[ai][bj][m][n] = __builtin_amdgcn_mfma_f32_16x16x32_bf16(Bt[n][k], At[m][k], acc[ai][bj][m][n], 0, 0, 0); __builtin_amdgcn_s_setprio(0); } while (0)
#define PG8_WAIT_V(n) asm volatile("s_waitcnt vmcnt(" #n ")" ::: "memory")
#define PG8_WAIT_L(n) asm volatile("s_waitcnt lgkmcnt(" #n ")" ::: "memory")
#define PG8_BAR __builtin_amdgcn_s_barrier()
#define PG8_SCHED __builtin_amdgcn_sched_barrier(0)
    Unit cur, nxt; int ui = 0;
    if (!S.next(0, cur)) return;
    f32x4 acc[2][2][4][2];
#pragma unroll
    for (int a = 0; a < 2; ++a)
#pragma unroll
        for (int b = 0; b < 2; ++b)
#pragma unroll
            for (int m = 0; m < 4; ++m)
#pragma unroll
                for (int n = 0; n < 2; ++n) acc[a][b][m][n] = (f32x4){0.f, 0.f, 0.f, 0.f};
    bf16x8 At[4][2], B0[2][2], B1[2][2];
    const char* cA = (const char*)g.A + (size_t)cur.pm * tstepA; const char* cB = (const char*)g.Bt + (size_t)cur.pn * tstepB;
    PG8_STAGE(PG8_SB(0, 0), cB, voffB); PG8_STAGE(PG8_SB(0, 1), cB + hstepB, voffB); PG8_STAGE(PG8_SA(0, 0), cA, voffA); PG8_STAGE(PG8_SA(0, 1), cA + hstepA, voffA);
    if (wr == 1) PG8_BAR;
    PG8_WAIT_V(2); PG8_BAR;
    PG8_STAGE(PG8_SB(1, 0), cB + kstep, voffB); PG8_STAGE(PG8_SA(1, 0), cA + kstep, voffA); PG8_STAGE(PG8_SB(1, 1), cB + hstepB + kstep, voffB);
    PG8_WAIT_V(6); PG8_BAR;
    for (;;) {
        const bool has_next = S.next(ui + 1, nxt);
        const char* nA = has_next ? (const char*)g.A + (size_t)nxt.pm * tstepA : cA; const char* nB = has_next ? (const char*)g.Bt + (size_t)nxt.pn * tstepB : cB;
#pragma unroll 1
        for (int t = 0; t < nt; t += 2) {
            const bool last = (t == nt - 2);
            const char* a1 = cA + (size_t)(t + 1) * kstep;
            const char* a2 = last ? nA : cA + (size_t)(t + 2) * kstep; const char* b2 = last ? nB : cB + (size_t)(t + 2) * kstep;
            const char* a3 = a2 + kstep; const char* b3 = b2 + kstep;
            PG8_LDB(B0, 0, 0); PG8_LDB(B1, 0, 1); PG8_SCHED; PG8_LDA(At, 0, 0); PG8_STAGE(PG8_SA(1, 1), a1 + hstepA, voffA);
            PG8_WAIT_V(8); PG8_WAIT_L(0); PG8_BAR; PG8_MMA(0, 0, At, B0); PG8_MMA(0, 1, At, B1); PG8_BAR; PG8_SCHED;
            PG8_LDA(At, 0, 1); PG8_STAGE(PG8_SB(0, 0), b2, voffB); PG8_STAGE(PG8_SB(0, 1), b2 + hstepB, voffB); PG8_STAGE(PG8_SA(0, 0), a2, voffA);
            PG8_WAIT_V(8); PG8_WAIT_L(0); PG8_BAR; PG8_MMA(1, 0, At, B0); PG8_MMA(1, 1, At, B1); PG8_BAR; PG8_SCHED;
            PG8_LDB(B0, 1, 0); PG8_LDB(B1, 1, 1); PG8_SCHED; PG8_LDA(At, 1, 0); PG8_STAGE(PG8_SA(0, 1), a2 + hstepA, voffA);
            PG8_WAIT_V(8); PG8_WAIT_L(0); PG8_BAR; PG8_MMA(0, 0, At, B0); PG8_MMA(0, 1, At, B1); PG8_BAR; PG8_SCHED;
            PG8_LDA(At, 1, 1); PG8_STAGE(PG8_SB(1, 0), b3, voffB); PG8_STAGE(PG8_SB(1, 1), b3 + hstepB, voffB); PG8_STAGE(PG8_SA(1, 0), a3, voffA);
            PG8_WAIT_V(8); PG8_WAIT_L(0); PG8_BAR; PG8_MMA(1, 0, At, B0); PG8_MMA(1, 1, At, B1); PG8_BAR; PG8_SCHED;
        }
        if (wr == 0) PG8_BAR;
        E(acc, cur, wr, wc, fr, fq);
        if (!has_next) break;
#pragma unroll
        for (int a = 0; a < 2; ++a)
#pragma unroll
            for (int b = 0; b < 2; ++b)
#pragma unroll
                for (int m = 0; m < 4; ++m)
#pragma unroll
                    for (int n = 0; n < 2; ++n) acc[a][b][m][n] = (f32x4){0.f, 0.f, 0.f, 0.f};
        cur = nxt; cA = nA; cB = nB; ++ui;
        if (wr == 1) PG8_BAR;
    }
    PG8_WAIT_V(0);
    PG8_BAR;
#undef PG8_SA
#undef PG8_SB
#undef PG8_STAGE
#undef PG8_LDA
#undef PG8_LDB
#undef PG8_MMA
#undef PG8_WAIT_V
#undef PG8_WAIT_L
#undef PG8_BAR
#undef PG8_SCHED
}
}

#ifndef EN
#define EN 0xFFFF
#endif
#define ON(b) ((EN >> (b)) & 1)
#ifndef REP
#define REP 0
#endif
#define RB(b) ((REP >> (b)) & 1)
#define REPLOOP(b) int nrep##b = 1 + RB(b); asm volatile("" : "+s"(nrep##b)); for (int q = 0; q < nrep##b; ++q)
constexpr int T = 16384, TH = 8192, SEQ = 2048, DM = 1024, DIN = 6304, NP = 3328, DFF = 2816;
constexpr int LDS_BYTES = 147456, QIDX_OFF = 140000;
constexpr size_t MiB = 1u << 20;
constexpr size_t WS_CTL = 0;
constexpr size_t WS_WT = 1 * MiB;
constexpr size_t W_IN = WS_WT, W_GATE = W_IN + (size_t)NP * 1024 * 2, W_BR = W_GATE + (size_t)3072 * 1024 * 2, W_OUT = W_BR + (size_t)3 * 1024 * 512 * 2,
                 W_MQ = W_OUT + (size_t)1024 * 1024 * 2, W_MKV = W_MQ + (size_t)768 * 256 * 2, W_XQ = W_MKV + (size_t)1024 * 128 * 2, W_XKV = W_XQ + (size_t)512 * 1024 * 2,
                 W_XO = W_XKV + (size_t)1024 * 1024 * 2, W_13 = W_XO + (size_t)1024 * 512 * 2, W_2 = W_13 + (size_t)5632 * 1024 * 2, W_BWA = W_2 + (size_t)1024 * 2816 * 2, W_GUP = W_BWA + (size_t)1024 * 128 * 2, W_END = W_GUP + (size_t)512 * 128 * 2;
static_assert(W_END <= 40 * MiB, "weights");
constexpr size_t WS_XB = 40 * MiB, WS_PART = 72 * MiB, WS_PQ = 73 * MiB, WS_PKV = WS_PQ + 256 * 1024, WS_Y = 74 * MiB, WS_R = 122 * MiB;
constexpr size_t R_P = WS_R, R_SI = WS_R + 52 * MiB, R_Q = WS_R + 100 * MiB, R_KM = WS_R + 112 * MiB, R_VT = WS_R + 124 * MiB;
constexpr size_t R_GS = WS_R, R_MS = WS_R + 32 * MiB, R_MG = WS_R + 96 * MiB, R_MEMB = WS_R + 128 * MiB;
constexpr size_t R_MK = WS_R, R_MVT = WS_R + 2 * MiB, R_XQ = WS_R + 32 * MiB, R_XO = WS_R + 48 * MiB, R_H = WS_R;
constexpr size_t WS_AG = WS_R + 132 * MiB;
constexpr size_t WS_END = WS_AG + 2 * MiB;
static_assert(WS_END <= 256 * MiB, "ws");

struct Params { const float* in[43]; float* out; unsigned char* ws; };
typedef const __attribute__((address_space(4))) Params* KP;
enum { I_X = 0, I_MEM, I_POS, I_NMIX, I_NXA, I_NMEM, I_NFFN, I_WIN, I_BGATE, I_MU, I_W0, I_WUP, I_A0, I_AUP, I_GUP, I_KK, I_KA, I_RK, I_LNG, I_LNB,
       I_CW, I_CB, I_WA, I_BA, I_WX, I_BX, I_LAM, I_QN, I_WUQ, I_KVN, I_WUKV, I_QG, I_KG, I_WBR, I_WOUT, I_XWQ, I_XWKV, I_XQG, I_XKG, I_XWO, I_W1, I_W3, I_W2 };

__device__ __forceinline__ float rstd16(const float* part, int row) {
    const f32x4* p = (const f32x4*)(part + (size_t)row * 16); const f32x4 a = p[0], b = p[1], c = p[2], d = p[3];
    const float s = ((a.x + a.y) + (a.z + a.w)) + ((b.x + b.y) + (b.z + b.w)) + ((c.x + c.y) + (c.z + c.w)) + ((d.x + d.y) + (d.z + d.w));
    return rsqrtf(s * (1.f / 1024.f) + 1e-6f);
}
__device__ __forceinline__ float rstd4(const float* pp, int row, float invn) { const f32x4 a = *(const f32x4*)(pp + (size_t)row * 4); return rsqrtf(((a.x + a.y) + (a.z + a.w)) * invn + 1e-6f); }
__device__ __forceinline__ float sumsq8(f32x4 a, f32x4 b) { return (a.x * a.x + a.y * a.y) + (a.z * a.z + a.w * a.w) + (b.x * b.x + b.y * b.y) + (b.z * b.z + b.w * b.w); }
#define EPI_HEAD static constexpr bool PERM = true; \
    __device__ __forceinline__ void operator()(const f32x4 (&acc)[2][2][4][2], const pg8::Unit& u, int wr, int wc, int fr, int fq) const
#define EPI_ROWS _Pragma("unroll") for (int ai = 0; ai < 2; ++ai) _Pragma("unroll") for (int m = 0; m < 4; ++m) if ((__builtin_amdgcn_sched_barrier(0), true))
#define EPI_ROW (u.pm * 256 + ai * 128 + wr * 64 + m * 16 + fr)

struct EpiP {
    bf16* P; const float* part; float* pq; float* pkv;
    EPI_HEAD {
        const int col0 = u.pn * 256 + wc * 32 + 8 * fq;
        EPI_ROWS { const int row = EPI_ROW; const float rs = rstd16(part, row); float ss = 0.f;
#pragma unroll
            for (int bj = 0; bj < 2; ++bj) { const f32x4 v0 = acc[ai][bj][m][0] * rs, v1 = acc[ai][bj][m][1] * rs;
                *(u32x4*)(P + (size_t)row * NP + col0 + bj * 128) = pk8(v0, v1);
                if (u.pn == 11 || bj == 0) ss += sumsq8(v0, v1); }
            if (u.pn == 11 || u.pn == 12) { ss += __shfl_xor(ss, 16); ss += __shfl_xor(ss, 32); if (fq == 0) (u.pn == 11 ? pq : pkv)[(size_t)row * 4 + wc] = ss; } }
    }
};
struct EpiQ {
    bf16* Q; const float* pq;
    EPI_HEAD {
        const int col0 = u.pn * 256 + wc * 32 + 8 * fq;
        EPI_ROWS { const int row = EPI_ROW; const float rs = rstd4(pq, row, 1.f / 256.f);
#pragma unroll
            for (int bj = 0; bj < 2; ++bj) *(u32x4*)(Q + (size_t)row * 768 + col0 + bj * 128) = pk8(acc[ai][bj][m][0] * rs, acc[ai][bj][m][1] * rs); }
    }
};
struct EpiKV {
    bf16* Km; bf16* Vt; const float* pkv;
    EPI_HEAD {
        const int j0 = wc * 32 + 8 * fq;
        EPI_ROWS { const int row = EPI_ROW; const float rs = rstd4(pkv, row, 1.f / 128.f);
#pragma unroll
            for (int bj = 0; bj < 2; ++bj) { const int h = 2 * u.pn + bj; const f32x4 v0 = acc[ai][bj][m][0] * rs, v1 = acc[ai][bj][m][1] * rs;
                if (wc < 2) *(u32x4*)(Km + (size_t)row * 768 + h * 96 + j0) = pk8(v0, v1);
                else { const int bl = row >> 11, t = row & 2047; bf16* vp = Vt + ((size_t)(bl * 8 + h) * 64 + (j0 - 64)) * 2048 + t;
                    vp[0 * 2048] = (bf16)f2bf(v0.x); vp[1 * 2048] = (bf16)f2bf(v0.y); vp[2 * 2048] = (bf16)f2bf(v0.z); vp[3 * 2048] = (bf16)f2bf(v0.w);
                    vp[4 * 2048] = (bf16)f2bf(v1.x); vp[5 * 2048] = (bf16)f2bf(v1.y); vp[6 * 2048] = (bf16)f2bf(v1.z); vp[7 * 2048] = (bf16)f2bf(v1.w); } } }
    }
};
struct EpiGate {
    bf16* GS; const float* part; const float* bg;
    EPI_HEAD {
        const int col0 = u.pn * 256 + wc * 32 + 8 * fq;
        f32x4 b0[2], b1[2];
#pragma unroll
        for (int bj = 0; bj < 2; ++bj) { b0[bj] = *(const f32x4*)(bg + col0 + bj * 128); b1[bj] = *(const f32x4*)(bg + col0 + bj * 128 + 4); }
        EPI_ROWS { const int row = EPI_ROW; const float rs = rstd16(part, row);
#pragma unroll
            for (int bj = 0; bj < 2; ++bj) { f32x4 v0 = acc[ai][bj][m][0] * rs + b0[bj], v1 = acc[ai][bj][m][1] * rs + b1[bj];
#pragma unroll
                for (int e = 0; e < 4; ++e) { v0[e] = fsig(v0[e]); v1[e] = fsig(v1[e]); }
                *(u32x4*)(GS + (size_t)row * 1024 + col0 + bj * 128) = pk8(v0, v1); } }
    }
};
struct EpiProj {
    const bf16* GS; float* MS; bf16* MG; int n;
    EPI_HEAD {
        const int col0 = u.pn * 256 + wc * 32 + 8 * fq;
        EPI_ROWS { const int row = EPI_ROW;
#pragma unroll
            for (int bj = 0; bj < 2; ++bj) { const size_t o = (size_t)row * 1024 + col0 + bj * 128; const u32x4 gw = *(const u32x4*)(GS + o);
                f32x4 v0 = acc[ai][bj][m][0], v1 = acc[ai][bj][m][1];
                v0.x *= bflo(gw.x); v0.y *= bfhi(gw.x); v0.z *= bflo(gw.y); v0.w *= bfhi(gw.y); v1.x *= bflo(gw.z); v1.y *= bfhi(gw.z); v1.z *= bflo(gw.w); v1.w *= bfhi(gw.w);
                if (n > 0) { v0 += *(const f32x4*)(MS + o); v1 += *(const f32x4*)(MS + o + 4); }
                if (n < 2) { *(f32x4*)(MS + o) = v0; *(f32x4*)(MS + o + 4) = v1; } else *(u32x4*)(MG + o) = pk8(v0, v1); } }
    }
};
struct EpiRes {
    const float* xold; float* xout; bf16* xb; float* part; int nowrite = 0;
    EPI_HEAD {
        const int col0 = u.pn * 256 + wc * 32 + 8 * fq;
        EPI_ROWS { const int row = EPI_ROW; float ss = 0.f;
#pragma unroll
            for (int bj = 0; bj < 2; ++bj) { const size_t o = (size_t)row * 1024 + col0 + bj * 128;
                const f32x4 v0 = acc[ai][bj][m][0] + *(const f32x4*)(xold + o), v1 = acc[ai][bj][m][1] + *(const f32x4*)(xold + o + 4);
                if (!nowrite) { *(f32x4*)(xout + o) = v0; *(f32x4*)(xout + o + 4) = v1; *(u32x4*)(xb + o) = pk8(v0, v1); } ss += sumsq8(v0, v1); }
            ss += __shfl_xor(ss, 16); ss += __shfl_xor(ss, 32); if (fq == 0 && !nowrite) part[(size_t)row * 16 + u.pn * 4 + wc] = ss; }
    }
};
struct EpiXQ {
    bf16* Q; const float* part;
    EPI_HEAD {
        const int col0 = u.pn * 256 + wc * 32 + 8 * fq;
        EPI_ROWS { const int row = EPI_ROW; const float rs = rstd16(part, row);
#pragma unroll
            for (int bj = 0; bj < 2; ++bj) *(u32x4*)(Q + (size_t)row * 512 + col0 + bj * 128) = pk8(acc[ai][bj][m][0] * rs, acc[ai][bj][m][1] * rs); }
    }
};
struct EpiBf {
    bf16* O; int ld;
    EPI_HEAD {
        const int col0 = u.pn * 256 + wc * 32 + 8 * fq;
        EPI_ROWS { const int row = EPI_ROW;
#pragma unroll
            for (int bj = 0; bj < 2; ++bj) *(u32x4*)(O + (size_t)row * ld + col0 + bj * 128) = pk8(acc[ai][bj][m][0], acc[ai][bj][m][1]); }
    }
};
struct EpiMemKV {
    bf16* mk; bf16* mVt;
    EPI_HEAD {
        const int j0 = wc * 32 + 8 * fq, h = u.pn;
        EPI_ROWS { const int row = EPI_ROW;
            *(u32x4*)(mk + (size_t)row * 512 + h * 128 + j0) = pk8(acc[ai][0][m][0], acc[ai][0][m][1]);
            const f32x4 v0 = acc[ai][1][m][0], v1 = acc[ai][1][m][1]; const int b = row >> 8, key = row & 255;
            bf16* vp = mVt + ((size_t)(b * 4 + h) * 128 + j0) * 256 + key;
            vp[0 * 256] = (bf16)f2bf(v0.x); vp[1 * 256] = (bf16)f2bf(v0.y); vp[2 * 256] = (bf16)f2bf(v0.z); vp[3 * 256] = (bf16)f2bf(v0.w);
            vp[4 * 256] = (bf16)f2bf(v1.x); vp[5 * 256] = (bf16)f2bf(v1.y); vp[6 * 256] = (bf16)f2bf(v1.z); vp[7 * 256] = (bf16)f2bf(v1.w); }
    }
};
struct EpiFFN1 {
    bf16* H; const float* part;
    EPI_HEAD {
        const int hc0 = (u.pn * 256 + wc * 32 + 8 * fq) >> 1;
        EPI_ROWS { const int row = EPI_ROW; const float rs = rstd16(part, row);
#pragma unroll
            for (int bj = 0; bj < 2; ++bj) { const f32x4 a1 = acc[ai][bj][m][0] * rs, a3 = acc[ai][bj][m][1] * rs; f32x4 hv;
#pragma unroll
                for (int e = 0; e < 4; ++e) hv[e] = a1[e] * fsig(a1[e]) * a3[e];
                u32x2 w; w.x = pk2(hv.x, hv.y); w.y = pk2(hv.z, hv.w);
                *(u32x2*)(H + (size_t)row * DFF + hc0 + bj * 64) = w; } }
    }
};

__device__ __forceinline__ void conv_job(const float* W, int ldw, int c0, int ncols, int kblk, const float* gain, bf16* WT, int K, int mode, float* scr, int gw, int NGW, int lane, int& off) {
    const int nblk = (ncols + 63) >> 6, nitems = nblk * kblk;
    int it0 = (gw - off) % NGW; if (it0 < 0) it0 += NGW;
    off = (off + nitems) % NGW;
    const int kq = lane >> 4, nq = lane & 15;
    for (int it = it0; it < nitems; it += NGW) {
        const int kb = it / nblk, nb = it % nblk, k0 = 64 * kb, n0 = 64 * nb;
        const bool ld_ok = (n0 + 4 * nq) < ncols;
        f32x4 v[16];
#pragma unroll
        for (int i = 0; i < 16; ++i) { v[i] = (f32x4){0.f, 0.f, 0.f, 0.f}; if (ld_ok) v[i] = *(const f32x4*)(W + (size_t)(k0 + 4 * i + kq) * ldw + c0 + n0 + 4 * nq); }
#pragma unroll
        for (int i = 0; i < 16; ++i) { const int kk = 4 * i + kq; const float gg = gain ? gain[k0 + kk] : 1.f; float* d = scr + kk * 65 + 4 * nq;
            d[0] = v[i].x * gg; d[1] = v[i].y * gg; d[2] = v[i].z * gg; d[3] = v[i].w * gg; }
        __builtin_amdgcn_wave_barrier(); asm volatile("s_waitcnt lgkmcnt(0)" ::: "memory");
        const int c = lane & 7;
#pragma unroll
        for (int jx = 0; jx < 8; ++jx) { const int nl = (lane >> 3) + 8 * jx, n = n0 + nl; const float* sp = scr + (8 * c) * 65 + nl;
            u32x4 o; o.x = pk2(sp[0 * 65], sp[1 * 65]); o.y = pk2(sp[2 * 65], sp[3 * 65]); o.z = pk2(sp[4 * 65], sp[5 * 65]); o.w = pk2(sp[6 * 65], sp[7 * 65]);
            const int dr = mode == 0 ? n : (8 * (n >> 2) + (n & 3) + (mode == 2 ? 4 : 0));
            if (n < ncols) *(u32x4*)(WT + (size_t)dr * K + k0 + 8 * c) = o; }
        __builtin_amdgcn_wave_barrier(); asm volatile("s_waitcnt lgkmcnt(0)" ::: "memory");
    }
}

__device__ __forceinline__ void phase_convert(int wid_s, KP p_, int l, float* ldsf) {
    KP p = p_; asm volatile("" : "+s"(p));
    unsigned char* ws = p->ws;
    const int tid_ = mk_tid(wid_s);
    const int tid = tid_, lane = tid & 63, wv = tid >> 6;
    const int gw = blockIdx.x * 8 + wv, NGW = gridDim.x * 8;
    float* scr = ldsf + wv * (64 * 65); int off = 0;
    const float* nmix = p->in[I_NMIX] + l * 1024;
    conv_job(p->in[I_WIN] + (size_t)l * 1024 * DIN, DIN, 0, 3232, 16, nmix, (bf16*)(ws + W_IN), 1024, 0, scr, gw, NGW, lane, off);
    conv_job(p->in[I_WIN] + (size_t)l * 1024 * DIN, DIN, 3232, 3072, 16, nmix, (bf16*)(ws + W_GATE), 1024, 0, scr, gw, NGW, lane, off);
    for (int n = 0; n < 3; ++n) conv_job(p->in[I_WBR] + ((size_t)l * 3 + n) * 512 * 1024, 1024, 0, 1024, 8, nullptr, (bf16*)(ws + W_BR) + (size_t)n * 1024 * 512, 512, 0, scr, gw, NGW, lane, off);
    conv_job(p->in[I_WOUT] + (size_t)l * 1024 * 1024, 1024, 0, 1024, 16, nullptr, (bf16*)(ws + W_OUT), 1024, 0, scr, gw, NGW, lane, off);
    conv_job(p->in[I_WUQ] + (size_t)l * 256 * 768, 768, 0, 768, 4, p->in[I_QN] + l * 256, (bf16*)(ws + W_MQ), 256, 0, scr, gw, NGW, lane, off);
    conv_job(p->in[I_WUKV] + (size_t)l * 128 * 1024, 1024, 0, 1024, 2, p->in[I_KVN] + l * 128, (bf16*)(ws + W_MKV), 128, 0, scr, gw, NGW, lane, off);
    conv_job(p->in[I_XWQ] + (size_t)l * 1024 * 512, 512, 0, 512, 16, p->in[I_NXA] + l * 1024, (bf16*)(ws + W_XQ), 1024, 0, scr, gw, NGW, lane, off);
    conv_job(p->in[I_XWKV] + (size_t)l * 1024 * 1024, 1024, 0, 1024, 16, p->in[I_NMEM] + l * 1024, (bf16*)(ws + W_XKV), 1024, 0, scr, gw, NGW, lane, off);
    conv_job(p->in[I_XWO] + (size_t)l * 512 * 1024, 1024, 0, 1024, 8, nullptr, (bf16*)(ws + W_XO), 512, 0, scr, gw, NGW, lane, off);
    conv_job(p->in[I_W1] + (size_t)l * 1024 * DFF, DFF, 0, 2816, 16, p->in[I_NFFN] + l * 1024, (bf16*)(ws + W_13), 1024, 1, scr, gw, NGW, lane, off);
    conv_job(p->in[I_W3] + (size_t)l * 1024 * DFF, DFF, 0, 2816, 16, p->in[I_NFFN] + l * 1024, (bf16*)(ws + W_13), 1024, 2, scr, gw, NGW, lane, off);
    conv_job(p->in[I_W2] + (size_t)l * DFF * 1024, 1024, 0, 1024, 44, nullptr, (bf16*)(ws + W_2), DFF, 0, scr, gw, NGW, lane, off);
    conv_job(p->in[I_WUP] + (size_t)l * 64 * 512, 512, 0, 512, 1, nullptr, (bf16*)(ws + W_BWA), 128, 0, scr, gw, NGW, lane, off);
    conv_job(p->in[I_AUP] + (size_t)l * 64 * 512, 512, 0, 512, 1, nullptr, (bf16*)(ws + W_BWA) + 512 * 128 + 64, 128, 0, scr, gw, NGW, lane, off);
    conv_job(p->in[I_GUP] + (size_t)l * 128 * 512, 512, 0, 512, 2, nullptr, (bf16*)(ws + W_GUP), 128, 0, scr, gw, NGW, lane, off);
    { unsigned zz = 0u; asm volatile("" : "+v"(zz)); const u32x4 zv = {zz, zz, zz, zz};
      for (int i = blockIdx.x * 512 + tid; i < 1024 * 8; i += gridDim.x * 512) { const int row = i >> 3, ch = i & 7; *(u32x4*)((bf16*)(ws + W_BWA) + row * 128 + (row < 512 ? 64 : 0) + ch * 8) = zv; } }
    { u32x4* z = (u32x4*)((bf16*)(ws + W_IN) + (size_t)3232 * 1024); const int n16 = 96 * 1024 * 2 / 16;
      unsigned zz = 0u; asm volatile("" : "+v"(zz)); const u32x4 zv = {zz, zz, zz, zz};
      for (int i = blockIdx.x * 512 + tid; i < n16; i += gridDim.x * 512) z[i] = zv; }
    if (l == 0) {
        const float* x = p->in[I_X]; bf16* xb = (bf16*)(ws + WS_XB); float* part = (float*)(ws + WS_PART);
        for (int row = gw; row < T; row += NGW) {
            const f32x4* xr = (const f32x4*)(x + (size_t)row * 1024) + lane; float s = 0.f;
#pragma unroll
            for (int j = 0; j < 4; ++j) { const f32x4 v = xr[64 * j]; s += (v.x * v.x + v.y * v.y) + (v.z * v.z + v.w * v.w);
                u32x2 w; w.x = pk2(v.x, v.y); w.y = pk2(v.z, v.w); *((u32x2*)(xb + (size_t)row * 1024) + lane + 64 * j) = w; }
            s = wave_sum(s);
            if (lane < 16) part[(size_t)row * 16 + lane] = lane == 0 ? s : 0.f;
        }
    }
}

__device__ __forceinline__ void rope_cs(int pos, int i, float& c, float& s) {
    const float invf = exp2f(-(float)i * 0.8304820237218406f);
    const float ang = (float)pos * invf;
    const double x = (double)ang * 0.15915494309189535; const float f = (float)(x - rint(x));
    c = __builtin_amdgcn_cosf(f); s = __builtin_amdgcn_sinf(f);
}
template <int DQK, int DV, bool CAUSAL, bool MLA>
__device__ __forceinline__ void attn_unit(int wid_s, unsigned char* lds, const bf16* Qb, int ldq, const bf16* Kb, int ldk, const bf16* Vtb, int ldv, bf16* Ob, int ldo,
                                          int q0, int nkt, const float* qgain, const int* pos, float qscale) {
    constexpr int KS = DQK * 2 + 16, VS = 144, NKS = DQK / 32, NDT = DV / 16, KCH = DQK / 8, NKC = (64 * KCH + 511) / 512, NVC = DV * 8 / 512;
    unsigned char* Ks = lds; unsigned char* Vs = lds + 64 * KS;
    const int tid_ = mk_tid(wid_s);
    const int tid = tid_, lane = tid & 63, wv = tid >> 6, g = lane >> 4, j = lane & 15;
    const int qrow = q0 + wv * 16 + j;
    bf16x8 qf[NKS];
    {
        float qv[NKS][8]; float ss = 0.f;
#pragma unroll
        for (int ks = 0; ks < NKS; ++ks) { const u32x4 w = *(const u32x4*)(Qb + (size_t)qrow * ldq + 32 * ks + 8 * g);
            qv[ks][0] = bflo(w.x); qv[ks][1] = bfhi(w.x); qv[ks][2] = bflo(w.y); qv[ks][3] = bfhi(w.y); qv[ks][4] = bflo(w.z); qv[ks][5] = bfhi(w.z); qv[ks][6] = bflo(w.w); qv[ks][7] = bfhi(w.w);
#pragma unroll
            for (int e = 0; e < 8; ++e) ss += qv[ks][e] * qv[ks][e]; }
        ss += __shfl_xor(ss, 16); ss += __shfl_xor(ss, 32);
        const float rs = rsqrtf(ss * (1.f / DQK) + 1e-6f);
#pragma unroll
        for (int ks = 0; ks < NKS; ++ks)
#pragma unroll
            for (int e = 0; e < 8; ++e) qv[ks][e] *= rs * qgain[32 * ks + 8 * g + e];
        if (MLA) {
            const int ps = pos[qrow];
#pragma unroll
            for (int e = 0; e < 8; ++e) { const float mine = qv[2][e], other = __shfl_xor(mine, 32); float c, s; rope_cs(ps, 8 * (g & 1) + e, c, s);
                qv[2][e] = (g < 2) ? (mine * c - other * s) : (mine * c + other * s); }
        }
#pragma unroll
        for (int ks = 0; ks < NKS; ++ks) { u32x4 w; w.x = pk2(qv[ks][0] * qscale, qv[ks][1] * qscale); w.y = pk2(qv[ks][2] * qscale, qv[ks][3] * qscale);
            w.z = pk2(qv[ks][4] * qscale, qv[ks][5] * qscale); w.w = pk2(qv[ks][6] * qscale, qv[ks][7] * qscale); qf[ks] = __builtin_bit_cast(bf16x8, w); }
    }
    f32x4 oT[NDT];
#pragma unroll
    for (int d = 0; d < NDT; ++d) oT[d] = (f32x4){0.f, 0.f, 0.f, 0.f};
    float mrun = -INFINITY, lsum = 0.f;
    u32x4 kreg[NKC], vreg[NVC];
#define ATT_PREFETCH(kt) do { _Pragma("unroll") for (int i = 0; i < NKC; ++i) { const int idx = tid + 512 * i; if (idx < 64 * KCH) { const int key = idx / KCH, ch = idx % KCH; \
            kreg[i] = *(const u32x4*)(Kb + (size_t)(64 * (kt) + key) * ldk + ch * 8); } } \
        _Pragma("unroll") for (int i = 0; i < NVC; ++i) { const int idx = tid + 512 * i; const int dv = idx >> 3, ch = idx & 7; vreg[i] = *(const u32x4*)(Vtb + (size_t)dv * ldv + 64 * (kt) + ch * 8); } } while (0)
    ATT_PREFETCH(0);
    for (int kt = 0; kt < nkt; ++kt) {
        __syncthreads();
#pragma unroll
        for (int i = 0; i < NKC; ++i) { const int idx = tid + 512 * i; if (idx < 64 * KCH) { const int key = idx / KCH, ch = idx % KCH; *(u32x4*)(Ks + key * KS + ch * 16) = kreg[i]; } }
#pragma unroll
        for (int i = 0; i < NVC; ++i) { const int idx = tid + 512 * i; const int dv = idx >> 3, ch = idx & 7; *(u32x4*)(Vs + dv * VS + ch * 16) = vreg[i]; }
        __syncthreads();
        if (kt + 1 < nkt) ATT_PREFETCH(kt + 1);
        const int qw0 = q0 + wv * 16;
        if (CAUSAL && 64 * kt > qw0 + 15) continue;
        f32x4 sT[4];
#pragma unroll
        for (int k4 = 0; k4 < 4; ++k4) { sT[k4] = (f32x4){0.f, 0.f, 0.f, 0.f};
#pragma unroll
            for (int ks = 0; ks < NKS; ++ks) { const bf16x8 a = *(const bf16x8*)(Ks + (16 * k4 + j) * KS + (32 * ks + 8 * g) * 2);
                sT[k4] = __builtin_amdgcn_mfma_f32_16x16x32_bf16(a, qf[ks], sT[k4], 0, 0, 0); } }
        if (CAUSAL && 64 * kt + 63 > qw0) {
#pragma unroll
            for (int k4 = 0; k4 < 4; ++k4)
#pragma unroll
                for (int r = 0; r < 4; ++r) if (64 * kt + 16 * k4 + 4 * g + r > qrow) sT[k4][r] = -INFINITY;
        }
        float mx = -INFINITY;
#pragma unroll
        for (int k4 = 0; k4 < 4; ++k4) mx = fmaxf(mx, fmaxf(fmaxf(sT[k4][0], sT[k4][1]), fmaxf(sT[k4][2], sT[k4][3])));
        mx = fmaxf(mx, __shfl_xor(mx, 16)); mx = fmaxf(mx, __shfl_xor(mx, 32));
        const float mnew = fmaxf(mrun, mx); const float alpha = __builtin_amdgcn_exp2f(mrun - mnew); mrun = mnew;
        float psum = 0.f;
#pragma unroll
        for (int k4 = 0; k4 < 4; ++k4)
#pragma unroll
            for (int r = 0; r < 4; ++r) { const float pv = __builtin_amdgcn_exp2f(sT[k4][r] - mnew); sT[k4][r] = pv; psum += pv; }
        lsum = lsum * alpha + psum;
#pragma unroll
        for (int d = 0; d < NDT; ++d) oT[d] *= alpha;
#pragma unroll
        for (int kc = 0; kc < 2; ++kc) {
            const bf16x8 pb = __builtin_bit_cast(bf16x8, pk8(sT[2 * kc], sT[2 * kc + 1]));
#pragma unroll
            for (int d = 0; d < NDT; ++d) { const unsigned char* vp = Vs + (16 * d + j) * VS + (32 * kc + 4 * g) * 2;
                const u32x2 lo = *(const u32x2*)vp, hi = *(const u32x2*)(vp + 32); u32x4 w; w.x = lo.x; w.y = lo.y; w.z = hi.x; w.w = hi.y;
                oT[d] = __builtin_amdgcn_mfma_f32_16x16x32_bf16(__builtin_bit_cast(bf16x8, w), pb, oT[d], 0, 0, 0); }
        }
    }
#undef ATT_PREFETCH
    lsum += __shfl_xor(lsum, 16); lsum += __shfl_xor(lsum, 32);
    const float inv = 1.f / lsum;
#pragma unroll
    for (int d = 0; d < NDT; ++d) { u32x2 w; w.x = pk2(oT[d][0] * inv, oT[d][1] * inv); w.y = pk2(oT[d][2] * inv, oT[d][3] * inv);
        *(u32x2*)(Ob + (size_t)qrow * ldo + 16 * d + 4 * g) = w; }
}

__device__ __forceinline__ void lora_act_rows(int wid_s, KP p_, int l, int r) {
    KP p = p_; asm volatile("" : "+s"(p));
    unsigned char* ws = p->ws;
    const int tid_ = mk_tid(wid_s);
    const int tid = tid_;
    const bf16* P = (const bf16*)(ws + R_P); bf16* Awa = (bf16*)(ws + WS_Y) + (size_t)r * TH * 1536 + 1024; bf16* Ag = (bf16*)(ws + WS_AG);
    const float* mu = p->in[I_MU] + l * 1792 + 1536;
    const int sub = tid & 31, j0 = sub * 8;
    f32x4 m0 = *(const f32x4*)(mu + j0), m1 = *(const f32x4*)(mu + j0 + 4);
    for (int row = blockIdx.x * 16 + (tid >> 5); row < TH; row += gridDim.x * 16) {
        const u32x4 cw = *(const u32x4*)(P + (size_t)row * NP + 1536 + j0);
        u32x4 pw = {0u, 0u, 0u, 0u}; if ((row & 2047) != 0) pw = *(const u32x4*)(P + (size_t)(row - 1) * NP + 1536 + j0);
        float c[8] = {bflo(cw.x), bfhi(cw.x), bflo(cw.y), bfhi(cw.y), bflo(cw.z), bfhi(cw.z), bflo(cw.w), bfhi(cw.w)};
        const float q[8] = {bflo(pw.x), bfhi(pw.x), bflo(pw.y), bfhi(pw.y), bflo(pw.z), bfhi(pw.z), bflo(pw.w), bfhi(pw.w)};
        const float mm[8] = {m0.x, m0.y, m0.z, m0.w, m1.x, m1.y, m1.z, m1.w};
#pragma unroll
        for (int e = 0; e < 8; ++e) { float v = c[e] + (q[e] - c[e]) * mm[e];
            if (j0 < 64) v = 2.f * fsig(2.f * v) - 1.f;
            else if (j0 >= 128) v = fsig(v);
            c[e] = v; }
        u32x4 o; o.x = pk2(c[0], c[1]); o.y = pk2(c[2], c[3]); o.z = pk2(c[4], c[5]); o.w = pk2(c[6], c[7]);
        if (j0 < 128) *(u32x4*)(Awa + (size_t)row * 1536 + j0) = o; else *(u32x4*)(Ag + (size_t)row * 128 + (j0 - 128)) = o;
    }
}
__device__ __forceinline__ void si_build_tile(int wid_s, KP p_, int l, int r, int tile) {
    KP p = p_; asm volatile("" : "+s"(p));
    unsigned char* ws = p->ws;
    const int tid_ = mk_tid(wid_s);
    const int tid = tid_, lane = tid & 63, wv = tid >> 6;
    const bf16* P = (const bf16*)(ws + R_P); bf16* SI = (bf16*)(ws + R_SI); const bf16* LW = (const bf16*)(ws + WS_Y) + (size_t)r * TH * 1536;
    const float* mu = p->in[I_MU] + l * 1792;
    const int row0 = tile * 32;
    const int c = tid, h = wv;
    const float w0c = p->in[I_W0][l * 512 + c], a0c = p->in[I_A0][l * 512 + c], kkc = p->in[I_KK][l * 512 + c], kac = p->in[I_KA][l * 512 + c];
    const float mur = mu[c], muk = mu[512 + c], muv = mu[1024 + c];
#pragma unroll 4
    for (int t = 0; t < 32; ++t) {
        const int row = row0 + t; const bool first = (row & 2047) == 0;
        const bf16* pr = P + (size_t)row * NP; const bf16* pp = pr - NP;
        const float rc = bf2f(pr[c]), kc = bf2f(pr[512 + c]), vc = bf2f(pr[1024 + c]);
        const float rp = first ? 0.f : bf2f(pp[c]), kp = first ? 0.f : bf2f(pp[512 + c]), vp = first ? 0.f : bf2f(pp[1024 + c]);
        const float wl = bf2f(LW[(size_t)row * 1536 + c]), al = bf2f(LW[(size_t)row * 1536 + 512 + c]);
        const float rr = rc + (rp - rc) * mur, k = kc + (kp - kc) * muk, v = vc + (vp - vc) * muv;
        const float om = 1.f - __expf(-0.6065306597126334f * fsig(w0c + wl));
        const float a = fsig(a0c + al);
        const float kkr = k * kkc; const float ss = wave_sum(kkr * kkr); const float kk = kkr / fmaxf(sqrtf(ss), 1e-12f);
        const float k2 = k * (1.f + (a - 1.f) * kac);
        bf16* o = SI + ((size_t)((row >> 11) * 8 + h) * 2048 + (row & 2047)) * 384 + lane;
        o[0] = (bf16)f2bf(rr); o[64] = (bf16)f2bf(om); o[128] = (bf16)f2bf(k2); o[192] = (bf16)f2bf(kk); o[256] = (bf16)f2bf(kk * a); o[320] = (bf16)f2bf(v);
    }
}

template <int CTRL> __device__ __forceinline__ float dppf(float x) { return __builtin_bit_cast(float, __builtin_amdgcn_update_dpp(0, __builtin_bit_cast(int, x), CTRL, 0xF, 0xF, true)); }
__device__ __forceinline__ float allreduce16(float x) { x += dppf<0xB1>(x); x += dppf<0x4E>(x); x += dppf<0x141>(x); x += dppf<0x140>(x); return x; }
__device__ __forceinline__ void rwkv_scan_unit(int wid_s, const bf16* SIbh, bf16* Yb, int quarter, float* ldsf) {
    const int tid_ = mk_tid(wid_s);
    const int tid = tid_, lane = tid & 63, wv = tid >> 6;
    u32x4 pre[3];
#pragma unroll
    for (int i = 0; i < 3; ++i) pre[i] = *(const u32x4*)(SIbh + (size_t)(tid + 512 * i) * 8);
    f32x2 Sa = {0.f, 0.f}, Sb = {0.f, 0.f};
    const int rowl = quarter * 16 + (wv & 3) * 4 + (lane >> 4), c4 = (lane & 15) * 4;
    __syncthreads();
    for (int ch = 0; ch < 64; ++ch) {
        float* B = ldsf + (ch & 1) * (32 * 384);
#pragma unroll
        for (int i = 0; i < 3; ++i) { float* d = B + (tid + 512 * i) * 8; const u32x4 w = pre[i];
            *(f32x4*)d = (f32x4){bflo(w.x), bfhi(w.x), bflo(w.y), bfhi(w.y)}; *(f32x4*)(d + 4) = (f32x4){bflo(w.z), bfhi(w.z), bflo(w.w), bfhi(w.w)}; }
        if (ch + 1 < 64) {
#pragma unroll
            for (int i = 0; i < 3; ++i) pre[i] = *(const u32x4*)(SIbh + (size_t)(ch + 1) * (32 * 384) + (size_t)(tid + 512 * i) * 8);
        }
        __syncthreads();
        if (wv < 4) {
            const float* q = B;
            f32x4 r4 = *(const f32x4*)(q + c4), om4 = *(const f32x4*)(q + 64 + c4), k4 = *(const f32x4*)(q + 128 + c4), kk4 = *(const f32x4*)(q + 192 + c4), ka4 = *(const f32x4*)(q + 256 + c4);
            float v = q[320 + rowl];
            float ykeep = 0.f;
#pragma unroll
            for (int s = 0; s < 32; ++s) {
                const float* qn = B + ((s + 1) & 31) * 384;
                const f32x4 nr4 = *(const f32x4*)(qn + c4), nom4 = *(const f32x4*)(qn + 64 + c4), nk4 = *(const f32x4*)(qn + 128 + c4), nkk4 = *(const f32x4*)(qn + 192 + c4), nka4 = *(const f32x4*)(qn + 256 + c4);
                const float nv = qn[320 + rowl];
                const f32x2 pa = Sa * (f32x2){kk4.x, kk4.y} + Sb * (f32x2){kk4.z, kk4.w};
                float sa = allreduce16(pa.x + pa.y);
                Sa = Sa - Sa * (f32x2){om4.x, om4.y} + (f32x2){k4.x, k4.y} * v; Sb = Sb - Sb * (f32x2){om4.z, om4.w} + (f32x2){k4.z, k4.w} * v;
                Sa = Sa - (f32x2){ka4.x, ka4.y} * sa; Sb = Sb - (f32x2){ka4.z, ka4.w} * sa;
                const f32x2 py = Sa * (f32x2){r4.x, r4.y} + Sb * (f32x2){r4.z, r4.w};
                const float y = allreduce16(py.x + py.y);
                ykeep = ((lane & 15) == (s & 15)) ? y : ykeep;
                if ((s & 15) == 15) Yb[(size_t)(ch * 32 + (s & 16) + (lane & 15)) * 1536 + rowl] = (bf16)f2bf(ykeep);
                r4 = nr4; om4 = nom4; k4 = nk4; kk4 = nkk4; ka4 = nka4; v = nv;
            }
        }
    }
    __syncthreads();
}

__device__ __forceinline__ void rwkv_post_tile(int wid_s, KP p_, int l, int r, int tile, int dummy) {
    KP p = p_; asm volatile("" : "+s"(p));
    unsigned char* ws = p->ws;
    const int tid_ = mk_tid(wid_s);
    const int tid = tid_, lane = tid & 63, wv = tid >> 6;
    const bf16* P = (const bf16*)(ws + R_P); const bf16* SI = (const bf16*)(ws + R_SI); bf16* Y = (bf16*)(ws + WS_Y) + (size_t)r * TH * 1536;
    const int row0 = tile * 32;
    const int c = tid, h = wv;
    const float rkc = p->in[I_RK][l * 512 + c], lng = p->in[I_LNG][l * 512 + c], lnb = p->in[I_LNB][l * 512 + c];
#pragma unroll 4
    for (int t = 0; t < 32; ++t) {
        const int row = row0 + t;
        const bf16* si = SI + ((size_t)((row >> 11) * 8 + h) * 2048 + (row & 2047)) * 384 + lane;
        const float rr = bf2f(si[0]), k2 = bf2f(si[128]), v = bf2f(si[320]);
        const float gg = bf2f(P[(size_t)row * NP + c]);
        bf16* yp = Y + (size_t)row * 1536 + c;
        const float y = bf2f(*yp);
        const float mean = wave_sum(y) * (1.f / 64.f); const float d = y - mean; const float var = wave_sum(d * d) * (1.f / 64.f);
        const float yn = d * rsqrtf(var + 64e-5f) * lng + lnb;
        const float bonus = wave_sum(rr * k2 * rkc) * v;
        if (dummy) yp = (bf16*)(ws + R_P) + (size_t)row * NP + 600 + c;
        *yp = (bf16)f2bf((yn + bonus) * gg);
    }
}

__device__ __forceinline__ float gelu_tanh(float x) { const float u = 0.7978845608028654f * (x + 0.044715f * x * x * x); return x * fsig(2.f * u); }
__device__ __forceinline__ void lru_unit(int wid_s, KP p_, int l, int r, int bl, int n, float* ldsf) {
    KP p = p_; asm volatile("" : "+s"(p));
    unsigned char* ws = p->ws;
    const int tid_ = mk_tid(wid_s);
    const int tid = tid_, lane = tid & 63, wv = tid >> 6, g = lane >> 4, j = lane & 15;
    const bf16* P = (const bf16*)(ws + R_P) + (size_t)bl * 2048 * NP; bf16* Yb = (bf16*)(ws + WS_Y) + ((size_t)(r * 4 + bl) * 2048) * 1536 + 512;
    const int cg_ = n * 64 + lane;
    float* s_xc = ldsf;
    float* s_a = ldsf + 8192;
    float* s_u = ldsf + 16384;
    float* s_AH = ldsf + 24576;
    unsigned char* s_xb16 = (unsigned char*)ldsf + 102400;
    unsigned char* s_wt16 = (unsigned char*)ldsf + 120832;
    __syncthreads();
    for (int e = tid; e < 8192; e += 512) { const int jj = e >> 6, ii = e & 63;
        const float w = (jj < 64) ? p->in[I_WA][((size_t)l * 8 + n) * 4096 + ii * 64 + jj] : p->in[I_WX][((size_t)l * 8 + n) * 4096 + ii * 64 + (jj - 64)];
        *(bf16*)(s_wt16 + (jj * 72 + ii) * 2) = (bf16)f2bf(w); }
    const float cw0 = p->in[I_CW][(l * 4 + 0) * 512 + cg_], cw1 = p->in[I_CW][(l * 4 + 1) * 512 + cg_], cw2 = p->in[I_CW][(l * 4 + 2) * 512 + cg_], cw3 = p->in[I_CW][(l * 4 + 3) * 512 + cg_];
    const float cb = p->in[I_CB][l * 512 + cg_];
    float ba4[4], bx4[4], sp4[4];
#pragma unroll
    for (int n4 = 0; n4 < 4; ++n4) { const int c = n * 64 + 16 * n4 + j; ba4[n4] = p->in[I_BA][l * 512 + c]; bx4[n4] = p->in[I_BX][l * 512 + c];
        sp4[n4] = -8.f * 1.4426950408889634f * log1pf(__expf(-p->in[I_LAM][l * 512 + c])); }
    float hcar = 0.f;
    for (int tile = 0; tile < 16; ++tile) {
        const int t0 = tile * 128 + wv * 16;
        float xc[16]; unsigned short gbr[16];
        {
            float x3 = (t0 >= 3) ? bf2f(P[(size_t)(t0 - 3) * NP + 1792 + cg_]) : 0.f, x2 = (t0 >= 2) ? bf2f(P[(size_t)(t0 - 2) * NP + 1792 + cg_]) : 0.f, x1 = (t0 >= 1) ? bf2f(P[(size_t)(t0 - 1) * NP + 1792 + cg_]) : 0.f;
#pragma unroll
            for (int i = 0; i < 16; ++i) { const float x0 = bf2f(P[(size_t)(t0 + i) * NP + 1792 + cg_]);
                xc[i] = cw0 * x3 + cw1 * x2 + cw2 * x1 + cw3 * x0 + cb; x3 = x2; x2 = x1; x1 = x0; }
#pragma unroll
            for (int i = 0; i < 16; ++i) gbr[i] = P[(size_t)(t0 + i) * NP + 2304 + cg_];
        }
        __syncthreads();
#pragma unroll
        for (int i = 0; i < 16; ++i) { s_xc[(wv * 16 + i) * 64 + lane] = xc[i]; *(bf16*)(s_xb16 + ((wv * 16 + i) * 72 + lane) * 2) = (bf16)f2bf(xc[i]); }
        __syncthreads();
        {
            f32x4 acc[8];
            const bf16x8 a0 = *(const bf16x8*)(s_xb16 + ((16 * wv + j) * 72 + 8 * g) * 2), a1 = *(const bf16x8*)(s_xb16 + ((16 * wv + j) * 72 + 32 + 8 * g) * 2);
#pragma unroll
            for (int nn = 0; nn < 8; ++nn) { acc[nn] = (f32x4){0.f, 0.f, 0.f, 0.f};
                const bf16x8 b0 = *(const bf16x8*)(s_wt16 + ((16 * nn + j) * 72 + 8 * g) * 2), b1 = *(const bf16x8*)(s_wt16 + ((16 * nn + j) * 72 + 32 + 8 * g) * 2);
                acc[nn] = __builtin_amdgcn_mfma_f32_16x16x32_bf16(a0, b0, acc[nn], 0, 0, 0); acc[nn] = __builtin_amdgcn_mfma_f32_16x16x32_bf16(a1, b1, acc[nn], 0, 0, 0); }
#pragma unroll
            for (int n4 = 0; n4 < 4; ++n4)
#pragma unroll
                for (int rr = 0; rr < 4; ++rr) { const int tk = 16 * wv + 4 * g + rr, c = 16 * n4 + j;
                    const float rg = fsig(acc[n4][rr] + ba4[n4]), ig = fsig(acc[n4 + 4][rr] + bx4[n4]);
                    const float a = __builtin_amdgcn_exp2f(sp4[n4] * rg);
                    const float uu = __builtin_amdgcn_sqrtf(fmaxf(1.f - a * a, 0.f)) * (ig * s_xc[tk * 64 + c]);
                    s_a[tk * 64 + c] = a; s_u[tk * 64 + c] = uu; }
        }
        __syncthreads();
        float av[16], uv[16]; float A = 1.f, H = 0.f;
#pragma unroll
        for (int i = 0; i < 16; ++i) { av[i] = s_a[(wv * 16 + i) * 64 + lane]; uv[i] = s_u[(wv * 16 + i) * 64 + lane]; A *= av[i]; H = av[i] * H + uv[i]; }
        s_AH[(wv * 64 + lane) * 2] = A; s_AH[(wv * 64 + lane) * 2 + 1] = H;
        __syncthreads();
        float hin = hcar, hall = hcar;
#pragma unroll
        for (int w = 0; w < 8; ++w) { const float Aw = s_AH[(w * 64 + lane) * 2], Hw = s_AH[(w * 64 + lane) * 2 + 1]; hall = Aw * hall + Hw; if (w < wv) hin = hall; }
        hcar = hall;
        float hh = hin;
#pragma unroll
        for (int i = 0; i < 16; ++i) { hh = av[i] * hh + uv[i];
            Yb[(size_t)(t0 + i) * 1536 + cg_] = (bf16)f2bf(hh * gelu_tanh(bf2f(gbr[i]))); }
    }
    __syncthreads();
}

__device__ __forceinline__ void kfix_rows(int wid_s, KP p_, int l, int r) {
    KP p = p_; asm volatile("" : "+s"(p));
    unsigned char* ws = p->ws;
    const int tid_ = mk_tid(wid_s);
    const int tid = tid_, lane = tid & 63, wv = tid >> 6, h = lane >> 3, sub = lane & 7;
    const bf16* P = (const bf16*)(ws + R_P); bf16* Km = (bf16*)(ws + R_KM);
    const float* kg = p->in[I_KG] + l * 96; const int* pos = (const int*)p->in[I_POS] + r * TH;
    for (int row = blockIdx.x * 8 + wv; row < TH; row += gridDim.x * 8) {
        bf16* kp = Km + (size_t)row * 768 + h * 96;
        const u32x4 w = *(const u32x4*)(kp + 8 * sub);
        float nv[8] = {bflo(w.x), bfhi(w.x), bflo(w.y), bfhi(w.y), bflo(w.z), bfhi(w.z), bflo(w.w), bfhi(w.w)};
        const unsigned k1 = *(const unsigned*)(P + (size_t)row * NP + 3200 + 2 * sub), k2 = *(const unsigned*)(P + (size_t)row * NP + 3216 + 2 * sub);
        float x1a = bflo(k1), x1b = bfhi(k1), x2a = bflo(k2), x2b = bfhi(k2);
        float ss = x1a * x1a + x1b * x1b + x2a * x2a + x2b * x2b;
#pragma unroll
        for (int e = 0; e < 8; ++e) ss += nv[e] * nv[e];
        ss += __shfl_xor(ss, 1); ss += __shfl_xor(ss, 2); ss += __shfl_xor(ss, 4);
        const float rs = rsqrtf(ss * (1.f / 96.f) + 1e-6f);
#pragma unroll
        for (int e = 0; e < 8; ++e) nv[e] *= rs * kg[8 * sub + e];
        x1a *= rs * kg[64 + 2 * sub]; x1b *= rs * kg[65 + 2 * sub]; x2a *= rs * kg[80 + 2 * sub]; x2b *= rs * kg[81 + 2 * sub];
        const int ps = pos[row]; float ca, sa, cb, sb; rope_cs(ps, 2 * sub, ca, sa); rope_cs(ps, 2 * sub + 1, cb, sb);
        u32x4 o; o.x = pk2(nv[0], nv[1]); o.y = pk2(nv[2], nv[3]); o.z = pk2(nv[4], nv[5]); o.w = pk2(nv[6], nv[7]);
        *(u32x4*)(kp + 8 * sub) = o;
        *(unsigned*)(kp + 64 + 2 * sub) = pk2(x1a * ca - x2a * sa, x1b * cb - x2b * sb);
        *(unsigned*)(kp + 80 + 2 * sub) = pk2(x2a * ca + x1a * sa, x2b * cb + x1b * sb);
    }
}
__device__ __forceinline__ void mkfix_rows(int wid_s, KP p_, int l) {
    KP p = p_; asm volatile("" : "+s"(p));
    unsigned char* ws = p->ws;
    const int tid_ = mk_tid(wid_s);
    const int tid = tid_, lane = tid & 63, wv = tid >> 6, h = lane >> 4, sub = lane & 15;
    bf16* mk = (bf16*)(ws + R_MK); const float* kg = p->in[I_XKG] + l * 128;
    for (int row = blockIdx.x * 8 + wv; row < 2048; row += gridDim.x * 8) {
        bf16* kp = mk + (size_t)row * 512 + h * 128 + 8 * sub;
        const u32x4 w = *(const u32x4*)kp;
        float nv[8] = {bflo(w.x), bfhi(w.x), bflo(w.y), bfhi(w.y), bflo(w.z), bfhi(w.z), bflo(w.w), bfhi(w.w)};
        float ss = 0.f;
#pragma unroll
        for (int e = 0; e < 8; ++e) ss += nv[e] * nv[e];
        ss += __shfl_xor(ss, 1); ss += __shfl_xor(ss, 2); ss += __shfl_xor(ss, 4); ss += __shfl_xor(ss, 8);
        const float rs = rsqrtf(ss * (1.f / 128.f) + 1e-6f);
#pragma unroll
        for (int e = 0; e < 8; ++e) nv[e] *= rs * kg[8 * sub + e];
        u32x4 o; o.x = pk2(nv[0], nv[1]); o.y = pk2(nv[2], nv[3]); o.z = pk2(nv[4], nv[5]); o.w = pk2(nv[6], nv[7]);
        *(u32x4*)kp = o;
    }
}
__device__ __forceinline__ void memb_rows(int wid_s, KP p_) {
    KP p = p_; asm volatile("" : "+s"(p));
    unsigned char* ws = p->ws;
    const int tid_ = mk_tid(wid_s);
    const int tid = tid_, lane = tid & 63, wv = tid >> 6;
    const float* mem = p->in[I_MEM]; bf16* memb = (bf16*)(ws + R_MEMB);
    for (int row = blockIdx.x * 8 + wv; row < 2048; row += gridDim.x * 8) {
        const f32x4* xr = (const f32x4*)(mem + (size_t)row * 1024) + lane; f32x4 v[4]; float s = 0.f;
#pragma unroll
        for (int jq = 0; jq < 4; ++jq) { v[jq] = xr[64 * jq]; s += (v[jq].x * v[jq].x + v[jq].y * v[jq].y) + (v[jq].z * v[jq].z + v[jq].w * v[jq].w); }
        const float rs = rsqrtf(wave_sum(s) * (1.f / 1024.f) + 1e-6f);
#pragma unroll
        for (int jq = 0; jq < 4; ++jq) { u32x2 w; w.x = pk2(v[jq].x * rs, v[jq].y * rs); w.y = pk2(v[jq].z * rs, v[jq].w * rs); *((u32x2*)(memb + (size_t)row * 1024) + lane + 64 * jq) = w; }
    }
}

#define XB_TMO      128
#define XB_XCNT(j)  (256  + 64 * (j))
#define XB_XSUB(j)  (1280 + 64 * (j))
#define XB_XGEN(j)  (2304 + 64 * (j))
#define XB_TOP      3328
#define XB_TOPGEN   3392
#define XCD_BAR_WORDS 3456
#define XB_SPIN_CAP (1u << 22)
__device__ __forceinline__ unsigned xb_ld(unsigned* p)              { return __hip_atomic_load(p, __ATOMIC_RELAXED, __HIP_MEMORY_SCOPE_AGENT); }
__device__ __forceinline__ unsigned xb_add(unsigned* p, unsigned v) { return __hip_atomic_fetch_add(p, v, __ATOMIC_RELAXED, __HIP_MEMORY_SCOPE_AGENT); }
__device__ __forceinline__ unsigned xb_xcc_id() { return (unsigned)__builtin_amdgcn_s_getreg((3 << 11) | 20) & 0xFu; }
#define XB_SPIN(cond, bar) do { unsigned _sp = 0; while (cond) { __builtin_amdgcn_s_sleep(1); \
    if ((++_sp & 255u) == 0u) { if (xb_ld(&(bar)[XB_TMO])) break; if (_sp > XB_SPIN_CAP) { atomicAdd(&(bar)[XB_TMO], 1u); break; } } } } while (0)
__device__ __forceinline__ void xcd_barrier_complete(unsigned* bar, unsigned x, unsigned& nloc, unsigned& nx) {
    const unsigned G = gridDim.x;
    unsigned sum, cnt, mine, sp = 0u;
    for (;;) {
        sum = 0u; cnt = 0u; mine = 0u;
#pragma unroll
        for (unsigned j = 0; j < 16; ++j) { const unsigned c = xb_ld(&bar[XB_XCNT(j)]); sum += c; cnt += (c > 0u) ? 1u : 0u; mine = (j == x) ? c : mine; }
        if (sum == G) break;
        __builtin_amdgcn_s_sleep(1);
        if ((++sp & 255u) == 0u) { if (xb_ld(&bar[XB_TMO])) break; if (sp > XB_SPIN_CAP) { atomicAdd(&bar[XB_TMO], 1u); break; } }
    }
    nloc = mine > 0u ? mine : 1u; nx = cnt > 0u ? cnt : 1u;
}
__device__ __forceinline__ void grid_barrier1(int wid_s, unsigned* bar, volatile unsigned* st) {
    asm volatile("s_waitcnt vmcnt(0)" ::: "memory");
    __syncthreads();
    if (mk_tid(wid_s) == 0) {
        const unsigned x = xb_xcc_id();
        __builtin_amdgcn_s_waitcnt(0);
        unsigned nloc = st[0], nx = st[1];
        if (nloc == 0u) { xcd_barrier_complete(bar, x, nloc, nx); st[0] = nloc; st[1] = nx; }
        const unsigned old = xb_add(&bar[XB_XSUB(x)], 1u);
        const unsigned gen = old / nloc;
        if (old + 1u == (gen + 1u) * nloc) {
            __builtin_amdgcn_fence(__ATOMIC_RELEASE, "agent");
            asm volatile("s_waitcnt vmcnt(0)" ::: "memory");
            const unsigned og = xb_add(&bar[XB_TOP], 1u);
            const unsigned tg = og / nx;
            if (og + 1u == (tg + 1u) * nx) xb_add(&bar[XB_TOPGEN], 1u);
            else XB_SPIN(xb_ld(&bar[XB_TOPGEN]) == tg, bar);
            __builtin_amdgcn_fence(__ATOMIC_ACQUIRE, "agent");
            xb_add(&bar[XB_XGEN(x)], 1u);
            asm volatile("s_waitcnt vmcnt(0)" ::: "memory");
        } else {
            XB_SPIN(xb_ld(&bar[XB_XGEN(x)]) == gen, bar);
            __builtin_amdgcn_fence(__ATOMIC_ACQUIRE, "agent");
            asm volatile("s_waitcnt vmcnt(0)" ::: "memory");
        }
    }
    __syncthreads();
}
__device__ __forceinline__ void grid_barrier(int wid_s, unsigned* bar, volatile unsigned* st) { int nb = 1 + RB(8); asm volatile("" : "+s"(nb)); for (int q = 0; q < nb; ++q) grid_barrier1(wid_s, bar, st); }
template <class Epi>
__device__ __forceinline__ void run_gemm(int wid_s, LAS unsigned char* lds, const bf16* A, int lda, const bf16* Bt, int M, int N, int K, const Epi& E) {
    int bx_ = blockIdx.x, gx_ = gridDim.x; asm volatile("" : "+s"(bx_), "+s"(gx_), "+s"(K), "+s"(lda));
    pg8::Gemm g{A, Bt, M, N, K, lda}; pg8::StaticOrder S; S.init(M, N, gx_, bx_);
    if (ON(1)) pg8::gemm_phase<Epi, pg8::StaticOrder>(wid_s, lds, g, S, E);
}

__device__ __forceinline__ unsigned char* wsl_(KP p) { unsigned char* w = p->ws; asm volatile("" : "+s"(w)); return w; }
__global__ void __launch_bounds__(512, 2) fwd_kernel(Params parg) {
    KP p = (KP)__builtin_amdgcn_kernarg_segment_ptr();
    extern __shared__ __attribute__((aligned(16))) unsigned char lds_raw[];
    const int wid_s = __builtin_amdgcn_readfirstlane((int)threadIdx.x >> 6);
    LAS unsigned char* lds3 = (LAS unsigned char*)lds_raw;
    unsigned char* lds = lds_raw; float* ldsf = (float*)lds_raw;
    unsigned char* ws = p->ws;
    const int bid = blockIdx.x;
    unsigned* ctl = (unsigned*)(wsl_(p) + WS_CTL);
    bf16* xb = (bf16*)(wsl_(p) + WS_XB); float* part = (float*)(wsl_(p) + WS_PART); float* pq = (float*)(wsl_(p) + WS_PQ); float* pkv = (float*)(wsl_(p) + WS_PKV);
    bf16* Y = (bf16*)(wsl_(p) + WS_Y);
    float* xcur = p->out;
    volatile unsigned* bst = (volatile unsigned*)(lds + QIDX_OFF + 16);
    if (threadIdx.x == 0) { bst[0] = 0u; bst[1] = 0u; (void)xb_add(&ctl[1024 + XB_XCNT(xb_xcc_id())], 1u); }
    __syncthreads();

    for (int l_ = 0; l_ < 2; ++l_) {
        int l = l_; asm volatile("" : "+s"(l));
        { REPLOOP(0) { if (ON(0)) phase_convert(wid_s, p, l, ldsf);
        grid_barrier(wid_s, ctl + 1024, bst); } }
        for (int r_ = 0; r_ < 2; ++r_) {
            int r = r_; asm volatile("" : "+s"(r));
            { REPLOOP(1) { EpiP E{(bf16*)(wsl_(p) + R_P), part + (size_t)r * TH * 16, pq, pkv};
              run_gemm(wid_s, lds3, xb + (size_t)r * TH * 1024, 1024, (const bf16*)(wsl_(p) + W_IN), TH, NP, 1024, E);
            grid_barrier(wid_s, ctl + 1024, bst); } }
            { REPLOOP(2) {
            if (ON(2)) lora_act_rows(wid_s, p, l, r);
            { EpiQ E{(bf16*)(wsl_(p) + R_Q), pq}; run_gemm(wid_s, lds3, (const bf16*)(wsl_(p) + R_P) + 2816, NP, (const bf16*)(wsl_(p) + W_MQ), TH, 768, 256, E); }
            { EpiKV E{(bf16*)(wsl_(p) + R_KM), (bf16*)(wsl_(p) + R_VT), pkv}; run_gemm(wid_s, lds3, (const bf16*)(wsl_(p) + R_P) + 3072, NP, (const bf16*)(wsl_(p) + W_MKV), TH, 1024, 128, E); }
            grid_barrier(wid_s, ctl + 1024, bst); } }
            { REPLOOP(9) { EpiBf E{Y + (size_t)r * TH * 1536, 1536}; run_gemm(wid_s, lds3, Y + (size_t)r * TH * 1536 + 1024, 1536, (const bf16*)(wsl_(p) + W_BWA), TH, 1024, 128, E);
            grid_barrier(wid_s, ctl + 1024, bst); } }
            { REPLOOP(13) { if (ON(2)) for (int tile = bid; tile < TH / 32; tile += gridDim.x) si_build_tile(wid_s, p, l, r, tile); } }
            if (ON(7)) kfix_rows(wid_s, p, l, r);
            grid_barrier(wid_s, ctl + 1024, bst);
            { REPLOOP(3) {
            if (ON(3) && !(q && RB(10)) && bid < 128) { const int xcd = bid & 7, idx = bid >> 3, hh = xcd * 4 + (idx >> 2), quarter = idx & 3;
                rwkv_scan_unit(wid_s, (const bf16*)(wsl_(p) + R_SI) + (size_t)hh * 2048 * 384, Y + ((size_t)(r * 4 + (hh >> 3)) * 2048) * 1536 + (hh & 7) * 64, quarter, ldsf); }
            else if (ON(4) && !(q && RB(11)) && bid >= 128 && bid < 160) { const int uu = bid - 128; lru_unit(wid_s, p, l, r, uu >> 3, uu & 7, ldsf); }
            {
                unsigned* ctr = ctl + q * 4 + l * 2 + r; volatile int* qidx = (volatile int*)(lds + QIDX_OFF);
                for (;;) {
                    __syncthreads();
                    if (mk_tid(wid_s) == 0) *qidx = (int)atomicAdd(ctr, 1u);
                    __syncthreads();
                    const int u = *qidx;
                    if (u >= 512 || !ON(5) || (q && RB(12))) break;
                    const int qb = 15 - (u >> 5), bh = u & 31, bl = bh >> 3, h = bh & 7;
                    attn_unit<96, 64, true, true>(wid_s, lds, (const bf16*)(wsl_(p) + R_Q) + (size_t)bl * 2048 * 768 + h * 96, 768, (const bf16*)(wsl_(p) + R_KM) + (size_t)bl * 2048 * 768 + h * 96, 768,
                        (const bf16*)(wsl_(p) + R_VT) + (size_t)(bl * 8 + h) * 64 * 2048, 2048, Y + ((size_t)(r * 4 + bl) * 2048) * 1536 + 1024 + h * 64, 1536,
                        qb * 128, 2 * qb + 2, p->in[I_QG] + l * 96, (const int*)p->in[I_POS] + (r * 4 + bl) * 2048, 0.14724444527f  );
                }
            }
            grid_barrier(wid_s, ctl + 1024, bst); } }
            { REPLOOP(14) { EpiBf E{(bf16*)(wsl_(p) + R_P), NP}; run_gemm(wid_s, lds3, (const bf16*)(wsl_(p) + WS_AG), 128, (const bf16*)(wsl_(p) + W_GUP), TH, 512, 128, E);
            grid_barrier(wid_s, ctl + 1024, bst); } }
            { REPLOOP(16) { if (ON(6)) for (int tile = bid; tile < TH / 32; tile += gridDim.x) rwkv_post_tile(wid_s, p, l, r, tile, q); } }
            grid_barrier(wid_s, ctl + 1024, bst);
        }
        if (ON(7)) memb_rows(wid_s, p);
        { REPLOOP(4) {
        for (int n = 0; n < 3; ++n) {
            { EpiGate E{(bf16*)(wsl_(p) + R_GS), part, p->in[I_BGATE] + l * 3072 + n * 1024}; run_gemm(wid_s, lds3, xb, 1024, (const bf16*)(wsl_(p) + W_GATE) + (size_t)n * 1024 * 1024, T, 1024, 1024, E); }
            { EpiProj E{(const bf16*)(wsl_(p) + R_GS), (float*)(wsl_(p) + R_MS), (bf16*)(wsl_(p) + R_MG), n}; run_gemm(wid_s, lds3, Y + n * 512, 1536, (const bf16*)(wsl_(p) + W_BR) + (size_t)n * 1024 * 512, T, 1024, 512, E); }
        }
        grid_barrier(wid_s, ctl + 1024, bst); } }
        { int nw = 1 + RB(15); asm volatile("" : "+s"(nw)); for (int q = 0; q < nw; ++q) { EpiRes E{l == 0 ? p->in[I_X] : xcur, xcur, xb, part, q + 1 < nw}; run_gemm(wid_s, lds3, (const bf16*)(wsl_(p) + R_MG), 1024, (const bf16*)(wsl_(p) + W_OUT), T, 1024, 1024, E); if (q + 1 < nw) grid_barrier(wid_s, ctl + 1024, bst); } }
        { REPLOOP(19) { EpiMemKV E{(bf16*)(wsl_(p) + R_MK), (bf16*)(wsl_(p) + R_MVT)}; run_gemm(wid_s, lds3, (const bf16*)(wsl_(p) + R_MEMB), 1024, (const bf16*)(wsl_(p) + W_XKV), 2048, 1024, 1024, E); } }
        grid_barrier(wid_s, ctl + 1024, bst);
        if (ON(7)) mkfix_rows(wid_s, p, l);
        { REPLOOP(5) { EpiXQ E{(bf16*)(wsl_(p) + R_XQ), part}; run_gemm(wid_s, lds3, xb, 1024, (const bf16*)(wsl_(p) + W_XQ), T, 512, 1024, E);
        grid_barrier(wid_s, ctl + 1024, bst); } }
        { REPLOOP(6) {
        if (ON(8)) for (int u = bid; u < 512; u += gridDim.x) { const int qb = u & 15, bh = u >> 4, b = bh >> 2, h = bh & 3;
            attn_unit<128, 128, false, false>(wid_s, lds, (const bf16*)(wsl_(p) + R_XQ) + (size_t)b * 2048 * 512 + h * 128, 512, (const bf16*)(wsl_(p) + R_MK) + (size_t)b * 256 * 512 + h * 128, 512,
                (const bf16*)(wsl_(p) + R_MVT) + (size_t)(b * 4 + h) * 128 * 256, 256, (bf16*)(wsl_(p) + R_XO) + (size_t)b * 2048 * 512 + h * 128, 512,
                qb * 128, 4, p->in[I_XQG] + l * 128, nullptr, 0.12751743082f  ); }
        grid_barrier(wid_s, ctl + 1024, bst); } }
        { int nw = 1 + RB(17); asm volatile("" : "+s"(nw)); for (int q = 0; q < nw; ++q) { EpiRes E{xcur, xcur, xb, part, q + 1 < nw}; run_gemm(wid_s, lds3, (const bf16*)(wsl_(p) + R_XO), 512, (const bf16*)(wsl_(p) + W_XO), T, 1024, 512, E); if (q + 1 < nw) grid_barrier(wid_s, ctl + 1024, bst); } }
        grid_barrier(wid_s, ctl + 1024, bst);
        { REPLOOP(7) { EpiFFN1 E{(bf16*)(wsl_(p) + R_H), part}; run_gemm(wid_s, lds3, xb, 1024, (const bf16*)(wsl_(p) + W_13), T, 5632, 1024, E);
        grid_barrier(wid_s, ctl + 1024, bst); } }
        { int nw = 1 + RB(18); asm volatile("" : "+s"(nw)); for (int q = 0; q < nw; ++q) { EpiRes E{xcur, xcur, xb, part, q + 1 < nw}; run_gemm(wid_s, lds3, (const bf16*)(wsl_(p) + R_H), DFF, (const bf16*)(wsl_(p) + W_2), T, 1024, DFF, E); if (q + 1 < nw) grid_barrier(wid_s, ctl + 1024, bst); } }
        grid_barrier(wid_s, ctl + 1024, bst);
    }
}

extern "C" void kernel_launch(void* const* d_in, const int* in_sizes, int n_in, void* d_out, int out_size, void* d_ws, size_t ws_size, hipStream_t stream) {
    static int grid = 0;
    if (grid == 0) {
        int dev = 0, cus = 0, per_cu = 0;
        if (n_in != 43 || ws_size < WS_END) { fprintf(stderr, "kernel_launch: unexpected n_in %d / ws %zu\n", n_in, ws_size); grid = -1; return; }
        (void)hipGetDevice(&dev);
        (void)hipDeviceGetAttribute(&cus, hipDeviceAttributeMultiprocessorCount, dev);
        (void)hipFuncSetAttribute((const void*)fwd_kernel, hipFuncAttributeMaxDynamicSharedMemorySize, LDS_BYTES);
        (void)hipOccupancyMaxActiveBlocksPerMultiprocessor(&per_cu, (const void*)fwd_kernel, 512, LDS_BYTES);
        fprintf(stderr, "cus %d per_cu %d ws %zu\n", cus, per_cu, ws_size);
        grid = cus * (per_cu >= 1 ? 1 : 0);
        if (grid <= 0) { grid = -1; return; }
    }
    if (grid < 0) return;
    Params p{};
    for (int i = 0; i < 43; ++i) p.in[i] = (const float*)d_in[i];
    p.out = (float*)d_out; p.ws = (unsigned char*)d_ws;
    (void)hipMemsetAsync((char*)d_ws + WS_CTL, 0, 32768, stream);
    void* args[] = {&p};
    hipError_t e = hipLaunchCooperativeKernel((const void*)fwd_kernel, dim3(grid), dim3(512), args, LDS_BYTES, stream);
    if (e != hipSuccess) fprintf(stderr, "cooperative launch failed: %s (grid %d)\n", hipGetErrorString(e), grid);
}
```

```cpp
#include <hip/hip_runtime.h>
#include <cstdio>
#include <cstdint>

#define LAS __attribute__((address_space(3)))
#define GAS __attribute__((address_space(1)))
typedef unsigned short bf16;
typedef short bf16x8 __attribute__((ext_vector_type(8)));
typedef float f32x4 __attribute__((ext_vector_type(4)));
typedef float f32x2 __attribute__((ext_vector_type(2)));
typedef unsigned u32x4 __attribute__((ext_vector_type(4)));
typedef unsigned u32x2 __attribute__((ext_vector_type(2)));

__device__ __forceinline__ unsigned f2bf(float f) { unsigned u = __builtin_bit_cast(unsigned, f); return (u + 0x7fffu + ((u >> 16) & 1u)) >> 16; }
typedef __bf16 bf16x2_t __attribute__((ext_vector_type(2)));
__device__ __forceinline__ unsigned pk2(float lo, float hi) { const f32x2 v = {lo, hi}; const bf16x2_t b = __builtin_convertvector(v, bf16x2_t); return __builtin_bit_cast(unsigned, b); }
__device__ __forceinline__ float bf2f(bf16 b) { return __builtin_bit_cast(float, (unsigned)b << 16); }
__device__ __forceinline__ float bflo(unsigned u) { return __builtin_bit_cast(float, u << 16); }
__device__ __forceinline__ float bfhi(unsigned u) { return __builtin_bit_cast(float, u & 0xffff0000u); }
__device__ __forceinline__ u32x4 pk8(f32x4 a, f32x4 b) { u32x4 w; w.x = pk2(a.x, a.y); w.y = pk2(a.z, a.w); w.z = pk2(b.x, b.y); w.w = pk2(b.z, b.w); return w; }
__device__ __forceinline__ float sigmoidf_(float x) { return 1.f / (1.f + __expf(-x)); }
__device__ __forceinline__ float fsig(float x) { return __builtin_amdgcn_rcpf(1.f + __builtin_amdgcn_exp2f(-1.4426950408889634f * x)); }
__device__ __forceinline__ int mk_tid(int wid_s) { int t = wid_s * 64 + (int)__builtin_amdgcn_mbcnt_hi(~0u, __builtin_amdgcn_mbcnt_lo(~0u, 0u)); asm volatile("" : "+v"(t)); return t; }
#define LBAR() asm volatile("s_waitcnt lgkmcnt(0)\n\ts_barrier" ::: "memory")
__device__ __forceinline__ float wave_sum(float v) {
#pragma unroll
    for (int o = 1; o < 64; o <<= 1) v += __shfl_xor(v, o);
    return v;
}

namespace pg8 {
#define PG8_LAS __attribute__((address_space(3)))
typedef unsigned short bf16_t;
constexpr int BM = 256, BK = 64, HALF = 128, HTB = HALF * BK * 2, STAGE_BYTES = 8 * HTB, NXCD = 8, WGM = 8;
__host__ __device__ __forceinline__ int lds_byte(int r, int c) { const int st = (r >> 4) * 2 + (c >> 5), rr = r & 15, cc = c & 31, ob = rr * 64 + cc * 2; return st * 1024 + (ob ^ (((ob >> 9) & 1) << 5)); }
__host__ __device__ __forceinline__ void stage_rc(int b, int& R, int& C) { const int st = b / 1024, sb = b % 1024, swz = sb ^ (((sb >> 9) & 1) << 5); R = (st >> 1) * 16 + swz / 64; C = (st & 1) * 32 + (swz % 64) / 2; }
__host__ __device__ __forceinline__ int perm32(int rho) { const int n = rho >> 4, i = rho & 15; return 8 * (i >> 2) + 4 * n + (i & 3); }
struct Unit { int pm, pn; };
struct Gemm { const bf16_t* A; const bf16_t* Bt; int M, N, K, lda; };
struct StaticOrder {
    int nM, nN, nwg, G, c;
    __host__ __device__ void init(int M, int N, int G_, int c_) { nM = M / BM; nN = N / BM; nwg = nM * nN; G = G_; c = c_; }
    __host__ __device__ bool next(int i, Unit& u) const {
        const long L = (long)i * G + c; if (L >= nwg) return false;
        int wgid = (int)L; { const int q = nwg / NXCD, r = nwg % NXCD, xcd = wgid % NXCD, off = wgid / NXCD; wgid = (xcd < r ? xcd * (q + 1) : r * (q + 1) + (xcd - r) * q) + off; }
        const int nig = WGM * nN, gid = wgid / nig, fm = gid * WGM, gsz = (nM - fm) < WGM ? (nM - fm) : WGM;
        u.pm = fm + ((wgid % nig) % gsz); u.pn = (wgid % nig) / gsz; return true;
    }
};
template <class Epi, class Sched>
__device__ __forceinline__ void gemm_phase(int wid_s, PG8_LAS unsigned char* lds, const Gemm g, const Sched& S, const Epi& E) {
    const int tid_ = mk_tid(wid_s);
    const int tid = tid_, wid = __builtin_amdgcn_readfirstlane(tid >> 6), lane = tid & 63, wr = wid >> 2, wc = wid & 3, fr = lane & 15, fq = lane >> 4;
    const int K = g.K, nt = K / BK, lda = g.lda;
    unsigned voffA[2], voffB[2];
#pragma unroll
    for (int i = 0; i < 2; ++i) { int R, C; stage_rc(tid * 16 + i * 8192, R, C); const int Rb = (R & ~31) + perm32(R & 31);
        voffA[i] = (unsigned)(R * lda + C) * 2u; voffB[i] = (unsigned)(Rb * K + C) * 2u; }
    const size_t kstep = (size_t)(BK * 2);
    const size_t hstepA = (size_t)HALF * lda * 2, hstepB = (size_t)HALF * K * 2;
    const size_t tstepA = 2 * hstepA, tstepB = 2 * hstepB;
    const unsigned ldsw = (unsigned)wid * 1024u;
    const int aoff = lds_byte(wr * 64 + fr, fq * 8), boff = lds_byte(wc * 32 + fr, fq * 8);
#define PG8_SA(b, h) (((b) * 2 + (h)) * HTB)
#define PG8_SB(b, h) ((4 + (b) * 2 + (h)) * HTB)
#define PG8_STAGE(bufoff, gbase, voff) do { _Pragma("unroll") for (int _i = 0; _i < 2; ++_i) \
        __builtin_amdgcn_global_load_lds((const unsigned*)((const char*)(gbase) + (voff)[_i]), (PG8_LAS unsigned*)(lds + (bufoff) + ldsw + _i * 8192), 16, 0, 0); } while (0)
#define PG8_LDA(dst, b, h) do { _Pragma("unroll") for (int m = 0; m < 4; ++m) _Pragma("unroll") for (int k = 0; k < 2; ++k) dst[m][k] = *(const PG8_LAS bf16x8*)(lds + PG8_SA(b, h) + aoff + m * 2048 + k * 1024); } while (0)
#define PG8_LDB(dst, b, h) do { _Pragma("unroll") for (int n = 0; n < 2; ++n) _Pragma("unroll") for (int k = 0; k < 2; ++k) dst[n][k] = *(const PG8_LAS bf16x8*)(lds + PG8_SB(b, h) + boff + n * 2048 + k * 1024); } while (0)
#define PG8_MMA(ai, bj, At, Bt) do { __builtin_amdgcn_s_setprio(1); _Pragma("unroll") for (int m = 0; m < 4; ++m) _Pragma("unroll") for (int n = 0; n < 2; ++n) _Pragma("unroll") for (int k = 0; k < 2; ++k) \
        acc[ai][bj][m][n] = __builtin_amdgcn_mfma_f32_16x16x32_bf16(Bt[n][k], At[m][k], acc[ai][bj][m][n], 0, 0, 0); __builtin_amdgcn_s_setprio(0); } while (0)
#define PG8_WAIT_V(n) asm volatile("s_waitcnt vmcnt(" #n ")" ::: "memory")
#define PG8_WAIT_L(n) asm volatile("s_waitcnt lgkmcnt(" #n ")" ::: "memory")
#define PG8_BAR __builtin_amdgcn_s_barrier()
#define PG8_SCHED __builtin_amdgcn_sched_barrier(0)
    Unit cur, nxt; int ui = 0;
    if (!S.next(0, cur)) return;
    f32x4 acc[2][2][4][2];
#pragma unroll
    for (int a = 0; a < 2; ++a)
#pragma unroll
        for (int b = 0; b < 2; ++b)
#pragma unroll
            for (int m = 0; m < 4; ++m)
#pragma unroll
                for (int n = 0; n < 2; ++n) acc[a][b][m][n] = (f32x4){0.f, 0.f, 0.f, 0.f};
    bf16x8 At[4][2], B0[2][2], B1[2][2];
    const char* cA = (const char*)g.A + (size_t)cur.pm * tstepA; const char* cB = (const char*)g.Bt + (size_t)cur.pn * tstepB;
    PG8_STAGE(PG8_SB(0, 0), cB, voffB); PG8_STAGE(PG8_SB(0, 1), cB + hstepB, voffB); PG8_STAGE(PG8_SA(0, 0), cA, voffA); PG8_STAGE(PG8_SA(0, 1), cA + hstepA, voffA);
    if (wr == 1) PG8_BAR;
    PG8_WAIT_V(2); PG8_BAR;
    PG8_STAGE(PG8_SB(1, 0), cB + kstep, voffB); PG8_STAGE(PG8_SA(1, 0), cA + kstep, voffA); PG8_STAGE(PG8_SB(1, 1), cB + hstepB + kstep, voffB);
    PG8_WAIT_V(6); PG8_BAR;
    for (;;) {
        const bool has_next = S.next(ui + 1, nxt);
        const char* nA = has_next ? (const char*)g.A + (size_t)nxt.pm * tstepA : cA; const char* nB = has_next ? (const char*)g.Bt + (size_t)nxt.pn * tstepB : cB;
#pragma unroll 1
        for (int t = 0; t < nt; t += 2) {
            const bool last = (t == nt - 2);
            const char* a1 = cA + (size_t)(t + 1) * kstep;
            const char* a2 = last ? nA : cA + (size_t)(t + 2) * kstep; const char* b2 = last ? nB : cB + (size_t)(t + 2) * kstep;
            const char* a3 = a2 + kstep; const char* b3 = b2 + kstep;
            PG8_LDB(B0, 0, 0); PG8_LDB(B1, 0, 1); PG8_SCHED; PG8_LDA(At, 0, 0); PG8_STAGE(PG8_SA(1, 1), a1 + hstepA, voffA);
            PG8_WAIT_V(8); PG8_WAIT_L(0); PG8_BAR; PG8_MMA(0, 0, At, B0); PG8_MMA(0, 1, At, B1); PG8_BAR; PG8_SCHED;
            PG8_LDA(At, 0, 1); PG8_STAGE(PG8_SB(0, 0), b2, voffB); PG8_STAGE(PG8_SB(0, 1), b2 + hstepB, voffB); PG8_STAGE(PG8_SA(0, 0), a2, voffA);
            PG8_WAIT_V(8); PG8_WAIT_L(0); PG8_BAR; PG8_MMA(1, 0, At, B0); PG8_MMA(1, 1, At, B1); PG8_BAR; PG8_SCHED;
            PG8_LDB(B0, 1, 0); PG8_LDB(B1, 1, 1); PG8_SCHED; PG8_LDA(At, 1, 0); PG8_STAGE(PG8_SA(0, 1), a2 + hstepA, voffA);
            PG8_WAIT_V(8); PG8_WAIT_L(0); PG8_BAR; PG8_MMA(0, 0, At, B0); PG8_MMA(0, 1, At, B1); PG8_BAR; PG8_SCHED;
            PG8_LDA(At, 1, 1); PG8_STAGE(PG8_SB(1, 0), b3, voffB); PG8_STAGE(PG8_SB(1, 1), b3 + hstepB, voffB); PG8_STAGE(PG8_SA(1, 0), a3, voffA);
            PG8_WAIT_V(8); PG8_WAIT_L(0); PG8_BAR; PG8_MMA(1, 0, At, B0); PG8_MMA(1, 1, At, B1); PG8_BAR; PG8_SCHED;
        }
        if (wr == 0) PG8_BAR;
        E(acc, cur, wr, wc, fr, fq);
        if (!has_next) break;
#pragma unroll
        for (int a = 0; a < 2; ++a)
#pragma unroll
            for (int b = 0; b < 2; ++b)
#pragma unroll
                for (int m = 0; m < 4; ++m)
#pragma unroll
                    for (int n = 0; n < 2; ++n) acc[a][b][m][n] = (f32x4){0.f, 0.f, 0.f, 0.f};
        cur = nxt; cA = nA; cB = nB; ++ui;
        if (wr == 1) PG8_BAR;
    }
    PG8_WAIT_V(0);
    PG8_BAR;
#undef PG8_SA
#undef PG8_SB
#undef PG8_STAGE
#undef PG8_LDA
#undef PG8_LDB
#undef PG8_MMA
#undef PG8_WAIT_V
#undef PG8_WAIT_L
#undef PG8_BAR
#undef PG8_SCHED
}
}

#ifndef EN
#define EN 0xFFFF
#endif
#define ON(b) ((EN >> (b)) & 1)
#ifndef REP
#define REP 0
#endif
#ifndef SCANMODE
#define SCANMODE 0
#endif
#define RB(b) ((REP >> (b)) & 1)
#define REPLOOP(b) int nrep##b = 1 + RB(b); asm volatile("" : "+s"(nrep##b)); for (int q = 0; q < nrep##b; ++q)
constexpr int T = 16384, TH = 8192, SEQ = 2048, DM = 1024, DIN = 6304, NP = 3328, DFF = 2816;
constexpr int LDS_BYTES = 147456, QIDX_OFF = 140000;
constexpr size_t MiB = 1u << 20;
constexpr size_t WS_CTL = 0;
constexpr size_t WS_WT = 1 * MiB;
constexpr size_t W_IN = WS_WT, W_GATE = W_IN + (size_t)NP * 1024 * 2, W_BR = W_GATE + (size_t)3072 * 1024 * 2, W_OUT = W_BR + (size_t)3 * 1024 * 512 * 2,
                 W_MQ = W_OUT + (size_t)1024 * 1024 * 2, W_MKV = W_MQ + (size_t)768 * 256 * 2, W_XQ = W_MKV + (size_t)1024 * 128 * 2, W_XKV = W_XQ + (size_t)512 * 1024 * 2,
                 W_XO = W_XKV + (size_t)1024 * 1024 * 2, W_13 = W_XO + (size_t)1024 * 512 * 2, W_2 = W_13 + (size_t)5632 * 1024 * 2, W_BWA = W_2 + (size_t)1024 * 2816 * 2, W_GUP = W_BWA + (size_t)1024 * 128 * 2, W_END = W_GUP + (size_t)512 * 128 * 2;
static_assert(W_END <= 40 * MiB, "weights");
constexpr size_t WS_XB = 40 * MiB, WS_PART = 72 * MiB, WS_PQ = 73 * MiB, WS_PKV = WS_PQ + 256 * 1024, WS_Y = 74 * MiB, WS_R = 122 * MiB;
constexpr size_t R_P = WS_R, R_SI = WS_R + 52 * MiB, R_Q = WS_R + 100 * MiB, R_KM = WS_R + 112 * MiB, R_VT = WS_R + 124 * MiB;
constexpr size_t R_GS = WS_R, R_MS = WS_R + 32 * MiB, R_MG = WS_R + 96 * MiB, R_MEMB = WS_R + 128 * MiB;
constexpr size_t R_MK = WS_R, R_MVT = WS_R + 2 * MiB, R_XQ = WS_R + 32 * MiB, R_XO = WS_R + 48 * MiB, R_H = WS_R;
constexpr size_t WS_AG = WS_R + 132 * MiB;
constexpr size_t WS_END = WS_AG + 2 * MiB;
static_assert(WS_END <= 256 * MiB, "ws");

struct Params { const float* in[43]; float* out; unsigned char* ws; };
typedef const __attribute__((address_space(4))) Params* KP;
enum { I_X = 0, I_MEM, I_POS, I_NMIX, I_NXA, I_NMEM, I_NFFN, I_WIN, I_BGATE, I_MU, I_W0, I_WUP, I_A0, I_AUP, I_GUP, I_KK, I_KA, I_RK, I_LNG, I_LNB,
       I_CW, I_CB, I_WA, I_BA, I_WX, I_BX, I_LAM, I_QN, I_WUQ, I_KVN, I_WUKV, I_QG, I_KG, I_WBR, I_WOUT, I_XWQ, I_XWKV, I_XQG, I_XKG, I_XWO, I_W1, I_W3, I_W2 };

__device__ __forceinline__ float rstd16(const float* part, int row) {
    const f32x4* p = (const f32x4*)(part + (size_t)row * 16); const f32x4 a = p[0], b = p[1], c = p[2], d = p[3];
    const float s = ((a.x + a.y) + (a.z + a.w)) + ((b.x + b.y) + (b.z + b.w)) + ((c.x + c.y) + (c.z + c.w)) + ((d.x + d.y) + (d.z + d.w));
    return rsqrtf(s * (1.f / 1024.f) + 1e-6f);
}
__device__ __forceinline__ float rstd4(const float* pp, int row, float invn) { const f32x4 a = *(const f32x4*)(pp + (size_t)row * 4); return rsqrtf(((a.x + a.y) + (a.z + a.w)) * invn + 1e-6f); }
__device__ __forceinline__ float sumsq8(f32x4 a, f32x4 b) { return (a.x * a.x + a.y * a.y) + (a.z * a.z + a.w * a.w) + (b.x * b.x + b.y * b.y) + (b.z * b.z + b.w * b.w); }
#define EPI_HEAD static constexpr bool PERM = true; \
    __device__ __forceinline__ void operator()(const f32x4 (&acc)[2][2][4][2], const pg8::Unit& u, int wr, int wc, int fr, int fq) const
#define EPI_ROWS _Pragma("unroll") for (int ai = 0; ai < 2; ++ai) _Pragma("unroll") for (int m = 0; m < 4; ++m) if ((__builtin_amdgcn_sched_barrier(0), true))
#define EPI_ROW (u.pm * 256 + ai * 128 + wr * 64 + m * 16 + fr)

struct EpiP {
    bf16* P; const float* part; float* pq; float* pkv;
    EPI_HEAD {
        const int col0 = u.pn * 256 + wc * 32 + 8 * fq;
        EPI_ROWS { const int row = EPI_ROW; const float rs = rstd16(part, row); float ss = 0.f;
#pragma unroll
            for (int bj = 0; bj < 2; ++bj) { const f32x4 v0 = acc[ai][bj][m][0] * rs, v1 = acc[ai][bj][m][1] * rs;
                *(u32x4*)(P + (size_t)row * NP + col0 + bj * 128) = pk8(v0, v1);
                if (u.pn == 11 || bj == 0) ss += sumsq8(v0, v1); }
            if (u.pn == 11 || u.pn == 12) { ss += __shfl_xor(ss, 16); ss += __shfl_xor(ss, 32); if (fq == 0) (u.pn == 11 ? pq : pkv)[(size_t)row * 4 + wc] = ss; } }
    }
};
struct EpiQ {
    bf16* Q; const float* pq;
    EPI_HEAD {
        const int col0 = u.pn * 256 + wc * 32 + 8 * fq;
        EPI_ROWS { const int row = EPI_ROW; const float rs = rstd4(pq, row, 1.f / 256.f);
#pragma unroll
            for (int bj = 0; bj < 2; ++bj) *(u32x4*)(Q + (size_t)row * 768 + col0 + bj * 128) = pk8(acc[ai][bj][m][0] * rs, acc[ai][bj][m][1] * rs); }
    }
};
struct EpiKV {
    bf16* Km; bf16* Vt; const float* pkv;
    EPI_HEAD {
        const int j0 = wc * 32 + 8 * fq;
        EPI_ROWS { const int row = EPI_ROW; const float rs = rstd4(pkv, row, 1.f / 128.f);
#pragma unroll
            for (int bj = 0; bj < 2; ++bj) { const int h = 2 * u.pn + bj; const f32x4 v0 = acc[ai][bj][m][0] * rs, v1 = acc[ai][bj][m][1] * rs;
                if (wc < 2) *(u32x4*)(Km + (size_t)row * 768 + h * 96 + j0) = pk8(v0, v1);
                else { const int bl = row >> 11, t = row & 2047; bf16* vp = Vt + ((size_t)(bl * 8 + h) * 64 + (j0 - 64)) * 2048 + t;
                    vp[0 * 2048] = (bf16)f2bf(v0.x); vp[1 * 2048] = (bf16)f2bf(v0.y); vp[2 * 2048] = (bf16)f2bf(v0.z); vp[3 * 2048] = (bf16)f2bf(v0.w);
                    vp[4 * 2048] = (bf16)f2bf(v1.x); vp[5 * 2048] = (bf16)f2bf(v1.y); vp[6 * 2048] = (bf16)f2bf(v1.z); vp[7 * 2048] = (bf16)f2bf(v1.w); } } }
    }
};
struct EpiGate {
    bf16* GS; const float* part; const float* bg;
    EPI_HEAD {
        const int col0 = u.pn * 256 + wc * 32 + 8 * fq;
        f32x4 b0[2], b1[2];
#pragma unroll
        for (int bj = 0; bj < 2; ++bj) { b0[bj] = *(const f32x4*)(bg + col0 + bj * 128); b1[bj] = *(const f32x4*)(bg + col0 + bj * 128 + 4); }
        EPI_ROWS { const int row = EPI_ROW; const float rs = rstd16(part, row);
#pragma unroll
            for (int bj = 0; bj < 2; ++bj) { f32x4 v0 = acc[ai][bj][m][0] * rs + b0[bj], v1 = acc[ai][bj][m][1] * rs + b1[bj];
#pragma unroll
                for (int e = 0; e < 4; ++e) { v0[e] = fsig(v0[e]); v1[e] = fsig(v1[e]); }
                *(u32x4*)(GS + (size_t)row * 1024 + col0 + bj * 128) = pk8(v0, v1); } }
    }
};
struct EpiProj {
    const bf16* GS; float* MS; bf16* MG; int n;
    EPI_HEAD {
        const int col0 = u.pn * 256 + wc * 32 + 8 * fq;
        EPI_ROWS { const int row = EPI_ROW;
#pragma unroll
            for (int bj = 0; bj < 2; ++bj) { const size_t o = (size_t)row * 1024 + col0 + bj * 128; const u32x4 gw = *(const u32x4*)(GS + o);
                f32x4 v0 = acc[ai][bj][m][0], v1 = acc[ai][bj][m][1];
                v0.x *= bflo(gw.x); v0.y *= bfhi(gw.x); v0.z *= bflo(gw.y); v0.w *= bfhi(gw.y); v1.x *= bflo(gw.z); v1.y *= bfhi(gw.z); v1.z *= bflo(gw.w); v1.w *= bfhi(gw.w);
                if (n > 0) { v0 += *(const f32x4*)(MS + o); v1 += *(const f32x4*)(MS + o + 4); }
                if (n < 2) { *(f32x4*)(MS + o) = v0; *(f32x4*)(MS + o + 4) = v1; } else *(u32x4*)(MG + o) = pk8(v0, v1); } }
    }
};
struct EpiRes {
    const float* xold; float* xout; bf16* xb; float* part; int nowrite = 0;
    EPI_HEAD {
        const int col0 = u.pn * 256 + wc * 32 + 8 * fq;
        EPI_ROWS { const int row = EPI_ROW; float ss = 0.f;
#pragma unroll
            for (int bj = 0; bj < 2; ++bj) { const size_t o = (size_t)row * 1024 + col0 + bj * 128;
                const f32x4 v0 = acc[ai][bj][m][0] + *(const f32x4*)(xold + o), v1 = acc[ai][bj][m][1] + *(const f32x4*)(xold + o + 4);
                if (!nowrite) { *(f32x4*)(xout + o) = v0; *(f32x4*)(xout + o + 4) = v1; *(u32x4*)(xb + o) = pk8(v0, v1); } ss += sumsq8(v0, v1); }
            ss += __shfl_xor(ss, 16); ss += __shfl_xor(ss, 32); if (fq == 0 && !nowrite) part[(size_t)row * 16 + u.pn * 4 + wc] = ss; }
    }
};
struct EpiXQ {
    bf16* Q; const float* part;
    EPI_HEAD {
        const int col0 = u.pn * 256 + wc * 32 + 8 * fq;
        EPI_ROWS { const int row = EPI_ROW; const float rs = rstd16(part, row);
#pragma unroll
            for (int bj = 0; bj < 2; ++bj) *(u32x4*)(Q + (size_t)row * 512 + col0 + bj * 128) = pk8(acc[ai][bj][m][0] * rs, acc[ai][bj][m][1] * rs); }
    }
};
struct EpiBf {
    bf16* O; int ld;
    EPI_HEAD {
        const int col0 = u.pn * 256 + wc * 32 + 8 * fq;
        EPI_ROWS { const int row = EPI_ROW;
#pragma unroll
            for (int bj = 0; bj < 2; ++bj) *(u32x4*)(O + (size_t)row * ld + col0 + bj * 128) = pk8(acc[ai][bj][m][0], acc[ai][bj][m][1]); }
    }
};
struct EpiMemKV {
    bf16* mk; bf16* mVt;
    EPI_HEAD {
        const int j0 = wc * 32 + 8 * fq, h = u.pn;
        EPI_ROWS { const int row = EPI_ROW;
            *(u32x4*)(mk + (size_t)row * 512 + h * 128 + j0) = pk8(acc[ai][0][m][0], acc[ai][0][m][1]);
            const f32x4 v0 = acc[ai][1][m][0], v1 = acc[ai][1][m][1]; const int b = row >> 8, key = row & 255;
            bf16* vp = mVt + ((size_t)(b * 4 + h) * 128 + j0) * 256 + key;
            vp[0 * 256] = (bf16)f2bf(v0.x); vp[1 * 256] = (bf16)f2bf(v0.y); vp[2 * 256] = (bf16)f2bf(v0.z); vp[3 * 256] = (bf16)f2bf(v0.w);
            vp[4 * 256] = (bf16)f2bf(v1.x); vp[5 * 256] = (bf16)f2bf(v1.y); vp[6 * 256] = (bf16)f2bf(v1.z); vp[7 * 256] = (bf16)f2bf(v1.w); }
    }
};
struct EpiFFN1 {
    bf16* H; const float* part;
    EPI_HEAD {
        const int hc0 = (u.pn * 256 + wc * 32 + 8 * fq) >> 1;
        EPI_ROWS { const int row = EPI_ROW; const float rs = rstd16(part, row);
#pragma unroll
            for (int bj = 0; bj < 2; ++bj) { const f32x4 a1 = acc[ai][bj][m][0] * rs, a3 = acc[ai][bj][m][1] * rs; f32x4 hv;
#pragma unroll
                for (int e = 0; e < 4; ++e) hv[e] = a1[e] * fsig(a1[e]) * a3[e];
                u32x2 w; w.x = pk2(hv.x, hv.y); w.y = pk2(hv.z, hv.w);
                *(u32x2*)(H + (size_t)row * DFF + hc0 + bj * 64) = w; } }
    }
};

__device__ __forceinline__ void conv_job(const float* W, int ldw, int c0, int ncols, int kblk, const float* gain, bf16* WT, int K, int mode, float* scr, int gw, int NGW, int lane, int& off) {
    const int nblk = (ncols + 63) >> 6, nitems = nblk * kblk;
    int it0 = (gw - off) % NGW; if (it0 < 0) it0 += NGW;
    off = (off + nitems) % NGW;
    const int kq = lane >> 4, nq = lane & 15;
    for (int it = it0; it < nitems; it += NGW) {
        const int kb = it / nblk, nb = it % nblk, k0 = 64 * kb, n0 = 64 * nb;
        const bool ld_ok = (n0 + 4 * nq) < ncols;
        f32x4 v[16];
#pragma unroll
        for (int i = 0; i < 16; ++i) { v[i] = (f32x4){0.f, 0.f, 0.f, 0.f}; if (ld_ok) v[i] = *(const f32x4*)(W + (size_t)(k0 + 4 * i + kq) * ldw + c0 + n0 + 4 * nq); }
#pragma unroll
        for (int i = 0; i < 16; ++i) { const int kk = 4 * i + kq; const float gg = gain ? gain[k0 + kk] : 1.f; float* d = scr + kk * 65 + 4 * nq;
            d[0] = v[i].x * gg; d[1] = v[i].y * gg; d[2] = v[i].z * gg; d[3] = v[i].w * gg; }
        __builtin_amdgcn_wave_barrier(); asm volatile("s_waitcnt lgkmcnt(0)" ::: "memory");
        const int c = lane & 7;
#pragma unroll
        for (int jx = 0; jx < 8; ++jx) { const int nl = (lane >> 3) + 8 * jx, n = n0 + nl; const float* sp = scr + (8 * c) * 65 + nl;
            u32x4 o; o.x = pk2(sp[0 * 65], sp[1 * 65]); o.y = pk2(sp[2 * 65], sp[3 * 65]); o.z = pk2(sp[4 * 65], sp[5 * 65]); o.w = pk2(sp[6 * 65], sp[7 * 65]);
            const int dr = mode == 0 ? n : (8 * (n >> 2) + (n & 3) + (mode == 2 ? 4 : 0));
            if (n < ncols) *(u32x4*)(WT + (size_t)dr * K + k0 + 8 * c) = o; }
        __builtin_amdgcn_wave_barrier(); asm volatile("s_waitcnt lgkmcnt(0)" ::: "memory");
    }
}

__device__ __forceinline__ void phase_convert(int wid_s, KP p_, int l, float* ldsf) {
    KP p = p_; asm volatile("" : "+s"(p));
    unsigned char* ws = p->ws;
    const int tid_ = mk_tid(wid_s);
    const int tid = tid_, lane = tid & 63, wv = tid >> 6;
    const int gw = blockIdx.x * 8 + wv, NGW = gridDim.x * 8;
    float* scr = ldsf + wv * (64 * 65); int off = 0;
    const float* nmix = p->in[I_NMIX] + l * 1024;
    conv_job(p->in[I_WIN] + (size_t)l * 1024 * DIN, DIN, 0, 3232, 16, nmix, (bf16*)(ws + W_IN), 1024, 0, scr, gw, NGW, lane, off);
    conv_job(p->in[I_WIN] + (size_t)l * 1024 * DIN, DIN, 3232, 3072, 16, nmix, (bf16*)(ws + W_GATE), 1024, 0, scr, gw, NGW, lane, off);
    for (int n = 0; n < 3; ++n) conv_job(p->in[I_WBR] + ((size_t)l * 3 + n) * 512 * 1024, 1024, 0, 1024, 8, nullptr, (bf16*)(ws + W_BR) + (size_t)n * 1024 * 512, 512, 0, scr, gw, NGW, lane, off);
    conv_job(p->in[I_WOUT] + (size_t)l * 1024 * 1024, 1024, 0, 1024, 16, nullptr, (bf16*)(ws + W_OUT), 1024, 0, scr, gw, NGW, lane, off);
    conv_job(p->in[I_WUQ] + (size_t)l * 256 * 768, 768, 0, 768, 4, p->in[I_QN] + l * 256, (bf16*)(ws + W_MQ), 256, 0, scr, gw, NGW, lane, off);
    conv_job(p->in[I_WUKV] + (size_t)l * 128 * 1024, 1024, 0, 1024, 2, p->in[I_KVN] + l * 128, (bf16*)(ws + W_MKV), 128, 0, scr, gw, NGW, lane, off);
    conv_job(p->in[I_XWQ] + (size_t)l * 1024 * 512, 512, 0, 512, 16, p->in[I_NXA] + l * 1024, (bf16*)(ws + W_XQ), 1024, 0, scr, gw, NGW, lane, off);
    conv_job(p->in[I_XWKV] + (size_t)l * 1024 * 1024, 1024, 0, 1024, 16, p->in[I_NMEM] + l * 1024, (bf16*)(ws + W_XKV), 1024, 0, scr, gw, NGW, lane, off);
    conv_job(p->in[I_XWO] + (size_t)l * 512 * 1024, 1024, 0, 1024, 8, nullptr, (bf16*)(ws + W_XO), 512, 0, scr, gw, NGW, lane, off);
    conv_job(p->in[I_W1] + (size_t)l * 1024 * DFF, DFF, 0, 2816, 16, p->in[I_NFFN] + l * 1024, (bf16*)(ws + W_13), 1024, 1, scr, gw, NGW, lane, off);
    conv_job(p->in[I_W3] + (size_t)l * 1024 * DFF, DFF, 0, 2816, 16, p->in[I_NFFN] + l * 1024, (bf16*)(ws + W_13), 1024, 2, scr, gw, NGW, lane, off);
    conv_job(p->in[I_W2] + (size_t)l * DFF * 1024, 1024, 0, 1024, 44, nullptr, (bf16*)(ws + W_2), DFF, 0, scr, gw, NGW, lane, off);
    conv_job(p->in[I_WUP] + (size_t)l * 64 * 512, 512, 0, 512, 1, nullptr, (bf16*)(ws + W_BWA), 128, 0, scr, gw, NGW, lane, off);
    conv_job(p->in[I_AUP] + (size_t)l * 64 * 512, 512, 0, 512, 1, nullptr, (bf16*)(ws + W_BWA) + 512 * 128 + 64, 128, 0, scr, gw, NGW, lane, off);
    conv_job(p->in[I_GUP] + (size_t)l * 128 * 512, 512, 0, 512, 2, nullptr, (bf16*)(ws + W_GUP), 128, 0, scr, gw, NGW, lane, off);
    { unsigned zz = 0u; asm volatile("" : "+v"(zz)); const u32x4 zv = {zz, zz, zz, zz};
      for (int i = blockIdx.x * 512 + tid; i < 1024 * 8; i += gridDim.x * 512) { const int row = i >> 3, ch = i & 7; *(u32x4*)((bf16*)(ws + W_BWA) + row * 128 + (row < 512 ? 64 : 0) + ch * 8) = zv; } }
    { u32x4* z = (u32x4*)((bf16*)(ws + W_IN) + (size_t)3232 * 1024); const int n16 = 96 * 1024 * 2 / 16;
      unsigned zz = 0u; asm volatile("" : "+v"(zz)); const u32x4 zv = {zz, zz, zz, zz};
      for (int i = blockIdx.x * 512 + tid; i < n16; i += gridDim.x * 512) z[i] = zv; }
    if (l == 0) {
        const float* x = p->in[I_X]; bf16* xb = (bf16*)(ws + WS_XB); float* part = (float*)(ws + WS_PART);
        for (int row = gw; row < T; row += NGW) {
            const f32x4* xr = (const f32x4*)(x + (size_t)row * 1024) + lane; float s = 0.f;
#pragma unroll
            for (int j = 0; j < 4; ++j) { const f32x4 v = xr[64 * j]; s += (v.x * v.x + v.y * v.y) + (v.z * v.z + v.w * v.w);
                u32x2 w; w.x = pk2(v.x, v.y); w.y = pk2(v.z, v.w); *((u32x2*)(xb + (size_t)row * 1024) + lane + 64 * j) = w; }
            s = wave_sum(s);
            if (lane < 16) part[(size_t)row * 16 + lane] = lane == 0 ? s : 0.f;
        }
    }
}

__device__ __forceinline__ void rope_cs(int pos, int i, float& c, float& s) {
    const float invf = exp2f(-(float)i * 0.8304820237218406f);
    const float ang = (float)pos * invf;
    const double x = (double)ang * 0.15915494309189535; const float f = (float)(x - rint(x));
    c = __builtin_amdgcn_cosf(f); s = __builtin_amdgcn_sinf(f);
}
template <int DQK, int DV, bool CAUSAL, bool MLA>
__device__ __forceinline__ void attn_unit(int wid_s, unsigned char* lds, const bf16* Qb_, int ldq, const bf16* Kb_, int ldk, const bf16* Vtb_, int ldv, bf16* Ob_, int ldo,
                                          int q0, int nkt, const float* qgain_, const int* pos_, float qscale) {
    const GAS bf16* Qb = (const GAS bf16*)Qb_; const GAS bf16* Kb = (const GAS bf16*)Kb_; const GAS bf16* Vtb = (const GAS bf16*)Vtb_; GAS bf16* Ob = (GAS bf16*)Ob_;
    const GAS float* qgain = (const GAS float*)qgain_; const GAS int* pos = (const GAS int*)pos_;
    constexpr int KS = DQK * 2 + 16, VS = 144, NKS = DQK / 32, NDT = DV / 16, KCH = DQK / 8, NKC = (64 * KCH + 511) / 512, NVC = DV * 8 / 512;
    unsigned char* Ks = lds; unsigned char* Vs = lds + 64 * KS;
    const int tid_ = mk_tid(wid_s);
    const int tid = tid_, lane = tid & 63, wv = tid >> 6, g = lane >> 4, j = lane & 15;
    const int qrow = q0 + wv * 16 + j;
    bf16x8 qf[NKS];
    {
        float qv[NKS][8]; float ss = 0.f;
#pragma unroll
        for (int ks = 0; ks < NKS; ++ks) { const u32x4 w = *(const GAS u32x4*)(Qb + (size_t)qrow * ldq + 32 * ks + 8 * g);
            qv[ks][0] = bflo(w.x); qv[ks][1] = bfhi(w.x); qv[ks][2] = bflo(w.y); qv[ks][3] = bfhi(w.y); qv[ks][4] = bflo(w.z); qv[ks][5] = bfhi(w.z); qv[ks][6] = bflo(w.w); qv[ks][7] = bfhi(w.w);
#pragma unroll
            for (int e = 0; e < 8; ++e) ss += qv[ks][e] * qv[ks][e]; }
        ss += __shfl_xor(ss, 16); ss += __shfl_xor(ss, 32);
        const float rs = rsqrtf(ss * (1.f / DQK) + 1e-6f);
#pragma unroll
        for (int ks = 0; ks < NKS; ++ks)
#pragma unroll
            for (int e = 0; e < 8; ++e) qv[ks][e] *= rs * qgain[32 * ks + 8 * g + e];
        if (MLA) {
            const int ps = pos[qrow];
#pragma unroll
            for (int e = 0; e < 8; ++e) { const float mine = qv[2][e], other = __shfl_xor(mine, 32); float c, s; rope_cs(ps, 8 * (g & 1) + e, c, s);
                qv[2][e] = (g < 2) ? (mine * c - other * s) : (mine * c + other * s); }
        }
#pragma unroll
        for (int ks = 0; ks < NKS; ++ks) { u32x4 w; w.x = pk2(qv[ks][0] * qscale, qv[ks][1] * qscale); w.y = pk2(qv[ks][2] * qscale, qv[ks][3] * qscale);
            w.z = pk2(qv[ks][4] * qscale, qv[ks][5] * qscale); w.w = pk2(qv[ks][6] * qscale, qv[ks][7] * qscale); qf[ks] = __builtin_bit_cast(bf16x8, w); }
    }
    f32x4 oT[NDT];
#pragma unroll
    for (int d = 0; d < NDT; ++d) oT[d] = (f32x4){0.f, 0.f, 0.f, 0.f};
    float mrun = -INFINITY, lsum = 0.f;
    u32x4 kreg[NKC], vreg[NVC];
#define ATT_PREFETCH(kt) do { _Pragma("unroll") for (int i = 0; i < NKC; ++i) { const int idx = tid + 512 * i; if (idx < 64 * KCH) { const int key = idx / KCH, ch = idx % KCH; \
            kreg[i] = *(const GAS u32x4*)(Kb + (size_t)(64 * (kt) + key) * ldk + ch * 8); } } \
        _Pragma("unroll") for (int i = 0; i < NVC; ++i) { const int idx = tid + 512 * i; const int dv = idx >> 3, ch = idx & 7; vreg[i] = *(const GAS u32x4*)(Vtb + (size_t)dv * ldv + 64 * (kt) + ch * 8); } } while (0)
    ATT_PREFETCH(0);
    for (int kt = 0; kt < nkt; ++kt) {
        LBAR();
#pragma unroll
        for (int i = 0; i < NKC; ++i) { const int idx = tid + 512 * i; if (idx < 64 * KCH) { const int key = idx / KCH, ch = idx % KCH; *(u32x4*)(Ks + key * KS + ch * 16) = kreg[i]; } }
#pragma unroll
        for (int i = 0; i < NVC; ++i) { const int idx = tid + 512 * i; const int dv = idx >> 3, ch = idx & 7; *(u32x4*)(Vs + dv * VS + ch * 16) = vreg[i]; }
        LBAR();
        if (kt + 1 < nkt) ATT_PREFETCH(kt + 1);
        const int qw0 = q0 + wv * 16;
        if (CAUSAL && 64 * kt > qw0 + 15) continue;
        f32x4 sT[4];
#pragma unroll
        for (int k4 = 0; k4 < 4; ++k4) { sT[k4] = (f32x4){0.f, 0.f, 0.f, 0.f};
#pragma unroll
            for (int ks = 0; ks < NKS; ++ks) { const bf16x8 a = *(const bf16x8*)(Ks + (16 * k4 + j) * KS + (32 * ks + 8 * g) * 2);
                sT[k4] = __builtin_amdgcn_mfma_f32_16x16x32_bf16(a, qf[ks], sT[k4], 0, 0, 0); } }
        if (CAUSAL && 64 * kt + 63 > qw0) {
#pragma unroll
            for (int k4 = 0; k4 < 4; ++k4)
#pragma unroll
                for (int r = 0; r < 4; ++r) if (64 * kt + 16 * k4 + 4 * g + r > qrow) sT[k4][r] = -INFINITY;
        }
        float mx = -INFINITY;
#pragma unroll
        for (int k4 = 0; k4 < 4; ++k4) mx = fmaxf(mx, fmaxf(fmaxf(sT[k4][0], sT[k4][1]), fmaxf(sT[k4][2], sT[k4][3])));
        mx = fmaxf(mx, __shfl_xor(mx, 16)); mx = fmaxf(mx, __shfl_xor(mx, 32));
        const float mnew = fmaxf(mrun, mx); const float alpha = __builtin_amdgcn_exp2f(mrun - mnew); mrun = mnew;
        float psum = 0.f;
#pragma unroll
        for (int k4 = 0; k4 < 4; ++k4)
#pragma unroll
            for (int r = 0; r < 4; ++r) { const float pv = __builtin_amdgcn_exp2f(sT[k4][r] - mnew); sT[k4][r] = pv; psum += pv; }
        lsum = lsum * alpha + psum;
#pragma unroll
        for (int d = 0; d < NDT; ++d) oT[d] *= alpha;
#pragma unroll
        for (int kc = 0; kc < 2; ++kc) {
            const bf16x8 pb = __builtin_bit_cast(bf16x8, pk8(sT[2 * kc], sT[2 * kc + 1]));
#pragma unroll
            for (int d = 0; d < NDT; ++d) { const unsigned char* vp = Vs + (16 * d + j) * VS + (32 * kc + 4 * g) * 2;
                const u32x2 lo = *(const u32x2*)vp, hi = *(const u32x2*)(vp + 32); u32x4 w; w.x = lo.x; w.y = lo.y; w.z = hi.x; w.w = hi.y;
                oT[d] = __builtin_amdgcn_mfma_f32_16x16x32_bf16(__builtin_bit_cast(bf16x8, w), pb, oT[d], 0, 0, 0); }
        }
    }
#undef ATT_PREFETCH
    lsum += __shfl_xor(lsum, 16); lsum += __shfl_xor(lsum, 32);
    const float inv = 1.f / lsum;
#pragma unroll
    for (int d = 0; d < NDT; ++d) { u32x2 w; w.x = pk2(oT[d][0] * inv, oT[d][1] * inv); w.y = pk2(oT[d][2] * inv, oT[d][3] * inv);
        *(GAS u32x2*)(Ob + (size_t)qrow * ldo + 16 * d + 4 * g) = w; }
}

__device__ __forceinline__ void lora_act_rows(int wid_s, KP p_, int l, int r) {
    KP p = p_; asm volatile("" : "+s"(p));
    unsigned char* ws = p->ws;
    const int tid_ = mk_tid(wid_s);
    const int tid = tid_;
    const bf16* P = (const bf16*)(ws + R_P); bf16* Awa = (bf16*)(ws + WS_Y) + (size_t)r * TH * 1536 + 1024; bf16* Ag = (bf16*)(ws + WS_AG);
    const float* mu = p->in[I_MU] + l * 1792 + 1536;
    const int sub = tid & 31, j0 = sub * 8;
    f32x4 m0 = *(const f32x4*)(mu + j0), m1 = *(const f32x4*)(mu + j0 + 4);
    for (int row = blockIdx.x * 16 + (tid >> 5); row < TH; row += gridDim.x * 16) {
        const u32x4 cw = *(const u32x4*)(P + (size_t)row * NP + 1536 + j0);
        u32x4 pw = {0u, 0u, 0u, 0u}; if ((row & 2047) != 0) pw = *(const u32x4*)(P + (size_t)(row - 1) * NP + 1536 + j0);
        float c[8] = {bflo(cw.x), bfhi(cw.x), bflo(cw.y), bfhi(cw.y), bflo(cw.z), bfhi(cw.z), bflo(cw.w), bfhi(cw.w)};
        const float q[8] = {bflo(pw.x), bfhi(pw.x), bflo(pw.y), bfhi(pw.y), bflo(pw.z), bfhi(pw.z), bflo(pw.w), bfhi(pw.w)};
        const float mm[8] = {m0.x, m0.y, m0.z, m0.w, m1.x, m1.y, m1.z, m1.w};
#pragma unroll
        for (int e = 0; e < 8; ++e) { float v = c[e] + (q[e] - c[e]) * mm[e];
            if (j0 < 64) v = 2.f * fsig(2.f * v) - 1.f;
            else if (j0 >= 128) v = fsig(v);
            c[e] = v; }
        u32x4 o; o.x = pk2(c[0], c[1]); o.y = pk2(c[2], c[3]); o.z = pk2(c[4], c[5]); o.w = pk2(c[6], c[7]);
        if (j0 < 128) *(u32x4*)(Awa + (size_t)row * 1536 + j0) = o; else *(u32x4*)(Ag + (size_t)row * 128 + (j0 - 128)) = o;
    }
}
__device__ __forceinline__ void si_build_tile(int wid_s, KP p_, int l, int r, int tile) {
    KP p = p_; asm volatile("" : "+s"(p));
    unsigned char* ws = p->ws;
    const int tid_ = mk_tid(wid_s);
    const int tid = tid_, lane = tid & 63, wv = tid >> 6;
    const GAS bf16* P = (const GAS bf16*)(ws + R_P); GAS bf16* SI = (GAS bf16*)(ws + R_SI); const GAS bf16* LW = (const GAS bf16*)(ws + WS_Y) + (size_t)r * TH * 1536;
    const float* mu = p->in[I_MU] + l * 1792;
    const int row0 = tile * 32;
    const int c = tid, h = wv;
    const float w0c = p->in[I_W0][l * 512 + c], a0c = p->in[I_A0][l * 512 + c], kkc = p->in[I_KK][l * 512 + c], kac = p->in[I_KA][l * 512 + c];
    const float mur = mu[c], muk = mu[512 + c], muv = mu[1024 + c];
#pragma unroll 4
    for (int t = 0; t < 32; ++t) {
        const int row = row0 + t; const bool first = (row & 2047) == 0;
        const GAS bf16* pr = P + (size_t)row * NP; const GAS bf16* pp = pr - NP;
        const float rc = bf2f(pr[c]), kc = bf2f(pr[512 + c]), vc = bf2f(pr[1024 + c]);
        const float rp = first ? 0.f : bf2f(pp[c]), kp = first ? 0.f : bf2f(pp[512 + c]), vp = first ? 0.f : bf2f(pp[1024 + c]);
        const float wl = bf2f(LW[(size_t)row * 1536 + c]), al = bf2f(LW[(size_t)row * 1536 + 512 + c]);
        const float rr = rc + (rp - rc) * mur, k = kc + (kp - kc) * muk, v = vc + (vp - vc) * muv;
        const float om = 1.f - __expf(-0.6065306597126334f * fsig(w0c + wl));
        const float a = fsig(a0c + al);
        const float kkr = k * kkc; const float ss = wave_sum(kkr * kkr); const float kk = kkr / fmaxf(sqrtf(ss), 1e-12f);
        const float k2 = k * (1.f + (a - 1.f) * kac);
        GAS bf16* o = SI + ((size_t)((row >> 11) * 8 + h) * 2048 + (row & 2047)) * 384 + lane;
        o[0] = (bf16)f2bf(rr); o[64] = (bf16)f2bf(om); o[128] = (bf16)f2bf(k2); o[192] = (bf16)f2bf(kk); o[256] = (bf16)f2bf(kk * a); o[320] = (bf16)f2bf(v);
    }
}

template <int CTRL> __device__ __forceinline__ float dppf(float x) { return __builtin_bit_cast(float, __builtin_amdgcn_update_dpp(0, __builtin_bit_cast(int, x), CTRL, 0xF, 0xF, true)); }
__device__ __forceinline__ float allreduce16(float x) { x += dppf<0xB1>(x); x += dppf<0x4E>(x); x += dppf<0x141>(x); x += dppf<0x140>(x); return x; }
template <int MODE>
__device__ __forceinline__ void rwkv_scan_unit(int wid_s, const bf16* SIbh_, bf16* Yb_, int ystride, int quarter, float* ldsf) {
    const int tid_ = mk_tid(wid_s);
    const GAS bf16* SIbh = (const GAS bf16*)SIbh_; GAS bf16* Yb = (GAS bf16*)Yb_;
    const int tid = tid_, lane = tid & 63, wv = tid >> 6;
    float* PYb = ldsf + 2 * (16 * 384);
    u32x4 pre[4][2];
#pragma unroll
    for (int d = 0; d < 4; ++d) { pre[d][0] = *(const GAS u32x4*)(SIbh + (size_t)d * (16 * 384) + (size_t)tid * 8);
        pre[d][1] = (u32x4){0u, 0u, 0u, 0u}; if (tid < 256) pre[d][1] = *(const GAS u32x4*)(SIbh + (size_t)d * (16 * 384) + (size_t)(tid + 512) * 8); }
    f32x2 Sa = {0.f, 0.f}, Sb = {0.f, 0.f};
    const int rowl = quarter * 16 + (wv & 3) * 4 + (lane >> 4), c4 = (lane & 15) * 4;
    LBAR();
    for (int ch0 = 0; ch0 < 132; ch0 += 4) {
#pragma unroll
      for (int jj = 0; jj < 4; ++jj) {
        const int ch = ch0 + jj;
        if (ch > 128) break;
        float* B = ldsf + (ch & 1) * (16 * 384);
        if (ch < 128) {
            { float* d = B + tid * 8; const u32x4 w = pre[jj][0];
              *(f32x4*)d = (f32x4){bflo(w.x), bfhi(w.x), bflo(w.y), bfhi(w.y)}; *(f32x4*)(d + 4) = (f32x4){bflo(w.z), bfhi(w.z), bflo(w.w), bfhi(w.w)}; }
            if (tid < 256) { float* d = B + (tid + 512) * 8; const u32x4 w = pre[jj][1];
              *(f32x4*)d = (f32x4){bflo(w.x), bfhi(w.x), bflo(w.y), bfhi(w.y)}; *(f32x4*)(d + 4) = (f32x4){bflo(w.z), bfhi(w.z), bflo(w.w), bfhi(w.w)}; }
            if (ch + 4 < 128) { pre[jj][0] = *(const GAS u32x4*)(SIbh + (size_t)(ch + 4) * (16 * 384) + (size_t)tid * 8);
                if (tid < 256) pre[jj][1] = *(const GAS u32x4*)(SIbh + (size_t)(ch + 4) * (16 * 384) + (size_t)(tid + 512) * 8); }
        }
        LBAR();
        if (wv < 4) {
            if (ch < 128) {
                float* PY = PYb + (ch & 1) * (16 * 256) + wv * 64 + lane;
                const float* q = B;
                f32x4 r4 = *(const f32x4*)(q + c4), om4 = *(const f32x4*)(q + 64 + c4), k4 = *(const f32x4*)(q + 128 + c4), kk4 = *(const f32x4*)(q + 192 + c4), ka4 = *(const f32x4*)(q + 256 + c4);
                float v = q[320 + rowl];
#pragma unroll
                for (int s = 0; s < 16; ++s) {
                    const float* qn = B + ((MODE & 2) ? 0 : ((s + 1) & 15)) * 384;
                    const f32x4 nr4 = *(const f32x4*)(qn + c4), nom4 = *(const f32x4*)(qn + 64 + c4), nk4 = *(const f32x4*)(qn + 128 + c4), nkk4 = *(const f32x4*)(qn + 192 + c4), nka4 = *(const f32x4*)(qn + 256 + c4);
                    const float nv = qn[320 + rowl];
                    const f32x2 pa = Sa * (f32x2){kk4.x, kk4.y} + Sb * (f32x2){kk4.z, kk4.w};
                    const float sa = (MODE & 1) ? (pa.x + pa.y) : allreduce16(pa.x + pa.y);
                    Sa = Sa - Sa * (f32x2){om4.x, om4.y} + (f32x2){k4.x, k4.y} * v; Sb = Sb - Sb * (f32x2){om4.z, om4.w} + (f32x2){k4.z, k4.w} * v;
                    Sa = Sa - (f32x2){ka4.x, ka4.y} * sa; Sb = Sb - (f32x2){ka4.z, ka4.w} * sa;
                    const f32x2 py = Sa * (f32x2){r4.x, r4.y} + Sb * (f32x2){r4.z, r4.w};
                    PY[s * 256] = py.x + py.y;
                    r4 = nr4; om4 = nom4; k4 = nk4; kk4 = nkk4; ka4 = nka4; v = nv;
                }
            }
        } else if (ch > 0) {
            const int hw = wv - 4, s = lane >> 2, rr = lane & 3;
            const float* src = PYb + ((ch - 1) & 1) * (16 * 256) + s * 256 + hw * 64 + rr * 16;
            const f32x4 a = *(const f32x4*)src, b = *(const f32x4*)(src + 4), c = *(const f32x4*)(src + 8), d = *(const f32x4*)(src + 12);
            const float y = ((a.x + a.y) + (a.z + a.w)) + ((b.x + b.y) + (b.z + b.w)) + ((c.x + c.y) + (c.z + c.w)) + ((d.x + d.y) + (d.z + d.w));
            Yb[(size_t)((ch - 1) * 16 + s) * ystride + quarter * 16 + hw * 4 + rr] = (bf16)f2bf(y);
        }
      }
    }
    LBAR();
}

__device__ __forceinline__ void rwkv_post_tile(int wid_s, KP p_, int l, int r, int tile, int dummy) {
    KP p = p_; asm volatile("" : "+s"(p));
    unsigned char* ws = p->ws;
    const int tid_ = mk_tid(wid_s);
    const int tid = tid_, lane = tid & 63, wv = tid >> 6;
    const GAS bf16* P = (const GAS bf16*)(ws + R_P); const GAS bf16* SI = (const GAS bf16*)(ws + R_SI); GAS bf16* Y = (GAS bf16*)(ws + WS_Y) + (size_t)r * TH * 1536;
    const int row0 = tile * 32;
    const int c = tid, h = wv;
    const float rkc = p->in[I_RK][l * 512 + c], lng = p->in[I_LNG][l * 512 + c], lnb = p->in[I_LNB][l * 512 + c];
#pragma unroll 4
    for (int t = 0; t < 32; ++t) {
        const int row = row0 + t;
        const GAS bf16* si = SI + ((size_t)((row >> 11) * 8 + h) * 2048 + (row & 2047)) * 384 + lane;
        const float rr = bf2f(si[0]), k2 = bf2f(si[128]), v = bf2f(si[320]);
        const float gg = bf2f(P[(size_t)row * NP + c]);
        GAS bf16* yp = Y + (size_t)row * 1536 + c;
        const float y = bf2f(*yp);
        const float mean = wave_sum(y) * (1.f / 64.f); const float d = y - mean; const float var = wave_sum(d * d) * (1.f / 64.f);
        const float yn = d * rsqrtf(var + 64e-5f) * lng + lnb;
        const float bonus = wave_sum(rr * k2 * rkc) * v;
        if (dummy) yp = (GAS bf16*)(ws + R_P) + (size_t)row * NP + 600 + c;
        *yp = (bf16)f2bf((yn + bonus) * gg);
    }
}

__device__ __forceinline__ float gelu_tanh(float x) { const float u = 0.7978845608028654f * (x + 0.044715f * x * x * x); return x * fsig(2.f * u); }
__device__ __forceinline__ void lru_unit(int wid_s, KP p_, int l, int r, int bl, int n, float* ldsf) {
    KP p = p_; asm volatile("" : "+s"(p));
    unsigned char* ws = p->ws;
    const int tid_ = mk_tid(wid_s);
    const int tid = tid_, lane = tid & 63, wv = tid >> 6, g = lane >> 4, j = lane & 15;
    const GAS bf16* P = (const GAS bf16*)(ws + R_P) + (size_t)bl * 2048 * NP; GAS bf16* Yb = (GAS bf16*)(ws + WS_Y) + ((size_t)(r * 4 + bl) * 2048) * 1536 + 512;
    const int cg_ = n * 64 + lane;
    float* s_xc = ldsf;
    float* s_a = ldsf + 8192;
    float* s_u = ldsf + 16384;
    float* s_AH = ldsf + 24576;
    unsigned char* s_xb16 = (unsigned char*)ldsf + 102400;
    unsigned char* s_wt16 = (unsigned char*)ldsf + 120832;
    LBAR();
    for (int e = tid; e < 8192; e += 512) { const int jj = e >> 6, ii = e & 63;
        const float w = (jj < 64) ? p->in[I_WA][((size_t)l * 8 + n) * 4096 + ii * 64 + jj] : p->in[I_WX][((size_t)l * 8 + n) * 4096 + ii * 64 + (jj - 64)];
        *(bf16*)(s_wt16 + (jj * 72 + ii) * 2) = (bf16)f2bf(w); }
    const float cw0 = p->in[I_CW][(l * 4 + 0) * 512 + cg_], cw1 = p->in[I_CW][(l * 4 + 1) * 512 + cg_], cw2 = p->in[I_CW][(l * 4 + 2) * 512 + cg_], cw3 = p->in[I_CW][(l * 4 + 3) * 512 + cg_];
    const float cb = p->in[I_CB][l * 512 + cg_];
    float ba4[4], bx4[4], sp4[4];
#pragma unroll
    for (int n4 = 0; n4 < 4; ++n4) { const int c = n * 64 + 16 * n4 + j; ba4[n4] = p->in[I_BA][l * 512 + c]; bx4[n4] = p->in[I_BX][l * 512 + c];
        sp4[n4] = -8.f * 1.4426950408889634f * log1pf(__expf(-p->in[I_LAM][l * 512 + c])); }
    float hcar = 0.f;
    for (int tile = 0; tile < 16; ++tile) {
        const int t0 = tile * 128 + wv * 16;
        float xc[16]; unsigned short gbr[16];
        {
            float x3 = (t0 >= 3) ? bf2f(P[(size_t)(t0 - 3) * NP + 1792 + cg_]) : 0.f, x2 = (t0 >= 2) ? bf2f(P[(size_t)(t0 - 2) * NP + 1792 + cg_]) : 0.f, x1 = (t0 >= 1) ? bf2f(P[(size_t)(t0 - 1) * NP + 1792 + cg_]) : 0.f;
#pragma unroll
            for (int i = 0; i < 16; ++i) { const float x0 = bf2f(P[(size_t)(t0 + i) * NP + 1792 + cg_]);
                xc[i] = cw0 * x3 + cw1 * x2 + cw2 * x1 + cw3 * x0 + cb; x3 = x2; x2 = x1; x1 = x0; }
#pragma unroll
            for (int i = 0; i < 16; ++i) gbr[i] = P[(size_t)(t0 + i) * NP + 2304 + cg_];
        }
        LBAR();
#pragma unroll
        for (int i = 0; i < 16; ++i) { s_xc[(wv * 16 + i) * 64 + lane] = xc[i]; *(bf16*)(s_xb16 + ((wv * 16 + i) * 72 + lane) * 2) = (bf16)f2bf(xc[i]); }
        LBAR();
        {
            f32x4 acc[8];
            const bf16x8 a0 = *(const bf16x8*)(s_xb16 + ((16 * wv + j) * 72 + 8 * g) * 2), a1 = *(const bf16x8*)(s_xb16 + ((16 * wv + j) * 72 + 32 + 8 * g) * 2);
#pragma unroll
            for (int nn = 0; nn < 8; ++nn) { acc[nn] = (f32x4){0.f, 0.f, 0.f, 0.f};
                const bf16x8 b0 = *(const bf16x8*)(s_wt16 + ((16 * nn + j) * 72 + 8 * g) * 2), b1 = *(const bf16x8*)(s_wt16 + ((16 * nn + j) * 72 + 32 + 8 * g) * 2);
                acc[nn] = __builtin_amdgcn_mfma_f32_16x16x32_bf16(a0, b0, acc[nn], 0, 0, 0); acc[nn] = __builtin_amdgcn_mfma_f32_16x16x32_bf16(a1, b1, acc[nn], 0, 0, 0); }
#pragma unroll
            for (int n4 = 0; n4 < 4; ++n4)
#pragma unroll
                for (int rr = 0; rr < 4; ++rr) { const int tk = 16 * wv + 4 * g + rr, c = 16 * n4 + j;
                    const float rg = fsig(acc[n4][rr] + ba4[n4]), ig = fsig(acc[n4 + 4][rr] + bx4[n4]);
                    const float a = __builtin_amdgcn_exp2f(sp4[n4] * rg);
                    const float uu = __builtin_amdgcn_sqrtf(fmaxf(1.f - a * a, 0.f)) * (ig * s_xc[tk * 64 + c]);
                    s_a[tk * 64 + c] = a; s_u[tk * 64 + c] = uu; }
        }
        LBAR();
        float av[16], uv[16]; float A = 1.f, H = 0.f;
#pragma unroll
        for (int i = 0; i < 16; ++i) { av[i] = s_a[(wv * 16 + i) * 64 + lane]; uv[i] = s_u[(wv * 16 + i) * 64 + lane]; A *= av[i]; H = av[i] * H + uv[i]; }
        s_AH[(wv * 64 + lane) * 2] = A; s_AH[(wv * 64 + lane) * 2 + 1] = H;
        LBAR();
        float hin = hcar, hall = hcar;
#pragma unroll
        for (int w = 0; w < 8; ++w) { const float Aw = s_AH[(w * 64 + lane) * 2], Hw = s_AH[(w * 64 + lane) * 2 + 1]; hall = Aw * hall + Hw; if (w < wv) hin = hall; }
        hcar = hall;
        float hh = hin;
#pragma unroll
        for (int i = 0; i < 16; ++i) { hh = av[i] * hh + uv[i];
            Yb[(size_t)(t0 + i) * 1536 + cg_] = (bf16)f2bf(hh * gelu_tanh(bf2f(gbr[i]))); }
    }
    LBAR();
}

__device__ __forceinline__ void kfix_rows(int wid_s, KP p_, int l, int r) {
    KP p = p_; asm volatile("" : "+s"(p));
    unsigned char* ws = p->ws;
    const int tid_ = mk_tid(wid_s);
    const int tid = tid_, lane = tid & 63, wv = tid >> 6, h = lane >> 3, sub = lane & 7;
    const GAS bf16* P = (const GAS bf16*)(ws + R_P); GAS bf16* Km = (GAS bf16*)(ws + R_KM);
    const float* kg = p->in[I_KG] + l * 96; const int* pos = (const int*)p->in[I_POS] + r * TH;
    for (int row = blockIdx.x * 8 + wv; row < TH; row += gridDim.x * 8) {
        GAS bf16* kp = Km + (size_t)row * 768 + h * 96;
        const u32x4 w = *(const GAS u32x4*)(kp + 8 * sub);
        float nv[8] = {bflo(w.x), bfhi(w.x), bflo(w.y), bfhi(w.y), bflo(w.z), bfhi(w.z), bflo(w.w), bfhi(w.w)};
        const unsigned k1 = *(const GAS unsigned*)(P + (size_t)row * NP + 3200 + 2 * sub), k2 = *(const GAS unsigned*)(P + (size_t)row * NP + 3216 + 2 * sub);
        float x1a = bflo(k1), x1b = bfhi(k1), x2a = bflo(k2), x2b = bfhi(k2);
        float ss = x1a * x1a + x1b * x1b + x2a * x2a + x2b * x2b;
#pragma unroll
        for (int e = 0; e < 8; ++e) ss += nv[e] * nv[e];
        ss += __shfl_xor(ss, 1); ss += __shfl_xor(ss, 2); ss += __shfl_xor(ss, 4);
        const float rs = rsqrtf(ss * (1.f / 96.f) + 1e-6f);
#pragma unroll
        for (int e = 0; e < 8; ++e) nv[e] *= rs * kg[8 * sub + e];
        x1a *= rs * kg[64 + 2 * sub]; x1b *= rs * kg[65 + 2 * sub]; x2a *= rs * kg[80 + 2 * sub]; x2b *= rs * kg[81 + 2 * sub];
        const int ps = pos[row]; float ca, sa, cb, sb; rope_cs(ps, 2 * sub, ca, sa); rope_cs(ps, 2 * sub + 1, cb, sb);
        u32x4 o; o.x = pk2(nv[0], nv[1]); o.y = pk2(nv[2], nv[3]); o.z = pk2(nv[4], nv[5]); o.w = pk2(nv[6], nv[7]);
        *(GAS u32x4*)(kp + 8 * sub) = o;
        *(GAS unsigned*)(kp + 64 + 2 * sub) = pk2(x1a * ca - x2a * sa, x1b * cb - x2b * sb);
        *(GAS unsigned*)(kp + 80 + 2 * sub) = pk2(x2a * ca + x1a * sa, x2b * cb + x1b * sb);
    }
}
__device__ __forceinline__ void mkfix_rows(int wid_s, KP p_, int l) {
    KP p = p_; asm volatile("" : "+s"(p));
    unsigned char* ws = p->ws;
    const int tid_ = mk_tid(wid_s);
    const int tid = tid_, lane = tid & 63, wv = tid >> 6, h = lane >> 4, sub = lane & 15;
    bf16* mk = (bf16*)(ws + R_MK); const float* kg = p->in[I_XKG] + l * 128;
    for (int row = blockIdx.x * 8 + wv; row < 2048; row += gridDim.x * 8) {
        bf16* kp = mk + (size_t)row * 512 + h * 128 + 8 * sub;
        const u32x4 w = *(const u32x4*)kp;
        float nv[8] = {bflo(w.x), bfhi(w.x), bflo(w.y), bfhi(w.y), bflo(w.z), bfhi(w.z), bflo(w.w), bfhi(w.w)};
        float ss = 0.f;
#pragma unroll
        for (int e = 0; e < 8; ++e) ss += nv[e] * nv[e];
        ss += __shfl_xor(ss, 1); ss += __shfl_xor(ss, 2); ss += __shfl_xor(ss, 4); ss += __shfl_xor(ss, 8);
        const float rs = rsqrtf(ss * (1.f / 128.f) + 1e-6f);
#pragma unroll
        for (int e = 0; e < 8; ++e) nv[e] *= rs * kg[8 * sub + e];
        u32x4 o; o.x = pk2(nv[0], nv[1]); o.y = pk2(nv[2], nv[3]); o.z = pk2(nv[4], nv[5]); o.w = pk2(nv[6], nv[7]);
        *(u32x4*)kp = o;
    }
}
__device__ __forceinline__ void memb_rows(int wid_s, KP p_) {
    KP p = p_; asm volatile("" : "+s"(p));
    unsigned char* ws = p->ws;
    const int tid_ = mk_tid(wid_s);
    const int tid = tid_, lane = tid & 63, wv = tid >> 6;
    const float* mem = p->in[I_MEM]; bf16* memb = (bf16*)(ws + R_MEMB);
    for (int row = blockIdx.x * 8 + wv; row < 2048; row += gridDim.x * 8) {
        const f32x4* xr = (const f32x4*)(mem + (size_t)row * 1024) + lane; f32x4 v[4]; float s = 0.f;
#pragma unroll
        for (int jq = 0; jq < 4; ++jq) { v[jq] = xr[64 * jq]; s += (v[jq].x * v[jq].x + v[jq].y * v[jq].y) + (v[jq].z * v[jq].z + v[jq].w * v[jq].w); }
        const float rs = rsqrtf(wave_sum(s) * (1.f / 1024.f) + 1e-6f);
#pragma unroll
        for (int jq = 0; jq < 4; ++jq) { u32x2 w; w.x = pk2(v[jq].x * rs, v[jq].y * rs); w.y = pk2(v[jq].z * rs, v[jq].w * rs); *((u32x2*)(memb + (size_t)row * 1024) + lane + 64 * jq) = w; }
    }
}

#define XB_TMO      128
#define XB_XCNT(j)  (256  + 64 * (j))
#define XB_XSUB(j)  (1280 + 64 * (j))
#define XB_XGEN(j)  (2304 + 64 * (j))
#define XB_TOP      3328
#define XB_TOPGEN   3392
#define XCD_BAR_WORDS 3456
#define XB_SPIN_CAP (1u << 22)
__device__ __forceinline__ unsigned xb_ld(unsigned* p)              { return __hip_atomic_load(p, __ATOMIC_RELAXED, __HIP_MEMORY_SCOPE_AGENT); }
__device__ __forceinline__ unsigned xb_add(unsigned* p, unsigned v) { return __hip_atomic_fetch_add(p, v, __ATOMIC_RELAXED, __HIP_MEMORY_SCOPE_AGENT); }
__device__ __forceinline__ unsigned xb_xcc_id() { return (unsigned)__builtin_amdgcn_s_getreg((3 << 11) | 20) & 0xFu; }
#define XB_SPIN(cond, bar) do { unsigned _sp = 0; while (cond) { __builtin_amdgcn_s_sleep(1); \
    if ((++_sp & 255u) == 0u) { if (xb_ld(&(bar)[XB_TMO])) break; if (_sp > XB_SPIN_CAP) { atomicAdd(&(bar)[XB_TMO], 1u); break; } } } } while (0)
__device__ __forceinline__ void xcd_barrier_complete(unsigned* bar, unsigned x, unsigned& nloc, unsigned& nx) {
    const unsigned G = gridDim.x;
    unsigned sum, cnt, mine, sp = 0u;
    for (;;) {
        sum = 0u; cnt = 0u; mine = 0u;
#pragma unroll
        for (unsigned j = 0; j < 16; ++j) { const unsigned c = xb_ld(&bar[XB_XCNT(j)]); sum += c; cnt += (c > 0u) ? 1u : 0u; mine = (j == x) ? c : mine; }
        if (sum == G) break;
        __builtin_amdgcn_s_sleep(1);
        if ((++sp & 255u) == 0u) { if (xb_ld(&bar[XB_TMO])) break; if (sp > XB_SPIN_CAP) { atomicAdd(&bar[XB_TMO], 1u); break; } }
    }
    nloc = mine > 0u ? mine : 1u; nx = cnt > 0u ? cnt : 1u;
}
__device__ __forceinline__ void grid_barrier1(int wid_s, unsigned* bar, volatile unsigned* st) {
    asm volatile("s_waitcnt vmcnt(0)" ::: "memory");
    __syncthreads();
    if (mk_tid(wid_s) == 0) {
        const unsigned x = xb_xcc_id();
        __builtin_amdgcn_s_waitcnt(0);
        unsigned nloc = st[0], nx = st[1];
        if (nloc == 0u) { xcd_barrier_complete(bar, x, nloc, nx); st[0] = nloc; st[1] = nx; }
        const unsigned old = xb_add(&bar[XB_XSUB(x)], 1u);
        const unsigned gen = old / nloc;
        if (old + 1u == (gen + 1u) * nloc) {
            __builtin_amdgcn_fence(__ATOMIC_RELEASE, "agent");
            asm volatile("s_waitcnt vmcnt(0)" ::: "memory");
            const unsigned og = xb_add(&bar[XB_TOP], 1u);
            const unsigned tg = og / nx;
            if (og + 1u == (tg + 1u) * nx) xb_add(&bar[XB_TOPGEN], 1u);
            else XB_SPIN(xb_ld(&bar[XB_TOPGEN]) == tg, bar);
            __builtin_amdgcn_fence(__ATOMIC_ACQUIRE, "agent");
            xb_add(&bar[XB_XGEN(x)], 1u);
            asm volatile("s_waitcnt vmcnt(0)" ::: "memory");
        } else {
            XB_SPIN(xb_ld(&bar[XB_XGEN(x)]) == gen, bar);
            __builtin_amdgcn_fence(__ATOMIC_ACQUIRE, "agent");
            asm volatile("s_waitcnt vmcnt(0)" ::: "memory");
        }
    }
    __syncthreads();
}
__device__ __forceinline__ void grid_barrier(int wid_s, unsigned* bar, volatile unsigned* st) { int nb = 1 + RB(8); asm volatile("" : "+s"(nb)); for (int q = 0; q < nb; ++q) grid_barrier1(wid_s, bar, st); }
template <class Epi>
__device__ __forceinline__ void run_gemm(int wid_s, LAS unsigned char* lds, const bf16* A, int lda, const bf16* Bt, int M, int N, int K, const Epi& E) {
    int bx_ = blockIdx.x, gx_ = gridDim.x; asm volatile("" : "+s"(bx_), "+s"(gx_), "+s"(K), "+s"(lda));
    pg8::Gemm g{A, Bt, M, N, K, lda}; pg8::StaticOrder S; S.init(M, N, gx_, bx_);
    if (ON(1)) pg8::gemm_phase<Epi, pg8::StaticOrder>(wid_s, lds, g, S, E);
}

__device__ __forceinline__ unsigned char* wsl_(KP p) { unsigned char* w = p->ws; asm volatile("" : "+s"(w)); return w; }
__global__ void __launch_bounds__(512, 2) fwd_kernel(Params parg) {
    KP p = (KP)__builtin_amdgcn_kernarg_segment_ptr();
    extern __shared__ __attribute__((aligned(16))) unsigned char lds_raw[];
    const int wid_s = __builtin_amdgcn_readfirstlane((int)threadIdx.x >> 6);
    LAS unsigned char* lds3 = (LAS unsigned char*)lds_raw;
    unsigned char* lds = lds_raw; float* ldsf = (float*)lds_raw;
    unsigned char* ws = p->ws;
    const int bid = blockIdx.x;
    unsigned* ctl = (unsigned*)(wsl_(p) + WS_CTL);
    bf16* xb = (bf16*)(wsl_(p) + WS_XB); float* part = (float*)(wsl_(p) + WS_PART); float* pq = (float*)(wsl_(p) + WS_PQ); float* pkv = (float*)(wsl_(p) + WS_PKV);
    bf16* Y = (bf16*)(wsl_(p) + WS_Y);
    float* xcur = p->out;
    volatile unsigned* bst = (volatile unsigned*)(lds + QIDX_OFF + 16);
    if (threadIdx.x == 0) { bst[0] = 0u; bst[1] = 0u; (void)xb_add(&ctl[1024 + XB_XCNT(xb_xcc_id())], 1u); }
    __syncthreads();

    for (int l_ = 0; l_ < 2; ++l_) {
        int l = l_; asm volatile("" : "+s"(l));
        { REPLOOP(0) { if (ON(0)) phase_convert(wid_s, p, l, ldsf);
        grid_barrier(wid_s, ctl + 1024, bst); } }
        for (int r_ = 0; r_ < 2; ++r_) {
            int r = r_; asm volatile("" : "+s"(r));
            { REPLOOP(1) { EpiP E{(bf16*)(wsl_(p) + R_P), part + (size_t)r * TH * 16, pq, pkv};
              run_gemm(wid_s, lds3, xb + (size_t)r * TH * 1024, 1024, (const bf16*)(wsl_(p) + W_IN), TH, NP, 1024, E);
            grid_barrier(wid_s, ctl + 1024, bst); } }
            { REPLOOP(2) {
            if (ON(2)) lora_act_rows(wid_s, p, l, r);
            { EpiQ E{(bf16*)(wsl_(p) + R_Q), pq}; run_gemm(wid_s, lds3, (const bf16*)(wsl_(p) + R_P) + 2816, NP, (const bf16*)(wsl_(p) + W_MQ), TH, 768, 256, E); }
            { EpiKV E{(bf16*)(wsl_(p) + R_KM), (bf16*)(wsl_(p) + R_VT), pkv}; run_gemm(wid_s, lds3, (const bf16*)(wsl_(p) + R_P) + 3072, NP, (const bf16*)(wsl_(p) + W_MKV), TH, 1024, 128, E); }
            grid_barrier(wid_s, ctl + 1024, bst); } }
            { REPLOOP(9) { EpiBf E{Y + (size_t)r * TH * 1536, 1536}; run_gemm(wid_s, lds3, Y + (size_t)r * TH * 1536 + 1024, 1536, (const bf16*)(wsl_(p) + W_BWA), TH, 1024, 128, E);
            grid_barrier(wid_s, ctl + 1024, bst); } }
            { REPLOOP(13) { if (ON(2)) for (int tile = bid; tile < TH / 32; tile += gridDim.x) si_build_tile(wid_s, p, l, r, tile); } }
            if (ON(7)) kfix_rows(wid_s, p, l, r);
            grid_barrier(wid_s, ctl + 1024, bst);
            { REPLOOP(3) {
            if (ON(3) && !(q && RB(10)) && bid < 128) { const int xcd = bid & 7, idx = bid >> 3, hh = xcd * 4 + (idx >> 2), quarter = idx & 3;
                if (q == 0 || SCANMODE == 0) rwkv_scan_unit<0>(wid_s, (const bf16*)(wsl_(p) + R_SI) + (size_t)hh * 2048 * 384, Y + ((size_t)(r * 4 + (hh >> 3)) * 2048) * 1536 + (hh & 7) * 64, 1536, quarter, ldsf);
                else rwkv_scan_unit<SCANMODE>(wid_s, (const bf16*)(wsl_(p) + R_SI) + (size_t)hh * 2048 * 384, (bf16*)(wsl_(p) + R_P) + ((size_t)(hh >> 3) * 2048) * NP + 600 + (hh & 7) * 64, NP, quarter, ldsf); }
            else if (ON(4) && !(q && RB(11)) && bid >= 128 && bid < 160) { const int uu = bid - 128; lru_unit(wid_s, p, l, r, uu >> 3, uu & 7, ldsf); }
            {
                unsigned* ctr = ctl + q * 4 + l * 2 + r; volatile int* qidx = (volatile int*)(lds + QIDX_OFF);
                for (;;) {
                    __syncthreads();
                    if (mk_tid(wid_s) == 0) *qidx = (int)atomicAdd(ctr, 1u);
                    __syncthreads();
                    const int u = *qidx;
                    if (u >= 512 || !ON(5) || (q && RB(12))) break;
                    const int qb = 15 - (u >> 5), bh = u & 31, bl = bh >> 3, h = bh & 7;
                    attn_unit<96, 64, true, true>(wid_s, lds, (const bf16*)(wsl_(p) + R_Q) + (size_t)bl * 2048 * 768 + h * 96, 768, (const bf16*)(wsl_(p) + R_KM) + (size_t)bl * 2048 * 768 + h * 96, 768,
                        (const bf16*)(wsl_(p) + R_VT) + (size_t)(bl * 8 + h) * 64 * 2048, 2048, Y + ((size_t)(r * 4 + bl) * 2048) * 1536 + 1024 + h * 64, 1536,
                        qb * 128, 2 * qb + 2, p->in[I_QG] + l * 96, (const int*)p->in[I_POS] + (r * 4 + bl) * 2048, 0.14724444527f  );
                }
            }
            grid_barrier(wid_s, ctl + 1024, bst); } }
            { REPLOOP(14) { EpiBf E{(bf16*)(wsl_(p) + R_P), NP}; run_gemm(wid_s, lds3, (const bf16*)(wsl_(p) + WS_AG), 128, (const bf16*)(wsl_(p) + W_GUP), TH, 512, 128, E);
            grid_barrier(wid_s, ctl + 1024, bst); } }
            { REPLOOP(16) { if (ON(6)) for (int tile = bid; tile < TH / 32; tile += gridDim.x) rwkv_post_tile(wid_s, p, l, r, tile, q); } }
            grid_barrier(wid_s, ctl + 1024, bst);
        }
        if (ON(7)) memb_rows(wid_s, p);
        { REPLOOP(4) {
        for (int n = 0; n < 3; ++n) {
            { EpiGate E{(bf16*)(wsl_(p) + R_GS), part, p->in[I_BGATE] + l * 3072 + n * 1024}; run_gemm(wid_s, lds3, xb, 1024, (const bf16*)(wsl_(p) + W_GATE) + (size_t)n * 1024 * 1024, T, 1024, 1024, E); }
            { EpiProj E{(const bf16*)(wsl_(p) + R_GS), (float*)(wsl_(p) + R_MS), (bf16*)(wsl_(p) + R_MG), n}; run_gemm(wid_s, lds3, Y + n * 512, 1536, (const bf16*)(wsl_(p) + W_BR) + (size_t)n * 1024 * 512, T, 1024, 512, E); }
        }
        grid_barrier(wid_s, ctl + 1024, bst); } }
        { int nw = 1 + RB(15); asm volatile("" : "+s"(nw)); for (int q = 0; q < nw; ++q) { EpiRes E{l == 0 ? p->in[I_X] : xcur, xcur, xb, part, q + 1 < nw}; run_gemm(wid_s, lds3, (const bf16*)(wsl_(p) + R_MG), 1024, (const bf16*)(wsl_(p) + W_OUT), T, 1024, 1024, E); if (q + 1 < nw) grid_barrier(wid_s, ctl + 1024, bst); } }
        { REPLOOP(19) { EpiMemKV E{(bf16*)(wsl_(p) + R_MK), (bf16*)(wsl_(p) + R_MVT)}; run_gemm(wid_s, lds3, (const bf16*)(wsl_(p) + R_MEMB), 1024, (const bf16*)(wsl_(p) + W_XKV), 2048, 1024, 1024, E); } }
        grid_barrier(wid_s, ctl + 1024, bst);
        if (ON(7)) mkfix_rows(wid_s, p, l);
        { REPLOOP(5) { EpiXQ E{(bf16*)(wsl_(p) + R_XQ), part}; run_gemm(wid_s, lds3, xb, 1024, (const bf16*)(wsl_(p) + W_XQ), T, 512, 1024, E);
        grid_barrier(wid_s, ctl + 1024, bst); } }
        { REPLOOP(6) {
        if (ON(8)) for (int u = bid; u < 512; u += gridDim.x) { const int qb = u & 15, bh = u >> 4, b = bh >> 2, h = bh & 3;
            attn_unit<128, 128, false, false>(wid_s, lds, (const bf16*)(wsl_(p) + R_XQ) + (size_t)b * 2048 * 512 + h * 128, 512, (const bf16*)(wsl_(p) + R_MK) + (size_t)b * 256 * 512 + h * 128, 512,
                (const bf16*)(wsl_(p) + R_MVT) + (size_t)(b * 4 + h) * 128 * 256, 256, (bf16*)(wsl_(p) + R_XO) + (size_t)b * 2048 * 512 + h * 128, 512,
                qb * 128, 4, p->in[I_XQG] + l * 128, nullptr, 0.12751743082f  ); }
        grid_barrier(wid_s, ctl + 1024, bst); } }
        { int nw = 1 + RB(17); asm volatile("" : "+s"(nw)); for (int q = 0; q < nw; ++q) { EpiRes E{xcur, xcur, xb, part, q + 1 < nw}; run_gemm(wid_s, lds3, (const bf16*)(wsl_(p) + R_XO), 512, (const bf16*)(wsl_(p) + W_XO), T, 1024, 512, E); if (q + 1 < nw) grid_barrier(wid_s, ctl + 1024, bst); } }
        grid_barrier(wid_s, ctl + 1024, bst);
        { REPLOOP(7) { EpiFFN1 E{(bf16*)(wsl_(p) + R_H), part}; run_gemm(wid_s, lds3, xb, 1024, (const bf16*)(wsl_(p) + W_13), T, 5632, 1024, E);
        grid_barrier(wid_s, ctl + 1024, bst); } }
        { int nw = 1 + RB(18); asm volatile("" : "+s"(nw)); for (int q = 0; q < nw; ++q) { EpiRes E{xcur, xcur, xb, part, q + 1 < nw}; run_gemm(wid_s, lds3, (const bf16*)(wsl_(p) + R_H), DFF, (const bf16*)(wsl_(p) + W_2), T, 1024, DFF, E); if (q + 1 < nw) grid_barrier(wid_s, ctl + 1024, bst); } }
        grid_barrier(wid_s, ctl + 1024, bst);
    }
}

extern "C" void kernel_launch(void* const* d_in, const int* in_sizes, int n_in, void* d_out, int out_size, void* d_ws, size_t ws_size, hipStream_t stream) {
    static int grid = 0;
    if (grid == 0) {
        int dev = 0, cus = 0, per_cu = 0;
        if (n_in != 43 || ws_size < WS_END) { fprintf(stderr, "kernel_launch: unexpected n_in %d / ws %zu\n", n_in, ws_size); grid = -1; return; }
        (void)hipGetDevice(&dev);
        (void)hipDeviceGetAttribute(&cus, hipDeviceAttributeMultiprocessorCount, dev);
        (void)hipFuncSetAttribute((const void*)fwd_kernel, hipFuncAttributeMaxDynamicSharedMemorySize, LDS_BYTES);
        (void)hipOccupancyMaxActiveBlocksPerMultiprocessor(&per_cu, (const void*)fwd_kernel, 512, LDS_BYTES);
        fprintf(stderr, "cus %d per_cu %d ws %zu\n", cus, per_cu, ws_size);
        grid = cus * (per_cu >= 1 ? 1 : 0);
        if (grid <= 0) { grid = -1; return; }
    }
    if (grid < 0) return;
    Params p{};
    for (int i = 0; i < 43; ++i) p.in[i] = (const float*)d_in[i];
    p.out = (float*)d_out; p.ws = (unsigned char*)d_ws;
    (void)hipMemsetAsync((char*)d_ws + WS_CTL, 0, 32768, stream);
    void* args[] = {&p};
    hipError_t e = hipLaunchCooperativeKernel((const void*)fwd_kernel, dim3(grid), dim3(512), args, LDS_BYTES, stream);
    if (e != hipSuccess) fprintf(stderr, "cooperative launch failed: %s (grid %d)\n", hipGetErrorString(e), grid);
}
```

```cpp
#include <hip/hip_runtime.h>
#include <cstdio>
#include <cstdint>

#define LAS __attribute__((address_space(3)))
#define GAS __attribute__((address_space(1)))
typedef unsigned short bf16;
typedef short bf16x8 __attribute__((ext_vector_type(8)));
typedef float f32x4 __attribute__((ext_vector_type(4)));
typedef float f32x2 __attribute__((ext_vector_type(2)));
typedef unsigned u32x4 __attribute__((ext_vector_type(4)));
typedef unsigned u32x2 __attribute__((ext_vector_type(2)));

__device__ __forceinline__ unsigned f2bf(float f) { unsigned u = __builtin_bit_cast(unsigned, f); return (u + 0x7fffu + ((u >> 16) & 1u)) >> 16; }
typedef __bf16 bf16x2_t __attribute__((ext_vector_type(2)));
__device__ __forceinline__ unsigned pk2(float lo, float hi) { const f32x2 v = {lo, hi}; const bf16x2_t b = __builtin_convertvector(v, bf16x2_t); return __builtin_bit_cast(unsigned, b); }
__device__ __forceinline__ float bf2f(bf16 b) { return __builtin_bit_cast(float, (unsigned)b << 16); }
__device__ __forceinline__ float bflo(unsigned u) { return __builtin_bit_cast(float, u << 16); }
__device__ __forceinline__ float bfhi(unsigned u) { return __builtin_bit_cast(float, u & 0xffff0000u); }
__device__ __forceinline__ u32x4 pk8(f32x4 a, f32x4 b) { u32x4 w; w.x = pk2(a.x, a.y); w.y = pk2(a.z, a.w); w.z = pk2(b.x, b.y); w.w = pk2(b.z, b.w); return w; }
__device__ __forceinline__ float sigmoidf_(float x) { return 1.f / (1.f + __expf(-x)); }
__device__ __forceinline__ float fsig(float x) { return __builtin_amdgcn_rcpf(1.f + __builtin_amdgcn_exp2f(-1.4426950408889634f * x)); }
__device__ __forceinline__ int mk_tid(int wid_s) { int t = wid_s * 64 + (int)__builtin_amdgcn_mbcnt_hi(~0u, __builtin_amdgcn_mbcnt_lo(~0u, 0u)); asm volatile("" : "+v"(t)); return t; }
#define LBAR() asm volatile("s_waitcnt lgkmcnt(0)\n\ts_barrier" ::: "memory")
__device__ __forceinline__ float wave_sum(float v) {
#pragma unroll
    for (int o = 1; o < 64; o <<= 1) v += __shfl_xor(v, o);
    return v;
}

namespace pg8 {
#define PG8_LAS __attribute__((address_space(3)))
typedef unsigned short bf16_t;
constexpr int BM = 256, BK = 64, HALF = 128, HTB = HALF * BK * 2, STAGE_BYTES = 8 * HTB, NXCD = 8, WGM = 8;
__host__ __device__ __forceinline__ int lds_byte(int r, int c) { const int st = (r >> 4) * 2 + (c >> 5), rr = r & 15, cc = c & 31, ob = rr * 64 + cc * 2; return st * 1024 + (ob ^ (((ob >> 9) & 1) << 5)); }
__host__ __device__ __forceinline__ void stage_rc(int b, int& R, int& C) { const int st = b / 1024, sb = b % 1024, swz = sb ^ (((sb >> 9) & 1) << 5); R = (st >> 1) * 16 + swz / 64; C = (st & 1) * 32 + (swz % 64) / 2; }
__host__ __device__ __forceinline__ int perm32(int rho) { const int n = rho >> 4, i = rho & 15; return 8 * (i >> 2) + 4 * n + (i & 3); }
struct Unit { int pm, pn; };
struct Gemm { const bf16_t* A; const bf16_t* Bt; int M, N, K, lda; };
struct StaticOrder {
    int nM, nN, nwg, G, c;
    __host__ __device__ void init(int M, int N, int G_, int c_) { nM = M / BM; nN = N / BM; nwg = nM * nN; G = G_; c = c_; }
    __host__ __device__ bool next(int i, Unit& u) const {
        const long L = (long)i * G + c; if (L >= nwg) return false;
        int wgid = (int)L; { const int q = nwg / NXCD, r = nwg % NXCD, xcd = wgid % NXCD, off = wgid / NXCD; wgid = (xcd < r ? xcd * (q + 1) : r * (q + 1) + (xcd - r) * q) + off; }
        const int nig = WGM * nN, gid = wgid / nig, fm = gid * WGM, gsz = (nM - fm) < WGM ? (nM - fm) : WGM;
        u.pm = fm + ((wgid % nig) % gsz); u.pn = (wgid % nig) / gsz; return true;
    }
};
template <class Epi, class Sched>
__device__ __forceinline__ void gemm_phase(int wid_s, PG8_LAS unsigned char* lds, const Gemm g, const Sched& S, const Epi& E) {
    const int tid_ = mk_tid(wid_s);
    const int tid = tid_, wid = __builtin_amdgcn_readfirstlane(tid >> 6), lane = tid & 63, wr = wid >> 2, wc = wid & 3, fr = lane & 15, fq = lane >> 4;
    const int K = g.K, nt = K / BK, lda = g.lda;
    unsigned voffA[2], voffB[2];
#pragma unroll
    for (int i = 0; i < 2; ++i) { int R, C; stage_rc(tid * 16 + i * 8192, R, C); const int Rb = (R & ~31) + perm32(R & 31);
        voffA[i] = (unsigned)(R * lda + C) * 2u; voffB[i] = (unsigned)(Rb * K + C) * 2u; }
    const size_t kstep = (size_t)(BK * 2);
    const size_t hstepA = (size_t)HALF * lda * 2, hstepB = (size_t)HALF * K * 2;
    const size_t tstepA = 2 * hstepA, tstepB = 2 * hstepB;
    const unsigned ldsw = (unsigned)wid * 1024u;
    const int aoff = lds_byte(wr * 64 + fr, fq * 8), boff = lds_byte(wc * 32 + fr, fq * 8);
#define PG8_SA(b, h) (((b) * 2 + (h)) * HTB)
#define PG8_SB(b, h) ((4 + (b) * 2 + (h)) * HTB)
#define PG8_STAGE(bufoff, gbase, voff) do { _Pragma("unroll") for (int _i = 0; _i < 2; ++_i) \
        __builtin_amdgcn_global_load_lds((const unsigned*)((const char*)(gbase) + (voff)[_i]), (PG8_LAS unsigned*)(lds + (bufoff) + ldsw + _i * 8192), 16, 0, 0); } while (0)
#define PG8_LDA(dst, b, h) do { _Pragma("unroll") for (int m = 0; m < 4; ++m) _Pragma("unroll") for (int k = 0; k < 2; ++k) dst[m][k] = *(const PG8_LAS bf16x8*)(lds + PG8_SA(b, h) + aoff + m * 2048 + k * 1024); } while (0)
#define PG8_LDB(dst, b, h) do { _Pragma("unroll") for (int n = 0; n < 2; ++n) _Pragma("unroll") for (int k = 0; k < 2; ++k) dst[n][k] = *(const PG8_LAS bf16x8*)(lds + PG8_SB(b, h) + boff + n * 2048 + k * 1024); } while (0)
#define PG8_MMA(ai, bj, At, Bt) do { __builtin_amdgcn_s_setprio(1); _Pragma("unroll") for (int m = 0; m < 4; ++m) _Pragma("unroll") for (int n = 0; n < 2; ++n) _Pragma("unroll") for (int k = 0; k < 2; ++k) \
        acc[ai][bj][m][n] = __builtin_amdgcn_mfma_f32_16x16x32_bf16(Bt[n][k], At[m][k], acc[ai][bj][m][n], 0, 0, 0); __builtin_amdgcn_s_setprio(0); } while (0)
#define PG8_WAIT_V(n) asm volatile("s_waitcnt vmcnt(" #n ")" ::: "memory")
#define PG8_WAIT_L(n) asm volatile("s_waitcnt lgkmcnt(" #n ")" ::: "memory")
#define PG8_BAR __builtin_amdgcn_s_barrier()
#define PG8_SCHED __builtin_amdgcn_sched_barrier(0)
    Unit cur, nxt; int ui = 0;
    if (!S.next(0, cur)) return;
    f32x4 acc[2][2][4][2];
#pragma unroll
    for (int a = 0; a < 2; ++a)
#pragma unroll
        for (int b = 0; b < 2; ++b)
#pragma unroll
            for (int m = 0; m < 4; ++m)
#pragma unroll
                for (int n = 0; n < 2; ++n) acc[a][b][m][n] = (f32x4){0.f, 0.f, 0.f, 0.f};
    bf16x8 At[4][2], B0[2][2], B1[2][2];
    const char* cA = (const char*)g.A + (size_t)cur.pm * tstepA; const char* cB = (const char*)g.Bt + (size_t)cur.pn * tstepB;
    PG8_STAGE(PG8_SB(0, 0), cB, voffB); PG8_STAGE(PG8_SB(0, 1), cB + hstepB, voffB); PG8_STAGE(PG8_SA(0, 0), cA, voffA); PG8_STAGE(PG8_SA(0, 1), cA + hstepA, voffA);
    if (wr == 1) PG8_BAR;
    PG8_WAIT_V(2); PG8_BAR;
    PG8_STAGE(PG8_SB(1, 0), cB + kstep, voffB); PG8_STAGE(PG8_SA(1, 0), cA + kstep, voffA); PG8_STAGE(PG8_SB(1, 1), cB + hstepB + kstep, voffB);
    PG8_WAIT_V(6); PG8_BAR;
    for (;;) {
        const bool has_next = S.next(ui + 1, nxt);
        const char* nA = has_next ? (const char*)g.A + (size_t)nxt.pm * tstepA : cA; const char* nB = has_next ? (const char*)g.Bt + (size_t)nxt.pn * tstepB : cB;
#pragma unroll 1
        for (int t = 0; t < nt; t += 2) {
            const bool last = (t == nt - 2);
            const char* a1 = cA + (size_t)(t + 1) * kstep;
            const char* a2 = last ? nA : cA + (size_t)(t + 2) * kstep; const char* b2 = last ? nB : cB + (size_t)(t + 2) * kstep;
            const char* a3 = a2 + kstep; const char* b3 = b2 + kstep;
            PG8_LDB(B0, 0, 0); PG8_LDB(B1, 0, 1); PG8_SCHED; PG8_LDA(At, 0, 0); PG8_STAGE(PG8_SA(1, 1), a1 + hstepA, voffA);
            PG8_WAIT_V(8); PG8_WAIT_L(0); PG8_BAR; PG8_MMA(0, 0, At, B0); PG8_MMA(0, 1, At, B1); PG8_BAR; PG8_SCHED;
            PG8_LDA(At, 0, 1); PG8_STAGE(PG8_SB(0, 0), b2, voffB); PG8_STAGE(PG8_SB(0, 1), b2 + hstepB, voffB); PG8_STAGE(PG8_SA(0, 0), a2, voffA);
            PG8_WAIT_V(8); PG8_WAIT_L(0); PG8_BAR; PG8_MMA(1, 0, At, B0); PG8_MMA(1, 1, At, B1); PG8_BAR; PG8_SCHED;
            PG8_LDB(B0, 1, 0); PG8_LDB(B1, 1, 1); PG8_SCHED; PG8_LDA(At, 1, 0); PG8_STAGE(PG8_SA(0, 1), a2 + hstepA, voffA);
            PG8_WAIT_V(8); PG8_WAIT_L(0); PG8_BAR; PG8_MMA(0, 0, At, B0); PG8_MMA(0, 1, At, B1); PG8_BAR; PG8_SCHED;
            PG8_LDA(At, 1, 1); PG8_STAGE(PG8_SB(1, 0), b3, voffB); PG8_STAGE(PG8_SB(1, 1), b3 + hstepB, voffB); PG8_STAGE(PG8_SA(1, 0), a3, voffA);
            PG8_WAIT_V(8); PG8_WAIT_L(0); PG8_BAR; PG8_MMA(1, 0, At, B0); PG8_MMA(1, 1, At, B1); PG8_BAR; PG8_SCHED;
        }
        if (wr == 0) PG8_BAR;
        E(acc, cur, wr, wc, fr, fq);
        if (!has_next) break;
#pragma unroll
        for (int a = 0; a < 2; ++a)
#pragma unroll
            for (int b = 0; b < 2; ++b)
#pragma unroll
                for (int m = 0; m < 4; ++m)
#pragma unroll
                    for (int n = 0; n < 2; ++n) acc[a][b][m][n] = (f32x4){0.f, 0.f, 0.f, 0.f};
        cur = nxt; cA = nA; cB = nB; ++ui;
        if (wr == 1) PG8_BAR;
    }
    PG8_WAIT_V(0);
    PG8_BAR;
#undef PG8_SA
#undef PG8_SB
#undef PG8_STAGE
#undef PG8_LDA
#undef PG8_LDB
#undef PG8_MMA
#undef PG8_WAIT_V
#undef PG8_WAIT_L
#undef PG8_BAR
#undef PG8_SCHED
}
}

#ifndef EN
#define EN 0xFFFF
#endif
#define ON(b) ((EN >> (b)) & 1)
#ifndef REP
#define REP 0
#endif
#ifndef SCANMODE
#define SCANMODE 0
#endif
#define RB(b) ((REP >> (b)) & 1)
#define REPLOOP(b) int nrep##b = 1 + RB(b); asm volatile("" : "+s"(nrep##b)); for (int q = 0; q < nrep##b; ++q)
constexpr int T = 16384, TH = 8192, SEQ = 2048, DM = 1024, DIN = 6304, NP = 3328, DFF = 2816;
constexpr int LDS_BYTES = 147456, QIDX_OFF = 140000;
constexpr size_t MiB = 1u << 20;
constexpr size_t WS_CTL = 0;
constexpr size_t WS_WT = 1 * MiB;
constexpr size_t W_IN = WS_WT, W_GATE = W_IN + (size_t)NP * 1024 * 2, W_BR = W_GATE + (size_t)3072 * 1024 * 2, W_OUT = W_BR + (size_t)3 * 1024 * 512 * 2,
                 W_MQ = W_OUT + (size_t)1024 * 1024 * 2, W_MKV = W_MQ + (size_t)768 * 256 * 2, W_XQ = W_MKV + (size_t)1024 * 128 * 2, W_XKV = W_XQ + (size_t)512 * 1024 * 2,
                 W_XO = W_XKV + (size_t)1024 * 1024 * 2, W_13 = W_XO + (size_t)1024 * 512 * 2, W_2 = W_13 + (size_t)5632 * 1024 * 2, W_BWA = W_2 + (size_t)1024 * 2816 * 2, W_GUP = W_BWA + (size_t)1024 * 128 * 2, W_END = W_GUP + (size_t)512 * 128 * 2;
static_assert(W_END <= 40 * MiB, "weights");
constexpr size_t WS_XB = 40 * MiB, WS_PART = 72 * MiB, WS_PQ = 73 * MiB, WS_PKV = WS_PQ + 256 * 1024, WS_Y = 74 * MiB, WS_R = 122 * MiB;
constexpr size_t R_P = WS_R, R_SI = WS_R + 52 * MiB, R_Q = WS_R + 100 * MiB, R_KM = WS_R + 112 * MiB, R_VT = WS_R + 124 * MiB;
constexpr size_t R_GS = WS_R, R_MS = WS_R + 32 * MiB, R_MG = WS_R + 96 * MiB, R_MEMB = WS_R + 128 * MiB;
constexpr size_t R_MK = WS_R, R_MVT = WS_R + 2 * MiB, R_XQ = WS_R + 32 * MiB, R_XO = WS_R + 48 * MiB, R_H = WS_R;
constexpr size_t WS_AG = WS_R + 132 * MiB;
constexpr size_t WS_END = WS_AG + 2 * MiB;
static_assert(WS_END <= 256 * MiB, "ws");

struct Params { const float* in[43]; float* out; unsigned char* ws; };
typedef const __attribute__((address_space(4))) Params* KP;
enum { I_X = 0, I_MEM, I_POS, I_NMIX, I_NXA, I_NMEM, I_NFFN, I_WIN, I_BGATE, I_MU, I_W0, I_WUP, I_A0, I_AUP, I_GUP, I_KK, I_KA, I_RK, I_LNG, I_LNB,
       I_CW, I_CB, I_WA, I_BA, I_WX, I_BX, I_LAM, I_QN, I_WUQ, I_KVN, I_WUKV, I_QG, I_KG, I_WBR, I_WOUT, I_XWQ, I_XWKV, I_XQG, I_XKG, I_XWO, I_W1, I_W3, I_W2 };

__device__ __forceinline__ float rstd16(const float* part, int row) {
    const f32x4* p = (const f32x4*)(part + (size_t)row * 16); const f32x4 a = p[0], b = p[1], c = p[2], d = p[3];
    const float s = ((a.x + a.y) + (a.z + a.w)) + ((b.x + b.y) + (b.z + b.w)) + ((c.x + c.y) + (c.z + c.w)) + ((d.x + d.y) + (d.z + d.w));
    return rsqrtf(s * (1.f / 1024.f) + 1e-6f);
}
__device__ __forceinline__ float rstd4(const float* pp, int row, float invn) { const f32x4 a = *(const f32x4*)(pp + (size_t)row * 4); return rsqrtf(((a.x + a.y) + (a.z + a.w)) * invn + 1e-6f); }
__device__ __forceinline__ float sumsq8(f32x4 a, f32x4 b) { return (a.x * a.x + a.y * a.y) + (a.z * a.z + a.w * a.w) + (b.x * b.x + b.y * b.y) + (b.z * b.z + b.w * b.w); }
#define EPI_HEAD static constexpr bool PERM = true; \
    __device__ __forceinline__ void operator()(const f32x4 (&acc)[2][2][4][2], const pg8::Unit& u, int wr, int wc, int fr, int fq) const
#define EPI_ROWS _Pragma("unroll") for (int ai = 0; ai < 2; ++ai) _Pragma("unroll") for (int m = 0; m < 4; ++m) if ((__builtin_amdgcn_sched_barrier(0), true))
#define EPI_ROW (u.pm * 256 + ai * 128 + wr * 64 + m * 16 + fr)

struct EpiP {
    bf16* P; const float* part; float* pq; float* pkv;
    EPI_HEAD {
        const int col0 = u.pn * 256 + wc * 32 + 8 * fq;
        EPI_ROWS { const int row = EPI_ROW; const float rs = rstd16(part, row); float ss = 0.f;
#pragma unroll
            for (int bj = 0; bj < 2; ++bj) { const f32x4 v0 = acc[ai][bj][m][0] * rs, v1 = acc[ai][bj][m][1] * rs;
                *(u32x4*)(P + (size_t)row * NP + col0 + bj * 128) = pk8(v0, v1);
                if (u.pn == 11 || bj == 0) ss += sumsq8(v0, v1); }
            if (u.pn == 11 || u.pn == 12) { ss += __shfl_xor(ss, 16); ss += __shfl_xor(ss, 32); if (fq == 0) (u.pn == 11 ? pq : pkv)[(size_t)row * 4 + wc] = ss; } }
    }
};
struct EpiQ {
    bf16* Q; const float* pq;
    EPI_HEAD {
        const int col0 = u.pn * 256 + wc * 32 + 8 * fq;
        EPI_ROWS { const int row = EPI_ROW; const float rs = rstd4(pq, row, 1.f / 256.f);
#pragma unroll
            for (int bj = 0; bj < 2; ++bj) *(u32x4*)(Q + (size_t)row * 768 + col0 + bj * 128) = pk8(acc[ai][bj][m][0] * rs, acc[ai][bj][m][1] * rs); }
    }
};
struct EpiKV {
    bf16* Km; bf16* Vt; const float* pkv;
    EPI_HEAD {
        const int j0 = wc * 32 + 8 * fq;
        EPI_ROWS { const int row = EPI_ROW; const float rs = rstd4(pkv, row, 1.f / 128.f);
#pragma unroll
            for (int bj = 0; bj < 2; ++bj) { const int h = 2 * u.pn + bj; const f32x4 v0 = acc[ai][bj][m][0] * rs, v1 = acc[ai][bj][m][1] * rs;
                if (wc < 2) *(u32x4*)(Km + (size_t)row * 768 + h * 96 + j0) = pk8(v0, v1);
                else { const int bl = row >> 11, t = row & 2047; bf16* vp = Vt + ((size_t)(bl * 8 + h) * 64 + (j0 - 64)) * 2048 + t;
                    vp[0 * 2048] = (bf16)f2bf(v0.x); vp[1 * 2048] = (bf16)f2bf(v0.y); vp[2 * 2048] = (bf16)f2bf(v0.z); vp[3 * 2048] = (bf16)f2bf(v0.w);
                    vp[4 * 2048] = (bf16)f2bf(v1.x); vp[5 * 2048] = (bf16)f2bf(v1.y); vp[6 * 2048] = (bf16)f2bf(v1.z); vp[7 * 2048] = (bf16)f2bf(v1.w); } } }
    }
};
struct EpiGate {
    bf16* GS; const float* part; const float* bg;
    EPI_HEAD {
        const int col0 = u.pn * 256 + wc * 32 + 8 * fq;
        f32x4 b0[2], b1[2];
#pragma unroll
        for (int bj = 0; bj < 2; ++bj) { b0[bj] = *(const f32x4*)(bg + col0 + bj * 128); b1[bj] = *(const f32x4*)(bg + col0 + bj * 128 + 4); }
        EPI_ROWS { const int row = EPI_ROW; const float rs = rstd16(part, row);
#pragma unroll
            for (int bj = 0; bj < 2; ++bj) { f32x4 v0 = acc[ai][bj][m][0] * rs + b0[bj], v1 = acc[ai][bj][m][1] * rs + b1[bj];
#pragma unroll
                for (int e = 0; e < 4; ++e) { v0[e] = fsig(v0[e]); v1[e] = fsig(v1[e]); }
                *(u32x4*)(GS + (size_t)row * 1024 + col0 + bj * 128) = pk8(v0, v1); } }
    }
};
struct EpiProj {
    const bf16* GS; float* MS; bf16* MG; int n;
    EPI_HEAD {
        const int col0 = u.pn * 256 + wc * 32 + 8 * fq;
        EPI_ROWS { const int row = EPI_ROW;
#pragma unroll
            for (int bj = 0; bj < 2; ++bj) { const size_t o = (size_t)row * 1024 + col0 + bj * 128; const u32x4 gw = *(const u32x4*)(GS + o);
                f32x4 v0 = acc[ai][bj][m][0], v1 = acc[ai][bj][m][1];
                v0.x *= bflo(gw.x); v0.y *= bfhi(gw.x); v0.z *= bflo(gw.y); v0.w *= bfhi(gw.y); v1.x *= bflo(gw.z); v1.y *= bfhi(gw.z); v1.z *= bflo(gw.w); v1.w *= bfhi(gw.w);
                if (n > 0) { v0 += *(const f32x4*)(MS + o); v1 += *(const f32x4*)(MS + o + 4); }
                if (n < 2) { *(f32x4*)(MS + o) = v0; *(f32x4*)(MS + o + 4) = v1; } else *(u32x4*)(MG + o) = pk8(v0, v1); } }
    }
};
struct EpiRes {
    const float* xold; float* xout; bf16* xb; float* part; int nowrite = 0;
    EPI_HEAD {
        const int col0 = u.pn * 256 + wc * 32 + 8 * fq;
        EPI_ROWS { const int row = EPI_ROW; float ss = 0.f;
#pragma unroll
            for (int bj = 0; bj < 2; ++bj) { const size_t o = (size_t)row * 1024 + col0 + bj * 128;
                const f32x4 v0 = acc[ai][bj][m][0] + *(const f32x4*)(xold + o), v1 = acc[ai][bj][m][1] + *(const f32x4*)(xold + o + 4);
                if (!nowrite) { *(f32x4*)(xout + o) = v0; *(f32x4*)(xout + o + 4) = v1; *(u32x4*)(xb + o) = pk8(v0, v1); } ss += sumsq8(v0, v1); }
            ss += __shfl_xor(ss, 16); ss += __shfl_xor(ss, 32); if (fq == 0 && !nowrite) part[(size_t)row * 16 + u.pn * 4 + wc] = ss; }
    }
};
struct EpiXQ {
    bf16* Q; const float* part;
    EPI_HEAD {
        const int col0 = u.pn * 256 + wc * 32 + 8 * fq;
        EPI_ROWS { const int row = EPI_ROW; const float rs = rstd16(part, row);
#pragma unroll
            for (int bj = 0; bj < 2; ++bj) *(u32x4*)(Q + (size_t)row * 512 + col0 + bj * 128) = pk8(acc[ai][bj][m][0] * rs, acc[ai][bj][m][1] * rs); }
    }
};
struct EpiBf {
    bf16* O; int ld;
    EPI_HEAD {
        const int col0 = u.pn * 256 + wc * 32 + 8 * fq;
        EPI_ROWS { const int row = EPI_ROW;
#pragma unroll
            for (int bj = 0; bj < 2; ++bj) *(u32x4*)(O + (size_t)row * ld + col0 + bj * 128) = pk8(acc[ai][bj][m][0], acc[ai][bj][m][1]); }
    }
};
struct EpiMemKV {
    bf16* mk; bf16* mVt;
    EPI_HEAD {
        const int j0 = wc * 32 + 8 * fq, h = u.pn;
        EPI_ROWS { const int row = EPI_ROW;
            *(u32x4*)(mk + (size_t)row * 512 + h * 128 + j0) = pk8(acc[ai][0][m][0], acc[ai][0][m][1]);
            const f32x4 v0 = acc[ai][1][m][0], v1 = acc[ai][1][m][1]; const int b = row >> 8, key = row & 255;
            bf16* vp = mVt + ((size_t)(b * 4 + h) * 128 + j0) * 256 + key;
            vp[0 * 256] = (bf16)f2bf(v0.x); vp[1 * 256] = (bf16)f2bf(v0.y); vp[2 * 256] = (bf16)f2bf(v0.z); vp[3 * 256] = (bf16)f2bf(v0.w);
            vp[4 * 256] = (bf16)f2bf(v1.x); vp[5 * 256] = (bf16)f2bf(v1.y); vp[6 * 256] = (bf16)f2bf(v1.z); vp[7 * 256] = (bf16)f2bf(v1.w); }
    }
};
struct EpiFFN1 {
    bf16* H; const float* part;
    EPI_HEAD {
        const int hc0 = (u.pn * 256 + wc * 32 + 8 * fq) >> 1;
        EPI_ROWS { const int row = EPI_ROW; const float rs = rstd16(part, row);
#pragma unroll
            for (int bj = 0; bj < 2; ++bj) { const f32x4 a1 = acc[ai][bj][m][0] * rs, a3 = acc[ai][bj][m][1] * rs; f32x4 hv;
#pragma unroll
                for (int e = 0; e < 4; ++e) hv[e] = a1[e] * fsig(a1[e]) * a3[e];
                u32x2 w; w.x = pk2(hv.x, hv.y); w.y = pk2(hv.z, hv.w);
                *(u32x2*)(H + (size_t)row * DFF + hc0 + bj * 64) = w; } }
    }
};

__device__ __forceinline__ void conv_job(const float* W, int ldw, int c0, int ncols, int kblk, const float* gain, bf16* WT, int K, int mode, float* scr, int gw, int NGW, int lane, int& off) {
    const int nblk = (ncols + 63) >> 6, nitems = nblk * kblk;
    int it0 = (gw - off) % NGW; if (it0 < 0) it0 += NGW;
    off = (off + nitems) % NGW;
    const int kq = lane >> 4, nq = lane & 15;
    for (int it = it0; it < nitems; it += NGW) {
        const int kb = it / nblk, nb = it % nblk, k0 = 64 * kb, n0 = 64 * nb;
        const bool ld_ok = (n0 + 4 * nq) < ncols;
        f32x4 v[16];
#pragma unroll
        for (int i = 0; i < 16; ++i) { v[i] = (f32x4){0.f, 0.f, 0.f, 0.f}; if (ld_ok) v[i] = *(const f32x4*)(W + (size_t)(k0 + 4 * i + kq) * ldw + c0 + n0 + 4 * nq); }
#pragma unroll
        for (int i = 0; i < 16; ++i) { const int kk = 4 * i + kq; const float gg = gain ? gain[k0 + kk] : 1.f; float* d = scr + kk * 65 + 4 * nq;
            d[0] = v[i].x * gg; d[1] = v[i].y * gg; d[2] = v[i].z * gg; d[3] = v[i].w * gg; }
        __builtin_amdgcn_wave_barrier(); asm volatile("s_waitcnt lgkmcnt(0)" ::: "memory");
        const int c = lane & 7;
#pragma unroll
        for (int jx = 0; jx < 8; ++jx) { const int nl = (lane >> 3) + 8 * jx, n = n0 + nl; const float* sp = scr + (8 * c) * 65 + nl;
            u32x4 o; o.x = pk2(sp[0 * 65], sp[1 * 65]); o.y = pk2(sp[2 * 65], sp[3 * 65]); o.z = pk2(sp[4 * 65], sp[5 * 65]); o.w = pk2(sp[6 * 65], sp[7 * 65]);
            const int dr = mode == 0 ? n : (8 * (n >> 2) + (n & 3) + (mode == 2 ? 4 : 0));
            if (n < ncols) *(u32x4*)(WT + (size_t)dr * K + k0 + 8 * c) = o; }
        __builtin_amdgcn_wave_barrier(); asm volatile("s_waitcnt lgkmcnt(0)" ::: "memory");
    }
}

__device__ __forceinline__ void phase_convert(int wid_s, KP p_, int l, float* ldsf) {
    KP p = p_; asm volatile("" : "+s"(p));
    unsigned char* ws = p->ws;
    const int tid_ = mk_tid(wid_s);
    const int tid = tid_, lane = tid & 63, wv = tid >> 6;
    const int gw = blockIdx.x * 8 + wv, NGW = gridDim.x * 8;
    float* scr = ldsf + wv * (64 * 65); int off = 0;
    const float* nmix = p->in[I_NMIX] + l * 1024;
    conv_job(p->in[I_WIN] + (size_t)l * 1024 * DIN, DIN, 0, 3232, 16, nmix, (bf16*)(ws + W_IN), 1024, 0, scr, gw, NGW, lane, off);
    conv_job(p->in[I_WIN] + (size_t)l * 1024 * DIN, DIN, 3232, 3072, 16, nmix, (bf16*)(ws + W_GATE), 1024, 0, scr, gw, NGW, lane, off);
    for (int n = 0; n < 3; ++n) conv_job(p->in[I_WBR] + ((size_t)l * 3 + n) * 512 * 1024, 1024, 0, 1024, 8, nullptr, (bf16*)(ws + W_BR) + (size_t)n * 1024 * 512, 512, 0, scr, gw, NGW, lane, off);
    conv_job(p->in[I_WOUT] + (size_t)l * 1024 * 1024, 1024, 0, 1024, 16, nullptr, (bf16*)(ws + W_OUT), 1024, 0, scr, gw, NGW, lane, off);
    conv_job(p->in[I_WUQ] + (size_t)l * 256 * 768, 768, 0, 768, 4, p->in[I_QN] + l * 256, (bf16*)(ws + W_MQ), 256, 0, scr, gw, NGW, lane, off);
    conv_job(p->in[I_WUKV] + (size_t)l * 128 * 1024, 1024, 0, 1024, 2, p->in[I_KVN] + l * 128, (bf16*)(ws + W_MKV), 128, 0, scr, gw, NGW, lane, off);
    conv_job(p->in[I_XWQ] + (size_t)l * 1024 * 512, 512, 0, 512, 16, p->in[I_NXA] + l * 1024, (bf16*)(ws + W_XQ), 1024, 0, scr, gw, NGW, lane, off);
    conv_job(p->in[I_XWKV] + (size_t)l * 1024 * 1024, 1024, 0, 1024, 16, p->in[I_NMEM] + l * 1024, (bf16*)(ws + W_XKV), 1024, 0, scr, gw, NGW, lane, off);
    conv_job(p->in[I_XWO] + (size_t)l * 512 * 1024, 1024, 0, 1024, 8, nullptr, (bf16*)(ws + W_XO), 512, 0, scr, gw, NGW, lane, off);
    conv_job(p->in[I_W1] + (size_t)l * 1024 * DFF, DFF, 0, 2816, 16, p->in[I_NFFN] + l * 1024, (bf16*)(ws + W_13), 1024, 1, scr, gw, NGW, lane, off);
    conv_job(p->in[I_W3] + (size_t)l * 1024 * DFF, DFF, 0, 2816, 16, p->in[I_NFFN] + l * 1024, (bf16*)(ws + W_13), 1024, 2, scr, gw, NGW, lane, off);
    conv_job(p->in[I_W2] + (size_t)l * DFF * 1024, 1024, 0, 1024, 44, nullptr, (bf16*)(ws + W_2), DFF, 0, scr, gw, NGW, lane, off);
    conv_job(p->in[I_WUP] + (size_t)l * 64 * 512, 512, 0, 512, 1, nullptr, (bf16*)(ws + W_BWA), 128, 0, scr, gw, NGW, lane, off);
    conv_job(p->in[I_AUP] + (size_t)l * 64 * 512, 512, 0, 512, 1, nullptr, (bf16*)(ws + W_BWA) + 512 * 128 + 64, 128, 0, scr, gw, NGW, lane, off);
    conv_job(p->in[I_GUP] + (size_t)l * 128 * 512, 512, 0, 512, 2, nullptr, (bf16*)(ws + W_GUP), 128, 0, scr, gw, NGW, lane, off);
    { unsigned zz = 0u; asm volatile("" : "+v"(zz)); const u32x4 zv = {zz, zz, zz, zz};
      for (int i = blockIdx.x * 512 + tid; i < 1024 * 8; i += gridDim.x * 512) { const int row = i >> 3, ch = i & 7; *(u32x4*)((bf16*)(ws + W_BWA) + row * 128 + (row < 512 ? 64 : 0) + ch * 8) = zv; } }
    { u32x4* z = (u32x4*)((bf16*)(ws + W_IN) + (size_t)3232 * 1024); const int n16 = 96 * 1024 * 2 / 16;
      unsigned zz = 0u; asm volatile("" : "+v"(zz)); const u32x4 zv = {zz, zz, zz, zz};
      for (int i = blockIdx.x * 512 + tid; i < n16; i += gridDim.x * 512) z[i] = zv; }
    if (l == 0) {
        const float* x = p->in[I_X]; bf16* xb = (bf16*)(ws + WS_XB); float* part = (float*)(ws + WS_PART);
        for (int row = gw; row < T; row += NGW) {
            const f32x4* xr = (const f32x4*)(x + (size_t)row * 1024) + lane; float s = 0.f;
#pragma unroll
            for (int j = 0; j < 4; ++j) { const f32x4 v = xr[64 * j]; s += (v.x * v.x + v.y * v.y) + (v.z * v.z + v.w * v.w);
                u32x2 w; w.x = pk2(v.x, v.y); w.y = pk2(v.z, v.w); *((u32x2*)(xb + (size_t)row * 1024) + lane + 64 * j) = w; }
            s = wave_sum(s);
            if (lane < 16) part[(size_t)row * 16 + lane] = lane == 0 ? s : 0.f;
        }
    }
}

__device__ __forceinline__ void rope_cs(int pos, int i, float& c, float& s) {
    const float invf = exp2f(-(float)i * 0.8304820237218406f);
    const float ang = (float)pos * invf;
    const double x = (double)ang * 0.15915494309189535; const float f = (float)(x - rint(x));
    c = __builtin_amdgcn_cosf(f); s = __builtin_amdgcn_sinf(f);
}
template <int DQK, int DV, bool CAUSAL, bool MLA>
__device__ __forceinline__ void attn_unit(int wid_s, unsigned char* lds, const bf16* Qb_, int ldq, const bf16* Kb_, int ldk, const bf16* Vtb_, int ldv, bf16* Ob_, int ldo,
                                          int q0, int nkt, const float* qgain_, const int* pos_, float qscale) {
    const GAS bf16* Qb = (const GAS bf16*)Qb_; const GAS bf16* Kb = (const GAS bf16*)Kb_; const GAS bf16* Vtb = (const GAS bf16*)Vtb_; GAS bf16* Ob = (GAS bf16*)Ob_;
    const GAS float* qgain = (const GAS float*)qgain_; const GAS int* pos = (const GAS int*)pos_;
    constexpr int KS = DQK * 2 + 16, VS = 144, NKS = DQK / 32, NDT = DV / 16, KCH = DQK / 8, NKC = (64 * KCH + 511) / 512, NVC = DV * 8 / 512;
    unsigned char* Ks = lds; unsigned char* Vs = lds + 64 * KS;
    const int tid_ = mk_tid(wid_s);
    const int tid = tid_, lane = tid & 63, wv = tid >> 6, g = lane >> 4, j = lane & 15;
    const int qrow = q0 + wv * 16 + j;
    bf16x8 qf[NKS];
    {
        float qv[NKS][8]; float ss = 0.f;
#pragma unroll
        for (int ks = 0; ks < NKS; ++ks) { const u32x4 w = *(const GAS u32x4*)(Qb + (size_t)qrow * ldq + 32 * ks + 8 * g);
            qv[ks][0] = bflo(w.x); qv[ks][1] = bfhi(w.x); qv[ks][2] = bflo(w.y); qv[ks][3] = bfhi(w.y); qv[ks][4] = bflo(w.z); qv[ks][5] = bfhi(w.z); qv[ks][6] = bflo(w.w); qv[ks][7] = bfhi(w.w);
#pragma unroll
            for (int e = 0; e < 8; ++e) ss += qv[ks][e] * qv[ks][e]; }
        ss += __shfl_xor(ss, 16); ss += __shfl_xor(ss, 32);
        const float rs = rsqrtf(ss * (1.f / DQK) + 1e-6f);
#pragma unroll
        for (int ks = 0; ks < NKS; ++ks)
#pragma unroll
            for (int e = 0; e < 8; ++e) qv[ks][e] *= rs * qgain[32 * ks + 8 * g + e];
        if (MLA) {
            const int ps = pos[qrow];
#pragma unroll
            for (int e = 0; e < 8; ++e) { const float mine = qv[2][e], other = __shfl_xor(mine, 32); float c, s; rope_cs(ps, 8 * (g & 1) + e, c, s);
                qv[2][e] = (g < 2) ? (mine * c - other * s) : (mine * c + other * s); }
        }
#pragma unroll
        for (int ks = 0; ks < NKS; ++ks) { u32x4 w; w.x = pk2(qv[ks][0] * qscale, qv[ks][1] * qscale); w.y = pk2(qv[ks][2] * qscale, qv[ks][3] * qscale);
            w.z = pk2(qv[ks][4] * qscale, qv[ks][5] * qscale); w.w = pk2(qv[ks][6] * qscale, qv[ks][7] * qscale); qf[ks] = __builtin_bit_cast(bf16x8, w); }
    }
    f32x4 oT[NDT];
#pragma unroll
    for (int d = 0; d < NDT; ++d) oT[d] = (f32x4){0.f, 0.f, 0.f, 0.f};
    float mrun = -INFINITY, lsum = 0.f;
    u32x4 kreg[NKC], vreg[NVC];
#define ATT_PREFETCH(kt) do { _Pragma("unroll") for (int i = 0; i < NKC; ++i) { const int idx = tid + 512 * i; if (idx < 64 * KCH) { const int key = idx / KCH, ch = idx % KCH; \
            kreg[i] = *(const GAS u32x4*)(Kb + (size_t)(64 * (kt) + key) * ldk + ch * 8); } } \
        _Pragma("unroll") for (int i = 0; i < NVC; ++i) { const int idx = tid + 512 * i; const int dv = idx >> 3, ch = idx & 7; vreg[i] = *(const GAS u32x4*)(Vtb + (size_t)dv * ldv + 64 * (kt) + ch * 8); } } while (0)
    ATT_PREFETCH(0);
    for (int kt = 0; kt < nkt; ++kt) {
        LBAR();
#pragma unroll
        for (int i = 0; i < NKC; ++i) { const int idx = tid + 512 * i; if (idx < 64 * KCH) { const int key = idx / KCH, ch = idx % KCH; *(u32x4*)(Ks + key * KS + ch * 16) = kreg[i]; } }
#pragma unroll
        for (int i = 0; i < NVC; ++i) { const int idx = tid + 512 * i; const int dv = idx >> 3, ch = idx & 7; *(u32x4*)(Vs + dv * VS + ch * 16) = vreg[i]; }
        LBAR();
        if (kt + 1 < nkt) ATT_PREFETCH(kt + 1);
        const int qw0 = q0 + wv * 16;
        if (CAUSAL && 64 * kt > qw0 + 15) continue;
        f32x4 sT[4];
#pragma unroll
        for (int k4 = 0; k4 < 4; ++k4) { sT[k4] = (f32x4){0.f, 0.f, 0.f, 0.f};
#pragma unroll
            for (int ks = 0; ks < NKS; ++ks) { const bf16x8 a = *(const bf16x8*)(Ks + (16 * k4 + j) * KS + (32 * ks + 8 * g) * 2);
                sT[k4] = __builtin_amdgcn_mfma_f32_16x16x32_bf16(a, qf[ks], sT[k4], 0, 0, 0); } }
        if (CAUSAL && 64 * kt + 63 > qw0) {
#pragma unroll
            for (int k4 = 0; k4 < 4; ++k4)
#pragma unroll
                for (int r = 0; r < 4; ++r) if (64 * kt + 16 * k4 + 4 * g + r > qrow) sT[k4][r] = -INFINITY;
        }
        float mx = -INFINITY;
#pragma unroll
        for (int k4 = 0; k4 < 4; ++k4) mx = fmaxf(mx, fmaxf(fmaxf(sT[k4][0], sT[k4][1]), fmaxf(sT[k4][2], sT[k4][3])));
        mx = fmaxf(mx, __shfl_xor(mx, 16)); mx = fmaxf(mx, __shfl_xor(mx, 32));
        const float mnew = fmaxf(mrun, mx); const float alpha = __builtin_amdgcn_exp2f(mrun - mnew); mrun = mnew;
        float psum = 0.f;
#pragma unroll
        for (int k4 = 0; k4 < 4; ++k4)
#pragma unroll
            for (int r = 0; r < 4; ++r) { const float pv = __builtin_amdgcn_exp2f(sT[k4][r] - mnew); sT[k4][r] = pv; psum += pv; }
        lsum = lsum * alpha + psum;
#pragma unroll
        for (int d = 0; d < NDT; ++d) oT[d] *= alpha;
#pragma unroll
        for (int kc = 0; kc < 2; ++kc) {
            const bf16x8 pb = __builtin_bit_cast(bf16x8, pk8(sT[2 * kc], sT[2 * kc + 1]));
#pragma unroll
            for (int d = 0; d < NDT; ++d) { const unsigned char* vp = Vs + (16 * d + j) * VS + (32 * kc + 4 * g) * 2;
                const u32x2 lo = *(const u32x2*)vp, hi = *(const u32x2*)(vp + 32); u32x4 w; w.x = lo.x; w.y = lo.y; w.z = hi.x; w.w = hi.y;
                oT[d] = __builtin_amdgcn_mfma_f32_16x16x32_bf16(__builtin_bit_cast(bf16x8, w), pb, oT[d], 0, 0, 0); }
        }
    }
#undef ATT_PREFETCH
    lsum += __shfl_xor(lsum, 16); lsum += __shfl_xor(lsum, 32);
    const float inv = 1.f / lsum;
#pragma unroll
    for (int d = 0; d < NDT; ++d) { u32x2 w; w.x = pk2(oT[d][0] * inv, oT[d][1] * inv); w.y = pk2(oT[d][2] * inv, oT[d][3] * inv);
        *(GAS u32x2*)(Ob + (size_t)qrow * ldo + 16 * d + 4 * g) = w; }
}

__device__ __forceinline__ void lora_act_rows(int wid_s, KP p_, int l, int r) {
    KP p = p_; asm volatile("" : "+s"(p));
    unsigned char* ws = p->ws;
    const int tid_ = mk_tid(wid_s);
    const int tid = tid_;
    const bf16* P = (const bf16*)(ws + R_P); bf16* Awa = (bf16*)(ws + WS_Y) + (size_t)r * TH * 1536 + 1024; bf16* Ag = (bf16*)(ws + WS_AG);
    const float* mu = p->in[I_MU] + l * 1792 + 1536;
    const int sub = tid & 31, j0 = sub * 8;
    f32x4 m0 = *(const f32x4*)(mu + j0), m1 = *(const f32x4*)(mu + j0 + 4);
    for (int row = blockIdx.x * 16 + (tid >> 5); row < TH; row += gridDim.x * 16) {
        const u32x4 cw = *(const u32x4*)(P + (size_t)row * NP + 1536 + j0);
        u32x4 pw = {0u, 0u, 0u, 0u}; if ((row & 2047) != 0) pw = *(const u32x4*)(P + (size_t)(row - 1) * NP + 1536 + j0);
        float c[8] = {bflo(cw.x), bfhi(cw.x), bflo(cw.y), bfhi(cw.y), bflo(cw.z), bfhi(cw.z), bflo(cw.w), bfhi(cw.w)};
        const float q[8] = {bflo(pw.x), bfhi(pw.x), bflo(pw.y), bfhi(pw.y), bflo(pw.z), bfhi(pw.z), bflo(pw.w), bfhi(pw.w)};
        const float mm[8] = {m0.x, m0.y, m0.z, m0.w, m1.x, m1.y, m1.z, m1.w};
#pragma unroll
        for (int e = 0; e < 8; ++e) { float v = c[e] + (q[e] - c[e]) * mm[e];
            if (j0 < 64) v = 2.f * fsig(2.f * v) - 1.f;
            else if (j0 >= 128) v = fsig(v);
            c[e] = v; }
        u32x4 o; o.x = pk2(c[0], c[1]); o.y = pk2(c[2], c[3]); o.z = pk2(c[4], c[5]); o.w = pk2(c[6], c[7]);
        if (j0 < 128) *(u32x4*)(Awa + (size_t)row * 1536 + j0) = o; else *(u32x4*)(Ag + (size_t)row * 128 + (j0 - 128)) = o;
    }
}
__device__ __forceinline__ void si_build_tile(int wid_s, KP p_, int l, int r, int tile) {
    KP p = p_; asm volatile("" : "+s"(p));
    unsigned char* ws = p->ws;
    const int tid_ = mk_tid(wid_s);
    const int tid = tid_, lane = tid & 63, wv = tid >> 6;
    const GAS bf16* P = (const GAS bf16*)(ws + R_P); GAS bf16* SI = (GAS bf16*)(ws + R_SI); const GAS bf16* LW = (const GAS bf16*)(ws + WS_Y) + (size_t)r * TH * 1536;
    const float* mu = p->in[I_MU] + l * 1792;
    const int row0 = tile * 32;
    const int c = tid, h = wv;
    const float w0c = p->in[I_W0][l * 512 + c], a0c = p->in[I_A0][l * 512 + c], kkc = p->in[I_KK][l * 512 + c], kac = p->in[I_KA][l * 512 + c];
    const float mur = mu[c], muk = mu[512 + c], muv = mu[1024 + c];
#pragma unroll 4
    for (int t = 0; t < 32; ++t) {
        const int row = row0 + t; const bool first = (row & 2047) == 0;
        const GAS bf16* pr = P + (size_t)row * NP; const GAS bf16* pp = pr - NP;
        const float rc = bf2f(pr[c]), kc = bf2f(pr[512 + c]), vc = bf2f(pr[1024 + c]);
        const float rp = first ? 0.f : bf2f(pp[c]), kp = first ? 0.f : bf2f(pp[512 + c]), vp = first ? 0.f : bf2f(pp[1024 + c]);
        const float wl = bf2f(LW[(size_t)row * 1536 + c]), al = bf2f(LW[(size_t)row * 1536 + 512 + c]);
        const float rr = rc + (rp - rc) * mur, k = kc + (kp - kc) * muk, v = vc + (vp - vc) * muv;
        const float om = 1.f - __expf(-0.6065306597126334f * fsig(w0c + wl));
        const float a = fsig(a0c + al);
        const float kkr = k * kkc; const float ss = wave_sum(kkr * kkr); const float kk = kkr / fmaxf(sqrtf(ss), 1e-12f);
        const float k2 = k * (1.f + (a - 1.f) * kac);
        GAS bf16* o = SI + ((size_t)((row >> 11) * 8 + h) * 2048 + (row & 2047)) * 384 + lane;
        o[0] = (bf16)f2bf(rr); o[64] = (bf16)f2bf(om); o[128] = (bf16)f2bf(k2); o[192] = (bf16)f2bf(kk); o[256] = (bf16)f2bf(kk * a); o[320] = (bf16)f2bf(v);
    }
}

template <int CTRL> __device__ __forceinline__ float dppf(float x) { return __builtin_bit_cast(float, __builtin_amdgcn_update_dpp(0, __builtin_bit_cast(int, x), CTRL, 0xF, 0xF, true)); }
__device__ __forceinline__ float allreduce16(float x) { x += dppf<0xB1>(x); x += dppf<0x4E>(x); x += dppf<0x141>(x); x += dppf<0x140>(x); return x; }
template <int MODE>
__device__ __forceinline__ void rwkv_scan_unit(int wid_s, const bf16* SIbh_, bf16* Yb_, int ystride, int quarter, float* ldsf) {
    const int tid_ = mk_tid(wid_s);
    const GAS bf16* SIbh = (const GAS bf16*)SIbh_; GAS bf16* Yb = (GAS bf16*)Yb_;
    const int tid = tid_, lane = tid & 63, wv = tid >> 6, hw = wv - 4;
    float* PYb = ldsf + 4 * (16 * 384);
    u32x4 hreg[12];
    if (wv >= 4 && wv < 7) {
#pragma unroll
        for (int i = 0; i < 12; ++i) hreg[i] = *(const GAS u32x4*)(SIbh + (size_t)hw * (16 * 384) + (size_t)(lane + 64 * i) * 8);
    }
    f32x2 Sa = {0.f, 0.f}, Sb = {0.f, 0.f};
    const int rowl = quarter * 16 + (wv & 3) * 4 + (lane >> 4), c4 = (lane & 15) * 4;
    __syncthreads();
#define SCAN_CONVERT(cn) do { float* Bd = ldsf + ((cn) & 3) * (16 * 384); \
        _Pragma("unroll") for (int i = 0; i < 12; ++i) { float* d = Bd + (lane + 64 * i) * 8; const u32x4 w = hreg[i]; \
            *(f32x4*)d = (f32x4){bflo(w.x), bfhi(w.x), bflo(w.y), bfhi(w.y)}; *(f32x4*)(d + 4) = (f32x4){bflo(w.z), bfhi(w.z), bflo(w.w), bfhi(w.w)}; } \
        if ((cn) + 3 < 128) { _Pragma("unroll") for (int i = 0; i < 12; ++i) hreg[i] = *(const GAS u32x4*)(SIbh + (size_t)((cn) + 3) * (16 * 384) + (size_t)(lane + 64 * i) * 8); } } while (0)
    if (wv == 4) SCAN_CONVERT(0);
    for (int ch = 0; ch <= 128; ++ch) {
        LBAR();
        if (wv < 4) {
            if (ch < 128) {
                const float* B = ldsf + (ch & 3) * (16 * 384);
                float* PY = PYb + (ch & 1) * (16 * 256) + wv * 64 + lane;
                const float* q = B;
                f32x4 r4 = *(const f32x4*)(q + c4), om4 = *(const f32x4*)(q + 64 + c4), k4 = *(const f32x4*)(q + 128 + c4), kk4 = *(const f32x4*)(q + 192 + c4), ka4 = *(const f32x4*)(q + 256 + c4);
                float v = q[320 + rowl];
#pragma unroll
                for (int s = 0; s < 16; ++s) {
                    const float* qn = B + ((MODE & 2) ? 0 : ((s + 1) & 15)) * 384;
                    const f32x4 nr4 = *(const f32x4*)(qn + c4), nom4 = *(const f32x4*)(qn + 64 + c4), nk4 = *(const f32x4*)(qn + 128 + c4), nkk4 = *(const f32x4*)(qn + 192 + c4), nka4 = *(const f32x4*)(qn + 256 + c4);
                    const float nv = qn[320 + rowl];
                    const f32x2 pa = Sa * (f32x2){kk4.x, kk4.y} + Sb * (f32x2){kk4.z, kk4.w};
                    const float sa = (MODE & 1) ? (pa.x + pa.y) : allreduce16(pa.x + pa.y);
                    Sa = Sa - Sa * (f32x2){om4.x, om4.y} + (f32x2){k4.x, k4.y} * v; Sb = Sb - Sb * (f32x2){om4.z, om4.w} + (f32x2){k4.z, k4.w} * v;
                    Sa = Sa - (f32x2){ka4.x, ka4.y} * sa; Sb = Sb - (f32x2){ka4.z, ka4.w} * sa;
                    const f32x2 py = Sa * (f32x2){r4.x, r4.y} + Sb * (f32x2){r4.z, r4.w};
                    PY[s * 256] = py.x + py.y;
                    r4 = nr4; om4 = nom4; k4 = nk4; kk4 = nkk4; ka4 = nka4; v = nv;
                }
            }
        } else if (wv == 7) {
            if (ch > 0) {
                const int s = lane >> 2, rr = lane & 3;
#pragma unroll
                for (int mw = 0; mw < 4; ++mw) {
                    const float* src = PYb + ((ch - 1) & 1) * (16 * 256) + s * 256 + mw * 64 + rr * 16;
                    const f32x4 a = *(const f32x4*)src, b = *(const f32x4*)(src + 4), c = *(const f32x4*)(src + 8), d = *(const f32x4*)(src + 12);
                    const float y = ((a.x + a.y) + (a.z + a.w)) + ((b.x + b.y) + (b.z + b.w)) + ((c.x + c.y) + (c.z + c.w)) + ((d.x + d.y) + (d.z + d.w));
                    Yb[(size_t)((ch - 1) * 16 + s) * ystride + quarter * 16 + mw * 4 + rr] = (bf16)f2bf(y);
                }
            }
        } else {
            const int cn = ch + 1;
            if (cn < 128 && (cn % 3) == hw) SCAN_CONVERT(cn);
        }
    }
#undef SCAN_CONVERT
    __syncthreads();
}

__device__ __forceinline__ void rwkv_post_tile(int wid_s, KP p_, int l, int r, int tile, int dummy) {
    KP p = p_; asm volatile("" : "+s"(p));
    unsigned char* ws = p->ws;
    const int tid_ = mk_tid(wid_s);
    const int tid = tid_, lane = tid & 63, wv = tid >> 6;
    const GAS bf16* P = (const GAS bf16*)(ws + R_P); const GAS bf16* SI = (const GAS bf16*)(ws + R_SI); GAS bf16* Y = (GAS bf16*)(ws + WS_Y) + (size_t)r * TH * 1536;
    const int row0 = tile * 32;
    const int c = tid, h = wv;
    const float rkc = p->in[I_RK][l * 512 + c], lng = p->in[I_LNG][l * 512 + c], lnb = p->in[I_LNB][l * 512 + c];
#pragma unroll 4
    for (int t = 0; t < 32; ++t) {
        const int row = row0 + t;
        const GAS bf16* si = SI + ((size_t)((row >> 11) * 8 + h) * 2048 + (row & 2047)) * 384 + lane;
        const float rr = bf2f(si[0]), k2 = bf2f(si[128]), v = bf2f(si[320]);
        const float gg = bf2f(P[(size_t)row * NP + c]);
        GAS bf16* yp = Y + (size_t)row * 1536 + c;
        const float y = bf2f(*yp);
        const float mean = wave_sum(y) * (1.f / 64.f); const float d = y - mean; const float var = wave_sum(d * d) * (1.f / 64.f);
        const float yn = d * rsqrtf(var + 64e-5f) * lng + lnb;
        const float bonus = wave_sum(rr * k2 * rkc) * v;
        if (dummy) yp = (GAS bf16*)(ws + R_P) + (size_t)row * NP + 600 + c;
        *yp = (bf16)f2bf((yn + bonus) * gg);
    }
}

__device__ __forceinline__ float gelu_tanh(float x) { const float u = 0.7978845608028654f * (x + 0.044715f * x * x * x); return x * fsig(2.f * u); }
__device__ __forceinline__ void lru_unit(int wid_s, KP p_, int l, int r, int bl, int n, float* ldsf) {
    KP p = p_; asm volatile("" : "+s"(p));
    unsigned char* ws = p->ws;
    const int tid_ = mk_tid(wid_s);
    const int tid = tid_, lane = tid & 63, wv = tid >> 6, g = lane >> 4, j = lane & 15;
    const GAS bf16* P = (const GAS bf16*)(ws + R_P) + (size_t)bl * 2048 * NP; GAS bf16* Yb = (GAS bf16*)(ws + WS_Y) + ((size_t)(r * 4 + bl) * 2048) * 1536 + 512;
    const int cg_ = n * 64 + lane;
    float* s_xc = ldsf;
    float* s_a = ldsf + 8192;
    float* s_u = ldsf + 16384;
    float* s_AH = ldsf + 24576;
    unsigned char* s_xb16 = (unsigned char*)ldsf + 102400;
    unsigned char* s_wt16 = (unsigned char*)ldsf + 120832;
    LBAR();
    for (int e = tid; e < 8192; e += 512) { const int jj = e >> 6, ii = e & 63;
        const float w = (jj < 64) ? p->in[I_WA][((size_t)l * 8 + n) * 4096 + ii * 64 + jj] : p->in[I_WX][((size_t)l * 8 + n) * 4096 + ii * 64 + (jj - 64)];
        *(bf16*)(s_wt16 + (jj * 72 + ii) * 2) = (bf16)f2bf(w); }
    const float cw0 = p->in[I_CW][(l * 4 + 0) * 512 + cg_], cw1 = p->in[I_CW][(l * 4 + 1) * 512 + cg_], cw2 = p->in[I_CW][(l * 4 + 2) * 512 + cg_], cw3 = p->in[I_CW][(l * 4 + 3) * 512 + cg_];
    const float cb = p->in[I_CB][l * 512 + cg_];
    float ba4[4], bx4[4], sp4[4];
#pragma unroll
    for (int n4 = 0; n4 < 4; ++n4) { const int c = n * 64 + 16 * n4 + j; ba4[n4] = p->in[I_BA][l * 512 + c]; bx4[n4] = p->in[I_BX][l * 512 + c];
        sp4[n4] = -8.f * 1.4426950408889634f * log1pf(__expf(-p->in[I_LAM][l * 512 + c])); }
    float hcar = 0.f;
    for (int tile = 0; tile < 16; ++tile) {
        const int t0 = tile * 128 + wv * 16;
        float xc[16]; unsigned short gbr[16];
        {
            float x3 = (t0 >= 3) ? bf2f(P[(size_t)(t0 - 3) * NP + 1792 + cg_]) : 0.f, x2 = (t0 >= 2) ? bf2f(P[(size_t)(t0 - 2) * NP + 1792 + cg_]) : 0.f, x1 = (t0 >= 1) ? bf2f(P[(size_t)(t0 - 1) * NP + 1792 + cg_]) : 0.f;
#pragma unroll
            for (int i = 0; i < 16; ++i) { const float x0 = bf2f(P[(size_t)(t0 + i) * NP + 1792 + cg_]);
                xc[i] = cw0 * x3 + cw1 * x2 + cw2 * x1 + cw3 * x0 + cb; x3 = x2; x2 = x1; x1 = x0; }
#pragma unroll
            for (int i = 0; i < 16; ++i) gbr[i] = P[(size_t)(t0 + i) * NP + 2304 + cg_];
        }
        LBAR();
#pragma unroll
        for (int i = 0; i < 16; ++i) { s_xc[(wv * 16 + i) * 64 + lane] = xc[i]; *(bf16*)(s_xb16 + ((wv * 16 + i) * 72 + lane) * 2) = (bf16)f2bf(xc[i]); }
        LBAR();
        {
            f32x4 acc[8];
            const bf16x8 a0 = *(const bf16x8*)(s_xb16 + ((16 * wv + j) * 72 + 8 * g) * 2), a1 = *(const bf16x8*)(s_xb16 + ((16 * wv + j) * 72 + 32 + 8 * g) * 2);
#pragma unroll
            for (int nn = 0; nn < 8; ++nn) { acc[nn] = (f32x4){0.f, 0.f, 0.f, 0.f};
                const bf16x8 b0 = *(const bf16x8*)(s_wt16 + ((16 * nn + j) * 72 + 8 * g) * 2), b1 = *(const bf16x8*)(s_wt16 + ((16 * nn + j) * 72 + 32 + 8 * g) * 2);
                acc[nn] = __builtin_amdgcn_mfma_f32_16x16x32_bf16(a0, b0, acc[nn], 0, 0, 0); acc[nn] = __builtin_amdgcn_mfma_f32_16x16x32_bf16(a1, b1, acc[nn], 0, 0, 0); }
#pragma unroll
            for (int n4 = 0; n4 < 4; ++n4)
#pragma unroll
                for (int rr = 0; rr < 4; ++rr) { const int tk = 16 * wv + 4 * g + rr, c = 16 * n4 + j;
                    const float rg = fsig(acc[n4][rr] + ba4[n4]), ig = fsig(acc[n4 + 4][rr] + bx4[n4]);
                    const float a = __builtin_amdgcn_exp2f(sp4[n4] * rg);
                    const float uu = __builtin_amdgcn_sqrtf(fmaxf(1.f - a * a, 0.f)) * (ig * s_xc[tk * 64 + c]);
                    s_a[tk * 64 + c] = a; s_u[tk * 64 + c] = uu; }
        }
        LBAR();
        float av[16], uv[16]; float A = 1.f, H = 0.f;
#pragma unroll
        for (int i = 0; i < 16; ++i) { av[i] = s_a[(wv * 16 + i) * 64 + lane]; uv[i] = s_u[(wv * 16 + i) * 64 + lane]; A *= av[i]; H = av[i] * H + uv[i]; }
        s_AH[(wv * 64 + lane) * 2] = A; s_AH[(wv * 64 + lane) * 2 + 1] = H;
        LBAR();
        float hin = hcar, hall = hcar;
#pragma unroll
        for (int w = 0; w < 8; ++w) { const float Aw = s_AH[(w * 64 + lane) * 2], Hw = s_AH[(w * 64 + lane) * 2 + 1]; hall = Aw * hall + Hw; if (w < wv) hin = hall; }
        hcar = hall;
        float hh = hin;
#pragma unroll
        for (int i = 0; i < 16; ++i) { hh = av[i] * hh + uv[i];
            Yb[(size_t)(t0 + i) * 1536 + cg_] = (bf16)f2bf(hh * gelu_tanh(bf2f(gbr[i]))); }
    }
    LBAR();
}

__device__ __forceinline__ void kfix_rows(int wid_s, KP p_, int l, int r) {
    KP p = p_; asm volatile("" : "+s"(p));
    unsigned char* ws = p->ws;
    const int tid_ = mk_tid(wid_s);
    const int tid = tid_, lane = tid & 63, wv = tid >> 6, h = lane >> 3, sub = lane & 7;
    const GAS bf16* P = (const GAS bf16*)(ws + R_P); GAS bf16* Km = (GAS bf16*)(ws + R_KM);
    const float* kg = p->in[I_KG] + l * 96; const int* pos = (const int*)p->in[I_POS] + r * TH;
    for (int row = blockIdx.x * 8 + wv; row < TH; row += gridDim.x * 8) {
        GAS bf16* kp = Km + (size_t)row * 768 + h * 96;
        const u32x4 w = *(const GAS u32x4*)(kp + 8 * sub);
        float nv[8] = {bflo(w.x), bfhi(w.x), bflo(w.y), bfhi(w.y), bflo(w.z), bfhi(w.z), bflo(w.w), bfhi(w.w)};
        const unsigned k1 = *(const GAS unsigned*)(P + (size_t)row * NP + 3200 + 2 * sub), k2 = *(const GAS unsigned*)(P + (size_t)row * NP + 3216 + 2 * sub);
        float x1a = bflo(k1), x1b = bfhi(k1), x2a = bflo(k2), x2b = bfhi(k2);
        float ss = x1a * x1a + x1b * x1b + x2a * x2a + x2b * x2b;
#pragma unroll
        for (int e = 0; e < 8; ++e) ss += nv[e] * nv[e];
        ss += __shfl_xor(ss, 1); ss += __shfl_xor(ss, 2); ss += __shfl_xor(ss, 4);
        const float rs = rsqrtf(ss * (1.f / 96.f) + 1e-6f);
#pragma unroll
        for (int e = 0; e < 8; ++e) nv[e] *= rs * kg[8 * sub + e];
        x1a *= rs * kg[64 + 2 * sub]; x1b *= rs * kg[65 + 2 * sub]; x2a *= rs * kg[80 + 2 * sub]; x2b *= rs * kg[81 + 2 * sub];
        const int ps = pos[row]; float ca, sa, cb, sb; rope_cs(ps, 2 * sub, ca, sa); rope_cs(ps, 2 * sub + 1, cb, sb);
        u32x4 o; o.x = pk2(nv[0], nv[1]); o.y = pk2(nv[2], nv[3]); o.z = pk2(nv[4], nv[5]); o.w = pk2(nv[6], nv[7]);
        *(GAS u32x4*)(kp + 8 * sub) = o;
        *(GAS unsigned*)(kp + 64 + 2 * sub) = pk2(x1a * ca - x2a * sa, x1b * cb - x2b * sb);
        *(GAS unsigned*)(kp + 80 + 2 * sub) = pk2(x2a * ca + x1a * sa, x2b * cb + x1b * sb);
    }
}
__device__ __forceinline__ void mkfix_rows(int wid_s, KP p_, int l) {
    KP p = p_; asm volatile("" : "+s"(p));
    unsigned char* ws = p->ws;
    const int tid_ = mk_tid(wid_s);
    const int tid = tid_, lane = tid & 63, wv = tid >> 6, h = lane >> 4, sub = lane & 15;
    bf16* mk = (bf16*)(ws + R_MK); const float* kg = p->in[I_XKG] + l * 128;
    for (int row = blockIdx.x * 8 + wv; row < 2048; row += gridDim.x * 8) {
        bf16* kp = mk + (size_t)row * 512 + h * 128 + 8 * sub;
        const u32x4 w = *(const u32x4*)kp;
        float nv[8] = {bflo(w.x), bfhi(w.x), bflo(w.y), bfhi(w.y), bflo(w.z), bfhi(w.z), bflo(w.w), bfhi(w.w)};
        float ss = 0.f;
#pragma unroll
        for (int e = 0; e < 8; ++e) ss += nv[e] * nv[e];
        ss += __shfl_xor(ss, 1); ss += __shfl_xor(ss, 2); ss += __shfl_xor(ss, 4); ss += __shfl_xor(ss, 8);
        const float rs = rsqrtf(ss * (1.f / 128.f) + 1e-6f);
#pragma unroll
        for (int e = 0; e < 8; ++e) nv[e] *= rs * kg[8 * sub + e];
        u32x4 o; o.x = pk2(nv[0], nv[1]); o.y = pk2(nv[2], nv[3]); o.z = pk2(nv[4], nv[5]); o.w = pk2(nv[6], nv[7]);
        *(u32x4*)kp = o;
    }
}
__device__ __forceinline__ void memb_rows(int wid_s, KP p_) {
    KP p = p_; asm volatile("" : "+s"(p));
    unsigned char* ws = p->ws;
    const int tid_ = mk_tid(wid_s);
    const int tid = tid_, lane = tid & 63, wv = tid >> 6;
    const float* mem = p->in[I_MEM]; bf16* memb = (bf16*)(ws + R_MEMB);
    for (int row = blockIdx.x * 8 + wv; row < 2048; row += gridDim.x * 8) {
        const f32x4* xr = (const f32x4*)(mem + (size_t)row * 1024) + lane; f32x4 v[4]; float s = 0.f;
#pragma unroll
        for (int jq = 0; jq < 4; ++jq) { v[jq] = xr[64 * jq]; s += (v[jq].x * v[jq].x + v[jq].y * v[jq].y) + (v[jq].z * v[jq].z + v[jq].w * v[jq].w); }
        const float rs = rsqrtf(wave_sum(s) * (1.f / 1024.f) + 1e-6f);
#pragma unroll
        for (int jq = 0; jq < 4; ++jq) { u32x2 w; w.x = pk2(v[jq].x * rs, v[jq].y * rs); w.y = pk2(v[jq].z * rs, v[jq].w * rs); *((u32x2*)(memb + (size_t)row * 1024) + lane + 64 * jq) = w; }
    }
}

#define XB_TMO      128
#define XB_XCNT(j)  (256  + 64 * (j))
#define XB_XSUB(j)  (1280 + 64 * (j))
#define XB_XGEN(j)  (2304 + 64 * (j))
#define XB_TOP      3328
#define XB_TOPGEN   3392
#define XCD_BAR_WORDS 3456
#define XB_SPIN_CAP (1u << 22)
__device__ __forceinline__ unsigned xb_ld(unsigned* p)              { return __hip_atomic_load(p, __ATOMIC_RELAXED, __HIP_MEMORY_SCOPE_AGENT); }
__device__ __forceinline__ unsigned xb_add(unsigned* p, unsigned v) { return __hip_atomic_fetch_add(p, v, __ATOMIC_RELAXED, __HIP_MEMORY_SCOPE_AGENT); }
__device__ __forceinline__ unsigned xb_xcc_id() { return (unsigned)__builtin_amdgcn_s_getreg((3 << 11) | 20) & 0xFu; }
#define XB_SPIN(cond, bar) do { unsigned _sp = 0; while (cond) { __builtin_amdgcn_s_sleep(1); \
    if ((++_sp & 255u) == 0u) { if (xb_ld(&(bar)[XB_TMO])) break; if (_sp > XB_SPIN_CAP) { atomicAdd(&(bar)[XB_TMO], 1u); break; } } } } while (0)
__device__ __forceinline__ void xcd_barrier_complete(unsigned* bar, unsigned x, unsigned& nloc, unsigned& nx) {
    const unsigned G = gridDim.x;
    unsigned sum, cnt, mine, sp = 0u;
    for (;;) {
        sum = 0u; cnt = 0u; mine = 0u;
#pragma unroll
        for (unsigned j = 0; j < 16; ++j) { const unsigned c = xb_ld(&bar[XB_XCNT(j)]); sum += c; cnt += (c > 0u) ? 1u : 0u; mine = (j == x) ? c : mine; }
        if (sum == G) break;
        __builtin_amdgcn_s_sleep(1);
        if ((++sp & 255u) == 0u) { if (xb_ld(&bar[XB_TMO])) break; if (sp > XB_SPIN_CAP) { atomicAdd(&bar[XB_TMO], 1u); break; } }
    }
    nloc = mine > 0u ? mine : 1u; nx = cnt > 0u ? cnt : 1u;
}
__device__ __forceinline__ void grid_barrier1(int wid_s, unsigned* bar, volatile unsigned* st) {
    asm volatile("s_waitcnt vmcnt(0)" ::: "memory");
    __syncthreads();
    if (mk_tid(wid_s) == 0) {
        const unsigned x = xb_xcc_id();
        __builtin_amdgcn_s_waitcnt(0);
        unsigned nloc = st[0], nx = st[1];
        if (nloc == 0u) { xcd_barrier_complete(bar, x, nloc, nx); st[0] = nloc; st[1] = nx; }
        const unsigned old = xb_add(&bar[XB_XSUB(x)], 1u);
        const unsigned gen = old / nloc;
        if (old + 1u == (gen + 1u) * nloc) {
            __builtin_amdgcn_fence(__ATOMIC_RELEASE, "agent");
            asm volatile("s_waitcnt vmcnt(0)" ::: "memory");
            const unsigned og = xb_add(&bar[XB_TOP], 1u);
            const unsigned tg = og / nx;
            if (og + 1u == (tg + 1u) * nx) xb_add(&bar[XB_TOPGEN], 1u);
            else XB_SPIN(xb_ld(&bar[XB_TOPGEN]) == tg, bar);
            __builtin_amdgcn_fence(__ATOMIC_ACQUIRE, "agent");
            xb_add(&bar[XB_XGEN(x)], 1u);
            asm volatile("s_waitcnt vmcnt(0)" ::: "memory");
        } else {
            XB_SPIN(xb_ld(&bar[XB_XGEN(x)]) == gen, bar);
            __builtin_amdgcn_fence(__ATOMIC_ACQUIRE, "agent");
            asm volatile("s_waitcnt vmcnt(0)" ::: "memory");
        }
    }
    __syncthreads();
}
__device__ __forceinline__ void grid_barrier(int wid_s, unsigned* bar, volatile unsigned* st) { int nb = 1 + RB(8); asm volatile("" : "+s"(nb)); for (int q = 0; q < nb; ++q) grid_barrier1(wid_s, bar, st); }
template <class Epi>
__device__ __forceinline__ void run_gemm(int wid_s, LAS unsigned char* lds, const bf16* A, int lda, const bf16* Bt, int M, int N, int K, const Epi& E, int shift = 0) {
    int bx_ = blockIdx.x, gx_ = gridDim.x; asm volatile("" : "+s"(bx_), "+s"(gx_), "+s"(K), "+s"(lda));
    pg8::Gemm g{A, Bt, M, N, K, lda}; pg8::StaticOrder S; S.init(M, N, gx_, (bx_ + shift) % gx_);
    if (ON(1)) pg8::gemm_phase<Epi, pg8::StaticOrder>(wid_s, lds, g, S, E);
}

__device__ __forceinline__ unsigned char* wsl_(KP p) { unsigned char* w = p->ws; asm volatile("" : "+s"(w)); return w; }
__global__ void __launch_bounds__(512, 2) fwd_kernel(Params parg) {
    KP p = (KP)__builtin_amdgcn_kernarg_segment_ptr();
    extern __shared__ __attribute__((aligned(16))) unsigned char lds_raw[];
    const int wid_s = __builtin_amdgcn_readfirstlane((int)threadIdx.x >> 6);
    LAS unsigned char* lds3 = (LAS unsigned char*)lds_raw;
    unsigned char* lds = lds_raw; float* ldsf = (float*)lds_raw;
    unsigned char* ws = p->ws;
    const int bid = blockIdx.x;
    unsigned* ctl = (unsigned*)(wsl_(p) + WS_CTL);
    bf16* xb = (bf16*)(wsl_(p) + WS_XB); float* part = (float*)(wsl_(p) + WS_PART); float* pq = (float*)(wsl_(p) + WS_PQ); float* pkv = (float*)(wsl_(p) + WS_PKV);
    bf16* Y = (bf16*)(wsl_(p) + WS_Y);
    float* xcur = p->out;
    volatile unsigned* bst = (volatile unsigned*)(lds + QIDX_OFF + 16);
    if (threadIdx.x == 0) { bst[0] = 0u; bst[1] = 0u; (void)xb_add(&ctl[1024 + XB_XCNT(xb_xcc_id())], 1u); }
    __syncthreads();

    for (int l_ = 0; l_ < 2; ++l_) {
        int l = l_; asm volatile("" : "+s"(l));
        { REPLOOP(0) { if (ON(0)) phase_convert(wid_s, p, l, ldsf);
        grid_barrier(wid_s, ctl + 1024, bst); } }
        for (int r_ = 0; r_ < 2; ++r_) {
            int r = r_; asm volatile("" : "+s"(r));
            { REPLOOP(1) { EpiP E{(bf16*)(wsl_(p) + R_P), part + (size_t)r * TH * 16, pq, pkv};
              run_gemm(wid_s, lds3, xb + (size_t)r * TH * 1024, 1024, (const bf16*)(wsl_(p) + W_IN), TH, NP, 1024, E);
            grid_barrier(wid_s, ctl + 1024, bst); } }
            { REPLOOP(2) {
            if (ON(2)) lora_act_rows(wid_s, p, l, r);
            { EpiQ E{(bf16*)(wsl_(p) + R_Q), pq}; run_gemm(wid_s, lds3, (const bf16*)(wsl_(p) + R_P) + 2816, NP, (const bf16*)(wsl_(p) + W_MQ), TH, 768, 256, E); }
            { EpiKV E{(bf16*)(wsl_(p) + R_KM), (bf16*)(wsl_(p) + R_VT), pkv}; run_gemm(wid_s, lds3, (const bf16*)(wsl_(p) + R_P) + 3072, NP, (const bf16*)(wsl_(p) + W_MKV), TH, 1024, 128, E); }
            grid_barrier(wid_s, ctl + 1024, bst); } }
            { REPLOOP(9) { EpiBf E{Y + (size_t)r * TH * 1536, 1536}; run_gemm(wid_s, lds3, Y + (size_t)r * TH * 1536 + 1024, 1536, (const bf16*)(wsl_(p) + W_BWA), TH, 1024, 128, E);
            grid_barrier(wid_s, ctl + 1024, bst); } }
            { REPLOOP(13) { if (ON(2)) for (int tile = bid; tile < TH / 32; tile += gridDim.x) si_build_tile(wid_s, p, l, r, tile); } }
            if (ON(7)) kfix_rows(wid_s, p, l, r);
            grid_barrier(wid_s, ctl + 1024, bst);
            { REPLOOP(3) {
            if (ON(3) && !(q && RB(10)) && bid < 128) { const int xcd = bid & 7, idx = bid >> 3, hh = xcd * 4 + (idx >> 2), quarter = idx & 3;
                if (q == 0 || SCANMODE == 0) rwkv_scan_unit<0>(wid_s, (const bf16*)(wsl_(p) + R_SI) + (size_t)hh * 2048 * 384, Y + ((size_t)(r * 4 + (hh >> 3)) * 2048) * 1536 + (hh & 7) * 64, 1536, quarter, ldsf);
                else rwkv_scan_unit<SCANMODE>(wid_s, (const bf16*)(wsl_(p) + R_SI) + (size_t)hh * 2048 * 384, (bf16*)(wsl_(p) + R_P) + ((size_t)(hh >> 3) * 2048) * NP + 600 + (hh & 7) * 64, NP, quarter, ldsf); }
            else if (ON(4) && !(q && RB(11)) && bid >= 128 && bid < 160) { const int uu = bid - 128; lru_unit(wid_s, p, l, r, uu >> 3, uu & 7, ldsf); }
            else if (q == 0) { EpiBf E{(bf16*)(wsl_(p) + R_P), NP}; run_gemm(wid_s, lds3, (const bf16*)(wsl_(p) + WS_AG), 128, (const bf16*)(wsl_(p) + W_GUP), TH, 512, 128, E, 96); }
            {
                unsigned* ctr = ctl + q * 4 + l * 2 + r; volatile int* qidx = (volatile int*)(lds + QIDX_OFF);
                for (;;) {
                    __syncthreads();
                    if (mk_tid(wid_s) == 0) *qidx = (int)atomicAdd(ctr, 1u);
                    __syncthreads();
                    const int u = *qidx;
                    if (u >= 512 || !ON(5) || (q && RB(12))) break;
                    const int qb = 15 - (u >> 5), bh = u & 31, bl = bh >> 3, h = bh & 7;
                    attn_unit<96, 64, true, true>(wid_s, lds, (const bf16*)(wsl_(p) + R_Q) + (size_t)bl * 2048 * 768 + h * 96, 768, (const bf16*)(wsl_(p) + R_KM) + (size_t)bl * 2048 * 768 + h * 96, 768,
                        (const bf16*)(wsl_(p) + R_VT) + (size_t)(bl * 8 + h) * 64 * 2048, 2048, Y + ((size_t)(r * 4 + bl) * 2048) * 1536 + 1024 + h * 64, 1536,
                        qb * 128, 2 * qb + 2, p->in[I_QG] + l * 96, (const int*)p->in[I_POS] + (r * 4 + bl) * 2048, 0.14724444527f  );
                }
            }
            grid_barrier(wid_s, ctl + 1024, bst); } }
            { REPLOOP(16) { if (ON(6)) for (int tile = bid; tile < TH / 32; tile += gridDim.x) rwkv_post_tile(wid_s, p, l, r, tile, q); } }
            grid_barrier(wid_s, ctl + 1024, bst);
        }
        if (ON(7)) memb_rows(wid_s, p);
        { REPLOOP(4) {
        for (int n = 0; n < 3; ++n) {
            { EpiGate E{(bf16*)(wsl_(p) + R_GS), part, p->in[I_BGATE] + l * 3072 + n * 1024}; run_gemm(wid_s, lds3, xb, 1024, (const bf16*)(wsl_(p) + W_GATE) + (size_t)n * 1024 * 1024, T, 1024, 1024, E); }
            { EpiProj E{(const bf16*)(wsl_(p) + R_GS), (float*)(wsl_(p) + R_MS), (bf16*)(wsl_(p) + R_MG), n}; run_gemm(wid_s, lds3, Y + n * 512, 1536, (const bf16*)(wsl_(p) + W_BR) + (size_t)n * 1024 * 512, T, 1024, 512, E); }
        }
        grid_barrier(wid_s, ctl + 1024, bst); } }
        { int nw = 1 + RB(15); asm volatile("" : "+s"(nw)); for (int q = 0; q < nw; ++q) { EpiRes E{l == 0 ? p->in[I_X] : xcur, xcur, xb, part, q + 1 < nw}; run_gemm(wid_s, lds3, (const bf16*)(wsl_(p) + R_MG), 1024, (const bf16*)(wsl_(p) + W_OUT), T, 1024, 1024, E); if (q + 1 < nw) grid_barrier(wid_s, ctl + 1024, bst); } }
        { REPLOOP(19) { EpiMemKV E{(bf16*)(wsl_(p) + R_MK), (bf16*)(wsl_(p) + R_MVT)}; run_gemm(wid_s, lds3, (const bf16*)(wsl_(p) + R_MEMB), 1024, (const bf16*)(wsl_(p) + W_XKV), 2048, 1024, 1024, E); } }
        grid_barrier(wid_s, ctl + 1024, bst);
        if (ON(7)) mkfix_rows(wid_s, p, l);
        { REPLOOP(5) { EpiXQ E{(bf16*)(wsl_(p) + R_XQ), part}; run_gemm(wid_s, lds3, xb, 1024, (const bf16*)(wsl_(p) + W_XQ), T, 512, 1024, E);
        grid_barrier(wid_s, ctl + 1024, bst); } }
        { REPLOOP(6) {
        if (ON(8)) for (int u = bid; u < 512; u += gridDim.x) { const int qb = u & 15, bh = u >> 4, b = bh >> 2, h = bh & 3;
            attn_unit<128, 128, false, false>(wid_s, lds, (const bf16*)(wsl_(p) + R_XQ) + (size_t)b * 2048 * 512 + h * 128, 512, (const bf16*)(wsl_(p) + R_MK) + (size_t)b * 256 * 512 + h * 128, 512,
                (const bf16*)(wsl_(p) + R_MVT) + (size_t)(b * 4 + h) * 128 * 256, 256, (bf16*)(wsl_(p) + R_XO) + (size_t)b * 2048 * 512 + h * 128, 512,
                qb * 128, 4, p->in[I_XQG] + l * 128, nullptr, 0.12751743082f  ); }
        grid_barrier(wid_s, ctl + 1024, bst); } }
        { int nw = 1 + RB(17); asm volatile("" : "+s"(nw)); for (int q = 0; q < nw; ++q) { EpiRes E{xcur, xcur, xb, part, q + 1 < nw}; run_gemm(wid_s, lds3, (const bf16*)(wsl_(p) + R_XO), 512, (const bf16*)(wsl_(p) + W_XO), T, 1024, 512, E); if (q + 1 < nw) grid_barrier(wid_s, ctl + 1024, bst); } }
        grid_barrier(wid_s, ctl + 1024, bst);
        { REPLOOP(7) { EpiFFN1 E{(bf16*)(wsl_(p) + R_H), part}; run_gemm(wid_s, lds3, xb, 1024, (const bf16*)(wsl_(p) + W_13), T, 5632, 1024, E);
        grid_barrier(wid_s, ctl + 1024, bst); } }
        { int nw = 1 + RB(18); asm volatile("" : "+s"(nw)); for (int q = 0; q < nw; ++q) { EpiRes E{xcur, xcur, xb, part, q + 1 < nw}; run_gemm(wid_s, lds3, (const bf16*)(wsl_(p) + R_H), DFF, (const bf16*)(wsl_(p) + W_2), T, 1024, DFF, E); if (q + 1 < nw) grid_barrier(wid_s, ctl + 1024, bst); } }
        grid_barrier(wid_s, ctl + 1024, bst);
    }
}

extern "C" void kernel_launch(void* const* d_in, const int* in_sizes, int n_in, void* d_out, int out_size, void* d_ws, size_t ws_size, hipStream_t stream) {
    static int grid = 0;
    if (grid == 0) {
        int dev = 0, cus = 0, per_cu = 0;
        if (n_in != 43 || ws_size < WS_END) { fprintf(stderr, "kernel_launch: unexpected n_in %d / ws %zu\n", n_in, ws_size); grid = -1; return; }
        (void)hipGetDevice(&dev);
        (void)hipDeviceGetAttribute(&cus, hipDeviceAttributeMultiprocessorCount, dev);
        (void)hipFuncSetAttribute((const void*)fwd_kernel, hipFuncAttributeMaxDynamicSharedMemorySize, LDS_BYTES);
        (void)hipOccupancyMaxActiveBlocksPerMultiprocessor(&per_cu, (const void*)fwd_kernel, 512, LDS_BYTES);
        fprintf(stderr, "cus %d per_cu %d ws %zu\n", cus, per_cu, ws_size);
        grid = cus * (per_cu >= 1 ? 1 : 0);
        if (grid <= 0) { grid = -1; return; }
    }
    if (grid < 0) return;
    Params p{};
    for (int i = 0; i < 43; ++i) p.in[i] = (const float*)d_in[i];
    p.out = (float*)d_out; p.ws = (unsigned char*)d_ws;
    (void)hipMemsetAsync((char*)d_ws + WS_CTL, 0, 32768, stream);
    void* args[] = {&p};
    hipError_t e = hipLaunchCooperativeKernel((const void*)fwd_kernel, dim3(grid), dim3(512), args, LDS_BYTES, stream);
    if (e != hipSuccess) fprintf(stderr, "cooperative launch failed: %s (grid %d)\n", hipGetErrorString(e), grid);
}
```

```cpp
#include <hip/hip_runtime.h>
#include <cstdio>
#include <cstdint>

#define LAS __attribute__((address_space(3)))
#define GAS __attribute__((address_space(1)))
typedef unsigned short bf16;
typedef short bf16x8 __attribute__((ext_vector_type(8)));
typedef float f32x4 __attribute__((ext_vector_type(4)));
typedef float f32x2 __attribute__((ext_vector_type(2)));
typedef unsigned u32x4 __attribute__((ext_vector_type(4)));
typedef unsigned u32x2 __attribute__((ext_vector_type(2)));

__device__ __forceinline__ unsigned f2bf(float f) { unsigned u = __builtin_bit_cast(unsigned, f); return (u + 0x7fffu + ((u >> 16) & 1u)) >> 16; }
typedef __bf16 bf16x2_t __attribute__((ext_vector_type(2)));
__device__ __forceinline__ unsigned pk2(float lo, float hi) { const f32x2 v = {lo, hi}; const bf16x2_t b = __builtin_convertvector(v, bf16x2_t); return __builtin_bit_cast(unsigned, b); }
__device__ __forceinline__ float bf2f(bf16 b) { return __builtin_bit_cast(float, (unsigned)b << 16); }
__device__ __forceinline__ float bflo(unsigned u) { return __builtin_bit_cast(float, u << 16); }
__device__ __forceinline__ float bfhi(unsigned u) { return __builtin_bit_cast(float, u & 0xffff0000u); }
__device__ __forceinline__ u32x4 pk8(f32x4 a, f32x4 b) { u32x4 w; w.x = pk2(a.x, a.y); w.y = pk2(a.z, a.w); w.z = pk2(b.x, b.y); w.w = pk2(b.z, b.w); return w; }
__device__ __forceinline__ float sigmoidf_(float x) { return 1.f / (1.f + __expf(-x)); }
__device__ __forceinline__ float fsig(float x) { return __builtin_amdgcn_rcpf(1.f + __builtin_amdgcn_exp2f(-1.4426950408889634f * x)); }
__device__ __forceinline__ int mk_tid(int wid_s) { int t = wid_s * 64 + (int)__builtin_amdgcn_mbcnt_hi(~0u, __builtin_amdgcn_mbcnt_lo(~0u, 0u)); asm volatile("" : "+v"(t)); return t; }
#define LBAR() asm volatile("s_waitcnt lgkmcnt(0)\n\ts_barrier" ::: "memory")
__device__ __forceinline__ float wave_sum(float v) {
#pragma unroll
    for (int o = 1; o < 64; o <<= 1) v += __shfl_xor(v, o);
    return v;
}

namespace pg8 {
#define PG8_LAS __attribute__((address_space(3)))
typedef unsigned short bf16_t;
constexpr int BM = 256, BK = 64, HALF = 128, HTB = HALF * BK * 2, STAGE_BYTES = 8 * HTB, NXCD = 8, WGM = 8;
__host__ __device__ __forceinline__ int lds_byte(int r, int c) { const int st = (r >> 4) * 2 + (c >> 5), rr = r & 15, cc = c & 31, ob = rr * 64 + cc * 2; return st * 1024 + (ob ^ (((ob >> 9) & 1) << 5)); }
__host__ __device__ __forceinline__ void stage_rc(int b, int& R, int& C) { const int st = b / 1024, sb = b % 1024, swz = sb ^ (((sb >> 9) & 1) << 5); R = (st >> 1) * 16 + swz / 64; C = (st & 1) * 32 + (swz % 64) / 2; }
__host__ __device__ __forceinline__ int perm32(int rho) { const int n = rho >> 4, i = rho & 15; return 8 * (i >> 2) + 4 * n + (i & 3); }
struct Unit { int pm, pn; };
struct Gemm { const bf16_t* A; const bf16_t* Bt; int M, N, K, lda; };
struct StaticOrder {
    int nM, nN, nwg, G, c;
    __host__ __device__ void init(int M, int N, int G_, int c_) { nM = M / BM; nN = N / BM; nwg = nM * nN; G = G_; c = c_; }
    __host__ __device__ bool next(int i, Unit& u) const {
        const long L = (long)i * G + c; if (L >= nwg) return false;
        int wgid = (int)L; { const int q = nwg / NXCD, r = nwg % NXCD, xcd = wgid % NXCD, off = wgid / NXCD; wgid = (xcd < r ? xcd * (q + 1) : r * (q + 1) + (xcd - r) * q) + off; }
        const int nig = WGM * nN, gid = wgid / nig, fm = gid * WGM, gsz = (nM - fm) < WGM ? (nM - fm) : WGM;
        u.pm = fm + ((wgid % nig) % gsz); u.pn = (wgid % nig) / gsz; return true;
    }
};
template <class Epi, class Sched>
__device__ __forceinline__ void gemm_phase(int wid_s, PG8_LAS unsigned char* lds, const Gemm g, const Sched& S, const Epi& E) {
    const int tid_ = mk_tid(wid_s);
    const int tid = tid_, wid = __builtin_amdgcn_readfirstlane(tid >> 6), lane = tid & 63, wr = wid >> 2, wc = wid & 3, fr = lane & 15, fq = lane >> 4;
    const int K = g.K, nt = K / BK, lda = g.lda;
    unsigned voffA[2], voffB[2];
#pragma unroll
    for (int i = 0; i < 2; ++i) { int R, C; stage_rc(tid * 16 + i * 8192, R, C); const int Rb = (R & ~31) + perm32(R & 31);
        voffA[i] = (unsigned)(R * lda + C) * 2u; voffB[i] = (unsigned)(Rb * K + C) * 2u; }
    const size_t kstep = (size_t)(BK * 2);
    const size_t hstepA = (size_t)HALF * lda * 2, hstepB = (size_t)HALF * K * 2;
    const size_t tstepA = 2 * hstepA, tstepB = 2 * hstepB;
    const unsigned ldsw = (unsigned)wid * 1024u;
    const int aoff = lds_byte(wr * 64 + fr, fq * 8), boff = lds_byte(wc * 32 + fr, fq * 8);
#define PG8_SA(b, h) (((b) * 2 + (h)) * HTB)
#define PG8_SB(b, h) ((4 + (b) * 2 + (h)) * HTB)
#define PG8_STAGE(bufoff, gbase, voff) do { _Pragma("unroll") for (int _i = 0; _i < 2; ++_i) \
        __builtin_amdgcn_global_load_lds((const unsigned*)((const char*)(gbase) + (voff)[_i]), (PG8_LAS unsigned*)(lds + (bufoff) + ldsw + _i * 8192), 16, 0, 0); } while (0)
#define PG8_LDA(dst, b, h) do { _Pragma("unroll") for (int m = 0; m < 4; ++m) _Pragma("unroll") for (int k = 0; k < 2; ++k) dst[m][k] = *(const PG8_LAS bf16x8*)(lds + PG8_SA(b, h) + aoff + m * 2048 + k * 1024); } while (0)
#define PG8_LDB(dst, b, h) do { _Pragma("unroll") for (int n = 0; n < 2; ++n) _Pragma("unroll") for (int k = 0; k < 2; ++k) dst[n][k] = *(const PG8_LAS bf16x8*)(lds + PG8_SB(b, h) + boff + n * 2048 + k * 1024); } while (0)
#define PG8_MMA(ai, bj, At, Bt) do { __builtin_amdgcn_s_setprio(1); _Pragma("unroll") for (int m = 0; m < 4; ++m) _Pragma("unroll") for (int n = 0; n < 2; ++n) _Pragma("unroll") for (int k = 0; k < 2; ++k) \
        acc[ai][bj][m][n] = __builtin_amdgcn_mfma_f32_16x16x32_bf16(Bt[n][k], At[m][k], acc[ai][bj][m][n], 0, 0, 0); __builtin_amdgcn_s_setprio(0); } while (0)
#define PG8_WAIT_V(n) asm volatile("s_waitcnt vmcnt(" #n ")" ::: "memory")
#define PG8_WAIT_L(n) asm volatile("s_waitcnt lgkmcnt(" #n ")" ::: "memory")
#define PG8_BAR __builtin_amdgcn_s_barrier()
#define PG8_SCHED __builtin_amdgcn_sched_barrier(0)
    Unit cur, nxt; int ui = 0;
    if (!S.next(0, cur)) return;
    f32x4 acc[2][2][4][2];
#pragma unroll
    for (int a = 0; a < 2; ++a)
#pragma unroll
        for (int b = 0; b < 2; ++b)
#pragma unroll
            for (int m = 0; m < 4; ++m)
#pragma unroll
                for (int n = 0; n < 2; ++n) acc[a][b][m][n] = (f32x4){0.f, 0.f, 0.f, 0.f};
    bf16x8 At[4][2], B0[2][2], B1[2][2];
    const char* cA = (const char*)g.A + (size_t)cur.pm * tstepA; const char* cB = (const char*)g.Bt + (size_t)cur.pn * tstepB;
    PG8_STAGE(PG8_SB(0, 0), cB, voffB); PG8_STAGE(PG8_SB(0, 1), cB + hstepB, voffB); PG8_STAGE(PG8_SA(0, 0), cA, voffA); PG8_STAGE(PG8_SA(0, 1), cA + hstepA, voffA);
    if (wr == 1) PG8_BAR;
    PG8_WAIT_V(2); PG8_BAR;
    PG8_STAGE(PG8_SB(1, 0), cB + kstep, voffB); PG8_STAGE(PG8_SA(1, 0), cA + kstep, voffA); PG8_STAGE(PG8_SB(1, 1), cB + hstepB + kstep, voffB);
    PG8_WAIT_V(6); PG8_BAR;
    for (;;) {
        const bool has_next = S.next(ui + 1, nxt);
        const char* nA = has_next ? (const char*)g.A + (size_t)nxt.pm * tstepA : cA; const char* nB = has_next ? (const char*)g.Bt + (size_t)nxt.pn * tstepB : cB;
#pragma unroll 1
        for (int t = 0; t < nt; t += 2) {
            const bool last = (t == nt - 2);
            const char* a1 = cA + (size_t)(t + 1) * kstep;
            const char* a2 = last ? nA : cA + (size_t)(t + 2) * kstep; const char* b2 = last ? nB : cB + (size_t)(t + 2) * kstep;
            const char* a3 = a2 + kstep; const char* b3 = b2 + kstep;
            PG8_LDB(B0, 0, 0); PG8_LDB(B1, 0, 1); PG8_SCHED; PG8_LDA(At, 0, 0); PG8_STAGE(PG8_SA(1, 1), a1 + hstepA, voffA);
            PG8_WAIT_V(8); PG8_WAIT_L(0); PG8_BAR; PG8_MMA(0, 0, At, B0); PG8_MMA(0, 1, At, B1); PG8_BAR; PG8_SCHED;
            PG8_LDA(At, 0, 1); PG8_STAGE(PG8_SB(0, 0), b2, voffB); PG8_STAGE(PG8_SB(0, 1), b2 + hstepB, voffB); PG8_STAGE(PG8_SA(0, 0), a2, voffA);
            PG8_WAIT_V(8); PG8_WAIT_L(0); PG8_BAR; PG8_MMA(1, 0, At, B0); PG8_MMA(1, 1, At, B1); PG8_BAR; PG8_SCHED;
            PG8_LDB(B0, 1, 0); PG8_LDB(B1, 1, 1); PG8_SCHED; PG8_LDA(At, 1, 0); PG8_STAGE(PG8_SA(0, 1), a2 + hstepA, voffA);
            PG8_WAIT_V(8); PG8_WAIT_L(0); PG8_BAR; PG8_MMA(0, 0, At, B0); PG8_MMA(0, 1, At, B1); PG8_BAR; PG8_SCHED;
            PG8_LDA(At, 1, 1); PG8_STAGE(PG8_SB(1, 0), b3, voffB); PG8_STAGE(PG8_SB(1, 1), b3 + hstepB, voffB); PG8_STAGE(PG8_SA(1, 0), a3, voffA);
            PG8_WAIT_V(8); PG8_WAIT_L(0); PG8_BAR; PG8_MMA(1, 0, At, B0); PG8_MMA(1, 1, At, B1); PG8_BAR; PG8_SCHED;
        }
        if (wr == 0) PG8_BAR;
        E(acc, cur, wr, wc, fr, fq);
        if (!has_next) break;
#pragma unroll
        for (int a = 0; a < 2; ++a)
#pragma unroll
            for (int b = 0; b < 2; ++b)
#pragma unroll
                for (int m = 0; m < 4; ++m)
#pragma unroll
                    for (int n = 0; n < 2; ++n) acc[a][b][m][n] = (f32x4){0.f, 0.f, 0.f, 0.f};
        cur = nxt; cA = nA; cB = nB; ++ui;
        if (wr == 1) PG8_BAR;
    }
    PG8_WAIT_V(0);
    PG8_BAR;
#undef PG8_SA
#undef PG8_SB
#undef PG8_STAGE
#undef PG8_LDA
#undef PG8_LDB
#undef PG8_MMA
#undef PG8_WAIT_V
#undef PG8_WAIT_L
#undef PG8_BAR
#undef PG8_SCHED
}
}

#ifndef EN
#define EN 0xFFFF
#endif
#define ON(b) ((EN >> (b)) & 1)
#ifndef REP
#define REP 0
#endif
#ifndef SCANMODE
#define SCANMODE 0
#endif
#define RB(b) ((REP >> (b)) & 1)
#define REPLOOP(b) int nrep##b = 1 + RB(b); asm volatile("" : "+s"(nrep##b)); for (int q = 0; q < nrep##b; ++q)
constexpr int T = 16384, TH = 8192, SEQ = 2048, DM = 1024, DIN = 6304, NP = 3328, DFF = 2816;
constexpr int LDS_BYTES = 147456, QIDX_OFF = 140000;
constexpr size_t MiB = 1u << 20;
constexpr size_t WS_CTL = 0;
constexpr size_t WS_WT = 1 * MiB;
constexpr size_t W_IN = WS_WT, W_GATE = W_IN + (size_t)NP * 1024 * 2, W_BR = W_GATE + (size_t)3072 * 1024 * 2, W_OUT = W_BR + (size_t)3 * 1024 * 512 * 2,
                 W_MQ = W_OUT + (size_t)1024 * 1024 * 2, W_MKV = W_MQ + (size_t)768 * 256 * 2, W_XQ = W_MKV + (size_t)1024 * 128 * 2, W_XKV = W_XQ + (size_t)512 * 1024 * 2,
                 W_XO = W_XKV + (size_t)1024 * 1024 * 2, W_13 = W_XO + (size_t)1024 * 512 * 2, W_2 = W_13 + (size_t)5632 * 1024 * 2, W_BWA = W_2 + (size_t)1024 * 2816 * 2, W_GUP = W_BWA + (size_t)1024 * 128 * 2, W_END = W_GUP + (size_t)512 * 128 * 2;
static_assert(W_END <= 40 * MiB, "weights");
constexpr size_t WS_XB = 40 * MiB, WS_PART = 72 * MiB, WS_PQ = 73 * MiB, WS_PKV = WS_PQ + 256 * 1024, WS_Y = 74 * MiB, WS_R = 122 * MiB;
constexpr size_t R_P = WS_R, R_SI = WS_R + 52 * MiB, R_Q = WS_R + 100 * MiB, R_KM = WS_R + 112 * MiB, R_VT = WS_R + 124 * MiB;
constexpr size_t R_GS = WS_R, R_MS = WS_R + 32 * MiB, R_MG = WS_R + 96 * MiB, R_MEMB = WS_R + 128 * MiB;
constexpr size_t R_MK = WS_R, R_MVT = WS_R + 2 * MiB, R_XQ = WS_R + 32 * MiB, R_XO = WS_R + 48 * MiB, R_H = WS_R;
constexpr size_t WS_AG = WS_R + 132 * MiB;
constexpr size_t WS_END = WS_AG + 2 * MiB;
static_assert(WS_END <= 256 * MiB, "ws");

struct Params { const float* in[43]; float* out; unsigned char* ws; };
typedef const __attribute__((address_space(4))) Params* KP;
enum { I_X = 0, I_MEM, I_POS, I_NMIX, I_NXA, I_NMEM, I_NFFN, I_WIN, I_BGATE, I_MU, I_W0, I_WUP, I_A0, I_AUP, I_GUP, I_KK, I_KA, I_RK, I_LNG, I_LNB,
       I_CW, I_CB, I_WA, I_BA, I_WX, I_BX, I_LAM, I_QN, I_WUQ, I_KVN, I_WUKV, I_QG, I_KG, I_WBR, I_WOUT, I_XWQ, I_XWKV, I_XQG, I_XKG, I_XWO, I_W1, I_W3, I_W2 };

__device__ __forceinline__ float rstd16(const float* part, int row) {
    const f32x4* p = (const f32x4*)(part + (size_t)row * 16); const f32x4 a = p[0], b = p[1], c = p[2], d = p[3];
    const float s = ((a.x + a.y) + (a.z + a.w)) + ((b.x + b.y) + (b.z + b.w)) + ((c.x + c.y) + (c.z + c.w)) + ((d.x + d.y) + (d.z + d.w));
    return rsqrtf(s * (1.f / 1024.f) + 1e-6f);
}
__device__ __forceinline__ float rstd4(const float* pp, int row, float invn) { const f32x4 a = *(const f32x4*)(pp + (size_t)row * 4); return rsqrtf(((a.x + a.y) + (a.z + a.w)) * invn + 1e-6f); }
__device__ __forceinline__ float sumsq8(f32x4 a, f32x4 b) { return (a.x * a.x + a.y * a.y) + (a.z * a.z + a.w * a.w) + (b.x * b.x + b.y * b.y) + (b.z * b.z + b.w * b.w); }
#define EPI_HEAD static constexpr bool PERM = true; \
    __device__ __forceinline__ void operator()(const f32x4 (&acc)[2][2][4][2], const pg8::Unit& u, int wr, int wc, int fr, int fq) const
#define EPI_ROWS _Pragma("unroll") for (int ai = 0; ai < 2; ++ai) _Pragma("unroll") for (int m = 0; m < 4; ++m) if ((__builtin_amdgcn_sched_barrier(0), true))
#define EPI_ROW (u.pm * 256 + ai * 128 + wr * 64 + m * 16 + fr)

struct EpiP {
    bf16* P; const float* part; float* pq; float* pkv;
    EPI_HEAD {
        const int col0 = u.pn * 256 + wc * 32 + 8 * fq;
        EPI_ROWS { const int row = EPI_ROW; const float rs = rstd16(part, row); float ss = 0.f;
#pragma unroll
            for (int bj = 0; bj < 2; ++bj) { const f32x4 v0 = acc[ai][bj][m][0] * rs, v1 = acc[ai][bj][m][1] * rs;
                *(u32x4*)(P + (size_t)row * NP + col0 + bj * 128) = pk8(v0, v1);
                if (u.pn == 11 || bj == 0) ss += sumsq8(v0, v1); }
            if (u.pn == 11 || u.pn == 12) { ss += __shfl_xor(ss, 16); ss += __shfl_xor(ss, 32); if (fq == 0) (u.pn == 11 ? pq : pkv)[(size_t)row * 4 + wc] = ss; } }
    }
};
struct EpiQ {
    bf16* Q; const float* pq;
    EPI_HEAD {
        const int col0 = u.pn * 256 + wc * 32 + 8 * fq;
        EPI_ROWS { const int row = EPI_ROW; const float rs = rstd4(pq, row, 1.f / 256.f);
#pragma unroll
            for (int bj = 0; bj < 2; ++bj) *(u32x4*)(Q + (size_t)row * 768 + col0 + bj * 128) = pk8(acc[ai][bj][m][0] * rs, acc[ai][bj][m][1] * rs); }
    }
};
struct EpiKV {
    bf16* Km; bf16* Vt; const float* pkv;
    EPI_HEAD {
        const int j0 = wc * 32 + 8 * fq;
        EPI_ROWS { const int row = EPI_ROW; const float rs = rstd4(pkv, row, 1.f / 128.f);
#pragma unroll
            for (int bj = 0; bj < 2; ++bj) { const int h = 2 * u.pn + bj; const f32x4 v0 = acc[ai][bj][m][0] * rs, v1 = acc[ai][bj][m][1] * rs;
                if (wc < 2) *(u32x4*)(Km + (size_t)row * 768 + h * 96 + j0) = pk8(v0, v1);
                else { const int bl = row >> 11, t = row & 2047; bf16* vp = Vt + ((size_t)(bl * 8 + h) * 64 + (j0 - 64)) * 2048 + t;
                    vp[0 * 2048] = (bf16)f2bf(v0.x); vp[1 * 2048] = (bf16)f2bf(v0.y); vp[2 * 2048] = (bf16)f2bf(v0.z); vp[3 * 2048] = (bf16)f2bf(v0.w);
                    vp[4 * 2048] = (bf16)f2bf(v1.x); vp[5 * 2048] = (bf16)f2bf(v1.y); vp[6 * 2048] = (bf16)f2bf(v1.z); vp[7 * 2048] = (bf16)f2bf(v1.w); } } }
    }
};
struct EpiGate {
    bf16* GS; const float* part; const float* bg;
    EPI_HEAD {
        const int col0 = u.pn * 256 + wc * 32 + 8 * fq;
        f32x4 b0[2], b1[2];
#pragma unroll
        for (int bj = 0; bj < 2; ++bj) { b0[bj] = *(const f32x4*)(bg + col0 + bj * 128); b1[bj] = *(const f32x4*)(bg + col0 + bj * 128 + 4); }
        EPI_ROWS { const int row = EPI_ROW; const float rs = rstd16(part, row);
#pragma unroll
            for (int bj = 0; bj < 2; ++bj) { f32x4 v0 = acc[ai][bj][m][0] * rs + b0[bj], v1 = acc[ai][bj][m][1] * rs + b1[bj];
#pragma unroll
                for (int e = 0; e < 4; ++e) { v0[e] = fsig(v0[e]); v1[e] = fsig(v1[e]); }
                *(u32x4*)(GS + (size_t)row * 1024 + col0 + bj * 128) = pk8(v0, v1); } }
    }
};
struct EpiProj {
    const bf16* GS; float* MS; bf16* MG; int n;
    EPI_HEAD {
        const int col0 = u.pn * 256 + wc * 32 + 8 * fq;
        EPI_ROWS { const int row = EPI_ROW;
#pragma unroll
            for (int bj = 0; bj < 2; ++bj) { const size_t o = (size_t)row * 1024 + col0 + bj * 128; const u32x4 gw = *(const u32x4*)(GS + o);
                f32x4 v0 = acc[ai][bj][m][0], v1 = acc[ai][bj][m][1];
                v0.x *= bflo(gw.x); v0.y *= bfhi(gw.x); v0.z *= bflo(gw.y); v0.w *= bfhi(gw.y); v1.x *= bflo(gw.z); v1.y *= bfhi(gw.z); v1.z *= bflo(gw.w); v1.w *= bfhi(gw.w);
                if (n > 0) { v0 += *(const f32x4*)(MS + o); v1 += *(const f32x4*)(MS + o + 4); }
                if (n < 2) { *(f32x4*)(MS + o) = v0; *(f32x4*)(MS + o + 4) = v1; } else *(u32x4*)(MG + o) = pk8(v0, v1); } }
    }
};
struct EpiRes {
    const float* xold; float* xout; bf16* xb; float* part; int nowrite = 0;
    EPI_HEAD {
        const int col0 = u.pn * 256 + wc * 32 + 8 * fq;
        EPI_ROWS { const int row = EPI_ROW; float ss = 0.f;
#pragma unroll
            for (int bj = 0; bj < 2; ++bj) { const size_t o = (size_t)row * 1024 + col0 + bj * 128;
                const f32x4 v0 = acc[ai][bj][m][0] + *(const f32x4*)(xold + o), v1 = acc[ai][bj][m][1] + *(const f32x4*)(xold + o + 4);
                if (!nowrite) { *(f32x4*)(xout + o) = v0; *(f32x4*)(xout + o + 4) = v1; *(u32x4*)(xb + o) = pk8(v0, v1); } ss += sumsq8(v0, v1); }
            ss += __shfl_xor(ss, 16); ss += __shfl_xor(ss, 32); if (fq == 0 && !nowrite) part[(size_t)row * 16 + u.pn * 4 + wc] = ss; }
    }
};
struct EpiXQ {
    bf16* Q; const float* part;
    EPI_HEAD {
        const int col0 = u.pn * 256 + wc * 32 + 8 * fq;
        EPI_ROWS { const int row = EPI_ROW; const float rs = rstd16(part, row);
#pragma unroll
            for (int bj = 0; bj < 2; ++bj) *(u32x4*)(Q + (size_t)row * 512 + col0 + bj * 128) = pk8(acc[ai][bj][m][0] * rs, acc[ai][bj][m][1] * rs); }
    }
};
struct EpiBf {
    bf16* O; int ld;
    EPI_HEAD {
        const int col0 = u.pn * 256 + wc * 32 + 8 * fq;
        EPI_ROWS { const int row = EPI_ROW;
#pragma unroll
            for (int bj = 0; bj < 2; ++bj) *(u32x4*)(O + (size_t)row * ld + col0 + bj * 128) = pk8(acc[ai][bj][m][0], acc[ai][bj][m][1]); }
    }
};
struct EpiMemKV {
    bf16* mk; bf16* mVt;
    EPI_HEAD {
        const int j0 = wc * 32 + 8 * fq, h = u.pn;
        EPI_ROWS { const int row = EPI_ROW;
            *(u32x4*)(mk + (size_t)row * 512 + h * 128 + j0) = pk8(acc[ai][0][m][0], acc[ai][0][m][1]);
            const f32x4 v0 = acc[ai][1][m][0], v1 = acc[ai][1][m][1]; const int b = row >> 8, key = row & 255;
            bf16* vp = mVt + ((size_t)(b * 4 + h) * 128 + j0) * 256 + key;
            vp[0 * 256] = (bf16)f2bf(v0.x); vp[1 * 256] = (bf16)f2bf(v0.y); vp[2 * 256] = (bf16)f2bf(v0.z); vp[3 * 256] = (bf16)f2bf(v0.w);
            vp[4 * 256] = (bf16)f2bf(v1.x); vp[5 * 256] = (bf16)f2bf(v1.y); vp[6 * 256] = (bf16)f2bf(v1.z); vp[7 * 256] = (bf16)f2bf(v1.w); }
    }
};
struct EpiFFN1 {
    bf16* H; const float* part;
    EPI_HEAD {
        const int hc0 = (u.pn * 256 + wc * 32 + 8 * fq) >> 1;
        EPI_ROWS { const int row = EPI_ROW; const float rs = rstd16(part, row);
#pragma unroll
            for (int bj = 0; bj < 2; ++bj) { const f32x4 a1 = acc[ai][bj][m][0] * rs, a3 = acc[ai][bj][m][1] * rs; f32x4 hv;
#pragma unroll
                for (int e = 0; e < 4; ++e) hv[e] = a1[e] * fsig(a1[e]) * a3[e];
                u32x2 w; w.x = pk2(hv.x, hv.y); w.y = pk2(hv.z, hv.w);
                *(u32x2*)(H + (size_t)row * DFF + hc0 + bj * 64) = w; } }
    }
};

__device__ __forceinline__ void conv_job(const float* W, int ldw, int c0, int ncols, int kblk, const float* gain, bf16* WT, int K, int mode, float* scr, int gw, int NGW, int lane, int& off) {
    const int nblk = (ncols + 63) >> 6, nitems = nblk * kblk;
    int it0 = (gw - off) % NGW; if (it0 < 0) it0 += NGW;
    off = (off + nitems) % NGW;
    const int kq = lane >> 4, nq = lane & 15;
    for (int it = it0; it < nitems; it += NGW) {
        const int kb = it / nblk, nb = it % nblk, k0 = 64 * kb, n0 = 64 * nb;
        const bool ld_ok = (n0 + 4 * nq) < ncols;
        f32x4 v[16];
#pragma unroll
        for (int i = 0; i < 16; ++i) { v[i] = (f32x4){0.f, 0.f, 0.f, 0.f}; if (ld_ok) v[i] = *(const f32x4*)(W + (size_t)(k0 + 4 * i + kq) * ldw + c0 + n0 + 4 * nq); }
#pragma unroll
        for (int i = 0; i < 16; ++i) { const int kk = 4 * i + kq; const float gg = gain ? gain[k0 + kk] : 1.f; float* d = scr + kk * 65 + 4 * nq;
            d[0] = v[i].x * gg; d[1] = v[i].y * gg; d[2] = v[i].z * gg; d[3] = v[i].w * gg; }
        __builtin_amdgcn_wave_barrier(); asm volatile("s_waitcnt lgkmcnt(0)" ::: "memory");
        const int c = lane & 7;
#pragma unroll
        for (int jx = 0; jx < 8; ++jx) { const int nl = (lane >> 3) + 8 * jx, n = n0 + nl; const float* sp = scr + (8 * c) * 65 + nl;
            u32x4 o; o.x = pk2(sp[0 * 65], sp[1 * 65]); o.y = pk2(sp[2 * 65], sp[3 * 65]); o.z = pk2(sp[4 * 65], sp[5 * 65]); o.w = pk2(sp[6 * 65], sp[7 * 65]);
            const int dr = mode == 0 ? n : (8 * (n >> 2) + (n & 3) + (mode == 2 ? 4 : 0));
            if (n < ncols) *(u32x4*)(WT + (size_t)dr * K + k0 + 8 * c) = o; }
        __builtin_amdgcn_wave_barrier(); asm volatile("s_waitcnt lgkmcnt(0)" ::: "memory");
    }
}

__device__ __forceinline__ void phase_convert(int wid_s, KP p_, int l, float* ldsf) {
    KP p = p_; asm volatile("" : "+s"(p));
    unsigned char* ws = p->ws;
    const int tid_ = mk_tid(wid_s);
    const int tid = tid_, lane = tid & 63, wv = tid >> 6;
    const int gw = blockIdx.x * 8 + wv, NGW = gridDim.x * 8;
    float* scr = ldsf + wv * (64 * 65); int off = 0;
    const float* nmix = p->in[I_NMIX] + l * 1024;
    conv_job(p->in[I_WIN] + (size_t)l * 1024 * DIN, DIN, 0, 3232, 16, nmix, (bf16*)(ws + W_IN), 1024, 0, scr, gw, NGW, lane, off);
    conv_job(p->in[I_WIN] + (size_t)l * 1024 * DIN, DIN, 3232, 3072, 16, nmix, (bf16*)(ws + W_GATE), 1024, 0, scr, gw, NGW, lane, off);
    for (int n = 0; n < 3; ++n) conv_job(p->in[I_WBR] + ((size_t)l * 3 + n) * 512 * 1024, 1024, 0, 1024, 8, nullptr, (bf16*)(ws + W_BR) + (size_t)n * 1024 * 512, 512, 0, scr, gw, NGW, lane, off);
    conv_job(p->in[I_WOUT] + (size_t)l * 1024 * 1024, 1024, 0, 1024, 16, nullptr, (bf16*)(ws + W_OUT), 1024, 0, scr, gw, NGW, lane, off);
    conv_job(p->in[I_WUQ] + (size_t)l * 256 * 768, 768, 0, 768, 4, p->in[I_QN] + l * 256, (bf16*)(ws + W_MQ), 256, 0, scr, gw, NGW, lane, off);
    conv_job(p->in[I_WUKV] + (size_t)l * 128 * 1024, 1024, 0, 1024, 2, p->in[I_KVN] + l * 128, (bf16*)(ws + W_MKV), 128, 0, scr, gw, NGW, lane, off);
    conv_job(p->in[I_XWQ] + (size_t)l * 1024 * 512, 512, 0, 512, 16, p->in[I_NXA] + l * 1024, (bf16*)(ws + W_XQ), 1024, 0, scr, gw, NGW, lane, off);
    conv_job(p->in[I_XWKV] + (size_t)l * 1024 * 1024, 1024, 0, 1024, 16, p->in[I_NMEM] + l * 1024, (bf16*)(ws + W_XKV), 1024, 0, scr, gw, NGW, lane, off);
    conv_job(p->in[I_XWO] + (size_t)l * 512 * 1024, 1024, 0, 1024, 8, nullptr, (bf16*)(ws + W_XO), 512, 0, scr, gw, NGW, lane, off);
    conv_job(p->in[I_W1] + (size_t)l * 1024 * DFF, DFF, 0, 2816, 16, p->in[I_NFFN] + l * 1024, (bf16*)(ws + W_13), 1024, 1, scr, gw, NGW, lane, off);
    conv_job(p->in[I_W3] + (size_t)l * 1024 * DFF, DFF, 0, 2816, 16, p->in[I_NFFN] + l * 1024, (bf16*)(ws + W_13), 1024, 2, scr, gw, NGW, lane, off);
    conv_job(p->in[I_W2] + (size_t)l * DFF * 1024, 1024, 0, 1024, 44, nullptr, (bf16*)(ws + W_2), DFF, 0, scr, gw, NGW, lane, off);
    conv_job(p->in[I_WUP] + (size_t)l * 64 * 512, 512, 0, 512, 1, nullptr, (bf16*)(ws + W_BWA), 128, 0, scr, gw, NGW, lane, off);
    conv_job(p->in[I_AUP] + (size_t)l * 64 * 512, 512, 0, 512, 1, nullptr, (bf16*)(ws + W_BWA) + 512 * 128 + 64, 128, 0, scr, gw, NGW, lane, off);
    conv_job(p->in[I_GUP] + (size_t)l * 128 * 512, 512, 0, 512, 2, nullptr, (bf16*)(ws + W_GUP), 128, 0, scr, gw, NGW, lane, off);
    { unsigned zz = 0u; asm volatile("" : "+v"(zz)); const u32x4 zv = {zz, zz, zz, zz};
      for (int i = blockIdx.x * 512 + tid; i < 1024 * 8; i += gridDim.x * 512) { const int row = i >> 3, ch = i & 7; *(u32x4*)((bf16*)(ws + W_BWA) + row * 128 + (row < 512 ? 64 : 0) + ch * 8) = zv; } }
    { u32x4* z = (u32x4*)((bf16*)(ws + W_IN) + (size_t)3232 * 1024); const int n16 = 96 * 1024 * 2 / 16;
      unsigned zz = 0u; asm volatile("" : "+v"(zz)); const u32x4 zv = {zz, zz, zz, zz};
      for (int i = blockIdx.x * 512 + tid; i < n16; i += gridDim.x * 512) z[i] = zv; }
    if (l == 0) {
        const float* x = p->in[I_X]; bf16* xb = (bf16*)(ws + WS_XB); float* part = (float*)(ws + WS_PART);
        for (int row = gw; row < T; row += NGW) {
            const f32x4* xr = (const f32x4*)(x + (size_t)row * 1024) + lane; float s = 0.f;
#pragma unroll
            for (int j = 0; j < 4; ++j) { const f32x4 v = xr[64 * j]; s += (v.x * v.x + v.y * v.y) + (v.z * v.z + v.w * v.w);
                u32x2 w; w.x = pk2(v.x, v.y); w.y = pk2(v.z, v.w); *((u32x2*)(xb + (size_t)row * 1024) + lane + 64 * j) = w; }
            s = wave_sum(s);
            if (lane < 16) part[(size_t)row * 16 + lane] = lane == 0 ? s : 0.f;
        }
    }
}

__device__ __forceinline__ void rope_cs(int pos, int i, float& c, float& s) {
    const float invf = exp2f(-(float)i * 0.8304820237218406f);
    const float ang = (float)pos * invf;
    const double x = (double)ang * 0.15915494309189535; const float f = (float)(x - rint(x));
    c = __builtin_amdgcn_cosf(f); s = __builtin_amdgcn_sinf(f);
}
template <int DQK, int DV, bool CAUSAL, bool MLA>
__device__ __forceinline__ void attn_unit(int wid_s, unsigned char* lds, const bf16* Qb_, int ldq, const bf16* Kb_, int ldk, const bf16* Vtb_, int ldv, bf16* Ob_, int ldo,
                                          int q0, int nkt, const float* qgain_, const int* pos_, float qscale) {
    const GAS bf16* Qb = (const GAS bf16*)Qb_; const GAS bf16* Kb = (const GAS bf16*)Kb_; const GAS bf16* Vtb = (const GAS bf16*)Vtb_; GAS bf16* Ob = (GAS bf16*)Ob_;
    const GAS float* qgain = (const GAS float*)qgain_; const GAS int* pos = (const GAS int*)pos_;
    constexpr int KS = DQK * 2 + 16, VS = 144, NKS = DQK / 32, NDT = DV / 16, KCH = DQK / 8, NKC = (64 * KCH + 511) / 512, NVC = DV * 8 / 512;
    unsigned char* Ks = lds; unsigned char* Vs = lds + 64 * KS;
    const int tid_ = mk_tid(wid_s);
    const int tid = tid_, lane = tid & 63, wv = tid >> 6, g = lane >> 4, j = lane & 15;
    const int qrow = q0 + wv * 16 + j;
    bf16x8 qf[NKS];
    {
        float qv[NKS][8]; float ss = 0.f;
#pragma unroll
        for (int ks = 0; ks < NKS; ++ks) { const u32x4 w = *(const GAS u32x4*)(Qb + (size_t)qrow * ldq + 32 * ks + 8 * g);
            qv[ks][0] = bflo(w.x); qv[ks][1] = bfhi(w.x); qv[ks][2] = bflo(w.y); qv[ks][3] = bfhi(w.y); qv[ks][4] = bflo(w.z); qv[ks][5] = bfhi(w.z); qv[ks][6] = bflo(w.w); qv[ks][7] = bfhi(w.w);
#pragma unroll
            for (int e = 0; e < 8; ++e) ss += qv[ks][e] * qv[ks][e]; }
        ss += __shfl_xor(ss, 16); ss += __shfl_xor(ss, 32);
        const float rs = rsqrtf(ss * (1.f / DQK) + 1e-6f);
#pragma unroll
        for (int ks = 0; ks < NKS; ++ks)
#pragma unroll
            for (int e = 0; e < 8; ++e) qv[ks][e] *= rs * qgain[32 * ks + 8 * g + e];
        if (MLA) {
            const int ps = pos[qrow];
#pragma unroll
            for (int e = 0; e < 8; ++e) { const float mine = qv[2][e], other = __shfl_xor(mine, 32); float c, s; rope_cs(ps, 8 * (g & 1) + e, c, s);
                qv[2][e] = (g < 2) ? (mine * c - other * s) : (mine * c + other * s); }
        }
#pragma unroll
        for (int ks = 0; ks < NKS; ++ks) { u32x4 w; w.x = pk2(qv[ks][0] * qscale, qv[ks][1] * qscale); w.y = pk2(qv[ks][2] * qscale, qv[ks][3] * qscale);
            w.z = pk2(qv[ks][4] * qscale, qv[ks][5] * qscale); w.w = pk2(qv[ks][6] * qscale, qv[ks][7] * qscale); qf[ks] = __builtin_bit_cast(bf16x8, w); }
    }
    f32x4 oT[NDT];
#pragma unroll
    for (int d = 0; d < NDT; ++d) oT[d] = (f32x4){0.f, 0.f, 0.f, 0.f};
    float mrun = -INFINITY, lsum = 0.f;
    u32x4 kreg[NKC], vreg[NVC];
#define ATT_PREFETCH(kt) do { _Pragma("unroll") for (int i = 0; i < NKC; ++i) { const int idx = tid + 512 * i; if (idx < 64 * KCH) { const int key = idx / KCH, ch = idx % KCH; \
            kreg[i] = *(const GAS u32x4*)(Kb + (size_t)(64 * (kt) + key) * ldk + ch * 8); } } \
        _Pragma("unroll") for (int i = 0; i < NVC; ++i) { const int idx = tid + 512 * i; const int dv = idx >> 3, ch = idx & 7; vreg[i] = *(const GAS u32x4*)(Vtb + (size_t)dv * ldv + 64 * (kt) + ch * 8); } } while (0)
    ATT_PREFETCH(0);
    for (int kt = 0; kt < nkt; ++kt) {
        LBAR();
#pragma unroll
        for (int i = 0; i < NKC; ++i) { const int idx = tid + 512 * i; if (idx < 64 * KCH) { const int key = idx / KCH, ch = idx % KCH; *(u32x4*)(Ks + key * KS + ch * 16) = kreg[i]; } }
#pragma unroll
        for (int i = 0; i < NVC; ++i) { const int idx = tid + 512 * i; const int dv = idx >> 3, ch = idx & 7; *(u32x4*)(Vs + dv * VS + ch * 16) = vreg[i]; }
        LBAR();
        if (kt + 1 < nkt) ATT_PREFETCH(kt + 1);
        const int qw0 = q0 + wv * 16;
        if (CAUSAL && 64 * kt > qw0 + 15) continue;
        f32x4 sT[4];
#pragma unroll
        for (int k4 = 0; k4 < 4; ++k4) { sT[k4] = (f32x4){0.f, 0.f, 0.f, 0.f};
#pragma unroll
            for (int ks = 0; ks < NKS; ++ks) { const bf16x8 a = *(const bf16x8*)(Ks + (16 * k4 + j) * KS + (32 * ks + 8 * g) * 2);
                sT[k4] = __builtin_amdgcn_mfma_f32_16x16x32_bf16(a, qf[ks], sT[k4], 0, 0, 0); } }
        if (CAUSAL && 64 * kt + 63 > qw0) {
#pragma unroll
            for (int k4 = 0; k4 < 4; ++k4)
#pragma unroll
                for (int r = 0; r < 4; ++r) if (64 * kt + 16 * k4 + 4 * g + r > qrow) sT[k4][r] = -INFINITY;
        }
        float mx = -INFINITY;
#pragma unroll
        for (int k4 = 0; k4 < 4; ++k4) mx = fmaxf(mx, fmaxf(fmaxf(sT[k4][0], sT[k4][1]), fmaxf(sT[k4][2], sT[k4][3])));
        mx = fmaxf(mx, __shfl_xor(mx, 16)); mx = fmaxf(mx, __shfl_xor(mx, 32));
        const float mnew = fmaxf(mrun, mx); const float alpha = __builtin_amdgcn_exp2f(mrun - mnew); mrun = mnew;
        float psum = 0.f;
#pragma unroll
        for (int k4 = 0; k4 < 4; ++k4)
#pragma unroll
            for (int r = 0; r < 4; ++r) { const float pv = __builtin_amdgcn_exp2f(sT[k4][r] - mnew); sT[k4][r] = pv; psum += pv; }
        lsum = lsum * alpha + psum;
#pragma unroll
        for (int d = 0; d < NDT; ++d) oT[d] *= alpha;
#pragma unroll
        for (int kc = 0; kc < 2; ++kc) {
            const bf16x8 pb = __builtin_bit_cast(bf16x8, pk8(sT[2 * kc], sT[2 * kc + 1]));
#pragma unroll
            for (int d = 0; d < NDT; ++d) { const unsigned char* vp = Vs + (16 * d + j) * VS + (32 * kc + 4 * g) * 2;
                const u32x2 lo = *(const u32x2*)vp, hi = *(const u32x2*)(vp + 32); u32x4 w; w.x = lo.x; w.y = lo.y; w.z = hi.x; w.w = hi.y;
                oT[d] = __builtin_amdgcn_mfma_f32_16x16x32_bf16(__builtin_bit_cast(bf16x8, w), pb, oT[d], 0, 0, 0); }
        }
    }
#undef ATT_PREFETCH
    lsum += __shfl_xor(lsum, 16); lsum += __shfl_xor(lsum, 32);
    const float inv = 1.f / lsum;
#pragma unroll
    for (int d = 0; d < NDT; ++d) { u32x2 w; w.x = pk2(oT[d][0] * inv, oT[d][1] * inv); w.y = pk2(oT[d][2] * inv, oT[d][3] * inv);
        *(GAS u32x2*)(Ob + (size_t)qrow * ldo + 16 * d + 4 * g) = w; }
}

__device__ __forceinline__ void lora_act_rows(int wid_s, KP p_, int l, int r) {
    KP p = p_; asm volatile("" : "+s"(p));
    unsigned char* ws = p->ws;
    const int tid_ = mk_tid(wid_s);
    const int tid = tid_;
    const bf16* P = (const bf16*)(ws + R_P); bf16* Awa = (bf16*)(ws + WS_Y) + (size_t)r * TH * 1536 + 1024; bf16* Ag = (bf16*)(ws + WS_AG);
    const float* mu = p->in[I_MU] + l * 1792 + 1536;
    const int sub = tid & 31, j0 = sub * 8;
    f32x4 m0 = *(const f32x4*)(mu + j0), m1 = *(const f32x4*)(mu + j0 + 4);
    for (int row = blockIdx.x * 16 + (tid >> 5); row < TH; row += gridDim.x * 16) {
        const u32x4 cw = *(const u32x4*)(P + (size_t)row * NP + 1536 + j0);
        u32x4 pw = {0u, 0u, 0u, 0u}; if ((row & 2047) != 0) pw = *(const u32x4*)(P + (size_t)(row - 1) * NP + 1536 + j0);
        float c[8] = {bflo(cw.x), bfhi(cw.x), bflo(cw.y), bfhi(cw.y), bflo(cw.z), bfhi(cw.z), bflo(cw.w), bfhi(cw.w)};
        const float q[8] = {bflo(pw.x), bfhi(pw.x), bflo(pw.y), bfhi(pw.y), bflo(pw.z), bfhi(pw.z), bflo(pw.w), bfhi(pw.w)};
        const float mm[8] = {m0.x, m0.y, m0.z, m0.w, m1.x, m1.y, m1.z, m1.w};
#pragma unroll
        for (int e = 0; e < 8; ++e) { float v = c[e] + (q[e] - c[e]) * mm[e];
            if (j0 < 64) v = 2.f * fsig(2.f * v) - 1.f;
            else if (j0 >= 128) v = fsig(v);
            c[e] = v; }
        u32x4 o; o.x = pk2(c[0], c[1]); o.y = pk2(c[2], c[3]); o.z = pk2(c[4], c[5]); o.w = pk2(c[6], c[7]);
        if (j0 < 128) *(u32x4*)(Awa + (size_t)row * 1536 + j0) = o; else *(u32x4*)(Ag + (size_t)row * 128 + (j0 - 128)) = o;
    }
}
__device__ __forceinline__ void si_build_tile(int wid_s, KP p_, int l, int r, int tile) {
    KP p = p_; asm volatile("" : "+s"(p));
    unsigned char* ws = p->ws;
    const int tid_ = mk_tid(wid_s);
    const int tid = tid_, lane = tid & 63, wv = tid >> 6;
    const GAS bf16* P = (const GAS bf16*)(ws + R_P); GAS bf16* SI = (GAS bf16*)(ws + R_SI); const GAS bf16* LW = (const GAS bf16*)(ws + WS_Y) + (size_t)r * TH * 1536;
    const float* mu = p->in[I_MU] + l * 1792;
    const int row0 = tile * 32;
    const int c = tid, h = wv;
    const float w0c = p->in[I_W0][l * 512 + c], a0c = p->in[I_A0][l * 512 + c], kkc = p->in[I_KK][l * 512 + c], kac = p->in[I_KA][l * 512 + c];
    const float mur = mu[c], muk = mu[512 + c], muv = mu[1024 + c];
#pragma unroll 4
    for (int t = 0; t < 32; ++t) {
        const int row = row0 + t; const bool first = (row & 2047) == 0;
        const GAS bf16* pr = P + (size_t)row * NP; const GAS bf16* pp = pr - NP;
        const float rc = bf2f(pr[c]), kc = bf2f(pr[512 + c]), vc = bf2f(pr[1024 + c]);
        const float rp = first ? 0.f : bf2f(pp[c]), kp = first ? 0.f : bf2f(pp[512 + c]), vp = first ? 0.f : bf2f(pp[1024 + c]);
        const float wl = bf2f(LW[(size_t)row * 1536 + c]), al = bf2f(LW[(size_t)row * 1536 + 512 + c]);
        const float rr = rc + (rp - rc) * mur, k = kc + (kp - kc) * muk, v = vc + (vp - vc) * muv;
        const float om = 1.f - __expf(-0.6065306597126334f * fsig(w0c + wl));
        const float a = fsig(a0c + al);
        const float kkr = k * kkc; const float ss = wave_sum(kkr * kkr); const float kk = kkr / fmaxf(sqrtf(ss), 1e-12f);
        const float k2 = k * (1.f + (a - 1.f) * kac);
        GAS bf16* o = SI + ((size_t)((row >> 11) * 8 + h) * 2048 + (row & 2047)) * 384 + lane;
        o[0] = (bf16)f2bf(rr); o[64] = (bf16)f2bf(om); o[128] = (bf16)f2bf(k2); o[192] = (bf16)f2bf(kk); o[256] = (bf16)f2bf(kk * a); o[320] = (bf16)f2bf(v);
    }
}

template <int CTRL> __device__ __forceinline__ float dppf(float x) { return __builtin_bit_cast(float, __builtin_amdgcn_update_dpp(0, __builtin_bit_cast(int, x), CTRL, 0xF, 0xF, true)); }
__device__ __forceinline__ float allreduce8(float x);
__device__ __forceinline__ float allreduce16(float x) { x += dppf<0xB1>(x); x += dppf<0x4E>(x); x += dppf<0x141>(x); x += dppf<0x140>(x); return x; }
template <int MODE>
__device__ __forceinline__ void rwkv_scan_unit(int wid_s, const bf16* SIbh_, bf16* Yb_, int ystride, int quarter, float* ldsf) {
    const int tid_ = mk_tid(wid_s);
    const GAS bf16* SIbh = (const GAS bf16*)SIbh_; GAS bf16* Yb = (GAS bf16*)Yb_;
    const int tid = tid_, lane = tid & 63, wv = tid >> 6, hw = wv - 4;
    float* PYb = ldsf + 4 * (16 * 384);
    u32x4 hreg[12];
    if (wv >= 4 && wv < 7) {
#pragma unroll
        for (int i = 0; i < 12; ++i) hreg[i] = *(const GAS u32x4*)(SIbh + (size_t)hw * (16 * 384) + (size_t)(lane + 64 * i) * 8);
    }
    f32x2 Sa = {0.f, 0.f}, Sb = {0.f, 0.f};
    const int rowl = quarter * 16 + (wv & 3) * 4 + (lane >> 4), c4 = (lane & 15) * 4;
    __syncthreads();
#define SCAN_CONVERT(cn) do { float* Bd = ldsf + ((cn) & 3) * (16 * 384); \
        _Pragma("unroll") for (int i = 0; i < 12; ++i) { float* d = Bd + (lane + 64 * i) * 8; const u32x4 w = hreg[i]; \
            *(f32x4*)d = (f32x4){bflo(w.x), bfhi(w.x), bflo(w.y), bfhi(w.y)}; *(f32x4*)(d + 4) = (f32x4){bflo(w.z), bfhi(w.z), bflo(w.w), bfhi(w.w)}; } \
        if ((cn) + 3 < 128) { _Pragma("unroll") for (int i = 0; i < 12; ++i) hreg[i] = *(const GAS u32x4*)(SIbh + (size_t)((cn) + 3) * (16 * 384) + (size_t)(lane + 64 * i) * 8); } } while (0)
    if (wv == 4) SCAN_CONVERT(0);
    for (int ch = 0; ch <= 128; ++ch) {
        LBAR();
        if (wv < 4) {
            if (ch < 128) {
                const float* B = ldsf + (ch & 3) * (16 * 384);
                float* PY = PYb + (ch & 1) * (16 * 256) + wv * 64 + lane;
                const float* q = B;
                f32x4 r4 = *(const f32x4*)(q + c4), om4 = *(const f32x4*)(q + 64 + c4), k4 = *(const f32x4*)(q + 128 + c4), kk4 = *(const f32x4*)(q + 192 + c4), ka4 = *(const f32x4*)(q + 256 + c4);
                float v = q[320 + rowl];
#pragma unroll
                for (int s = 0; s < 16; ++s) {
                    const float* qn = B + ((MODE & 2) ? 0 : ((s + 1) & 15)) * 384;
                    const f32x4 nr4 = *(const f32x4*)(qn + c4), nom4 = *(const f32x4*)(qn + 64 + c4), nk4 = *(const f32x4*)(qn + 128 + c4), nkk4 = *(const f32x4*)(qn + 192 + c4), nka4 = *(const f32x4*)(qn + 256 + c4);
                    const float nv = qn[320 + rowl];
                    const f32x2 pa = Sa * (f32x2){kk4.x, kk4.y} + Sb * (f32x2){kk4.z, kk4.w};
                    const float sa = (MODE & 1) ? (pa.x + pa.y) : allreduce16(pa.x + pa.y);
                    Sa = Sa - Sa * (f32x2){om4.x, om4.y} + (f32x2){k4.x, k4.y} * v; Sb = Sb - Sb * (f32x2){om4.z, om4.w} + (f32x2){k4.z, k4.w} * v;
                    Sa = Sa - (f32x2){ka4.x, ka4.y} * sa; Sb = Sb - (f32x2){ka4.z, ka4.w} * sa;
                    const f32x2 py = Sa * (f32x2){r4.x, r4.y} + Sb * (f32x2){r4.z, r4.w};
                    PY[s * 256] = py.x + py.y;
                    r4 = nr4; om4 = nom4; k4 = nk4; kk4 = nkk4; ka4 = nka4; v = nv;
                }
            }
        } else if (wv == 7) {
            if (ch > 0) {
                const int s = lane >> 2, rr = lane & 3;
#pragma unroll
                for (int mw = 0; mw < 4; ++mw) {
                    const float* src = PYb + ((ch - 1) & 1) * (16 * 256) + s * 256 + mw * 64 + rr * 16;
                    const f32x4 a = *(const f32x4*)src, b = *(const f32x4*)(src + 4), c = *(const f32x4*)(src + 8), d = *(const f32x4*)(src + 12);
                    const float y = ((a.x + a.y) + (a.z + a.w)) + ((b.x + b.y) + (b.z + b.w)) + ((c.x + c.y) + (c.z + c.w)) + ((d.x + d.y) + (d.z + d.w));
                    Yb[(size_t)((ch - 1) * 16 + s) * ystride + quarter * 16 + mw * 4 + rr] = (bf16)f2bf(y);
                }
            }
        } else {
            const int cn = ch + 1;
            if (cn < 128 && (cn % 3) == hw) SCAN_CONVERT(cn);
        }
    }
#undef SCAN_CONVERT
    __syncthreads();
}

__device__ __forceinline__ void rwkv_post_tile(int wid_s, KP p_, int l, int r, int tile, int dummy) {
    KP p = p_; asm volatile("" : "+s"(p));
    unsigned char* ws = p->ws;
    const int tid_ = mk_tid(wid_s);
    const int tid = tid_, lane = tid & 63, wv = tid >> 6;
    const GAS bf16* P = (const GAS bf16*)(ws + R_P); const GAS bf16* SI = (const GAS bf16*)(ws + R_SI); GAS bf16* Y = (GAS bf16*)(ws + WS_Y) + (size_t)r * TH * 1536;
    const int row0 = tile * 32;
    const int c = tid, h = wv;
    const float rkc = p->in[I_RK][l * 512 + c], lng = p->in[I_LNG][l * 512 + c], lnb = p->in[I_LNB][l * 512 + c];
#pragma unroll 4
    for (int t = 0; t < 32; ++t) {
        const int row = row0 + t;
        const GAS bf16* si = SI + ((size_t)((row >> 11) * 8 + h) * 2048 + (row & 2047)) * 384 + lane;
        const float rr = bf2f(si[0]), k2 = bf2f(si[128]), v = bf2f(si[320]);
        const float gg = bf2f(P[(size_t)row * NP + c]);
        GAS bf16* yp = Y + (size_t)row * 1536 + c;
        const float y = bf2f(*yp);
        const float mean = wave_sum(y) * (1.f / 64.f); const float d = y - mean; const float var = wave_sum(d * d) * (1.f / 64.f);
        const float yn = d * rsqrtf(var + 64e-5f) * lng + lnb;
        const float bonus = wave_sum(rr * k2 * rkc) * v;
        if (dummy) yp = (GAS bf16*)(ws + R_P) + (size_t)row * NP + 600 + c;
        *yp = (bf16)f2bf((yn + bonus) * gg);
    }
}

__device__ __forceinline__ float allreduce8(float x) { x += dppf<0xB1>(x); x += dppf<0x4E>(x); x += dppf<0x141>(x); return x; }
__device__ __forceinline__ void unpack8(const u32x4 w, float* f) { f[0] = bflo(w.x); f[1] = bfhi(w.x); f[2] = bflo(w.y); f[3] = bfhi(w.y); f[4] = bflo(w.z); f[5] = bfhi(w.z); f[6] = bflo(w.w); f[7] = bfhi(w.w); }
__device__ __forceinline__ u32x4 pack8(const float* f) { u32x4 o; o.x = pk2(f[0], f[1]); o.y = pk2(f[2], f[3]); o.z = pk2(f[4], f[5]); o.w = pk2(f[6], f[7]); return o; }
__device__ __forceinline__ void ld8f(const GAS float* q, float* f) { const f32x4 a = *(const GAS f32x4*)q, b = *(const GAS f32x4*)(q + 4); f[0] = a.x; f[1] = a.y; f[2] = a.z; f[3] = a.w; f[4] = b.x; f[5] = b.y; f[6] = b.z; f[7] = b.w; }
__device__ __forceinline__ void si_build_rows(int wid_s, KP p_, int l, int r) {
    KP p = p_; asm volatile("" : "+s"(p));
    unsigned char* ws = p->ws;
    const int tid_ = mk_tid(wid_s);
    const int tid = tid_, lane = tid & 63, wv = tid >> 6, c0 = lane * 8, h = lane >> 3;
    const GAS bf16* P = (const GAS bf16*)(ws + R_P); GAS bf16* SI = (GAS bf16*)(ws + R_SI); const GAS bf16* LW = (const GAS bf16*)(ws + WS_Y) + (size_t)r * TH * 1536;
    float w0c[8], a0c[8], kkc[8], kac[8], mur[8], muk[8], muv[8];
    ld8f((const GAS float*)p->in[I_W0] + l * 512 + c0, w0c); ld8f((const GAS float*)p->in[I_A0] + l * 512 + c0, a0c); ld8f((const GAS float*)p->in[I_KK] + l * 512 + c0, kkc); ld8f((const GAS float*)p->in[I_KA] + l * 512 + c0, kac);
    ld8f((const GAS float*)p->in[I_MU] + l * 1792 + c0, mur); ld8f((const GAS float*)p->in[I_MU] + l * 1792 + 512 + c0, muk); ld8f((const GAS float*)p->in[I_MU] + l * 1792 + 1024 + c0, muv);
    for (int row = blockIdx.x * 8 + wv; row < TH; row += gridDim.x * 8) {
        const bool first = (row & 2047) == 0;
        const GAS bf16* pr = P + (size_t)row * NP + c0; const GAS bf16* pp = pr - NP;
        const u32x4 z4 = {0u, 0u, 0u, 0u};
        const u32x4 rcw = *(const GAS u32x4*)pr, kcw = *(const GAS u32x4*)(pr + 512), vcw = *(const GAS u32x4*)(pr + 1024);
        const u32x4 rpw = first ? z4 : *(const GAS u32x4*)pp, kpw = first ? z4 : *(const GAS u32x4*)(pp + 512), vpw = first ? z4 : *(const GAS u32x4*)(pp + 1024);
        const u32x4 wlw = *(const GAS u32x4*)(LW + (size_t)row * 1536 + c0), alw = *(const GAS u32x4*)(LW + (size_t)row * 1536 + 512 + c0);
        float rc[8], kc[8], vc[8], rp[8], kp[8], vp[8], wl[8], al[8];
        unpack8(rcw, rc); unpack8(kcw, kc); unpack8(vcw, vc); unpack8(rpw, rp); unpack8(kpw, kp); unpack8(vpw, vp); unpack8(wlw, wl); unpack8(alw, al);
        float rr[8], om[8], k2[8], kk[8], ka[8], vv[8]; float ss = 0.f;
#pragma unroll
        for (int e = 0; e < 8; ++e) { rr[e] = rc[e] + (rp[e] - rc[e]) * mur[e]; const float k = kc[e] + (kp[e] - kc[e]) * muk[e]; vv[e] = vc[e] + (vp[e] - vc[e]) * muv[e];
            om[e] = 1.f - __expf(-0.6065306597126334f * fsig(w0c[e] + wl[e]));
            const float a = fsig(a0c[e] + al[e]);
            kk[e] = k * kkc[e]; ss += kk[e] * kk[e]; k2[e] = k * (1.f + (a - 1.f) * kac[e]); ka[e] = a; }
        ss = allreduce8(ss);
        const float inv = 1.f / fmaxf(sqrtf(ss), 1e-12f);
#pragma unroll
        for (int e = 0; e < 8; ++e) { kk[e] *= inv; ka[e] *= kk[e]; }
        GAS bf16* o = SI + ((size_t)((row >> 11) * 8 + h) * 2048 + (row & 2047)) * 384 + (lane & 7) * 8;
        *(GAS u32x4*)o = pack8(rr); *(GAS u32x4*)(o + 64) = pack8(om); *(GAS u32x4*)(o + 128) = pack8(k2); *(GAS u32x4*)(o + 192) = pack8(kk); *(GAS u32x4*)(o + 256) = pack8(ka); *(GAS u32x4*)(o + 320) = pack8(vv);
    }
}
__device__ __forceinline__ void rwkv_post_rows(int wid_s, KP p_, int l, int r, int dummy) {
    KP p = p_; asm volatile("" : "+s"(p));
    unsigned char* ws = p->ws;
    const int tid_ = mk_tid(wid_s);
    const int tid = tid_, lane = tid & 63, wv = tid >> 6, c0 = lane * 8, h = lane >> 3;
    const GAS bf16* P = (const GAS bf16*)(ws + R_P); const GAS bf16* SI = (const GAS bf16*)(ws + R_SI); GAS bf16* Y = (GAS bf16*)(ws + WS_Y) + (size_t)r * TH * 1536;
    float rkc[8], lng[8], lnb[8];
    ld8f((const GAS float*)p->in[I_RK] + l * 512 + c0, rkc); ld8f((const GAS float*)p->in[I_LNG] + l * 512 + c0, lng); ld8f((const GAS float*)p->in[I_LNB] + l * 512 + c0, lnb);
    for (int row = blockIdx.x * 8 + wv; row < TH; row += gridDim.x * 8) {
        const GAS bf16* si = SI + ((size_t)((row >> 11) * 8 + h) * 2048 + (row & 2047)) * 384 + (lane & 7) * 8;
        const u32x4 rw = *(const GAS u32x4*)si, kw = *(const GAS u32x4*)(si + 128), vw = *(const GAS u32x4*)(si + 320);
        const u32x4 gw = *(const GAS u32x4*)(P + (size_t)row * NP + c0);
        GAS bf16* yp = Y + (size_t)row * 1536 + c0;
        const u32x4 yw = *(const GAS u32x4*)yp;
        float rr[8], k2[8], vv[8], gg[8], y[8];
        unpack8(rw, rr); unpack8(kw, k2); unpack8(vw, vv); unpack8(gw, gg); unpack8(yw, y);
        float sy = 0.f, sb = 0.f;
#pragma unroll
        for (int e = 0; e < 8; ++e) { sy += y[e]; sb += rr[e] * k2[e] * rkc[e]; }
        const float mean = allreduce8(sy) * (1.f / 64.f); const float bonus = allreduce8(sb);
        float sv = 0.f;
#pragma unroll
        for (int e = 0; e < 8; ++e) { y[e] -= mean; sv += y[e] * y[e]; }
        const float rs = rsqrtf(allreduce8(sv) * (1.f / 64.f) + 64e-5f);
#pragma unroll
        for (int e = 0; e < 8; ++e) y[e] = (y[e] * rs * lng[e] + lnb[e] + bonus * vv[e]) * gg[e];
        if (dummy) yp = (GAS bf16*)(ws + R_P) + (size_t)row * NP + 600 + c0;
        *(GAS u32x4*)yp = pack8(y);
    }
}

__device__ __forceinline__ float gelu_tanh(float x) { const float u = 0.7978845608028654f * (x + 0.044715f * x * x * x); return x * fsig(2.f * u); }
__device__ __forceinline__ void lru_unit(int wid_s, KP p_, int l, int r, int bl, int n, float* ldsf) {
    KP p = p_; asm volatile("" : "+s"(p));
    unsigned char* ws = p->ws;
    const int tid_ = mk_tid(wid_s);
    const int tid = tid_, lane = tid & 63, wv = tid >> 6, g = lane >> 4, j = lane & 15;
    const GAS bf16* P = (const GAS bf16*)(ws + R_P) + (size_t)bl * 2048 * NP; GAS bf16* Yb = (GAS bf16*)(ws + WS_Y) + ((size_t)(r * 4 + bl) * 2048) * 1536 + 512;
    const int cg_ = n * 64 + lane;
    float* s_xc = ldsf;
    float* s_a = ldsf + 8192;
    float* s_u = ldsf + 16384;
    float* s_AH = ldsf + 24576;
    unsigned char* s_xb16 = (unsigned char*)ldsf + 102400;
    unsigned char* s_wt16 = (unsigned char*)ldsf + 120832;
    LBAR();
    for (int e = tid; e < 8192; e += 512) { const int jj = e >> 6, ii = e & 63;
        const float w = (jj < 64) ? p->in[I_WA][((size_t)l * 8 + n) * 4096 + ii * 64 + jj] : p->in[I_WX][((size_t)l * 8 + n) * 4096 + ii * 64 + (jj - 64)];
        *(bf16*)(s_wt16 + (jj * 72 + ii) * 2) = (bf16)f2bf(w); }
    const float cw0 = p->in[I_CW][(l * 4 + 0) * 512 + cg_], cw1 = p->in[I_CW][(l * 4 + 1) * 512 + cg_], cw2 = p->in[I_CW][(l * 4 + 2) * 512 + cg_], cw3 = p->in[I_CW][(l * 4 + 3) * 512 + cg_];
    const float cb = p->in[I_CB][l * 512 + cg_];
    float ba4[4], bx4[4], sp4[4];
#pragma unroll
    for (int n4 = 0; n4 < 4; ++n4) { const int c = n * 64 + 16 * n4 + j; ba4[n4] = p->in[I_BA][l * 512 + c]; bx4[n4] = p->in[I_BX][l * 512 + c];
        sp4[n4] = -8.f * 1.4426950408889634f * log1pf(__expf(-p->in[I_LAM][l * 512 + c])); }
    float hcar = 0.f;
    for (int tile = 0; tile < 16; ++tile) {
        const int t0 = tile * 128 + wv * 16;
        float xc[16]; unsigned short gbr[16];
        {
            float x3 = (t0 >= 3) ? bf2f(P[(size_t)(t0 - 3) * NP + 1792 + cg_]) : 0.f, x2 = (t0 >= 2) ? bf2f(P[(size_t)(t0 - 2) * NP + 1792 + cg_]) : 0.f, x1 = (t0 >= 1) ? bf2f(P[(size_t)(t0 - 1) * NP + 1792 + cg_]) : 0.f;
#pragma unroll
            for (int i = 0; i < 16; ++i) { const float x0 = bf2f(P[(size_t)(t0 + i) * NP + 1792 + cg_]);
                xc[i] = cw0 * x3 + cw1 * x2 + cw2 * x1 + cw3 * x0 + cb; x3 = x2; x2 = x1; x1 = x0; }
#pragma unroll
            for (int i = 0; i < 16; ++i) gbr[i] = P[(size_t)(t0 + i) * NP + 2304 + cg_];
        }
        LBAR();
#pragma unroll
        for (int i = 0; i < 16; ++i) { s_xc[(wv * 16 + i) * 64 + lane] = xc[i]; *(bf16*)(s_xb16 + ((wv * 16 + i) * 72 + lane) * 2) = (bf16)f2bf(xc[i]); }
        LBAR();
        {
            f32x4 acc[8];
            const bf16x8 a0 = *(const bf16x8*)(s_xb16 + ((16 * wv + j) * 72 + 8 * g) * 2), a1 = *(const bf16x8*)(s_xb16 + ((16 * wv + j) * 72 + 32 + 8 * g) * 2);
#pragma unroll
            for (int nn = 0; nn < 8; ++nn) { acc[nn] = (f32x4){0.f, 0.f, 0.f, 0.f};
                const bf16x8 b0 = *(const bf16x8*)(s_wt16 + ((16 * nn + j) * 72 + 8 * g) * 2), b1 = *(const bf16x8*)(s_wt16 + ((16 * nn + j) * 72 + 32 + 8 * g) * 2);
                acc[nn] = __builtin_amdgcn_mfma_f32_16x16x32_bf16(a0, b0, acc[nn], 0, 0, 0); acc[nn] = __builtin_amdgcn_mfma_f32_16x16x32_bf16(a1, b1, acc[nn], 0, 0, 0); }
#pragma unroll
            for (int n4 = 0; n4 < 4; ++n4)
#pragma unroll
                for (int rr = 0; rr < 4; ++rr) { const int tk = 16 * wv + 4 * g + rr, c = 16 * n4 + j;
                    const float rg = fsig(acc[n4][rr] + ba4[n4]), ig = fsig(acc[n4 + 4][rr] + bx4[n4]);
                    const float a = __builtin_amdgcn_exp2f(sp4[n4] * rg);
                    const float uu = __builtin_amdgcn_sqrtf(fmaxf(1.f - a * a, 0.f)) * (ig * s_xc[tk * 64 + c]);
                    s_a[tk * 64 + c] = a; s_u[tk * 64 + c] = uu; }
        }
        LBAR();
        float av[16], uv[16]; float A = 1.f, H = 0.f;
#pragma unroll
        for (int i = 0; i < 16; ++i) { av[i] = s_a[(wv * 16 + i) * 64 + lane]; uv[i] = s_u[(wv * 16 + i) * 64 + lane]; A *= av[i]; H = av[i] * H + uv[i]; }
        s_AH[(wv * 64 + lane) * 2] = A; s_AH[(wv * 64 + lane) * 2 + 1] = H;
        LBAR();
        float hin = hcar, hall = hcar;
#pragma unroll
        for (int w = 0; w < 8; ++w) { const float Aw = s_AH[(w * 64 + lane) * 2], Hw = s_AH[(w * 64 + lane) * 2 + 1]; hall = Aw * hall + Hw; if (w < wv) hin = hall; }
        hcar = hall;
        float hh = hin;
#pragma unroll
        for (int i = 0; i < 16; ++i) { hh = av[i] * hh + uv[i];
            Yb[(size_t)(t0 + i) * 1536 + cg_] = (bf16)f2bf(hh * gelu_tanh(bf2f(gbr[i]))); }
    }
    LBAR();
}

__device__ __forceinline__ void kfix_rows(int wid_s, KP p_, int l, int r) {
    KP p = p_; asm volatile("" : "+s"(p));
    unsigned char* ws = p->ws;
    const int tid_ = mk_tid(wid_s);
    const int tid = tid_, lane = tid & 63, wv = tid >> 6, h = lane >> 3, sub = lane & 7;
    const GAS bf16* P = (const GAS bf16*)(ws + R_P); GAS bf16* Km = (GAS bf16*)(ws + R_KM);
    const float* kg = p->in[I_KG] + l * 96; const int* pos = (const int*)p->in[I_POS] + r * TH;
    for (int row = blockIdx.x * 8 + wv; row < TH; row += gridDim.x * 8) {
        GAS bf16* kp = Km + (size_t)row * 768 + h * 96;
        const u32x4 w = *(const GAS u32x4*)(kp + 8 * sub);
        float nv[8] = {bflo(w.x), bfhi(w.x), bflo(w.y), bfhi(w.y), bflo(w.z), bfhi(w.z), bflo(w.w), bfhi(w.w)};
        const unsigned k1 = *(const GAS unsigned*)(P + (size_t)row * NP + 3200 + 2 * sub), k2 = *(const GAS unsigned*)(P + (size_t)row * NP + 3216 + 2 * sub);
        float x1a = bflo(k1), x1b = bfhi(k1), x2a = bflo(k2), x2b = bfhi(k2);
        float ss = x1a * x1a + x1b * x1b + x2a * x2a + x2b * x2b;
#pragma unroll
        for (int e = 0; e < 8; ++e) ss += nv[e] * nv[e];
        ss += __shfl_xor(ss, 1); ss += __shfl_xor(ss, 2); ss += __shfl_xor(ss, 4);
        const float rs = rsqrtf(ss * (1.f / 96.f) + 1e-6f);
#pragma unroll
        for (int e = 0; e < 8; ++e) nv[e] *= rs * kg[8 * sub + e];
        x1a *= rs * kg[64 + 2 * sub]; x1b *= rs * kg[65 + 2 * sub]; x2a *= rs * kg[80 + 2 * sub]; x2b *= rs * kg[81 + 2 * sub];
        const int ps = pos[row]; float ca, sa, cb, sb; rope_cs(ps, 2 * sub, ca, sa); rope_cs(ps, 2 * sub + 1, cb, sb);
        u32x4 o; o.x = pk2(nv[0], nv[1]); o.y = pk2(nv[2], nv[3]); o.z = pk2(nv[4], nv[5]); o.w = pk2(nv[6], nv[7]);
        *(GAS u32x4*)(kp + 8 * sub) = o;
        *(GAS unsigned*)(kp + 64 + 2 * sub) = pk2(x1a * ca - x2a * sa, x1b * cb - x2b * sb);
        *(GAS unsigned*)(kp + 80 + 2 * sub) = pk2(x2a * ca + x1a * sa, x2b * cb + x1b * sb);
    }
}
__device__ __forceinline__ void mkfix_rows(int wid_s, KP p_, int l) {
    KP p = p_; asm volatile("" : "+s"(p));
    unsigned char* ws = p->ws;
    const int tid_ = mk_tid(wid_s);
    const int tid = tid_, lane = tid & 63, wv = tid >> 6, h = lane >> 4, sub = lane & 15;
    bf16* mk = (bf16*)(ws + R_MK); const float* kg = p->in[I_XKG] + l * 128;
    for (int row = blockIdx.x * 8 + wv; row < 2048; row += gridDim.x * 8) {
        bf16* kp = mk + (size_t)row * 512 + h * 128 + 8 * sub;
        const u32x4 w = *(const u32x4*)kp;
        float nv[8] = {bflo(w.x), bfhi(w.x), bflo(w.y), bfhi(w.y), bflo(w.z), bfhi(w.z), bflo(w.w), bfhi(w.w)};
        float ss = 0.f;
#pragma unroll
        for (int e = 0; e < 8; ++e) ss += nv[e] * nv[e];
        ss += __shfl_xor(ss, 1); ss += __shfl_xor(ss, 2); ss += __shfl_xor(ss, 4); ss += __shfl_xor(ss, 8);
        const float rs = rsqrtf(ss * (1.f / 128.f) + 1e-6f);
#pragma unroll
        for (int e = 0; e < 8; ++e) nv[e] *= rs * kg[8 * sub + e];
        u32x4 o; o.x = pk2(nv[0], nv[1]); o.y = pk2(nv[2], nv[3]); o.z = pk2(nv[4], nv[5]); o.w = pk2(nv[6], nv[7]);
        *(u32x4*)kp = o;
    }
}
__device__ __forceinline__ void memb_rows(int wid_s, KP p_) {
    KP p = p_; asm volatile("" : "+s"(p));
    unsigned char* ws = p->ws;
    const int tid_ = mk_tid(wid_s);
    const int tid = tid_, lane = tid & 63, wv = tid >> 6;
    const float* mem = p->in[I_MEM]; bf16* memb = (bf16*)(ws + R_MEMB);
    for (int row = blockIdx.x * 8 + wv; row < 2048; row += gridDim.x * 8) {
        const f32x4* xr = (const f32x4*)(mem + (size_t)row * 1024) + lane; f32x4 v[4]; float s = 0.f;
#pragma unroll
        for (int jq = 0; jq < 4; ++jq) { v[jq] = xr[64 * jq]; s += (v[jq].x * v[jq].x + v[jq].y * v[jq].y) + (v[jq].z * v[jq].z + v[jq].w * v[jq].w); }
        const float rs = rsqrtf(wave_sum(s) * (1.f / 1024.f) + 1e-6f);
#pragma unroll
        for (int jq = 0; jq < 4; ++jq) { u32x2 w; w.x = pk2(v[jq].x * rs, v[jq].y * rs); w.y = pk2(v[jq].z * rs, v[jq].w * rs); *((u32x2*)(memb + (size_t)row * 1024) + lane + 64 * jq) = w; }
    }
}

#define XB_TMO      128
#define XB_XCNT(j)  (256  + 64 * (j))
#define XB_XSUB(j)  (1280 + 64 * (j))
#define XB_XGEN(j)  (2304 + 64 * (j))
#define XB_TOP      3328
#define XB_TOPGEN   3392
#define XCD_BAR_WORDS 3456
#define XB_SPIN_CAP (1u << 22)
__device__ __forceinline__ unsigned xb_ld(unsigned* p)              { return __hip_atomic_load(p, __ATOMIC_RELAXED, __HIP_MEMORY_SCOPE_AGENT); }
__device__ __forceinline__ unsigned xb_add(unsigned* p, unsigned v) { return __hip_atomic_fetch_add(p, v, __ATOMIC_RELAXED, __HIP_MEMORY_SCOPE_AGENT); }
__device__ __forceinline__ unsigned xb_xcc_id() { return (unsigned)__builtin_amdgcn_s_getreg((3 << 11) | 20) & 0xFu; }
#define XB_SPIN(cond, bar) do { unsigned _sp = 0; while (cond) { __builtin_amdgcn_s_sleep(1); \
    if ((++_sp & 255u) == 0u) { if (xb_ld(&(bar)[XB_TMO])) break; if (_sp > XB_SPIN_CAP) { atomicAdd(&(bar)[XB_TMO], 1u); break; } } } } while (0)
__device__ __forceinline__ void xcd_barrier_complete(unsigned* bar, unsigned x, unsigned& nloc, unsigned& nx) {
    const unsigned G = gridDim.x;
    unsigned sum, cnt, mine, sp = 0u;
    for (;;) {
        sum = 0u; cnt = 0u; mine = 0u;
#pragma unroll
        for (unsigned j = 0; j < 16; ++j) { const unsigned c = xb_ld(&bar[XB_XCNT(j)]); sum += c; cnt += (c > 0u) ? 1u : 0u; mine = (j == x) ? c : mine; }
        if (sum == G) break;
        __builtin_amdgcn_s_sleep(1);
        if ((++sp & 255u) == 0u) { if (xb_ld(&bar[XB_TMO])) break; if (sp > XB_SPIN_CAP) { atomicAdd(&bar[XB_TMO], 1u); break; } }
    }
    nloc = mine > 0u ? mine : 1u; nx = cnt > 0u ? cnt : 1u;
}
__device__ __forceinline__ void grid_barrier1(int wid_s, unsigned* bar, volatile unsigned* st) {
    asm volatile("s_waitcnt vmcnt(0)" ::: "memory");
    __syncthreads();
    if (mk_tid(wid_s) == 0) {
        const unsigned x = xb_xcc_id();
        __builtin_amdgcn_s_waitcnt(0);
        unsigned nloc = st[0], nx = st[1];
        if (nloc == 0u) { xcd_barrier_complete(bar, x, nloc, nx); st[0] = nloc; st[1] = nx; }
        const unsigned old = xb_add(&bar[XB_XSUB(x)], 1u);
        const unsigned gen = old / nloc;
        if (old + 1u == (gen + 1u) * nloc) {
            __builtin_amdgcn_fence(__ATOMIC_RELEASE, "agent");
            asm volatile("s_waitcnt vmcnt(0)" ::: "memory");
            const unsigned og = xb_add(&bar[XB_TOP], 1u);
            const unsigned tg = og / nx;
            if (og + 1u == (tg + 1u) * nx) xb_add(&bar[XB_TOPGEN], 1u);
            else XB_SPIN(xb_ld(&bar[XB_TOPGEN]) == tg, bar);
            __builtin_amdgcn_fence(__ATOMIC_ACQUIRE, "agent");
            xb_add(&bar[XB_XGEN(x)], 1u);
            asm volatile("s_waitcnt vmcnt(0)" ::: "memory");
        } else {
            XB_SPIN(xb_ld(&bar[XB_XGEN(x)]) == gen, bar);
            __builtin_amdgcn_fence(__ATOMIC_ACQUIRE, "agent");
            asm volatile("s_waitcnt vmcnt(0)" ::: "memory");
        }
    }
    __syncthreads();
}
__device__ __forceinline__ void grid_barrier(int wid_s, unsigned* bar, volatile unsigned* st) { int nb = 1 + RB(8); asm volatile("" : "+s"(nb)); for (int q = 0; q < nb; ++q) grid_barrier1(wid_s, bar, st); }
template <class Epi>
__device__ __forceinline__ void run_gemm(int wid_s, LAS unsigned char* lds, const bf16* A, int lda, const bf16* Bt, int M, int N, int K, const Epi& E, int shift = 0) {
    int bx_ = blockIdx.x, gx_ = gridDim.x; asm volatile("" : "+s"(bx_), "+s"(gx_), "+s"(K), "+s"(lda));
    pg8::Gemm g{A, Bt, M, N, K, lda}; pg8::StaticOrder S; S.init(M, N, gx_, (bx_ + shift) % gx_);
    if (ON(1)) pg8::gemm_phase<Epi, pg8::StaticOrder>(wid_s, lds, g, S, E);
}

__device__ __forceinline__ unsigned char* wsl_(KP p) { unsigned char* w = p->ws; asm volatile("" : "+s"(w)); return w; }
__global__ void __launch_bounds__(512, 2) fwd_kernel(Params parg) {
    KP p = (KP)__builtin_amdgcn_kernarg_segment_ptr();
    extern __shared__ __attribute__((aligned(16))) unsigned char lds_raw[];
    const int wid_s = __builtin_amdgcn_readfirstlane((int)threadIdx.x >> 6);
    LAS unsigned char* lds3 = (LAS unsigned char*)lds_raw;
    unsigned char* lds = lds_raw; float* ldsf = (float*)lds_raw;
    unsigned char* ws = p->ws;
    const int bid = blockIdx.x;
    unsigned* ctl = (unsigned*)(wsl_(p) + WS_CTL);
    bf16* xb = (bf16*)(wsl_(p) + WS_XB); float* part = (float*)(wsl_(p) + WS_PART); float* pq = (float*)(wsl_(p) + WS_PQ); float* pkv = (float*)(wsl_(p) + WS_PKV);
    bf16* Y = (bf16*)(wsl_(p) + WS_Y);
    float* xcur = p->out;
    volatile unsigned* bst = (volatile unsigned*)(lds + QIDX_OFF + 16);
    if (threadIdx.x == 0) { bst[0] = 0u; bst[1] = 0u; (void)xb_add(&ctl[1024 + XB_XCNT(xb_xcc_id())], 1u); }
    __syncthreads();

    for (int l_ = 0; l_ < 2; ++l_) {
        int l = l_; asm volatile("" : "+s"(l));
        { REPLOOP(0) { if (ON(0)) phase_convert(wid_s, p, l, ldsf);
        grid_barrier(wid_s, ctl + 1024, bst); } }
        for (int r_ = 0; r_ < 2; ++r_) {
            int r = r_; asm volatile("" : "+s"(r));
            { REPLOOP(1) { EpiP E{(bf16*)(wsl_(p) + R_P), part + (size_t)r * TH * 16, pq, pkv};
              run_gemm(wid_s, lds3, xb + (size_t)r * TH * 1024, 1024, (const bf16*)(wsl_(p) + W_IN), TH, NP, 1024, E);
            grid_barrier(wid_s, ctl + 1024, bst); } }
            { REPLOOP(2) {
            if (ON(2)) lora_act_rows(wid_s, p, l, r);
            { EpiQ E{(bf16*)(wsl_(p) + R_Q), pq}; run_gemm(wid_s, lds3, (const bf16*)(wsl_(p) + R_P) + 2816, NP, (const bf16*)(wsl_(p) + W_MQ), TH, 768, 256, E); }
            { EpiKV E{(bf16*)(wsl_(p) + R_KM), (bf16*)(wsl_(p) + R_VT), pkv}; run_gemm(wid_s, lds3, (const bf16*)(wsl_(p) + R_P) + 3072, NP, (const bf16*)(wsl_(p) + W_MKV), TH, 1024, 128, E); }
            grid_barrier(wid_s, ctl + 1024, bst); } }
            { REPLOOP(9) { EpiBf E{Y + (size_t)r * TH * 1536, 1536}; run_gemm(wid_s, lds3, Y + (size_t)r * TH * 1536 + 1024, 1536, (const bf16*)(wsl_(p) + W_BWA), TH, 1024, 128, E);
            grid_barrier(wid_s, ctl + 1024, bst); } }
            { REPLOOP(13) { if (ON(2)) si_build_rows(wid_s, p, l, r); } }
            if (ON(7)) kfix_rows(wid_s, p, l, r);
            grid_barrier(wid_s, ctl + 1024, bst);
            { REPLOOP(3) {
            if (ON(3) && !(q && RB(10)) && bid < 128) { const int xcd = bid & 7, idx = bid >> 3, hh = xcd * 4 + (idx >> 2), quarter = idx & 3;
                if (q == 0 || SCANMODE == 0) rwkv_scan_unit<0>(wid_s, (const bf16*)(wsl_(p) + R_SI) + (size_t)hh * 2048 * 384, Y + ((size_t)(r * 4 + (hh >> 3)) * 2048) * 1536 + (hh & 7) * 64, 1536, quarter, ldsf);
                else rwkv_scan_unit<SCANMODE>(wid_s, (const bf16*)(wsl_(p) + R_SI) + (size_t)hh * 2048 * 384, (bf16*)(wsl_(p) + R_P) + ((size_t)(hh >> 3) * 2048) * NP + 600 + (hh & 7) * 64, NP, quarter, ldsf); }
            else if (ON(4) && !(q && RB(11)) && bid >= 128 && bid < 160) { const int uu = bid - 128; lru_unit(wid_s, p, l, r, uu >> 3, uu & 7, ldsf); }
            else if (q == 0) { EpiBf E{(bf16*)(wsl_(p) + R_P), NP}; run_gemm(wid_s, lds3, (const bf16*)(wsl_(p) + WS_AG), 128, (const bf16*)(wsl_(p) + W_GUP), TH, 512, 128, E, 96); }
            {
                unsigned* ctr = ctl + q * 4 + l * 2 + r; volatile int* qidx = (volatile int*)(lds + QIDX_OFF);
                for (;;) {
                    __syncthreads();
                    if (mk_tid(wid_s) == 0) *qidx = (int)atomicAdd(ctr, 1u);
                    __syncthreads();
                    const int u = *qidx;
                    if (u >= 512 || !ON(5) || (q && RB(12))) break;
                    const int qb = 15 - (u >> 5), bh = u & 31, bl = bh >> 3, h = bh & 7;
                    attn_unit<96, 64, true, true>(wid_s, lds, (const bf16*)(wsl_(p) + R_Q) + (size_t)bl * 2048 * 768 + h * 96, 768, (const bf16*)(wsl_(p) + R_KM) + (size_t)bl * 2048 * 768 + h * 96, 768,
                        (const bf16*)(wsl_(p) + R_VT) + (size_t)(bl * 8 + h) * 64 * 2048, 2048, Y + ((size_t)(r * 4 + bl) * 2048) * 1536 + 1024 + h * 64, 1536,
                        qb * 128, 2 * qb + 2, p->in[I_QG] + l * 96, (const int*)p->in[I_POS] + (r * 4 + bl) * 2048, 0.14724444527f  );
                }
            }
            grid_barrier(wid_s, ctl + 1024, bst); } }
            { REPLOOP(16) { if (ON(6)) rwkv_post_rows(wid_s, p, l, r, q); } }
            grid_barrier(wid_s, ctl + 1024, bst);
        }
        if (ON(7)) memb_rows(wid_s, p);
        { REPLOOP(4) {
        for (int n = 0; n < 3; ++n) {
            { EpiGate E{(bf16*)(wsl_(p) + R_GS), part, p->in[I_BGATE] + l * 3072 + n * 1024}; run_gemm(wid_s, lds3, xb, 1024, (const bf16*)(wsl_(p) + W_GATE) + (size_t)n * 1024 * 1024, T, 1024, 1024, E); }
            { EpiProj E{(const bf16*)(wsl_(p) + R_GS), (float*)(wsl_(p) + R_MS), (bf16*)(wsl_(p) + R_MG), n}; run_gemm(wid_s, lds3, Y + n * 512, 1536, (const bf16*)(wsl_(p) + W_BR) + (size_t)n * 1024 * 512, T, 1024, 512, E); }
        }
        grid_barrier(wid_s, ctl + 1024, bst); } }
        { int nw = 1 + RB(15); asm volatile("" : "+s"(nw)); for (int q = 0; q < nw; ++q) { EpiRes E{l == 0 ? p->in[I_X] : xcur, xcur, xb, part, q + 1 < nw}; run_gemm(wid_s, lds3, (const bf16*)(wsl_(p) + R_MG), 1024, (const bf16*)(wsl_(p) + W_OUT), T, 1024, 1024, E); if (q + 1 < nw) grid_barrier(wid_s, ctl + 1024, bst); } }
        { REPLOOP(19) { EpiMemKV E{(bf16*)(wsl_(p) + R_MK), (bf16*)(wsl_(p) + R_MVT)}; run_gemm(wid_s, lds3, (const bf16*)(wsl_(p) + R_MEMB), 1024, (const bf16*)(wsl_(p) + W_XKV), 2048, 1024, 1024, E); } }
        grid_barrier(wid_s, ctl + 1024, bst);
        if (ON(7)) mkfix_rows(wid_s, p, l);
        { REPLOOP(5) { EpiXQ E{(bf16*)(wsl_(p) + R_XQ), part}; run_gemm(wid_s, lds3, xb, 1024, (const bf16*)(wsl_(p) + W_XQ), T, 512, 1024, E);
        grid_barrier(wid_s, ctl + 1024, bst); } }
        { REPLOOP(6) {
        if (ON(8)) for (int u = bid; u < 512; u += gridDim.x) { const int qb = u & 15, bh = u >> 4, b = bh >> 2, h = bh & 3;
            attn_unit<128, 128, false, false>(wid_s, lds, (const bf16*)(wsl_(p) + R_XQ) + (size_t)b * 2048 * 512 + h * 128, 512, (const bf16*)(wsl_(p) + R_MK) + (size_t)b * 256 * 512 + h * 128, 512,
                (const bf16*)(wsl_(p) + R_MVT) + (size_t)(b * 4 + h) * 128 * 256, 256, (bf16*)(wsl_(p) + R_XO) + (size_t)b * 2048 * 512 + h * 128, 512,
                qb * 128, 4, p->in[I_XQG] + l * 128, nullptr, 0.12751743082f  ); }
        grid_barrier(wid_s, ctl + 1024, bst); } }
        { int nw = 1 + RB(17); asm volatile("" : "+s"(nw)); for (int q = 0; q < nw; ++q) { EpiRes E{xcur, xcur, xb, part, q + 1 < nw}; run_gemm(wid_s, lds3, (const bf16*)(wsl_(p) + R_XO), 512, (const bf16*)(wsl_(p) + W_XO), T, 1024, 512, E); if (q + 1 < nw) grid_barrier(wid_s, ctl + 1024, bst); } }
        grid_barrier(wid_s, ctl + 1024, bst);
        { REPLOOP(7) { EpiFFN1 E{(bf16*)(wsl_(p) + R_H), part}; run_gemm(wid_s, lds3, xb, 1024, (const bf16*)(wsl_(p) + W_13), T, 5632, 1024, E);
        grid_barrier(wid_s, ctl + 1024, bst); } }
        { int nw = 1 + RB(18); asm volatile("" : "+s"(nw)); for (int q = 0; q < nw; ++q) { EpiRes E{xcur, xcur, xb, part, q + 1 < nw}; run_gemm(wid_s, lds3, (const bf16*)(wsl_(p) + R_H), DFF, (const bf16*)(wsl_(p) + W_2), T, 1024, DFF, E); if (q + 1 < nw) grid_barrier(wid_s, ctl + 1024, bst); } }
        grid_barrier(wid_s, ctl + 1024, bst);
    }
}

extern "C" void kernel_launch(void* const* d_in, const int* in_sizes, int n_in, void* d_out, int out_size, void* d_ws, size_t ws_size, hipStream_t stream) {
    static int grid = 0;
    if (grid == 0) {
        int dev = 0, cus = 0, per_cu = 0;
        if (n_in != 43 || ws_size < WS_END) { fprintf(stderr, "kernel_launch: unexpected n_in %d / ws %zu\n", n_in, ws_size); grid = -1; return; }
        (void)hipGetDevice(&dev);
        (void)hipDeviceGetAttribute(&cus, hipDeviceAttributeMultiprocessorCount, dev);
        (void)hipFuncSetAttribute((const void*)fwd_kernel, hipFuncAttributeMaxDynamicSharedMemorySize, LDS_BYTES);
        (void)hipOccupancyMaxActiveBlocksPerMultiprocessor(&per_cu, (const void*)fwd_kernel, 512, LDS_BYTES);
        fprintf(stderr, "cus %d per_cu %d ws %zu\n", cus, per_cu, ws_size);
        grid = cus * (per_cu >= 1 ? 1 : 0);
        if (grid <= 0) { grid = -1; return; }
    }
    if (grid < 0) return;
    Params p{};
    for (int i = 0; i < 43; ++i) p.in[i] = (const float*)d_in[i];
    p.out = (float*)d_out; p.ws = (unsigned char*)d_ws;
    (void)hipMemsetAsync((char*)d_ws + WS_CTL, 0, 32768, stream);
    void* args[] = {&p};
    hipError_t e = hipLaunchCooperativeKernel((const void*)fwd_kernel, dim3(grid), dim3(512), args, LDS_BYTES, stream);
    if (e != hipSuccess) fprintf(stderr, "cooperative launch failed: %s (grid %d)\n", hipGetErrorString(e), grid);
}
```

```cpp
#include <hip/hip_runtime.h>
#include <cstdio>
#include <cstdint>

#define LAS __attribute__((address_space(3)))
#define GAS __attribute__((address_space(1)))
typedef unsigned short bf16;
typedef short bf16x8 __attribute__((ext_vector_type(8)));
typedef float f32x4 __attribute__((ext_vector_type(4)));
typedef float f32x2 __attribute__((ext_vector_type(2)));
typedef unsigned u32x4 __attribute__((ext_vector_type(4)));
typedef unsigned u32x2 __attribute__((ext_vector_type(2)));

__device__ __forceinline__ unsigned f2bf(float f) { unsigned u = __builtin_bit_cast(unsigned, f); return (u + 0x7fffu + ((u >> 16) & 1u)) >> 16; }
typedef __bf16 bf16x2_t __attribute__((ext_vector_type(2)));
__device__ __forceinline__ unsigned pk2(float lo, float hi) { const f32x2 v = {lo, hi}; const bf16x2_t b = __builtin_convertvector(v, bf16x2_t); return __builtin_bit_cast(unsigned, b); }
__device__ __forceinline__ float bf2f(bf16 b) { return __builtin_bit_cast(float, (unsigned)b << 16); }
__device__ __forceinline__ float bflo(unsigned u) { return __builtin_bit_cast(float, u << 16); }
__device__ __forceinline__ float bfhi(unsigned u) { return __builtin_bit_cast(float, u & 0xffff0000u); }
__device__ __forceinline__ u32x4 pk8(f32x4 a, f32x4 b) { u32x4 w; w.x = pk2(a.x, a.y); w.y = pk2(a.z, a.w); w.z = pk2(b.x, b.y); w.w = pk2(b.z, b.w); return w; }
__device__ __forceinline__ float sigmoidf_(float x) { return 1.f / (1.f + __expf(-x)); }
__device__ __forceinline__ float fsig(float x) { return __builtin_amdgcn_rcpf(1.f + __builtin_amdgcn_exp2f(-1.4426950408889634f * x)); }
__device__ __forceinline__ int mk_tid(int wid_s) { int t = wid_s * 64 + (int)__builtin_amdgcn_mbcnt_hi(~0u, __builtin_amdgcn_mbcnt_lo(~0u, 0u)); asm volatile("" : "+v"(t)); return t; }
#define LBAR() asm volatile("s_waitcnt lgkmcnt(0)\n\ts_barrier" ::: "memory")
__device__ __forceinline__ float wave_sum(float v) {
#pragma unroll
    for (int o = 1; o < 64; o <<= 1) v += __shfl_xor(v, o);
    return v;
}

namespace pg8 {
#define PG8_LAS __attribute__((address_space(3)))
typedef unsigned short bf16_t;
constexpr int BM = 256, BK = 64, HALF = 128, HTB = HALF * BK * 2, STAGE_BYTES = 8 * HTB, NXCD = 8, WGM = 8;
__host__ __device__ __forceinline__ int lds_byte(int r, int c) { const int st = (r >> 4) * 2 + (c >> 5), rr = r & 15, cc = c & 31, ob = rr * 64 + cc * 2; return st * 1024 + (ob ^ (((ob >> 9) & 1) << 5)); }
__host__ __device__ __forceinline__ void stage_rc(int b, int& R, int& C) { const int st = b / 1024, sb = b % 1024, swz = sb ^ (((sb >> 9) & 1) << 5); R = (st >> 1) * 16 + swz / 64; C = (st & 1) * 32 + (swz % 64) / 2; }
__host__ __device__ __forceinline__ int perm32(int rho) { const int n = rho >> 4, i = rho & 15; return 8 * (i >> 2) + 4 * n + (i & 3); }
struct Unit { int pm, pn; };
struct Gemm { const bf16_t* A; const bf16_t* Bt; int M, N, K, lda; };
struct StaticOrder {
    int nM, nN, nwg, G, c;
    __host__ __device__ void init(int M, int N, int G_, int c_) { nM = M / BM; nN = N / BM; nwg = nM * nN; G = G_; c = c_; }
    __host__ __device__ bool next(int i, Unit& u) const {
        const long L = (long)i * G + c; if (L >= nwg) return false;
        int wgid = (int)L; { const int q = nwg / NXCD, r = nwg % NXCD, xcd = wgid % NXCD, off = wgid / NXCD; wgid = (xcd < r ? xcd * (q + 1) : r * (q + 1) + (xcd - r) * q) + off; }
        const int nig = WGM * nN, gid = wgid / nig, fm = gid * WGM, gsz = (nM - fm) < WGM ? (nM - fm) : WGM;
        u.pm = fm + ((wgid % nig) % gsz); u.pn = (wgid % nig) / gsz; return true;
    }
};
template <class Epi, class Sched>
__device__ __forceinline__ void gemm_phase(int wid_s, PG8_LAS unsigned char* lds, const Gemm g, const Sched& S, const Epi& E) {
    const int tid_ = mk_tid(wid_s);
    const int tid = tid_, wid = __builtin_amdgcn_readfirstlane(tid >> 6), lane = tid & 63, wr = wid >> 2, wc = wid & 3, fr = lane & 15, fq = lane >> 4;
    const int K = g.K, nt = K / BK, lda = g.lda;
    unsigned voffA[2], voffB[2];
#pragma unroll
    for (int i = 0; i < 2; ++i) { int R, C; stage_rc(tid * 16 + i * 8192, R, C); const int Rb = (R & ~31) + perm32(R & 31);
        voffA[i] = (unsigned)(R * lda + C) * 2u; voffB[i] = (unsigned)(Rb * K + C) * 2u; }
    const size_t kstep = (size_t)(BK * 2);
    const size_t hstepA = (size_t)HALF * lda * 2, hstepB = (size_t)HALF * K * 2;
    const size_t tstepA = 2 * hstepA, tstepB = 2 * hstepB;
    const unsigned ldsw = (unsigned)wid * 1024u;
    const int aoff = lds_byte(wr * 64 + fr, fq * 8), boff = lds_byte(wc * 32 + fr, fq * 8);
#define PG8_SA(b, h) (((b) * 2 + (h)) * HTB)
#define PG8_SB(b, h) ((4 + (b) * 2 + (h)) * HTB)
#define PG8_STAGE(bufoff, gbase, voff) do { _Pragma("unroll") for (int _i = 0; _i < 2; ++_i) \
        __builtin_amdgcn_global_load_lds((const unsigned*)((const char*)(gbase) + (voff)[_i]), (PG8_LAS unsigned*)(lds + (bufoff) + ldsw + _i * 8192), 16, 0, 0); } while (0)
#define PG8_LDA(dst, b, h) do { _Pragma("unroll") for (int m = 0; m < 4; ++m) _Pragma("unroll") for (int k = 0; k < 2; ++k) dst[m][k] = *(const PG8_LAS bf16x8*)(lds + PG8_SA(b, h) + aoff + m * 2048 + k * 1024); } while (0)
#define PG8_LDB(dst, b, h) do { _Pragma("unroll") for (int n = 0; n < 2; ++n) _Pragma("unroll") for (int k = 0; k < 2; ++k) dst[n][k] = *(const PG8_LAS bf16x8*)(lds + PG8_SB(b, h) + boff + n * 2048 + k * 1024); } while (0)
#define PG8_MMA(ai, bj, At, Bt) do { __builtin_amdgcn_s_setprio(1); _Pragma("unroll") for (int m = 0; m < 4; ++m) _Pragma("unroll") for (int n = 0; n < 2; ++n) _Pragma("unroll") for (int k = 0; k < 2; ++k) \
        acc[ai][bj][m][n] = __builtin_amdgcn_mfma_f32_16x16x32_bf16(Bt[n][k], At[m][k], acc[ai][bj][m][n], 0, 0, 0); __builtin_amdgcn_s_setprio(0); } while (0)
#define PG8_WAIT_V(n) asm volatile("s_waitcnt vmcnt(" #n ")" ::: "memory")
#define PG8_WAIT_L(n) asm volatile("s_waitcnt lgkmcnt(" #n ")" ::: "memory")
#define PG8_BAR __builtin_amdgcn_s_barrier()
#define PG8_SCHED __builtin_amdgcn_sched_barrier(0)
    Unit cur, nxt; int ui = 0;
    if (!S.next(0, cur)) return;
    f32x4 acc[2][2][4][2];
#pragma unroll
    for (int a = 0; a < 2; ++a)
#pragma unroll
        for (int b = 0; b < 2; ++b)
#pragma unroll
            for (int m = 0; m < 4; ++m)
#pragma unroll
                for (int n = 0; n < 2; ++n) acc[a][b][m][n] = (f32x4){0.f, 0.f, 0.f, 0.f};
    bf16x8 At[4][2], B0[2][2], B1[2][2];
    const char* cA = (const char*)g.A + (size_t)cur.pm * tstepA; const char* cB = (const char*)g.Bt + (size_t)cur.pn * tstepB;
    PG8_STAGE(PG8_SB(0, 0), cB, voffB); PG8_STAGE(PG8_SB(0, 1), cB + hstepB, voffB); PG8_STAGE(PG8_SA(0, 0), cA, voffA); PG8_STAGE(PG8_SA(0, 1), cA + hstepA, voffA);
    if (wr == 1) PG8_BAR;
    PG8_WAIT_V(2); PG8_BAR;
    PG8_STAGE(PG8_SB(1, 0), cB + kstep, voffB); PG8_STAGE(PG8_SA(1, 0), cA + kstep, voffA); PG8_STAGE(PG8_SB(1, 1), cB + hstepB + kstep, voffB);
    PG8_WAIT_V(6); PG8_BAR;
    for (;;) {
        const bool has_next = S.next(ui + 1, nxt);
        const char* nA = has_next ? (const char*)g.A + (size_t)nxt.pm * tstepA : cA; const char* nB = has_next ? (const char*)g.Bt + (size_t)nxt.pn * tstepB : cB;
#pragma unroll 1
        for (int t = 0; t < nt; t += 2) {
            const bool last = (t == nt - 2);
            const char* a1 = cA + (size_t)(t + 1) * kstep;
            const char* a2 = last ? nA : cA + (size_t)(t + 2) * kstep; const char* b2 = last ? nB : cB + (size_t)(t + 2) * kstep;
            const char* a3 = a2 + kstep; const char* b3 = b2 + kstep;
            PG8_LDB(B0, 0, 0); PG8_LDB(B1, 0, 1); PG8_SCHED; PG8_LDA(At, 0, 0); PG8_STAGE(PG8_SA(1, 1), a1 + hstepA, voffA);
            PG8_WAIT_V(8); PG8_WAIT_L(0); PG8_BAR; PG8_MMA(0, 0, At, B0); PG8_MMA(0, 1, At, B1); PG8_BAR; PG8_SCHED;
            PG8_LDA(At, 0, 1); PG8_STAGE(PG8_SB(0, 0), b2, voffB); PG8_STAGE(PG8_SB(0, 1), b2 + hstepB, voffB); PG8_STAGE(PG8_SA(0, 0), a2, voffA);
            PG8_WAIT_V(8); PG8_WAIT_L(0); PG8_BAR; PG8_MMA(1, 0, At, B0); PG8_MMA(1, 1, At, B1); PG8_BAR; PG8_SCHED;
            PG8_LDB(B0, 1, 0); PG8_LDB(B1, 1, 1); PG8_SCHED; PG8_LDA(At, 1, 0); PG8_STAGE(PG8_SA(0, 1), a2 + hstepA, voffA);
            PG8_WAIT_V(8); PG8_WAIT_L(0); PG8_BAR; PG8_MMA(0, 0, At, B0); PG8_MMA(0, 1, At, B1); PG8_BAR; PG8_SCHED;
            PG8_LDA(At, 1, 1); PG8_STAGE(PG8_SB(1, 0), b3, voffB); PG8_STAGE(PG8_SB(1, 1), b3 + hstepB, voffB); PG8_STAGE(PG8_SA(1, 0), a3, voffA);
            PG8_WAIT_V(8); PG8_WAIT_L(0); PG8_BAR; PG8_MMA(1, 0, At, B0); PG8_MMA(1, 1, At, B1); PG8_BAR; PG8_SCHED;
        }
        if (wr == 0) PG8_BAR;
        E(acc, cur, wr, wc, fr, fq);
        if (!has_next) break;
#pragma unroll
        for (int a = 0; a < 2; ++a)
#pragma unroll
            for (int b = 0; b < 2; ++b)
#pragma unroll
                for (int m = 0; m < 4; ++m)
#pragma unroll
                    for (int n = 0; n < 2; ++n) acc[a][b][m][n] = (f32x4){0.f, 0.f, 0.f, 0.f};
        cur = nxt; cA = nA; cB = nB; ++ui;
        if (wr == 1) PG8_BAR;
    }
    PG8_WAIT_V(0);
    PG8_BAR;
#undef PG8_SA
#undef PG8_SB
#undef PG8_STAGE
#undef PG8_LDA
#undef PG8_LDB
#undef PG8_MMA
#undef PG8_WAIT_V
#undef PG8_WAIT_L
#undef PG8_BAR
#undef PG8_SCHED
}
}

#ifndef EN
#define EN 0xFFFF
#endif
#define ON(b) ((EN >> (b)) & 1)
#ifndef REP
#define REP 0
#endif
#ifndef SCANMODE
#define SCANMODE 0
#endif
#define RB(b) ((REP >> (b)) & 1)
#define REPLOOP(b) int nrep##b = 1 + RB(b); asm volatile("" : "+s"(nrep##b)); for (int q = 0; q < nrep##b; ++q)
constexpr int T = 16384, TH = 8192, SEQ = 2048, DM = 1024, DIN = 6304, NP = 3328, DFF = 2816;
constexpr int LDS_BYTES = 147456, QIDX_OFF = 140000;
constexpr size_t MiB = 1u << 20;
constexpr size_t WS_CTL = 0;
constexpr size_t WS_WT = 1 * MiB;
constexpr size_t W_IN = WS_WT, W_GATE = W_IN + (size_t)NP * 1024 * 2, W_BR = W_GATE + (size_t)3072 * 1024 * 2, W_OUT = W_BR + (size_t)3 * 1024 * 512 * 2,
                 W_MQ = W_OUT + (size_t)1024 * 1024 * 2, W_MKV = W_MQ + (size_t)768 * 256 * 2, W_XQ = W_MKV + (size_t)1024 * 128 * 2, W_XKV = W_XQ + (size_t)512 * 1024 * 2,
                 W_XO = W_XKV + (size_t)1024 * 1024 * 2, W_13 = W_XO + (size_t)1024 * 512 * 2, W_2 = W_13 + (size_t)5632 * 1024 * 2, W_BWA = W_2 + (size_t)1024 * 2816 * 2, W_GUP = W_BWA + (size_t)1024 * 128 * 2, W_END = W_GUP + (size_t)512 * 128 * 2;
static_assert(W_END <= 40 * MiB, "weights");
constexpr size_t WS_XB = 40 * MiB, WS_PART = 72 * MiB, WS_PQ = 73 * MiB, WS_PKV = WS_PQ + 256 * 1024, WS_Y = 74 * MiB, WS_R = 122 * MiB;
constexpr size_t R_P = WS_R, R_SI = WS_R + 52 * MiB, R_Q = WS_R + 100 * MiB, R_KM = WS_R + 112 * MiB, R_VT = WS_R + 124 * MiB;
constexpr size_t R_GS = WS_R, R_MS = WS_R + 32 * MiB, R_MG = WS_R + 96 * MiB, R_MEMB = WS_R + 128 * MiB;
constexpr size_t R_MK = WS_R, R_MVT = WS_R + 2 * MiB, R_XQ = WS_R + 32 * MiB, R_XO = WS_R + 48 * MiB, R_H = WS_R;
constexpr size_t WS_AG = WS_R + 132 * MiB;
constexpr size_t WS_END = WS_AG + 2 * MiB;
static_assert(WS_END <= 256 * MiB, "ws");

struct Params { const float* in[43]; float* out; unsigned char* ws; };
typedef const __attribute__((address_space(4))) Params* KP;
enum { I_X = 0, I_MEM, I_POS, I_NMIX, I_NXA, I_NMEM, I_NFFN, I_WIN, I_BGATE, I_MU, I_W0, I_WUP, I_A0, I_AUP, I_GUP, I_KK, I_KA, I_RK, I_LNG, I_LNB,
       I_CW, I_CB, I_WA, I_BA, I_WX, I_BX, I_LAM, I_QN, I_WUQ, I_KVN, I_WUKV, I_QG, I_KG, I_WBR, I_WOUT, I_XWQ, I_XWKV, I_XQG, I_XKG, I_XWO, I_W1, I_W3, I_W2 };

__device__ __forceinline__ float rstd16(const float* part, int row) {
    const f32x4* p = (const f32x4*)(part + (size_t)row * 16); const f32x4 a = p[0], b = p[1], c = p[2], d = p[3];
    const float s = ((a.x + a.y) + (a.z + a.w)) + ((b.x + b.y) + (b.z + b.w)) + ((c.x + c.y) + (c.z + c.w)) + ((d.x + d.y) + (d.z + d.w));
    return rsqrtf(s * (1.f / 1024.f) + 1e-6f);
}
__device__ __forceinline__ float rstd4(const float* pp, int row, float invn) { const f32x4 a = *(const f32x4*)(pp + (size_t)row * 4); return rsqrtf(((a.x + a.y) + (a.z + a.w)) * invn + 1e-6f); }
__device__ __forceinline__ float sumsq8(f32x4 a, f32x4 b) { return (a.x * a.x + a.y * a.y) + (a.z * a.z + a.w * a.w) + (b.x * b.x + b.y * b.y) + (b.z * b.z + b.w * b.w); }
#define EPI_HEAD static constexpr bool PERM = true; \
    __device__ __forceinline__ void operator()(const f32x4 (&acc)[2][2][4][2], const pg8::Unit& u, int wr, int wc, int fr, int fq) const
#define EPI_ROWS _Pragma("unroll") for (int ai = 0; ai < 2; ++ai) _Pragma("unroll") for (int m = 0; m < 4; ++m) if ((__builtin_amdgcn_sched_barrier(0), true))
#define EPI_ROW (u.pm * 256 + ai * 128 + wr * 64 + m * 16 + fr)

struct EpiP {
    bf16* P; const float* part; float* pq; float* pkv;
    EPI_HEAD {
        const int col0 = u.pn * 256 + wc * 32 + 8 * fq;
        EPI_ROWS { const int row = EPI_ROW; const float rs = rstd16(part, row); float ss = 0.f;
#pragma unroll
            for (int bj = 0; bj < 2; ++bj) { const f32x4 v0 = acc[ai][bj][m][0] * rs, v1 = acc[ai][bj][m][1] * rs;
                *(u32x4*)(P + (size_t)row * NP + col0 + bj * 128) = pk8(v0, v1);
                if (u.pn == 11 || bj == 0) ss += sumsq8(v0, v1); }
            if (u.pn == 11 || u.pn == 12) { ss += __shfl_xor(ss, 16); ss += __shfl_xor(ss, 32); if (fq == 0) (u.pn == 11 ? pq : pkv)[(size_t)row * 4 + wc] = ss; } }
    }
};
struct EpiQ {
    bf16* Q; const float* pq;
    EPI_HEAD {
        const int col0 = u.pn * 256 + wc * 32 + 8 * fq;
        EPI_ROWS { const int row = EPI_ROW; const float rs = rstd4(pq, row, 1.f / 256.f);
#pragma unroll
            for (int bj = 0; bj < 2; ++bj) *(u32x4*)(Q + (size_t)row * 768 + col0 + bj * 128) = pk8(acc[ai][bj][m][0] * rs, acc[ai][bj][m][1] * rs); }
    }
};
struct EpiKV {
    bf16* Km; bf16* Vt; const float* pkv;
    EPI_HEAD {
        const int j0 = wc * 32 + 8 * fq;
        EPI_ROWS { const int row = EPI_ROW; const float rs = rstd4(pkv, row, 1.f / 128.f);
#pragma unroll
            for (int bj = 0; bj < 2; ++bj) { const int h = 2 * u.pn + bj; const f32x4 v0 = acc[ai][bj][m][0] * rs, v1 = acc[ai][bj][m][1] * rs;
                if (wc < 2) *(u32x4*)(Km + (size_t)row * 768 + h * 96 + j0) = pk8(v0, v1);
                else { const int bl = row >> 11, t = row & 2047; bf16* vp = Vt + ((size_t)(bl * 8 + h) * 64 + (j0 - 64)) * 2048 + t;
                    vp[0 * 2048] = (bf16)f2bf(v0.x); vp[1 * 2048] = (bf16)f2bf(v0.y); vp[2 * 2048] = (bf16)f2bf(v0.z); vp[3 * 2048] = (bf16)f2bf(v0.w);
                    vp[4 * 2048] = (bf16)f2bf(v1.x); vp[5 * 2048] = (bf16)f2bf(v1.y); vp[6 * 2048] = (bf16)f2bf(v1.z); vp[7 * 2048] = (bf16)f2bf(v1.w); } } }
    }
};
struct EpiGate {
    bf16* GS; const float* part; const float* bg;
    EPI_HEAD {
        const int col0 = u.pn * 256 + wc * 32 + 8 * fq;
        f32x4 b0[2], b1[2];
#pragma unroll
        for (int bj = 0; bj < 2; ++bj) { b0[bj] = *(const f32x4*)(bg + col0 + bj * 128); b1[bj] = *(const f32x4*)(bg + col0 + bj * 128 + 4); }
        EPI_ROWS { const int row = EPI_ROW; const float rs = rstd16(part, row);
#pragma unroll
            for (int bj = 0; bj < 2; ++bj) { f32x4 v0 = acc[ai][bj][m][0] * rs + b0[bj], v1 = acc[ai][bj][m][1] * rs + b1[bj];
#pragma unroll
                for (int e = 0; e < 4; ++e) { v0[e] = fsig(v0[e]); v1[e] = fsig(v1[e]); }
                *(u32x4*)(GS + (size_t)row * 1024 + col0 + bj * 128) = pk8(v0, v1); } }
    }
};
struct EpiProj {
    const bf16* GS; float* MS; bf16* MG; int n;
    EPI_HEAD {
        const int col0 = u.pn * 256 + wc * 32 + 8 * fq;
        EPI_ROWS { const int row = EPI_ROW;
#pragma unroll
            for (int bj = 0; bj < 2; ++bj) { const size_t o = (size_t)row * 1024 + col0 + bj * 128; const u32x4 gw = *(const u32x4*)(GS + o);
                f32x4 v0 = acc[ai][bj][m][0], v1 = acc[ai][bj][m][1];
                v0.x *= bflo(gw.x); v0.y *= bfhi(gw.x); v0.z *= bflo(gw.y); v0.w *= bfhi(gw.y); v1.x *= bflo(gw.z); v1.y *= bfhi(gw.z); v1.z *= bflo(gw.w); v1.w *= bfhi(gw.w);
                if (n > 0) { v0 += *(const f32x4*)(MS + o); v1 += *(const f32x4*)(MS + o + 4); }
                if (n < 2) { *(f32x4*)(MS + o) = v0; *(f32x4*)(MS + o + 4) = v1; } else *(u32x4*)(MG + o) = pk8(v0, v1); } }
    }
};
struct EpiRes {
    const float* xold; float* xout; bf16* xb; float* part; int nowrite = 0;
    EPI_HEAD {
        const int col0 = u.pn * 256 + wc * 32 + 8 * fq;
        EPI_ROWS { const int row = EPI_ROW; float ss = 0.f;
#pragma unroll
            for (int bj = 0; bj < 2; ++bj) { const size_t o = (size_t)row * 1024 + col0 + bj * 128;
                const f32x4 v0 = acc[ai][bj][m][0] + *(const f32x4*)(xold + o), v1 = acc[ai][bj][m][1] + *(const f32x4*)(xold + o + 4);
                if (!nowrite) { *(f32x4*)(xout + o) = v0; *(f32x4*)(xout + o + 4) = v1; *(u32x4*)(xb + o) = pk8(v0, v1); } ss += sumsq8(v0, v1); }
            ss += __shfl_xor(ss, 16); ss += __shfl_xor(ss, 32); if (fq == 0 && !nowrite) part[(size_t)row * 16 + u.pn * 4 + wc] = ss; }
    }
};
struct EpiXQ {
    bf16* Q; const float* part;
    EPI_HEAD {
        const int col0 = u.pn * 256 + wc * 32 + 8 * fq;
        EPI_ROWS { const int row = EPI_ROW; const float rs = rstd16(part, row);
#pragma unroll
            for (int bj = 0; bj < 2; ++bj) *(u32x4*)(Q + (size_t)row * 512 + col0 + bj * 128) = pk8(acc[ai][bj][m][0] * rs, acc[ai][bj][m][1] * rs); }
    }
};
struct EpiBf {
    bf16* O; int ld;
    EPI_HEAD {
        const int col0 = u.pn * 256 + wc * 32 + 8 * fq;
        EPI_ROWS { const int row = EPI_ROW;
#pragma unroll
            for (int bj = 0; bj < 2; ++bj) *(u32x4*)(O + (size_t)row * ld + col0 + bj * 128) = pk8(acc[ai][bj][m][0], acc[ai][bj][m][1]); }
    }
};
struct EpiMemKV {
    bf16* mk; bf16* mVt;
    EPI_HEAD {
        const int j0 = wc * 32 + 8 * fq, h = u.pn;
        EPI_ROWS { const int row = EPI_ROW;
            *(u32x4*)(mk + (size_t)row * 512 + h * 128 + j0) = pk8(acc[ai][0][m][0], acc[ai][0][m][1]);
            const f32x4 v0 = acc[ai][1][m][0], v1 = acc[ai][1][m][1]; const int b = row >> 8, key = row & 255;
            bf16* vp = mVt + ((size_t)(b * 4 + h) * 128 + j0) * 256 + key;
            vp[0 * 256] = (bf16)f2bf(v0.x); vp[1 * 256] = (bf16)f2bf(v0.y); vp[2 * 256] = (bf16)f2bf(v0.z); vp[3 * 256] = (bf16)f2bf(v0.w);
            vp[4 * 256] = (bf16)f2bf(v1.x); vp[5 * 256] = (bf16)f2bf(v1.y); vp[6 * 256] = (bf16)f2bf(v1.z); vp[7 * 256] = (bf16)f2bf(v1.w); }
    }
};
struct EpiFFN1 {
    bf16* H; const float* part;
    EPI_HEAD {
        const int hc0 = (u.pn * 256 + wc * 32 + 8 * fq) >> 1;
        EPI_ROWS { const int row = EPI_ROW; const float rs = rstd16(part, row);
#pragma unroll
            for (int bj = 0; bj < 2; ++bj) { const f32x4 a1 = acc[ai][bj][m][0] * rs, a3 = acc[ai][bj][m][1] * rs; f32x4 hv;
#pragma unroll
                for (int e = 0; e < 4; ++e) hv[e] = a1[e] * fsig(a1[e]) * a3[e];
                u32x2 w; w.x = pk2(hv.x, hv.y); w.y = pk2(hv.z, hv.w);
                *(u32x2*)(H + (size_t)row * DFF + hc0 + bj * 64) = w; } }
    }
};

__device__ __forceinline__ void conv_job(const float* W, int ldw, int c0, int ncols, int kblk, const float* gain, bf16* WT, int K, int mode, float* scr, int gw, int NGW, int lane, int& off) {
    const int nblk = (ncols + 63) >> 6, nitems = nblk * kblk;
    int it0 = (gw - off) % NGW; if (it0 < 0) it0 += NGW;
    off = (off + nitems) % NGW;
    const int kq = lane >> 4, nq = lane & 15;
    for (int it = it0; it < nitems; it += NGW) {
        const int kb = it / nblk, nb = it % nblk, k0 = 64 * kb, n0 = 64 * nb;
        const bool ld_ok = (n0 + 4 * nq) < ncols;
        f32x4 v[16];
#pragma unroll
        for (int i = 0; i < 16; ++i) { v[i] = (f32x4){0.f, 0.f, 0.f, 0.f}; if (ld_ok) v[i] = *(const f32x4*)(W + (size_t)(k0 + 4 * i + kq) * ldw + c0 + n0 + 4 * nq); }
#pragma unroll
        for (int i = 0; i < 16; ++i) { const int kk = 4 * i + kq; const float gg = gain ? gain[k0 + kk] : 1.f; float* d = scr + kk * 65 + 4 * nq;
            d[0] = v[i].x * gg; d[1] = v[i].y * gg; d[2] = v[i].z * gg; d[3] = v[i].w * gg; }
        __builtin_amdgcn_wave_barrier(); asm volatile("s_waitcnt lgkmcnt(0)" ::: "memory");
        const int c = lane & 7;
#pragma unroll
        for (int jx = 0; jx < 8; ++jx) { const int nl = (lane >> 3) + 8 * jx, n = n0 + nl; const float* sp = scr + (8 * c) * 65 + nl;
            u32x4 o; o.x = pk2(sp[0 * 65], sp[1 * 65]); o.y = pk2(sp[2 * 65], sp[3 * 65]); o.z = pk2(sp[4 * 65], sp[5 * 65]); o.w = pk2(sp[6 * 65], sp[7 * 65]);
            const int dr = mode == 0 ? n : (8 * (n >> 2) + (n & 3) + (mode == 2 ? 4 : 0));
            if (n < ncols) *(u32x4*)(WT + (size_t)dr * K + k0 + 8 * c) = o; }
        __builtin_amdgcn_wave_barrier(); asm volatile("s_waitcnt lgkmcnt(0)" ::: "memory");
    }
}

__device__ __forceinline__ void phase_convert(int wid_s, KP p_, int l, float* ldsf) {
    KP p = p_; asm volatile("" : "+s"(p));
    unsigned char* ws = p->ws;
    const int tid_ = mk_tid(wid_s);
    const int tid = tid_, lane = tid & 63, wv = tid >> 6;
    const int gw = blockIdx.x * 8 + wv, NGW = gridDim.x * 8;
    float* scr = ldsf + wv * (64 * 65); int off = 0;
    const float* nmix = p->in[I_NMIX] + l * 1024;
    conv_job(p->in[I_WIN] + (size_t)l * 1024 * DIN, DIN, 0, 3232, 16, nmix, (bf16*)(ws + W_IN), 1024, 0, scr, gw, NGW, lane, off);
    conv_job(p->in[I_WIN] + (size_t)l * 1024 * DIN, DIN, 3232, 3072, 16, nmix, (bf16*)(ws + W_GATE), 1024, 0, scr, gw, NGW, lane, off);
    for (int n = 0; n < 3; ++n) conv_job(p->in[I_WBR] + ((size_t)l * 3 + n) * 512 * 1024, 1024, 0, 1024, 8, nullptr, (bf16*)(ws + W_BR) + (size_t)n * 1024 * 512, 512, 0, scr, gw, NGW, lane, off);
    conv_job(p->in[I_WOUT] + (size_t)l * 1024 * 1024, 1024, 0, 1024, 16, nullptr, (bf16*)(ws + W_OUT), 1024, 0, scr, gw, NGW, lane, off);
    conv_job(p->in[I_WUQ] + (size_t)l * 256 * 768, 768, 0, 768, 4, p->in[I_QN] + l * 256, (bf16*)(ws + W_MQ), 256, 0, scr, gw, NGW, lane, off);
    conv_job(p->in[I_WUKV] + (size_t)l * 128 * 1024, 1024, 0, 1024, 2, p->in[I_KVN] + l * 128, (bf16*)(ws + W_MKV), 128, 0, scr, gw, NGW, lane, off);
    conv_job(p->in[I_XWQ] + (size_t)l * 1024 * 512, 512, 0, 512, 16, p->in[I_NXA] + l * 1024, (bf16*)(ws + W_XQ), 1024, 0, scr, gw, NGW, lane, off);
    conv_job(p->in[I_XWKV] + (size_t)l * 1024 * 1024, 1024, 0, 1024, 16, p->in[I_NMEM] + l * 1024, (bf16*)(ws + W_XKV), 1024, 0, scr, gw, NGW, lane, off);
    conv_job(p->in[I_XWO] + (size_t)l * 512 * 1024, 1024, 0, 1024, 8, nullptr, (bf16*)(ws + W_XO), 512, 0, scr, gw, NGW, lane, off);
    conv_job(p->in[I_W1] + (size_t)l * 1024 * DFF, DFF, 0, 2816, 16, p->in[I_NFFN] + l * 1024, (bf16*)(ws + W_13), 1024, 1, scr, gw, NGW, lane, off);
    conv_job(p->in[I_W3] + (size_t)l * 1024 * DFF, DFF, 0, 2816, 16, p->in[I_NFFN] + l * 1024, (bf16*)(ws + W_13), 1024, 2, scr, gw, NGW, lane, off);
    conv_job(p->in[I_W2] + (size_t)l * DFF * 1024, 1024, 0, 1024, 44, nullptr, (bf16*)(ws + W_2), DFF, 0, scr, gw, NGW, lane, off);
    conv_job(p->in[I_WUP] + (size_t)l * 64 * 512, 512, 0, 512, 1, nullptr, (bf16*)(ws + W_BWA), 128, 0, scr, gw, NGW, lane, off);
    conv_job(p->in[I_AUP] + (size_t)l * 64 * 512, 512, 0, 512, 1, nullptr, (bf16*)(ws + W_BWA) + 512 * 128 + 64, 128, 0, scr, gw, NGW, lane, off);
    conv_job(p->in[I_GUP] + (size_t)l * 128 * 512, 512, 0, 512, 2, nullptr, (bf16*)(ws + W_GUP), 128, 0, scr, gw, NGW, lane, off);
    { unsigned zz = 0u; asm volatile("" : "+v"(zz)); const u32x4 zv = {zz, zz, zz, zz};
      for (int i = blockIdx.x * 512 + tid; i < 1024 * 8; i += gridDim.x * 512) { const int row = i >> 3, ch = i & 7; *(u32x4*)((bf16*)(ws + W_BWA) + row * 128 + (row < 512 ? 64 : 0) + ch * 8) = zv; } }
    { u32x4* z = (u32x4*)((bf16*)(ws + W_IN) + (size_t)3232 * 1024); const int n16 = 96 * 1024 * 2 / 16;
      unsigned zz = 0u; asm volatile("" : "+v"(zz)); const u32x4 zv = {zz, zz, zz, zz};
      for (int i = blockIdx.x * 512 + tid; i < n16; i += gridDim.x * 512) z[i] = zv; }
    if (l == 0) {
        const float* x = p->in[I_X]; bf16* xb = (bf16*)(ws + WS_XB); float* part = (float*)(ws + WS_PART);
        for (int row = gw; row < T; row += NGW) {
            const f32x4* xr = (const f32x4*)(x + (size_t)row * 1024) + lane; float s = 0.f;
#pragma unroll
            for (int j = 0; j < 4; ++j) { const f32x4 v = xr[64 * j]; s += (v.x * v.x + v.y * v.y) + (v.z * v.z + v.w * v.w);
                u32x2 w; w.x = pk2(v.x, v.y); w.y = pk2(v.z, v.w); *((u32x2*)(xb + (size_t)row * 1024) + lane + 64 * j) = w; }
            s = wave_sum(s);
            if (lane < 16) part[(size_t)row * 16 + lane] = lane == 0 ? s : 0.f;
        }
    }
}

__device__ __forceinline__ void rope_cs(int pos, int i, float& c, float& s) {
    const float invf = exp2f(-(float)i * 0.8304820237218406f);
    const float ang = (float)pos * invf;
    const double x = (double)ang * 0.15915494309189535; const float f = (float)(x - rint(x));
    c = __builtin_amdgcn_cosf(f); s = __builtin_amdgcn_sinf(f);
}
template <int DQK, int DV, bool CAUSAL, bool MLA>
__device__ __forceinline__ void attn_unit(int wid_s, unsigned char* lds, const bf16* Qb_, int ldq, const bf16* Kb_, int ldk, const bf16* Vtb_, int ldv, bf16* Ob_, int ldo,
                                          int q0, int nkt, const float* qgain_, const int* pos_, float qscale) {
    const GAS bf16* Qb = (const GAS bf16*)Qb_; const GAS bf16* Kb = (const GAS bf16*)Kb_; const GAS bf16* Vtb = (const GAS bf16*)Vtb_; GAS bf16* Ob = (GAS bf16*)Ob_;
    const GAS float* qgain = (const GAS float*)qgain_; const GAS int* pos = (const GAS int*)pos_;
    constexpr int KS = DQK * 2 + 16, VS = 144, NKS = DQK / 32, NDT = DV / 16, KCH = DQK / 8, NKC = (64 * KCH + 511) / 512, NVC = DV * 8 / 512;
    unsigned char* Ks = lds; unsigned char* Vs = lds + 64 * KS;
    const int tid_ = mk_tid(wid_s);
    const int tid = tid_, lane = tid & 63, wv = tid >> 6, g = lane >> 4, j = lane & 15;
    const int qrow = q0 + wv * 16 + j;
    bf16x8 qf[NKS];
    {
        float qv[NKS][8]; float ss = 0.f;
#pragma unroll
        for (int ks = 0; ks < NKS; ++ks) { const u32x4 w = *(const GAS u32x4*)(Qb + (size_t)qrow * ldq + 32 * ks + 8 * g);
            qv[ks][0] = bflo(w.x); qv[ks][1] = bfhi(w.x); qv[ks][2] = bflo(w.y); qv[ks][3] = bfhi(w.y); qv[ks][4] = bflo(w.z); qv[ks][5] = bfhi(w.z); qv[ks][6] = bflo(w.w); qv[ks][7] = bfhi(w.w);
#pragma unroll
            for (int e = 0; e < 8; ++e) ss += qv[ks][e] * qv[ks][e]; }
        ss += __shfl_xor(ss, 16); ss += __shfl_xor(ss, 32);
        const float rs = rsqrtf(ss * (1.f / DQK) + 1e-6f);
#pragma unroll
        for (int ks = 0; ks < NKS; ++ks)
#pragma unroll
            for (int e = 0; e < 8; ++e) qv[ks][e] *= rs * qgain[32 * ks + 8 * g + e];
        if (MLA) {
            const int ps = pos[qrow];
#pragma unroll
            for (int e = 0; e < 8; ++e) { const float mine = qv[2][e], other = __shfl_xor(mine, 32); float c, s; rope_cs(ps, 8 * (g & 1) + e, c, s);
                qv[2][e] = (g < 2) ? (mine * c - other * s) : (mine * c + other * s); }
        }
#pragma unroll
        for (int ks = 0; ks < NKS; ++ks) { u32x4 w; w.x = pk2(qv[ks][0] * qscale, qv[ks][1] * qscale); w.y = pk2(qv[ks][2] * qscale, qv[ks][3] * qscale);
            w.z = pk2(qv[ks][4] * qscale, qv[ks][5] * qscale); w.w = pk2(qv[ks][6] * qscale, qv[ks][7] * qscale); qf[ks] = __builtin_bit_cast(bf16x8, w); }
    }
    f32x4 oT[NDT];
#pragma unroll
    for (int d = 0; d < NDT; ++d) oT[d] = (f32x4){0.f, 0.f, 0.f, 0.f};
    float mrun = -INFINITY, lsum = 0.f;
    u32x4 kreg[NKC], vreg[NVC];
#define ATT_PREFETCH(kt) do { _Pragma("unroll") for (int i = 0; i < NKC; ++i) { const int idx = tid + 512 * i; if (idx < 64 * KCH) { const int key = idx / KCH, ch = idx % KCH; \
            kreg[i] = *(const GAS u32x4*)(Kb + (size_t)(64 * (kt) + key) * ldk + ch * 8); } } \
        _Pragma("unroll") for (int i = 0; i < NVC; ++i) { const int idx = tid + 512 * i; const int dv = idx >> 3, ch = idx & 7; vreg[i] = *(const GAS u32x4*)(Vtb + (size_t)dv * ldv + 64 * (kt) + ch * 8); } } while (0)
    ATT_PREFETCH(0);
    for (int kt = 0; kt < nkt; ++kt) {
        LBAR();
#pragma unroll
        for (int i = 0; i < NKC; ++i) { const int idx = tid + 512 * i; if (idx < 64 * KCH) { const int key = idx / KCH, ch = idx % KCH; *(u32x4*)(Ks + key * KS + ch * 16) = kreg[i]; } }
#pragma unroll
        for (int i = 0; i < NVC; ++i) { const int idx = tid + 512 * i; const int dv = idx >> 3, ch = idx & 7; *(u32x4*)(Vs + dv * VS + ch * 16) = vreg[i]; }
        LBAR();
        if (kt + 1 < nkt) ATT_PREFETCH(kt + 1);
        const int qw0 = q0 + wv * 16;
        if (CAUSAL && 64 * kt > qw0 + 15) continue;
        f32x4 sT[4];
#pragma unroll
        for (int k4 = 0; k4 < 4; ++k4) { sT[k4] = (f32x4){0.f, 0.f, 0.f, 0.f};
#pragma unroll
            for (int ks = 0; ks < NKS; ++ks) { const bf16x8 a = *(const bf16x8*)(Ks + (16 * k4 + j) * KS + (32 * ks + 8 * g) * 2);
                sT[k4] = __builtin_amdgcn_mfma_f32_16x16x32_bf16(a, qf[ks], sT[k4], 0, 0, 0); } }
        if (CAUSAL && 64 * kt + 63 > qw0) {
#pragma unroll
            for (int k4 = 0; k4 < 4; ++k4)
#pragma unroll
                for (int r = 0; r < 4; ++r) if (64 * kt + 16 * k4 + 4 * g + r > qrow) sT[k4][r] = -INFINITY;
        }
        float mx = -INFINITY;
#pragma unroll
        for (int k4 = 0; k4 < 4; ++k4) mx = fmaxf(mx, fmaxf(fmaxf(sT[k4][0], sT[k4][1]), fmaxf(sT[k4][2], sT[k4][3])));
        mx = fmaxf(mx, __shfl_xor(mx, 16)); mx = fmaxf(mx, __shfl_xor(mx, 32));
        const float mnew = fmaxf(mrun, mx); const float alpha = __builtin_amdgcn_exp2f(mrun - mnew); mrun = mnew;
        float psum = 0.f;
#pragma unroll
        for (int k4 = 0; k4 < 4; ++k4)
#pragma unroll
            for (int r = 0; r < 4; ++r) { const float pv = __builtin_amdgcn_exp2f(sT[k4][r] - mnew); sT[k4][r] = pv; psum += pv; }
        lsum = lsum * alpha + psum;
#pragma unroll
        for (int d = 0; d < NDT; ++d) oT[d] *= alpha;
#pragma unroll
        for (int kc = 0; kc < 2; ++kc) {
            const bf16x8 pb = __builtin_bit_cast(bf16x8, pk8(sT[2 * kc], sT[2 * kc + 1]));
#pragma unroll
            for (int d = 0; d < NDT; ++d) { const unsigned char* vp = Vs + (16 * d + j) * VS + (32 * kc + 4 * g) * 2;
                const u32x2 lo = *(const u32x2*)vp, hi = *(const u32x2*)(vp + 32); u32x4 w; w.x = lo.x; w.y = lo.y; w.z = hi.x; w.w = hi.y;
                oT[d] = __builtin_amdgcn_mfma_f32_16x16x32_bf16(__builtin_bit_cast(bf16x8, w), pb, oT[d], 0, 0, 0); }
        }
    }
#undef ATT_PREFETCH
    lsum += __shfl_xor(lsum, 16); lsum += __shfl_xor(lsum, 32);
    const float inv = 1.f / lsum;
#pragma unroll
    for (int d = 0; d < NDT; ++d) { u32x2 w; w.x = pk2(oT[d][0] * inv, oT[d][1] * inv); w.y = pk2(oT[d][2] * inv, oT[d][3] * inv);
        *(GAS u32x2*)(Ob + (size_t)qrow * ldo + 16 * d + 4 * g) = w; }
}

__device__ __forceinline__ void lora_act_rows(int wid_s, KP p_, int l, int r) {
    KP p = p_; asm volatile("" : "+s"(p));
    unsigned char* ws = p->ws;
    const int tid_ = mk_tid(wid_s);
    const int tid = tid_;
    const bf16* P = (const bf16*)(ws + R_P); bf16* Awa = (bf16*)(ws + WS_Y) + (size_t)r * TH * 1536 + 1024; bf16* Ag = (bf16*)(ws + WS_AG);
    const float* mu = p->in[I_MU] + l * 1792 + 1536;
    const int sub = tid & 31, j0 = sub * 8;
    f32x4 m0 = *(const f32x4*)(mu + j0), m1 = *(const f32x4*)(mu + j0 + 4);
    for (int row = blockIdx.x * 16 + (tid >> 5); row < TH; row += gridDim.x * 16) {
        const u32x4 cw = *(const u32x4*)(P + (size_t)row * NP + 1536 + j0);
        u32x4 pw = {0u, 0u, 0u, 0u}; if ((row & 2047) != 0) pw = *(const u32x4*)(P + (size_t)(row - 1) * NP + 1536 + j0);
        float c[8] = {bflo(cw.x), bfhi(cw.x), bflo(cw.y), bfhi(cw.y), bflo(cw.z), bfhi(cw.z), bflo(cw.w), bfhi(cw.w)};
        const float q[8] = {bflo(pw.x), bfhi(pw.x), bflo(pw.y), bfhi(pw.y), bflo(pw.z), bfhi(pw.z), bflo(pw.w), bfhi(pw.w)};
        const float mm[8] = {m0.x, m0.y, m0.z, m0.w, m1.x, m1.y, m1.z, m1.w};
#pragma unroll
        for (int e = 0; e < 8; ++e) { float v = c[e] + (q[e] - c[e]) * mm[e];
            if (j0 < 64) v = 2.f * fsig(2.f * v) - 1.f;
            else if (j0 >= 128) v = fsig(v);
            c[e] = v; }
        u32x4 o; o.x = pk2(c[0], c[1]); o.y = pk2(c[2], c[3]); o.z = pk2(c[4], c[5]); o.w = pk2(c[6], c[7]);
        if (j0 < 128) *(u32x4*)(Awa + (size_t)row * 1536 + j0) = o; else *(u32x4*)(Ag + (size_t)row * 128 + (j0 - 128)) = o;
    }
}
__device__ __forceinline__ void si_build_tile(int wid_s, KP p_, int l, int r, int tile) {
    KP p = p_; asm volatile("" : "+s"(p));
    unsigned char* ws = p->ws;
    const int tid_ = mk_tid(wid_s);
    const int tid = tid_, lane = tid & 63, wv = tid >> 6;
    const GAS bf16* P = (const GAS bf16*)(ws + R_P); GAS bf16* SI = (GAS bf16*)(ws + R_SI); const GAS bf16* LW = (const GAS bf16*)(ws + WS_Y) + (size_t)r * TH * 1536;
    const float* mu = p->in[I_MU] + l * 1792;
    const int row0 = tile * 32;
    const int c = tid, h = wv;
    const float w0c = p->in[I_W0][l * 512 + c], a0c = p->in[I_A0][l * 512 + c], kkc = p->in[I_KK][l * 512 + c], kac = p->in[I_KA][l * 512 + c];
    const float mur = mu[c], muk = mu[512 + c], muv = mu[1024 + c];
#pragma unroll 4
    for (int t = 0; t < 32; ++t) {
        const int row = row0 + t; const bool first = (row & 2047) == 0;
        const GAS bf16* pr = P + (size_t)row * NP; const GAS bf16* pp = pr - NP;
        const float rc = bf2f(pr[c]), kc = bf2f(pr[512 + c]), vc = bf2f(pr[1024 + c]);
        const float rp = first ? 0.f : bf2f(pp[c]), kp = first ? 0.f : bf2f(pp[512 + c]), vp = first ? 0.f : bf2f(pp[1024 + c]);
        const float wl = bf2f(LW[(size_t)row * 1536 + c]), al = bf2f(LW[(size_t)row * 1536 + 512 + c]);
        const float rr = rc + (rp - rc) * mur, k = kc + (kp - kc) * muk, v = vc + (vp - vc) * muv;
        const float om = 1.f - __expf(-0.6065306597126334f * fsig(w0c + wl));
        const float a = fsig(a0c + al);
        const float kkr = k * kkc; const float ss = wave_sum(kkr * kkr); const float kk = kkr / fmaxf(sqrtf(ss), 1e-12f);
        const float k2 = k * (1.f + (a - 1.f) * kac);
        GAS bf16* o = SI + ((size_t)((row >> 11) * 8 + h) * 2048 + (row & 2047)) * 384 + lane;
        o[0] = (bf16)f2bf(rr); o[64] = (bf16)f2bf(om); o[128] = (bf16)f2bf(k2); o[192] = (bf16)f2bf(kk); o[256] = (bf16)f2bf(kk * a); o[320] = (bf16)f2bf(v);
    }
}

template <int CTRL> __device__ __forceinline__ float dppf(float x) { return __builtin_bit_cast(float, __builtin_amdgcn_update_dpp(0, __builtin_bit_cast(int, x), CTRL, 0xF, 0xF, true)); }
__device__ __forceinline__ float allreduce8(float x);
__device__ __forceinline__ float allreduce16(float x) { x += dppf<0xB1>(x); x += dppf<0x4E>(x); x += dppf<0x141>(x); x += dppf<0x140>(x); return x; }
template <int MODE>
__device__ __forceinline__ void rwkv_scan_unit(int wid_s, const bf16* SIbh_, bf16* Yb_, int ystride, int quarter, float* ldsf) {
    const int tid_ = mk_tid(wid_s);
    const GAS bf16* SIbh = (const GAS bf16*)SIbh_; GAS bf16* Yb = (GAS bf16*)Yb_;
    const int tid = tid_, lane = tid & 63, wv = tid >> 6, hw = wv - 4;
    float* PYb = ldsf + 4 * (16 * 384);
    u32x4 hreg[12];
    if (wv >= 4 && wv < 7) {
#pragma unroll
        for (int i = 0; i < 12; ++i) hreg[i] = *(const GAS u32x4*)(SIbh + (size_t)hw * (16 * 384) + (size_t)(lane + 64 * i) * 8);
    }
    f32x2 Sa = {0.f, 0.f}, Sb = {0.f, 0.f};
    const int rowl = quarter * 16 + (wv & 3) * 4 + (lane >> 4), c4 = (lane & 15) * 4;
    __syncthreads();
#define SCAN_CONVERT(cn) do { float* Bd = ldsf + ((cn) & 3) * (16 * 384); \
        _Pragma("unroll") for (int i = 0; i < 12; ++i) { float* d = Bd + (lane + 64 * i) * 8; const u32x4 w = hreg[i]; \
            *(f32x4*)d = (f32x4){bflo(w.x), bfhi(w.x), bflo(w.y), bfhi(w.y)}; *(f32x4*)(d + 4) = (f32x4){bflo(w.z), bfhi(w.z), bflo(w.w), bfhi(w.w)}; } \
        if ((cn) + 3 < 128) { _Pragma("unroll") for (int i = 0; i < 12; ++i) hreg[i] = *(const GAS u32x4*)(SIbh + (size_t)((cn) + 3) * (16 * 384) + (size_t)(lane + 64 * i) * 8); } } while (0)
    if (wv == 4) SCAN_CONVERT(0);
    for (int ch = 0; ch <= 128; ++ch) {
        LBAR();
        if (wv < 4) {
            if (ch < 128) {
                const float* B = ldsf + (ch & 3) * (16 * 384);
                float* PY = PYb + (ch & 1) * (16 * 256) + wv * 64 + lane;
                const float* q = B;
                f32x4 r4 = *(const f32x4*)(q + c4), om4 = *(const f32x4*)(q + 64 + c4), k4 = *(const f32x4*)(q + 128 + c4), kk4 = *(const f32x4*)(q + 192 + c4), ka4 = *(const f32x4*)(q + 256 + c4);
                float v = q[320 + rowl];
                __builtin_amdgcn_s_setprio(3);
#pragma unroll
                for (int s = 0; s < 16; ++s) {
                    const float* qn = B + ((MODE & 2) ? 0 : ((s + 1) & 15)) * 384;
                    const f32x4 nr4 = *(const f32x4*)(qn + c4), nom4 = *(const f32x4*)(qn + 64 + c4), nk4 = *(const f32x4*)(qn + 128 + c4), nkk4 = *(const f32x4*)(qn + 192 + c4), nka4 = *(const f32x4*)(qn + 256 + c4);
                    const float nv = qn[320 + rowl];
                    const f32x2 pa = Sa * (f32x2){kk4.x, kk4.y} + Sb * (f32x2){kk4.z, kk4.w};
                    const float sa = (MODE & 1) ? (pa.x + pa.y) : allreduce16(pa.x + pa.y);
                    Sa = Sa - Sa * (f32x2){om4.x, om4.y} + (f32x2){k4.x, k4.y} * v; Sb = Sb - Sb * (f32x2){om4.z, om4.w} + (f32x2){k4.z, k4.w} * v;
                    Sa = Sa - (f32x2){ka4.x, ka4.y} * sa; Sb = Sb - (f32x2){ka4.z, ka4.w} * sa;
                    const f32x2 py = Sa * (f32x2){r4.x, r4.y} + Sb * (f32x2){r4.z, r4.w};
                    PY[s * 256] = py.x + py.y;
                    r4 = nr4; om4 = nom4; k4 = nk4; kk4 = nkk4; ka4 = nka4; v = nv;
                }
                __builtin_amdgcn_s_setprio(0);
            }
        } else if (wv == 7) {
            if (ch > 0) {
                const int s = lane >> 2, rr = lane & 3;
#pragma unroll
                for (int mw = 0; mw < 4; ++mw) {
                    const float* src = PYb + ((ch - 1) & 1) * (16 * 256) + s * 256 + mw * 64 + rr * 16;
                    const f32x4 a = *(const f32x4*)src, b = *(const f32x4*)(src + 4), c = *(const f32x4*)(src + 8), d = *(const f32x4*)(src + 12);
                    const float y = ((a.x + a.y) + (a.z + a.w)) + ((b.x + b.y) + (b.z + b.w)) + ((c.x + c.y) + (c.z + c.w)) + ((d.x + d.y) + (d.z + d.w));
                    Yb[(size_t)((ch - 1) * 16 + s) * ystride + quarter * 16 + mw * 4 + rr] = (bf16)f2bf(y);
                }
            }
        } else {
            const int cn = ch + 1;
            if (cn < 128 && (cn % 3) == hw) SCAN_CONVERT(cn);
        }
    }
#undef SCAN_CONVERT
    __syncthreads();
}

__device__ __forceinline__ void rwkv_post_tile(int wid_s, KP p_, int l, int r, int tile, int dummy) {
    KP p = p_; asm volatile("" : "+s"(p));
    unsigned char* ws = p->ws;
    const int tid_ = mk_tid(wid_s);
    const int tid = tid_, lane = tid & 63, wv = tid >> 6;
    const GAS bf16* P = (const GAS bf16*)(ws + R_P); const GAS bf16* SI = (const GAS bf16*)(ws + R_SI); GAS bf16* Y = (GAS bf16*)(ws + WS_Y) + (size_t)r * TH * 1536;
    const int row0 = tile * 32;
    const int c = tid, h = wv;
    const float rkc = p->in[I_RK][l * 512 + c], lng = p->in[I_LNG][l * 512 + c], lnb = p->in[I_LNB][l * 512 + c];
#pragma unroll 4
    for (int t = 0; t < 32; ++t) {
        const int row = row0 + t;
        const GAS bf16* si = SI + ((size_t)((row >> 11) * 8 + h) * 2048 + (row & 2047)) * 384 + lane;
        const float rr = bf2f(si[0]), k2 = bf2f(si[128]), v = bf2f(si[320]);
        const float gg = bf2f(P[(size_t)row * NP + c]);
        GAS bf16* yp = Y + (size_t)row * 1536 + c;
        const float y = bf2f(*yp);
        const float mean = wave_sum(y) * (1.f / 64.f); const float d = y - mean; const float var = wave_sum(d * d) * (1.f / 64.f);
        const float yn = d * rsqrtf(var + 64e-5f) * lng + lnb;
        const float bonus = wave_sum(rr * k2 * rkc) * v;
        if (dummy) yp = (GAS bf16*)(ws + R_P) + (size_t)row * NP + 600 + c;
        *yp = (bf16)f2bf((yn + bonus) * gg);
    }
}

__device__ __forceinline__ float allreduce8(float x) { x += dppf<0xB1>(x); x += dppf<0x4E>(x); x += dppf<0x141>(x); return x; }
__device__ __forceinline__ void unpack8(const u32x4 w, float* f) { f[0] = bflo(w.x); f[1] = bfhi(w.x); f[2] = bflo(w.y); f[3] = bfhi(w.y); f[4] = bflo(w.z); f[5] = bfhi(w.z); f[6] = bflo(w.w); f[7] = bfhi(w.w); }
__device__ __forceinline__ u32x4 pack8(const float* f) { u32x4 o; o.x = pk2(f[0], f[1]); o.y = pk2(f[2], f[3]); o.z = pk2(f[4], f[5]); o.w = pk2(f[6], f[7]); return o; }
__device__ __forceinline__ void ld8f(const GAS float* q, float* f) { const f32x4 a = *(const GAS f32x4*)q, b = *(const GAS f32x4*)(q + 4); f[0] = a.x; f[1] = a.y; f[2] = a.z; f[3] = a.w; f[4] = b.x; f[5] = b.y; f[6] = b.z; f[7] = b.w; }
__device__ __forceinline__ void si_build_rows(int wid_s, KP p_, int l, int r) {
    KP p = p_; asm volatile("" : "+s"(p));
    unsigned char* ws = p->ws;
    const int tid_ = mk_tid(wid_s);
    const int tid = tid_, lane = tid & 63, wv = tid >> 6, c0 = lane * 8, h = lane >> 3;
    const GAS bf16* P = (const GAS bf16*)(ws + R_P); GAS bf16* SI = (GAS bf16*)(ws + R_SI); const GAS bf16* LW = (const GAS bf16*)(ws + WS_Y) + (size_t)r * TH * 1536;
    float w0c[8], a0c[8], kkc[8], kac[8], mur[8], muk[8], muv[8];
    ld8f((const GAS float*)p->in[I_W0] + l * 512 + c0, w0c); ld8f((const GAS float*)p->in[I_A0] + l * 512 + c0, a0c); ld8f((const GAS float*)p->in[I_KK] + l * 512 + c0, kkc); ld8f((const GAS float*)p->in[I_KA] + l * 512 + c0, kac);
    ld8f((const GAS float*)p->in[I_MU] + l * 1792 + c0, mur); ld8f((const GAS float*)p->in[I_MU] + l * 1792 + 512 + c0, muk); ld8f((const GAS float*)p->in[I_MU] + l * 1792 + 1024 + c0, muv);
    for (int row = blockIdx.x * 8 + wv; row < TH; row += gridDim.x * 8) {
        const bool first = (row & 2047) == 0;
        const GAS bf16* pr = P + (size_t)row * NP + c0; const GAS bf16* pp = pr - NP;
        const u32x4 z4 = {0u, 0u, 0u, 0u};
        const u32x4 rcw = *(const GAS u32x4*)pr, kcw = *(const GAS u32x4*)(pr + 512), vcw = *(const GAS u32x4*)(pr + 1024);
        const u32x4 rpw = first ? z4 : *(const GAS u32x4*)pp, kpw = first ? z4 : *(const GAS u32x4*)(pp + 512), vpw = first ? z4 : *(const GAS u32x4*)(pp + 1024);
        const u32x4 wlw = *(const GAS u32x4*)(LW + (size_t)row * 1536 + c0), alw = *(const GAS u32x4*)(LW + (size_t)row * 1536 + 512 + c0);
        float rc[8], kc[8], vc[8], rp[8], kp[8], vp[8], wl[8], al[8];
        unpack8(rcw, rc); unpack8(kcw, kc); unpack8(vcw, vc); unpack8(rpw, rp); unpack8(kpw, kp); unpack8(vpw, vp); unpack8(wlw, wl); unpack8(alw, al);
        float rr[8], om[8], k2[8], kk[8], ka[8], vv[8]; float ss = 0.f;
#pragma unroll
        for (int e = 0; e < 8; ++e) { rr[e] = rc[e] + (rp[e] - rc[e]) * mur[e]; const float k = kc[e] + (kp[e] - kc[e]) * muk[e]; vv[e] = vc[e] + (vp[e] - vc[e]) * muv[e];
            om[e] = 1.f - __expf(-0.6065306597126334f * fsig(w0c[e] + wl[e]));
            const float a = fsig(a0c[e] + al[e]);
            kk[e] = k * kkc[e]; ss += kk[e] * kk[e]; k2[e] = k * (1.f + (a - 1.f) * kac[e]); ka[e] = a; }
        ss = allreduce8(ss);
        const float inv = 1.f / fmaxf(sqrtf(ss), 1e-12f);
#pragma unroll
        for (int e = 0; e < 8; ++e) { kk[e] *= inv; ka[e] *= kk[e]; }
        GAS bf16* o = SI + ((size_t)((row >> 11) * 8 + h) * 2048 + (row & 2047)) * 384 + (lane & 7) * 8;
        *(GAS u32x4*)o = pack8(rr); *(GAS u32x4*)(o + 64) = pack8(om); *(GAS u32x4*)(o + 128) = pack8(k2); *(GAS u32x4*)(o + 192) = pack8(kk); *(GAS u32x4*)(o + 256) = pack8(ka); *(GAS u32x4*)(o + 320) = pack8(vv);
    }
}
__device__ __forceinline__ void rwkv_post_rows(int wid_s, KP p_, int l, int r, int dummy) {
    KP p = p_; asm volatile("" : "+s"(p));
    unsigned char* ws = p->ws;
    const int tid_ = mk_tid(wid_s);
    const int tid = tid_, lane = tid & 63, wv = tid >> 6, c0 = lane * 8, h = lane >> 3;
    const GAS bf16* P = (const GAS bf16*)(ws + R_P); const GAS bf16* SI = (const GAS bf16*)(ws + R_SI); GAS bf16* Y = (GAS bf16*)(ws + WS_Y) + (size_t)r * TH * 1536;
    float rkc[8], lng[8], lnb[8];
    ld8f((const GAS float*)p->in[I_RK] + l * 512 + c0, rkc); ld8f((const GAS float*)p->in[I_LNG] + l * 512 + c0, lng); ld8f((const GAS float*)p->in[I_LNB] + l * 512 + c0, lnb);
    for (int row = blockIdx.x * 8 + wv; row < TH; row += gridDim.x * 8) {
        const GAS bf16* si = SI + ((size_t)((row >> 11) * 8 + h) * 2048 + (row & 2047)) * 384 + (lane & 7) * 8;
        const u32x4 rw = *(const GAS u32x4*)si, kw = *(const GAS u32x4*)(si + 128), vw = *(const GAS u32x4*)(si + 320);
        const u32x4 gw = *(const GAS u32x4*)(P + (size_t)row * NP + c0);
        GAS bf16* yp = Y + (size_t)row * 1536 + c0;
        const u32x4 yw = *(const GAS u32x4*)yp;
        float rr[8], k2[8], vv[8], gg[8], y[8];
        unpack8(rw, rr); unpack8(kw, k2); unpack8(vw, vv); unpack8(gw, gg); unpack8(yw, y);
        float sy = 0.f, sb = 0.f;
#pragma unroll
        for (int e = 0; e < 8; ++e) { sy += y[e]; sb += rr[e] * k2[e] * rkc[e]; }
        const float mean = allreduce8(sy) * (1.f / 64.f); const float bonus = allreduce8(sb);
        float sv = 0.f;
#pragma unroll
        for (int e = 0; e < 8; ++e) { y[e] -= mean; sv += y[e] * y[e]; }
        const float rs = rsqrtf(allreduce8(sv) * (1.f / 64.f) + 64e-5f);
#pragma unroll
        for (int e = 0; e < 8; ++e) y[e] = (y[e] * rs * lng[e] + lnb[e] + bonus * vv[e]) * gg[e];
        if (dummy) yp = (GAS bf16*)(ws + R_P) + (size_t)row * NP + 600 + c0;
        *(GAS u32x4*)yp = pack8(y);
    }
}

__device__ __forceinline__ float gelu_tanh(float x) { const float u = 0.7978845608028654f * (x + 0.044715f * x * x * x); return x * fsig(2.f * u); }
__device__ __forceinline__ void lru_unit(int wid_s, KP p_, int l, int r, int bl, int n, float* ldsf) {
    KP p = p_; asm volatile("" : "+s"(p));
    unsigned char* ws = p->ws;
    const int tid_ = mk_tid(wid_s);
    const int tid = tid_, lane = tid & 63, wv = tid >> 6, g = lane >> 4, j = lane & 15;
    const GAS bf16* P = (const GAS bf16*)(ws + R_P) + (size_t)bl * 2048 * NP; GAS bf16* Yb = (GAS bf16*)(ws + WS_Y) + ((size_t)(r * 4 + bl) * 2048) * 1536 + 512;
    const int cg_ = n * 64 + lane;
    float* s_xc = ldsf;
    float* s_a = ldsf + 8192;
    float* s_u = ldsf + 16384;
    float* s_AH = ldsf + 24576;
    unsigned char* s_xb16 = (unsigned char*)ldsf + 102400;
    unsigned char* s_wt16 = (unsigned char*)ldsf + 120832;
    LBAR();
    for (int e = tid; e < 8192; e += 512) { const int jj = e >> 6, ii = e & 63;
        const float w = (jj < 64) ? p->in[I_WA][((size_t)l * 8 + n) * 4096 + ii * 64 + jj] : p->in[I_WX][((size_t)l * 8 + n) * 4096 + ii * 64 + (jj - 64)];
        *(bf16*)(s_wt16 + (jj * 72 + ii) * 2) = (bf16)f2bf(w); }
    const float cw0 = p->in[I_CW][(l * 4 + 0) * 512 + cg_], cw1 = p->in[I_CW][(l * 4 + 1) * 512 + cg_], cw2 = p->in[I_CW][(l * 4 + 2) * 512 + cg_], cw3 = p->in[I_CW][(l * 4 + 3) * 512 + cg_];
    const float cb = p->in[I_CB][l * 512 + cg_];
    float ba4[4], bx4[4], sp4[4];
#pragma unroll
    for (int n4 = 0; n4 < 4; ++n4) { const int c = n * 64 + 16 * n4 + j; ba4[n4] = p->in[I_BA][l * 512 + c]; bx4[n4] = p->in[I_BX][l * 512 + c];
        sp4[n4] = -8.f * 1.4426950408889634f * log1pf(__expf(-p->in[I_LAM][l * 512 + c])); }
    float hcar = 0.f;
    for (int tile = 0; tile < 16; ++tile) {
        const int t0 = tile * 128 + wv * 16;
        float xc[16]; unsigned short gbr[16];
        {
            float x3 = (t0 >= 3) ? bf2f(P[(size_t)(t0 - 3) * NP + 1792 + cg_]) : 0.f, x2 = (t0 >= 2) ? bf2f(P[(size_t)(t0 - 2) * NP + 1792 + cg_]) : 0.f, x1 = (t0 >= 1) ? bf2f(P[(size_t)(t0 - 1) * NP + 1792 + cg_]) : 0.f;
#pragma unroll
            for (int i = 0; i < 16; ++i) { const float x0 = bf2f(P[(size_t)(t0 + i) * NP + 1792 + cg_]);
                xc[i] = cw0 * x3 + cw1 * x2 + cw2 * x1 + cw3 * x0 + cb; x3 = x2; x2 = x1; x1 = x0; }
#pragma unroll
            for (int i = 0; i < 16; ++i) gbr[i] = P[(size_t)(t0 + i) * NP + 2304 + cg_];
        }
        LBAR();
#pragma unroll
        for (int i = 0; i < 16; ++i) { s_xc[(wv * 16 + i) * 64 + lane] = xc[i]; *(bf16*)(s_xb16 + ((wv * 16 + i) * 72 + lane) * 2) = (bf16)f2bf(xc[i]); }
        LBAR();
        {
            f32x4 acc[8];
            const bf16x8 a0 = *(const bf16x8*)(s_xb16 + ((16 * wv + j) * 72 + 8 * g) * 2), a1 = *(const bf16x8*)(s_xb16 + ((16 * wv + j) * 72 + 32 + 8 * g) * 2);
#pragma unroll
            for (int nn = 0; nn < 8; ++nn) { acc[nn] = (f32x4){0.f, 0.f, 0.f, 0.f};
                const bf16x8 b0 = *(const bf16x8*)(s_wt16 + ((16 * nn + j) * 72 + 8 * g) * 2), b1 = *(const bf16x8*)(s_wt16 + ((16 * nn + j) * 72 + 32 + 8 * g) * 2);
                acc[nn] = __builtin_amdgcn_mfma_f32_16x16x32_bf16(a0, b0, acc[nn], 0, 0, 0); acc[nn] = __builtin_amdgcn_mfma_f32_16x16x32_bf16(a1, b1, acc[nn], 0, 0, 0); }
#pragma unroll
            for (int n4 = 0; n4 < 4; ++n4)
#pragma unroll
                for (int rr = 0; rr < 4; ++rr) { const int tk = 16 * wv + 4 * g + rr, c = 16 * n4 + j;
                    const float rg = fsig(acc[n4][rr] + ba4[n4]), ig = fsig(acc[n4 + 4][rr] + bx4[n4]);
                    const float a = __builtin_amdgcn_exp2f(sp4[n4] * rg);
                    const float uu = __builtin_amdgcn_sqrtf(fmaxf(1.f - a * a, 0.f)) * (ig * s_xc[tk * 64 + c]);
                    s_a[tk * 64 + c] = a; s_u[tk * 64 + c] = uu; }
        }
        LBAR();
        float av[16], uv[16]; float A = 1.f, H = 0.f;
#pragma unroll
        for (int i = 0; i < 16; ++i) { av[i] = s_a[(wv * 16 + i) * 64 + lane]; uv[i] = s_u[(wv * 16 + i) * 64 + lane]; A *= av[i]; H = av[i] * H + uv[i]; }
        s_AH[(wv * 64 + lane) * 2] = A; s_AH[(wv * 64 + lane) * 2 + 1] = H;
        LBAR();
        float hin = hcar, hall = hcar;
#pragma unroll
        for (int w = 0; w < 8; ++w) { const float Aw = s_AH[(w * 64 + lane) * 2], Hw = s_AH[(w * 64 + lane) * 2 + 1]; hall = Aw * hall + Hw; if (w < wv) hin = hall; }
        hcar = hall;
        float hh = hin;
#pragma unroll
        for (int i = 0; i < 16; ++i) { hh = av[i] * hh + uv[i];
            Yb[(size_t)(t0 + i) * 1536 + cg_] = (bf16)f2bf(hh * gelu_tanh(bf2f(gbr[i]))); }
    }
    LBAR();
}

__device__ __forceinline__ void kfix_rows(int wid_s, KP p_, int l, int r) {
    KP p = p_; asm volatile("" : "+s"(p));
    unsigned char* ws = p->ws;
    const int tid_ = mk_tid(wid_s);
    const int tid = tid_, lane = tid & 63, wv = tid >> 6, h = lane >> 3, sub = lane & 7;
    const GAS bf16* P = (const GAS bf16*)(ws + R_P); GAS bf16* Km = (GAS bf16*)(ws + R_KM);
    const float* kg = p->in[I_KG] + l * 96; const int* pos = (const int*)p->in[I_POS] + r * TH;
    for (int row = blockIdx.x * 8 + wv; row < TH; row += gridDim.x * 8) {
        GAS bf16* kp = Km + (size_t)row * 768 + h * 96;
        const u32x4 w = *(const GAS u32x4*)(kp + 8 * sub);
        float nv[8] = {bflo(w.x), bfhi(w.x), bflo(w.y), bfhi(w.y), bflo(w.z), bfhi(w.z), bflo(w.w), bfhi(w.w)};
        const unsigned k1 = *(const GAS unsigned*)(P + (size_t)row * NP + 3200 + 2 * sub), k2 = *(const GAS unsigned*)(P + (size_t)row * NP + 3216 + 2 * sub);
        float x1a = bflo(k1), x1b = bfhi(k1), x2a = bflo(k2), x2b = bfhi(k2);
        float ss = x1a * x1a + x1b * x1b + x2a * x2a + x2b * x2b;
#pragma unroll
        for (int e = 0; e < 8; ++e) ss += nv[e] * nv[e];
        ss += __shfl_xor(ss, 1); ss += __shfl_xor(ss, 2); ss += __shfl_xor(ss, 4);
        const float rs = rsqrtf(ss * (1.f / 96.f) + 1e-6f);
#pragma unroll
        for (int e = 0; e < 8; ++e) nv[e] *= rs * kg[8 * sub + e];
        x1a *= rs * kg[64 + 2 * sub]; x1b *= rs * kg[65 + 2 * sub]; x2a *= rs * kg[80 + 2 * sub]; x2b *= rs * kg[81 + 2 * sub];
        const int ps = pos[row]; float ca, sa, cb, sb; rope_cs(ps, 2 * sub, ca, sa); rope_cs(ps, 2 * sub + 1, cb, sb);
        u32x4 o; o.x = pk2(nv[0], nv[1]); o.y = pk2(nv[2], nv[3]); o.z = pk2(nv[4], nv[5]); o.w = pk2(nv[6], nv[7]);
        *(GAS u32x4*)(kp + 8 * sub) = o;
        *(GAS unsigned*)(kp + 64 + 2 * sub) = pk2(x1a * ca - x2a * sa, x1b * cb - x2b * sb);
        *(GAS unsigned*)(kp + 80 + 2 * sub) = pk2(x2a * ca + x1a * sa, x2b * cb + x1b * sb);
    }
}
__device__ __forceinline__ void mkfix_rows(int wid_s, KP p_, int l) {
    KP p = p_; asm volatile("" : "+s"(p));
    unsigned char* ws = p->ws;
    const int tid_ = mk_tid(wid_s);
    const int tid = tid_, lane = tid & 63, wv = tid >> 6, h = lane >> 4, sub = lane & 15;
    bf16* mk = (bf16*)(ws + R_MK); const float* kg = p->in[I_XKG] + l * 128;
    for (int row = blockIdx.x * 8 + wv; row < 2048; row += gridDim.x * 8) {
        bf16* kp = mk + (size_t)row * 512 + h * 128 + 8 * sub;
        const u32x4 w = *(const u32x4*)kp;
        float nv[8] = {bflo(w.x), bfhi(w.x), bflo(w.y), bfhi(w.y), bflo(w.z), bfhi(w.z), bflo(w.w), bfhi(w.w)};
        float ss = 0.f;
#pragma unroll
        for (int e = 0; e < 8; ++e) ss += nv[e] * nv[e];
        ss += __shfl_xor(ss, 1); ss += __shfl_xor(ss, 2); ss += __shfl_xor(ss, 4); ss += __shfl_xor(ss, 8);
        const float rs = rsqrtf(ss * (1.f / 128.f) + 1e-6f);
#pragma unroll
        for (int e = 0; e < 8; ++e) nv[e] *= rs * kg[8 * sub + e];
        u32x4 o; o.x = pk2(nv[0], nv[1]); o.y = pk2(nv[2], nv[3]); o.z = pk2(nv[4], nv[5]); o.w = pk2(nv[6], nv[7]);
        *(u32x4*)kp = o;
    }
}
__device__ __forceinline__ void memb_rows(int wid_s, KP p_) {
    KP p = p_; asm volatile("" : "+s"(p));
    unsigned char* ws = p->ws;
    const int tid_ = mk_tid(wid_s);
    const int tid = tid_, lane = tid & 63, wv = tid >> 6;
    const float* mem = p->in[I_MEM]; bf16* memb = (bf16*)(ws + R_MEMB);
    for (int row = blockIdx.x * 8 + wv; row < 2048; row += gridDim.x * 8) {
        const f32x4* xr = (const f32x4*)(mem + (size_t)row * 1024) + lane; f32x4 v[4]; float s = 0.f;
#pragma unroll
        for (int jq = 0; jq < 4; ++jq) { v[jq] = xr[64 * jq]; s += (v[jq].x * v[jq].x + v[jq].y * v[jq].y) + (v[jq].z * v[jq].z + v[jq].w * v[jq].w); }
        const float rs = rsqrtf(wave_sum(s) * (1.f / 1024.f) + 1e-6f);
#pragma unroll
        for (int jq = 0; jq < 4; ++jq) { u32x2 w; w.x = pk2(v[jq].x * rs, v[jq].y * rs); w.y = pk2(v[jq].z * rs, v[jq].w * rs); *((u32x2*)(memb + (size_t)row * 1024) + lane + 64 * jq) = w; }
    }
}

#define XB_TMO      128
#define XB_XCNT(j)  (256  + 64 * (j))
#define XB_XSUB(j)  (1280 + 64 * (j))
#define XB_XGEN(j)  (2304 + 64 * (j))
#define XB_TOP      3328
#define XB_TOPGEN   3392
#define XCD_BAR_WORDS 3456
#define XB_SPIN_CAP (1u << 22)
__device__ __forceinline__ unsigned xb_ld(unsigned* p)              { return __hip_atomic_load(p, __ATOMIC_RELAXED, __HIP_MEMORY_SCOPE_AGENT); }
__device__ __forceinline__ unsigned xb_add(unsigned* p, unsigned v) { return __hip_atomic_fetch_add(p, v, __ATOMIC_RELAXED, __HIP_MEMORY_SCOPE_AGENT); }
__device__ __forceinline__ unsigned xb_xcc_id() { return (unsigned)__builtin_amdgcn_s_getreg((3 << 11) | 20) & 0xFu; }
#define XB_SPIN(cond, bar) do { unsigned _sp = 0; while (cond) { __builtin_amdgcn_s_sleep(1); \
    if ((++_sp & 255u) == 0u) { if (xb_ld(&(bar)[XB_TMO])) break; if (_sp > XB_SPIN_CAP) { atomicAdd(&(bar)[XB_TMO], 1u); break; } } } } while (0)
__device__ __forceinline__ void xcd_barrier_complete(unsigned* bar, unsigned x, unsigned& nloc, unsigned& nx) {
    const unsigned G = gridDim.x;
    unsigned sum, cnt, mine, sp = 0u;
    for (;;) {
        sum = 0u; cnt = 0u; mine = 0u;
#pragma unroll
        for (unsigned j = 0; j < 16; ++j) { const unsigned c = xb_ld(&bar[XB_XCNT(j)]); sum += c; cnt += (c > 0u) ? 1u : 0u; mine = (j == x) ? c : mine; }
        if (sum == G) break;
        __builtin_amdgcn_s_sleep(1);
        if ((++sp & 255u) == 0u) { if (xb_ld(&bar[XB_TMO])) break; if (sp > XB_SPIN_CAP) { atomicAdd(&bar[XB_TMO], 1u); break; } }
    }
    nloc = mine > 0u ? mine : 1u; nx = cnt > 0u ? cnt : 1u;
}
__device__ __forceinline__ void grid_barrier1(int wid_s, unsigned* bar, volatile unsigned* st) {
    asm volatile("s_waitcnt vmcnt(0)" ::: "memory");
    __syncthreads();
    if (mk_tid(wid_s) == 0) {
        const unsigned x = xb_xcc_id();
        __builtin_amdgcn_s_waitcnt(0);
        unsigned nloc = st[0], nx = st[1];
        if (nloc == 0u) { xcd_barrier_complete(bar, x, nloc, nx); st[0] = nloc; st[1] = nx; }
        const unsigned old = xb_add(&bar[XB_XSUB(x)], 1u);
        const unsigned gen = old / nloc;
        if (old + 1u == (gen + 1u) * nloc) {
            __builtin_amdgcn_fence(__ATOMIC_RELEASE, "agent");
            asm volatile("s_waitcnt vmcnt(0)" ::: "memory");
            const unsigned og = xb_add(&bar[XB_TOP], 1u);
            const unsigned tg = og / nx;
            if (og + 1u == (tg + 1u) * nx) xb_add(&bar[XB_TOPGEN], 1u);
            else XB_SPIN(xb_ld(&bar[XB_TOPGEN]) == tg, bar);
            __builtin_amdgcn_fence(__ATOMIC_ACQUIRE, "agent");
            xb_add(&bar[XB_XGEN(x)], 1u);
            asm volatile("s_waitcnt vmcnt(0)" ::: "memory");
        } else {
            XB_SPIN(xb_ld(&bar[XB_XGEN(x)]) == gen, bar);
            __builtin_amdgcn_fence(__ATOMIC_ACQUIRE, "agent");
            asm volatile("s_waitcnt vmcnt(0)" ::: "memory");
        }
    }
    __syncthreads();
}
__device__ __forceinline__ void grid_barrier(int wid_s, unsigned* bar, volatile unsigned* st) { int nb = 1 + RB(8); asm volatile("" : "+s"(nb)); for (int q = 0; q < nb; ++q) grid_barrier1(wid_s, bar, st); }
template <class Epi>
__device__ __forceinline__ void run_gemm(int wid_s, LAS unsigned char* lds, const bf16* A, int lda, const bf16* Bt, int M, int N, int K, const Epi& E, int shift = 0) {
    int bx_ = blockIdx.x, gx_ = gridDim.x; asm volatile("" : "+s"(bx_), "+s"(gx_), "+s"(K), "+s"(lda));
    pg8::Gemm g{A, Bt, M, N, K, lda}; pg8::StaticOrder S; S.init(M, N, gx_, (bx_ + shift) % gx_);
    if (ON(1)) pg8::gemm_phase<Epi, pg8::StaticOrder>(wid_s, lds, g, S, E);
}

__device__ __forceinline__ unsigned char* wsl_(KP p) { unsigned char* w = p->ws; asm volatile("" : "+s"(w)); return w; }
__global__ void __launch_bounds__(512, 2) fwd_kernel(Params parg) {
    KP p = (KP)__builtin_amdgcn_kernarg_segment_ptr();
    extern __shared__ __attribute__((aligned(16))) unsigned char lds_raw[];
    const int wid_s = __builtin_amdgcn_readfirstlane((int)threadIdx.x >> 6);
    LAS unsigned char* lds3 = (LAS unsigned char*)lds_raw;
    unsigned char* lds = lds_raw; float* ldsf = (float*)lds_raw;
    unsigned char* ws = p->ws;
    const int bid = blockIdx.x;
    unsigned* ctl = (unsigned*)(wsl_(p) + WS_CTL);
    bf16* xb = (bf16*)(wsl_(p) + WS_XB); float* part = (float*)(wsl_(p) + WS_PART); float* pq = (float*)(wsl_(p) + WS_PQ); float* pkv = (float*)(wsl_(p) + WS_PKV);
    bf16* Y = (bf16*)(wsl_(p) + WS_Y);
    float* xcur = p->out;
    volatile unsigned* bst = (volatile unsigned*)(lds + QIDX_OFF + 16);
    if (threadIdx.x == 0) { bst[0] = 0u; bst[1] = 0u; (void)xb_add(&ctl[1024 + XB_XCNT(xb_xcc_id())], 1u); }
    __syncthreads();

    for (int l_ = 0; l_ < 2; ++l_) {
        int l = l_; asm volatile("" : "+s"(l));
        { REPLOOP(0) { if (ON(0)) phase_convert(wid_s, p, l, ldsf);
        grid_barrier(wid_s, ctl + 1024, bst); } }
        for (int r_ = 0; r_ < 2; ++r_) {
            int r = r_; asm volatile("" : "+s"(r));
            { REPLOOP(1) { EpiP E{(bf16*)(wsl_(p) + R_P), part + (size_t)r * TH * 16, pq, pkv};
              run_gemm(wid_s, lds3, xb + (size_t)r * TH * 1024, 1024, (const bf16*)(wsl_(p) + W_IN), TH, NP, 1024, E);
            grid_barrier(wid_s, ctl + 1024, bst); } }
            { REPLOOP(2) {
            if (ON(2)) lora_act_rows(wid_s, p, l, r);
            { EpiQ E{(bf16*)(wsl_(p) + R_Q), pq}; run_gemm(wid_s, lds3, (const bf16*)(wsl_(p) + R_P) + 2816, NP, (const bf16*)(wsl_(p) + W_MQ), TH, 768, 256, E); }
            { EpiKV E{(bf16*)(wsl_(p) + R_KM), (bf16*)(wsl_(p) + R_VT), pkv}; run_gemm(wid_s, lds3, (const bf16*)(wsl_(p) + R_P) + 3072, NP, (const bf16*)(wsl_(p) + W_MKV), TH, 1024, 128, E); }
            grid_barrier(wid_s, ctl + 1024, bst); } }
            { REPLOOP(9) { EpiBf E{Y + (size_t)r * TH * 1536, 1536}; run_gemm(wid_s, lds3, Y + (size_t)r * TH * 1536 + 1024, 1536, (const bf16*)(wsl_(p) + W_BWA), TH, 1024, 128, E);
            grid_barrier(wid_s, ctl + 1024, bst); } }
            { REPLOOP(13) { if (ON(2)) si_build_rows(wid_s, p, l, r); } }
            if (ON(7)) kfix_rows(wid_s, p, l, r);
            grid_barrier(wid_s, ctl + 1024, bst);
            { REPLOOP(3) {
            if (ON(3) && !(q && RB(10)) && bid < 128) { const int xcd = bid & 7, idx = bid >> 3, hh = xcd * 4 + (idx >> 2), quarter = idx & 3;
                if (q == 0 || SCANMODE == 0) rwkv_scan_unit<0>(wid_s, (const bf16*)(wsl_(p) + R_SI) + (size_t)hh * 2048 * 384, Y + ((size_t)(r * 4 + (hh >> 3)) * 2048) * 1536 + (hh & 7) * 64, 1536, quarter, ldsf);
                else rwkv_scan_unit<SCANMODE>(wid_s, (const bf16*)(wsl_(p) + R_SI) + (size_t)hh * 2048 * 384, (bf16*)(wsl_(p) + R_P) + ((size_t)(hh >> 3) * 2048) * NP + 600 + (hh & 7) * 64, NP, quarter, ldsf); }
            else if (ON(4) && !(q && RB(11)) && bid >= 128 && bid < 160) { const int uu = bid - 128; lru_unit(wid_s, p, l, r, uu >> 3, uu & 7, ldsf); }
            else if (q == 0) { EpiBf E{(bf16*)(wsl_(p) + R_P), NP}; run_gemm(wid_s, lds3, (const bf16*)(wsl_(p) + WS_AG), 128, (const bf16*)(wsl_(p) + W_GUP), TH, 512, 128, E, 96); }
            {
                unsigned* ctr = ctl + q * 4 + l * 2 + r; volatile int* qidx = (volatile int*)(lds + QIDX_OFF);
                for (;;) {
                    __syncthreads();
                    if (mk_tid(wid_s) == 0) *qidx = (int)atomicAdd(ctr, 1u);
                    __syncthreads();
                    const int u = *qidx;
                    if (u >= 512 || !ON(5) || (q && RB(12))) break;
                    const int qb = 15 - (u >> 5), bh = u & 31, bl = bh >> 3, h = bh & 7;
                    attn_unit<96, 64, true, true>(wid_s, lds, (const bf16*)(wsl_(p) + R_Q) + (size_t)bl * 2048 * 768 + h * 96, 768, (const bf16*)(wsl_(p) + R_KM) + (size_t)bl * 2048 * 768 + h * 96, 768,
                        (const bf16*)(wsl_(p) + R_VT) + (size_t)(bl * 8 + h) * 64 * 2048, 2048, Y + ((size_t)(r * 4 + bl) * 2048) * 1536 + 1024 + h * 64, 1536,
                        qb * 128, 2 * qb + 2, p->in[I_QG] + l * 96, (const int*)p->in[I_POS] + (r * 4 + bl) * 2048, 0.14724444527f  );
                }
            }
            grid_barrier(wid_s, ctl + 1024, bst); } }
            { REPLOOP(16) { if (ON(6)) rwkv_post_rows(wid_s, p, l, r, q); } }
            grid_barrier(wid_s, ctl + 1024, bst);
        }
        if (ON(7)) memb_rows(wid_s, p);
        { REPLOOP(4) {
        for (int n = 0; n < 3; ++n) {
            { EpiGate E{(bf16*)(wsl_(p) + R_GS), part, p->in[I_BGATE] + l * 3072 + n * 1024}; run_gemm(wid_s, lds3, xb, 1024, (const bf16*)(wsl_(p) + W_GATE) + (size_t)n * 1024 * 1024, T, 1024, 1024, E); }
            { EpiProj E{(const bf16*)(wsl_(p) + R_GS), (float*)(wsl_(p) + R_MS), (bf16*)(wsl_(p) + R_MG), n}; run_gemm(wid_s, lds3, Y + n * 512, 1536, (const bf16*)(wsl_(p) + W_BR) + (size_t)n * 1024 * 512, T, 1024, 512, E); }
        }
        grid_barrier(wid_s, ctl + 1024, bst); } }
        { int nw = 1 + RB(15); asm volatile("" : "+s"(nw)); for (int q = 0; q < nw; ++q) { EpiRes E{l == 0 ? p->in[I_X] : xcur, xcur, xb, part, q + 1 < nw}; run_gemm(wid_s, lds3, (const bf16*)(wsl_(p) + R_MG), 1024, (const bf16*)(wsl_(p) + W_OUT), T, 1024, 1024, E); if (q + 1 < nw) grid_barrier(wid_s, ctl + 1024, bst); } }
        { REPLOOP(19) { EpiMemKV E{(bf16*)(wsl_(p) + R_MK), (bf16*)(wsl_(p) + R_MVT)}; run_gemm(wid_s, lds3, (const bf16*)(wsl_(p) + R_MEMB), 1024, (const bf16*)(wsl_(p) + W_XKV), 2048, 1024, 1024, E); } }
        grid_barrier(wid_s, ctl + 1024, bst);
        if (ON(7)) mkfix_rows(wid_s, p, l);
        { REPLOOP(5) { EpiXQ E{(bf16*)(wsl_(p) + R_XQ), part}; run_gemm(wid_s, lds3, xb, 1024, (const bf16*)(wsl_(p) + W_XQ), T, 512, 1024, E);
        grid_barrier(wid_s, ctl + 1024, bst); } }
        { REPLOOP(6) {
        if (ON(8)) for (int u = bid; u < 512; u += gridDim.x) { const int qb = u & 15, bh = u >> 4, b = bh >> 2, h = bh & 3;
            attn_unit<128, 128, false, false>(wid_s, lds, (const bf16*)(wsl_(p) + R_XQ) + (size_t)b * 2048 * 512 + h * 128, 512, (const bf16*)(wsl_(p) + R_MK) + (size_t)b * 256 * 512 + h * 128, 512,
                (const bf16*)(wsl_(p) + R_MVT) + (size_t)(b * 4 + h) * 128 * 256, 256, (bf16*)(wsl_(p) + R_XO) + (size_t)b * 2048 * 512 + h * 128, 512,
                qb * 128, 4, p->in[I_XQG] + l * 128, nullptr, 0.12751743082f  ); }
        grid_barrier(wid_s, ctl + 1024, bst); } }
        { int nw = 1 + RB(17); asm volatile("" : "+s"(nw)); for (int q = 0; q < nw; ++q) { EpiRes E{xcur, xcur, xb, part, q + 1 < nw}; run_gemm(wid_s, lds3, (const bf16*)(wsl_(p) + R_XO), 512, (const bf16*)(wsl_(p) + W_XO), T, 1024, 512, E); if (q + 1 < nw) grid_barrier(wid_s, ctl + 1024, bst); } }
        grid_barrier(wid_s, ctl + 1024, bst);
        { REPLOOP(7) { EpiFFN1 E{(bf16*)(wsl_(p) + R_H), part}; run_gemm(wid_s, lds3, xb, 1024, (const bf16*)(wsl_(p) + W_13), T, 5632, 1024, E);
        grid_barrier(wid_s, ctl + 1024, bst); } }
        { int nw = 1 + RB(18); asm volatile("" : "+s"(nw)); for (int q = 0; q < nw; ++q) { EpiRes E{xcur, xcur, xb, part, q + 1 < nw}; run_gemm(wid_s, lds3, (const bf16*)(wsl_(p) + R_H), DFF, (const bf16*)(wsl_(p) + W_2), T, 1024, DFF, E); if (q + 1 < nw) grid_barrier(wid_s, ctl + 1024, bst); } }
        grid_barrier(wid_s, ctl + 1024, bst);
    }
}

extern "C" void kernel_launch(void* const* d_in, const int* in_sizes, int n_in, void* d_out, int out_size, void* d_ws, size_t ws_size, hipStream_t stream) {
    static int grid = 0;
    if (grid == 0) {
        int dev = 0, cus = 0, per_cu = 0;
        if (n_in != 43 || ws_size < WS_END) { fprintf(stderr, "kernel_launch: unexpected n_in %d / ws %zu\n", n_in, ws_size); grid = -1; return; }
        (void)hipGetDevice(&dev);
        (void)hipDeviceGetAttribute(&cus, hipDeviceAttributeMultiprocessorCount, dev);
        (void)hipFuncSetAttribute((const void*)fwd_kernel, hipFuncAttributeMaxDynamicSharedMemorySize, LDS_BYTES);
        (void)hipOccupancyMaxActiveBlocksPerMultiprocessor(&per_cu, (const void*)fwd_kernel, 512, LDS_BYTES);
        fprintf(stderr, "cus %d per_cu %d ws %zu\n", cus, per_cu, ws_size);
        grid = cus * (per_cu >= 1 ? 1 : 0);
        if (grid <= 0) { grid = -1; return; }
    }
    if (grid < 0) return;
    Params p{};
    for (int i = 0; i < 43; ++i) p.in[i] = (const float*)d_in[i];
    p.out = (float*)d_out; p.ws = (unsigned char*)d_ws;
    (void)hipMemsetAsync((char*)d_ws + WS_CTL, 0, 32768, stream);
    void* args[] = {&p};
    hipError_t e = hipLaunchCooperativeKernel((const void*)fwd_kernel, dim3(grid), dim3(512), args, LDS_BYTES, stream);
    if (e != hipSuccess) fprintf(stderr, "cooperative launch failed: %s (grid %d)\n", hipGetErrorString(e), grid);
}
```

```cpp
#include <hip/hip_runtime.h>
#include <cstdio>
#include <cstdint>

#define LAS __attribute__((address_space(3)))
#define GAS __attribute__((address_space(1)))
typedef unsigned short bf16;
typedef short bf16x8 __attribute__((ext_vector_type(8)));
typedef float f32x4 __attribute__((ext_vector_type(4)));
typedef float f32x2 __attribute__((ext_vector_type(2)));
typedef unsigned u32x4 __attribute__((ext_vector_type(4)));
typedef unsigned u32x2 __attribute__((ext_vector_type(2)));

__device__ __forceinline__ unsigned f2bf(float f) { unsigned u = __builtin_bit_cast(unsigned, f); return (u + 0x7fffu + ((u >> 16) & 1u)) >> 16; }
typedef __bf16 bf16x2_t __attribute__((ext_vector_type(2)));
__device__ __forceinline__ unsigned pk2(float lo, float hi) { const f32x2 v = {lo, hi}; const bf16x2_t b = __builtin_convertvector(v, bf16x2_t); return __builtin_bit_cast(unsigned, b); }
__device__ __forceinline__ float bf2f(bf16 b) { return __builtin_bit_cast(float, (unsigned)b << 16); }
__device__ __forceinline__ float bflo(unsigned u) { return __builtin_bit_cast(float, u << 16); }
__device__ __forceinline__ float bfhi(unsigned u) { return __builtin_bit_cast(float, u & 0xffff0000u); }
__device__ __forceinline__ u32x4 pk8(f32x4 a, f32x4 b) { u32x4 w; w.x = pk2(a.x, a.y); w.y = pk2(a.z, a.w); w.z = pk2(b.x, b.y); w.w = pk2(b.z, b.w); return w; }
__device__ __forceinline__ float sigmoidf_(float x) { return 1.f / (1.f + __expf(-x)); }
__device__ __forceinline__ float fsig(float x) { return __builtin_amdgcn_rcpf(1.f + __builtin_amdgcn_exp2f(-1.4426950408889634f * x)); }
__device__ __forceinline__ int mk_tid(int wid_s) { int t = wid_s * 64 + (int)__builtin_amdgcn_mbcnt_hi(~0u, __builtin_amdgcn_mbcnt_lo(~0u, 0u)); asm volatile("" : "+v"(t)); return t; }
#define LBAR() asm volatile("s_waitcnt lgkmcnt(0)\n\ts_barrier" ::: "memory")
__device__ __forceinline__ float wave_sum(float v) {
#pragma unroll
    for (int o = 1; o < 64; o <<= 1) v += __shfl_xor(v, o);
    return v;
}

namespace pg8 {
#define PG8_LAS __attribute__((address_space(3)))
typedef unsigned short bf16_t;
constexpr int BM = 256, BK = 64, HALF = 128, HTB = HALF * BK * 2, STAGE_BYTES = 8 * HTB, NXCD = 8, WGM = 8;
__host__ __device__ __forceinline__ int lds_byte(int r, int c) { const int st = (r >> 4) * 2 + (c >> 5), rr = r & 15, cc = c & 31, ob = rr * 64 + cc * 2; return st * 1024 + (ob ^ (((ob >> 9) & 1) << 5)); }
__host__ __device__ __forceinline__ void stage_rc(int b, int& R, int& C) { const int st = b / 1024, sb = b % 1024, swz = sb ^ (((sb >> 9) & 1) << 5); R = (st >> 1) * 16 + swz / 64; C = (st & 1) * 32 + (swz % 64) / 2; }
__host__ __device__ __forceinline__ int perm32(int rho) { const int n = rho >> 4, i = rho & 15; return 8 * (i >> 2) + 4 * n + (i & 3); }
struct Unit { int pm, pn; };
struct Gemm { const bf16_t* A; const bf16_t* Bt; int M, N, K, lda; };
struct StaticOrder {
    int nM, nN, nwg, G, c;
    __host__ __device__ void init(int M, int N, int G_, int c_) { nM = M / BM; nN = N / BM; nwg = nM * nN; G = G_; c = c_; }
    __host__ __device__ bool next(int i, Unit& u) const {
        const long L = (long)i * G + c; if (L >= nwg) return false;
        int wgid = (int)L; { const int q = nwg / NXCD, r = nwg % NXCD, xcd = wgid % NXCD, off = wgid / NXCD; wgid = (xcd < r ? xcd * (q + 1) : r * (q + 1) + (xcd - r) * q) + off; }
        const int nig = WGM * nN, gid = wgid / nig, fm = gid * WGM, gsz = (nM - fm) < WGM ? (nM - fm) : WGM;
        u.pm = fm + ((wgid % nig) % gsz); u.pn = (wgid % nig) / gsz; return true;
    }
};
template <class Epi, class Sched>
__device__ __forceinline__ void gemm_phase(int wid_s, PG8_LAS unsigned char* lds, const Gemm g, const Sched& S, const Epi& E) {
    const int tid_ = mk_tid(wid_s);
    const int tid = tid_, wid = __builtin_amdgcn_readfirstlane(tid >> 6), lane = tid & 63, wr = wid >> 2, wc = wid & 3, fr = lane & 15, fq = lane >> 4;
    const int K = g.K, nt = K / BK, lda = g.lda;
    unsigned voffA[2], voffB[2];
#pragma unroll
    for (int i = 0; i < 2; ++i) { int R, C; stage_rc(tid * 16 + i * 8192, R, C); const int Rb = (R & ~31) + perm32(R & 31);
        voffA[i] = (unsigned)(R * lda + C) * 2u; voffB[i] = (unsigned)(Rb * K + C) * 2u; }
    const size_t kstep = (size_t)(BK * 2);
    const size_t hstepA = (size_t)HALF * lda * 2, hstepB = (size_t)HALF * K * 2;
    const size_t tstepA = 2 * hstepA, tstepB = 2 * hstepB;
    const unsigned ldsw = (unsigned)wid * 1024u;
    const int aoff = lds_byte(wr * 64 + fr, fq * 8), boff = lds_byte(wc * 32 + fr, fq * 8);
#define PG8_SA(b, h) (((b) * 2 + (h)) * HTB)
#define PG8_SB(b, h) ((4 + (b) * 2 + (h)) * HTB)
#define PG8_STAGE(bufoff, gbase, voff) do { _Pragma("unroll") for (int _i = 0; _i < 2; ++_i) \
        __builtin_amdgcn_global_load_lds((const unsigned*)((const char*)(gbase) + (voff)[_i]), (PG8_LAS unsigned*)(lds + (bufoff) + ldsw + _i * 8192), 16, 0, 0); } while (0)
#define PG8_LDA(dst, b, h) do { _Pragma("unroll") for (int m = 0; m < 4; ++m) _Pragma("unroll") for (int k = 0; k < 2; ++k) dst[m][k] = *(const PG8_LAS bf16x8*)(lds + PG8_SA(b, h) + aoff + m * 2048 + k * 1024); } while (0)
#define PG8_LDB(dst, b, h) do { _Pragma("unroll") for (int n = 0; n < 2; ++n) _Pragma("unroll") for (int k = 0; k < 2; ++k) dst[n][k] = *(const PG8_LAS bf16x8*)(lds + PG8_SB(b, h) + boff + n * 2048 + k * 1024); } while (0)
#define PG8_MMA(ai, bj, At, Bt) do { __builtin_amdgcn_s_setprio(1); _Pragma("unroll") for (int m = 0; m < 4; ++m) _Pragma("unroll") for (int n = 0; n < 2; ++n) _Pragma("unroll") for (int k = 0; k < 2; ++k) \
        acc[ai][bj][m][n] = __builtin_amdgcn_mfma_f32_16x16x32_bf16(Bt[n][k], At[m][k], acc[ai][bj][m][n], 0, 0, 0); __builtin_amdgcn_s_setprio(0); } while (0)
#define PG8_WAIT_V(n) asm volatile("s_waitcnt vmcnt(" #n ")" ::: "memory")
#define PG8_WAIT_L(n) asm volatile("s_waitcnt lgkmcnt(" #n ")" ::: "memory")
#define PG8_BAR __builtin_amdgcn_s_barrier()
#define PG8_SCHED __builtin_amdgcn_sched_barrier(0)
    Unit cur, nxt; int ui = 0;
    if (!S.next(0, cur)) return;
    f32x4 acc[2][2][4][2];
#pragma unroll
    for (int a = 0; a < 2; ++a)
#pragma unroll
        for (int b = 0; b < 2; ++b)
#pragma unroll
            for (int m = 0; m < 4; ++m)
#pragma unroll
                for (int n = 0; n < 2; ++n) acc[a][b][m][n] = (f32x4){0.f, 0.f, 0.f, 0.f};
    bf16x8 At[4][2], B0[2][2], B1[2][2];
    const char* cA = (const char*)g.A + (size_t)cur.pm * tstepA; const char* cB = (const char*)g.Bt + (size_t)cur.pn * tstepB;
    PG8_STAGE(PG8_SB(0, 0), cB, voffB); PG8_STAGE(PG8_SB(0, 1), cB + hstepB, voffB); PG8_STAGE(PG8_SA(0, 0), cA, voffA); PG8_STAGE(PG8_SA(0, 1), cA + hstepA, voffA);
    if (wr == 1) PG8_BAR;
    PG8_WAIT_V(2); PG8_BAR;
    PG8_STAGE(PG8_SB(1, 0), cB + kstep, voffB); PG8_STAGE(PG8_SA(1, 0), cA + kstep, voffA); PG8_STAGE(PG8_SB(1, 1), cB + hstepB + kstep, voffB);
    PG8_WAIT_V(6); PG8_BAR;
    for (;;) {
        const bool has_next = S.next(ui + 1, nxt);
        const char* nA = has_next ? (const char*)g.A + (size_t)nxt.pm * tstepA : cA; const char* nB = has_next ? (const char*)g.Bt + (size_t)nxt.pn * tstepB : cB;
#pragma unroll 1
        for (int t = 0; t < nt; t += 2) {
            const bool last = (t == nt - 2);
            const char* a1 = cA + (size_t)(t + 1) * kstep;
            const char* a2 = last ? nA : cA + (size_t)(t + 2) * kstep; const char* b2 = last ? nB : cB + (size_t)(t + 2) * kstep;
            const char* a3 = a2 + kstep; const char* b3 = b2 + kstep;
            PG8_LDB(B0, 0, 0); PG8_LDB(B1, 0, 1); PG8_SCHED; PG8_LDA(At, 0, 0); PG8_STAGE(PG8_SA(1, 1), a1 + hstepA, voffA);
            PG8_WAIT_V(8); PG8_WAIT_L(0); PG8_BAR; PG8_MMA(0, 0, At, B0); PG8_MMA(0, 1, At, B1); PG8_BAR; PG8_SCHED;
            PG8_LDA(At, 0, 1); PG8_STAGE(PG8_SB(0, 0), b2, voffB); PG8_STAGE(PG8_SB(0, 1), b2 + hstepB, voffB); PG8_STAGE(PG8_SA(0, 0), a2, voffA);
            PG8_WAIT_V(8); PG8_WAIT_L(0); PG8_BAR; PG8_MMA(1, 0, At, B0); PG8_MMA(1, 1, At, B1); PG8_BAR; PG8_SCHED;
            PG8_LDB(B0, 1, 0); PG8_LDB(B1, 1, 1); PG8_SCHED; PG8_LDA(At, 1, 0); PG8_STAGE(PG8_SA(0, 1), a2 + hstepA, voffA);
            PG8_WAIT_V(8); PG8_WAIT_L(0); PG8_BAR; PG8_MMA(0, 0, At, B0); PG8_MMA(0, 1, At, B1); PG8_BAR; PG8_SCHED;
            PG8_LDA(At, 1, 1); PG8_STAGE(PG8_SB(1, 0), b3, voffB); PG8_STAGE(PG8_SB(1, 1), b3 + hstepB, voffB); PG8_STAGE(PG8_SA(1, 0), a3, voffA);
            PG8_WAIT_V(8); PG8_WAIT_L(0); PG8_BAR; PG8_MMA(1, 0, At, B0); PG8_MMA(1, 1, At, B1); PG8_BAR; PG8_SCHED;
        }
        if (wr == 0) PG8_BAR;
        E(acc, cur, wr, wc, fr, fq);
        if (!has_next) break;
#pragma unroll
        for (int a = 0; a < 2; ++a)
#pragma unroll
            for (int b = 0; b < 2; ++b)
#pragma unroll
                for (int m = 0; m < 4; ++m)
#pragma unroll
                    for (int n = 0; n < 2; ++n) acc[a][b][m][n] = (f32x4){0.f, 0.f, 0.f, 0.f};
        cur = nxt; cA = nA; cB = nB; ++ui;
        if (wr == 1) PG8_BAR;
    }
    PG8_WAIT_V(0);
    PG8_BAR;
#undef PG8_SA
#undef PG8_SB
#undef PG8_STAGE
#undef PG8_LDA
#undef PG8_LDB
#undef PG8_MMA
#undef PG8_WAIT_V
#undef PG8_WAIT_L
#undef PG8_BAR
#undef PG8_SCHED
}
}

#ifndef EN
#define EN 0xFFFF
#endif
#define ON(b) ((EN >> (b)) & 1)
#ifndef REP
#define REP 0
#endif
#ifndef SCANMODE
#define SCANMODE 0
#endif
#define RB(b) ((REP >> (b)) & 1)
#define REPLOOP(b) int nrep##b = 1 + RB(b); asm volatile("" : "+s"(nrep##b)); for (int q = 0; q < nrep##b; ++q)
constexpr int T = 16384, TH = 8192, SEQ = 2048, DM = 1024, DIN = 6304, NP = 3328, DFF = 2816;
constexpr int LDS_BYTES = 147456, QIDX_OFF = 140000;
constexpr size_t MiB = 1u << 20;
constexpr size_t WS_CTL = 0;
constexpr size_t WS_WT = 1 * MiB;
constexpr size_t W_IN = WS_WT, W_GATE = W_IN + (size_t)NP * 1024 * 2, W_BR = W_GATE + (size_t)3072 * 1024 * 2, W_OUT = W_BR + (size_t)3 * 1024 * 512 * 2,
                 W_MQ = W_OUT + (size_t)1024 * 1024 * 2, W_MKV = W_MQ + (size_t)768 * 256 * 2, W_XQ = W_MKV + (size_t)1024 * 128 * 2, W_XKV = W_XQ + (size_t)512 * 1024 * 2,
                 W_XO = W_XKV + (size_t)1024 * 1024 * 2, W_13 = W_XO + (size_t)1024 * 512 * 2, W_2 = W_13 + (size_t)5632 * 1024 * 2, W_BWA = W_2 + (size_t)1024 * 2816 * 2, W_GUP = W_BWA + (size_t)1024 * 128 * 2, W_END = W_GUP + (size_t)512 * 128 * 2;
static_assert(W_END <= 40 * MiB, "weights");
constexpr size_t WS_XB = 40 * MiB, WS_PART = 72 * MiB, WS_PQ = 73 * MiB, WS_PKV = WS_PQ + 256 * 1024, WS_Y = 74 * MiB, WS_R = 122 * MiB;
constexpr size_t R_P = WS_R, R_SI = WS_R + 52 * MiB, R_Q = WS_R + 100 * MiB, R_KM = WS_R + 112 * MiB, R_VT = WS_R + 124 * MiB;
constexpr size_t R_GS = WS_R, R_MS = WS_R + 32 * MiB, R_MG = WS_R + 96 * MiB, R_MEMB = WS_R + 128 * MiB;
constexpr size_t R_MK = WS_R, R_MVT = WS_R + 2 * MiB, R_XQ = WS_R + 32 * MiB, R_XO = WS_R + 48 * MiB, R_H = WS_R;
constexpr size_t WS_AG = WS_R + 132 * MiB;
constexpr size_t WS_END = WS_AG + 2 * MiB;
static_assert(WS_END <= 256 * MiB, "ws");

struct Params { const float* in[43]; float* out; unsigned char* ws; };
typedef const __attribute__((address_space(4))) Params* KP;
enum { I_X = 0, I_MEM, I_POS, I_NMIX, I_NXA, I_NMEM, I_NFFN, I_WIN, I_BGATE, I_MU, I_W0, I_WUP, I_A0, I_AUP, I_GUP, I_KK, I_KA, I_RK, I_LNG, I_LNB,
       I_CW, I_CB, I_WA, I_BA, I_WX, I_BX, I_LAM, I_QN, I_WUQ, I_KVN, I_WUKV, I_QG, I_KG, I_WBR, I_WOUT, I_XWQ, I_XWKV, I_XQG, I_XKG, I_XWO, I_W1, I_W3, I_W2 };

__device__ __forceinline__ float rstd16(const float* part, int row) {
    const f32x4* p = (const f32x4*)(part + (size_t)row * 16); const f32x4 a = p[0], b = p[1], c = p[2], d = p[3];
    const float s = ((a.x + a.y) + (a.z + a.w)) + ((b.x + b.y) + (b.z + b.w)) + ((c.x + c.y) + (c.z + c.w)) + ((d.x + d.y) + (d.z + d.w));
    return rsqrtf(s * (1.f / 1024.f) + 1e-6f);
}
__device__ __forceinline__ float rstd4(const float* pp, int row, float invn) { const f32x4 a = *(const f32x4*)(pp + (size_t)row * 4); return rsqrtf(((a.x + a.y) + (a.z + a.w)) * invn + 1e-6f); }
__device__ __forceinline__ float sumsq8(f32x4 a, f32x4 b) { return (a.x * a.x + a.y * a.y) + (a.z * a.z + a.w * a.w) + (b.x * b.x + b.y * b.y) + (b.z * b.z + b.w * b.w); }
#define EPI_HEAD static constexpr bool PERM = true; \
    __device__ __forceinline__ void operator()(const f32x4 (&acc)[2][2][4][2], const pg8::Unit& u, int wr, int wc, int fr, int fq) const
#define EPI_ROWS _Pragma("unroll") for (int ai = 0; ai < 2; ++ai) _Pragma("unroll") for (int m = 0; m < 4; ++m) if ((__builtin_amdgcn_sched_barrier(0), true))
#define EPI_ROW (u.pm * 256 + ai * 128 + wr * 64 + m * 16 + fr)

struct EpiP {
    bf16* P; const float* part; float* pq; float* pkv;
    EPI_HEAD {
        const int col0 = u.pn * 256 + wc * 32 + 8 * fq;
        EPI_ROWS { const int row = EPI_ROW; const float rs = rstd16(part, row); float ss = 0.f;
#pragma unroll
            for (int bj = 0; bj < 2; ++bj) { const f32x4 v0 = acc[ai][bj][m][0] * rs, v1 = acc[ai][bj][m][1] * rs;
                *(u32x4*)(P + (size_t)row * NP + col0 + bj * 128) = pk8(v0, v1);
                if (u.pn == 11 || bj == 0) ss += sumsq8(v0, v1); }
            if (u.pn == 11 || u.pn == 12) { ss += __shfl_xor(ss, 16); ss += __shfl_xor(ss, 32); if (fq == 0) (u.pn == 11 ? pq : pkv)[(size_t)row * 4 + wc] = ss; } }
    }
};
struct EpiQ {
    bf16* Q; const float* pq;
    EPI_HEAD {
        const int col0 = u.pn * 256 + wc * 32 + 8 * fq;
        EPI_ROWS { const int row = EPI_ROW; const float rs = rstd4(pq, row, 1.f / 256.f);
#pragma unroll
            for (int bj = 0; bj < 2; ++bj) *(u32x4*)(Q + (size_t)row * 768 + col0 + bj * 128) = pk8(acc[ai][bj][m][0] * rs, acc[ai][bj][m][1] * rs); }
    }
};
struct EpiKV {
    bf16* Km; bf16* Vt; const float* pkv;
    EPI_HEAD {
        const int j0 = wc * 32 + 8 * fq;
        EPI_ROWS { const int row = EPI_ROW; const float rs = rstd4(pkv, row, 1.f / 128.f);
#pragma unroll
            for (int bj = 0; bj < 2; ++bj) { const int h = 2 * u.pn + bj; const f32x4 v0 = acc[ai][bj][m][0] * rs, v1 = acc[ai][bj][m][1] * rs;
                if (wc < 2) *(u32x4*)(Km + (size_t)row * 768 + h * 96 + j0) = pk8(v0, v1);
                else { const int bl = row >> 11, t = row & 2047; bf16* vp = Vt + ((size_t)(bl * 8 + h) * 64 + (j0 - 64)) * 2048 + t;
                    vp[0 * 2048] = (bf16)f2bf(v0.x); vp[1 * 2048] = (bf16)f2bf(v0.y); vp[2 * 2048] = (bf16)f2bf(v0.z); vp[3 * 2048] = (bf16)f2bf(v0.w);
                    vp[4 * 2048] = (bf16)f2bf(v1.x); vp[5 * 2048] = (bf16)f2bf(v1.y); vp[6 * 2048] = (bf16)f2bf(v1.z); vp[7 * 2048] = (bf16)f2bf(v1.w); } } }
    }
};
struct EpiGate {
    bf16* GS; const float* part; const float* bg;
    EPI_HEAD {
        const int col0 = u.pn * 256 + wc * 32 + 8 * fq;
        f32x4 b0[2], b1[2];
#pragma unroll
        for (int bj = 0; bj < 2; ++bj) { b0[bj] = *(const f32x4*)(bg + col0 + bj * 128); b1[bj] = *(const f32x4*)(bg + col0 + bj * 128 + 4); }
        EPI_ROWS { const int row = EPI_ROW; const float rs = rstd16(part, row);
#pragma unroll
            for (int bj = 0; bj < 2; ++bj) { f32x4 v0 = acc[ai][bj][m][0] * rs + b0[bj], v1 = acc[ai][bj][m][1] * rs + b1[bj];
#pragma unroll
                for (int e = 0; e < 4; ++e) { v0[e] = fsig(v0[e]); v1[e] = fsig(v1[e]); }
                *(u32x4*)(GS + (size_t)row * 1024 + col0 + bj * 128) = pk8(v0, v1); } }
    }
};
struct EpiProj {
    const bf16* GS; float* MS; bf16* MG; int n;
    EPI_HEAD {
        const int col0 = u.pn * 256 + wc * 32 + 8 * fq;
        EPI_ROWS { const int row = EPI_ROW;
#pragma unroll
            for (int bj = 0; bj < 2; ++bj) { const size_t o = (size_t)row * 1024 + col0 + bj * 128; const u32x4 gw = *(const u32x4*)(GS + o);
                f32x4 v0 = acc[ai][bj][m][0], v1 = acc[ai][bj][m][1];
                v0.x *= bflo(gw.x); v0.y *= bfhi(gw.x); v0.z *= bflo(gw.y); v0.w *= bfhi(gw.y); v1.x *= bflo(gw.z); v1.y *= bfhi(gw.z); v1.z *= bflo(gw.w); v1.w *= bfhi(gw.w);
                if (n > 0) { v0 += *(const f32x4*)(MS + o); v1 += *(const f32x4*)(MS + o + 4); }
                if (n < 2) { *(f32x4*)(MS + o) = v0; *(f32x4*)(MS + o + 4) = v1; } else *(u32x4*)(MG + o) = pk8(v0, v1); } }
    }
};
struct EpiRes {
    const float* xold; float* xout; bf16* xb; float* part; int nowrite = 0;
    EPI_HEAD {
        const int col0 = u.pn * 256 + wc * 32 + 8 * fq;
        EPI_ROWS { const int row = EPI_ROW; float ss = 0.f;
#pragma unroll
            for (int bj = 0; bj < 2; ++bj) { const size_t o = (size_t)row * 1024 + col0 + bj * 128;
                const f32x4 v0 = acc[ai][bj][m][0] + *(const f32x4*)(xold + o), v1 = acc[ai][bj][m][1] + *(const f32x4*)(xold + o + 4);
                if (!nowrite) { *(f32x4*)(xout + o) = v0; *(f32x4*)(xout + o + 4) = v1; *(u32x4*)(xb + o) = pk8(v0, v1); } ss += sumsq8(v0, v1); }
            ss += __shfl_xor(ss, 16); ss += __shfl_xor(ss, 32); if (fq == 0 && !nowrite) part[(size_t)row * 16 + u.pn * 4 + wc] = ss; }
    }
};
struct EpiXQ {
    bf16* Q; const float* part;
    EPI_HEAD {
        const int col0 = u.pn * 256 + wc * 32 + 8 * fq;
        EPI_ROWS { const int row = EPI_ROW; const float rs = rstd16(part, row);
#pragma unroll
            for (int bj = 0; bj < 2; ++bj) *(u32x4*)(Q + (size_t)row * 512 + col0 + bj * 128) = pk8(acc[ai][bj][m][0] * rs, acc[ai][bj][m][1] * rs); }
    }
};
struct EpiBf {
    bf16* O; int ld;
    EPI_HEAD {
        const int col0 = u.pn * 256 + wc * 32 + 8 * fq;
        EPI_ROWS { const int row = EPI_ROW;
#pragma unroll
            for (int bj = 0; bj < 2; ++bj) *(u32x4*)(O + (size_t)row * ld + col0 + bj * 128) = pk8(acc[ai][bj][m][0], acc[ai][bj][m][1]); }
    }
};
struct EpiMemKV {
    bf16* mk; bf16* mVt;
    EPI_HEAD {
        const int j0 = wc * 32 + 8 * fq, h = u.pn;
        EPI_ROWS { const int row = EPI_ROW;
            *(u32x4*)(mk + (size_t)row * 512 + h * 128 + j0) = pk8(acc[ai][0][m][0], acc[ai][0][m][1]);
            const f32x4 v0 = acc[ai][1][m][0], v1 = acc[ai][1][m][1]; const int b = row >> 8, key = row & 255;
            bf16* vp = mVt + ((size_t)(b * 4 + h) * 128 + j0) * 256 + key;
            vp[0 * 256] = (bf16)f2bf(v0.x); vp[1 * 256] = (bf16)f2bf(v0.y); vp[2 * 256] = (bf16)f2bf(v0.z); vp[3 * 256] = (bf16)f2bf(v0.w);
            vp[4 * 256] = (bf16)f2bf(v1.x); vp[5 * 256] = (bf16)f2bf(v1.y); vp[6 * 256] = (bf16)f2bf(v1.z); vp[7 * 256] = (bf16)f2bf(v1.w); }
    }
};
struct EpiFFN1 {
    bf16* H; const float* part;
    EPI_HEAD {
        const int hc0 = (u.pn * 256 + wc * 32 + 8 * fq) >> 1;
        EPI_ROWS { const int row = EPI_ROW; const float rs = rstd16(part, row);
#pragma unroll
            for (int bj = 0; bj < 2; ++bj) { const f32x4 a1 = acc[ai][bj][m][0] * rs, a3 = acc[ai][bj][m][1] * rs; f32x4 hv;
#pragma unroll
                for (int e = 0; e < 4; ++e) hv[e] = a1[e] * fsig(a1[e]) * a3[e];
                u32x2 w; w.x = pk2(hv.x, hv.y); w.y = pk2(hv.z, hv.w);
                *(u32x2*)(H + (size_t)row * DFF + hc0 + bj * 64) = w; } }
    }
};

__device__ __forceinline__ void conv_job(const float* W, int ldw, int c0, int ncols, int kblk, const float* gain, bf16* WT, int K, int mode, float* scr, int gw, int NGW, int lane, int& off) {
    const int nblk = (ncols + 63) >> 6, nitems = nblk * kblk;
    int it0 = (gw - off) % NGW; if (it0 < 0) it0 += NGW;
    off = (off + nitems) % NGW;
    const int kq = lane >> 4, nq = lane & 15;
    for (int it = it0; it < nitems; it += NGW) {
        const int kb = it / nblk, nb = it % nblk, k0 = 64 * kb, n0 = 64 * nb;
        const bool ld_ok = (n0 + 4 * nq) < ncols;
        f32x4 v[16];
#pragma unroll
        for (int i = 0; i < 16; ++i) { v[i] = (f32x4){0.f, 0.f, 0.f, 0.f}; if (ld_ok) v[i] = *(const f32x4*)(W + (size_t)(k0 + 4 * i + kq) * ldw + c0 + n0 + 4 * nq); }
#pragma unroll
        for (int i = 0; i < 16; ++i) { const int kk = 4 * i + kq; const float gg = gain ? gain[k0 + kk] : 1.f; float* d = scr + kk * 65 + 4 * nq;
            d[0] = v[i].x * gg; d[1] = v[i].y * gg; d[2] = v[i].z * gg; d[3] = v[i].w * gg; }
        __builtin_amdgcn_wave_barrier(); asm volatile("s_waitcnt lgkmcnt(0)" ::: "memory");
        const int c = lane & 7;
#pragma unroll
        for (int jx = 0; jx < 8; ++jx) { const int nl = (lane >> 3) + 8 * jx, n = n0 + nl; const float* sp = scr + (8 * c) * 65 + nl;
            u32x4 o; o.x = pk2(sp[0 * 65], sp[1 * 65]); o.y = pk2(sp[2 * 65], sp[3 * 65]); o.z = pk2(sp[4 * 65], sp[5 * 65]); o.w = pk2(sp[6 * 65], sp[7 * 65]);
            const int dr = mode == 0 ? n : (8 * (n >> 2) + (n & 3) + (mode == 2 ? 4 : 0));
            if (n < ncols) *(u32x4*)(WT + (size_t)dr * K + k0 + 8 * c) = o; }
        __builtin_amdgcn_wave_barrier(); asm volatile("s_waitcnt lgkmcnt(0)" ::: "memory");
    }
}

__device__ __forceinline__ void phase_convert(int wid_s, KP p_, int l, float* ldsf) {
    KP p = p_; asm volatile("" : "+s"(p));
    unsigned char* ws = p->ws;
    const int tid_ = mk_tid(wid_s);
    const int tid = tid_, lane = tid & 63, wv = tid >> 6;
    const int gw = blockIdx.x * 8 + wv, NGW = gridDim.x * 8;
    float* scr = ldsf + wv * (64 * 65); int off = 0;
    const float* nmix = p->in[I_NMIX] + l * 1024;
    conv_job(p->in[I_WIN] + (size_t)l * 1024 * DIN, DIN, 0, 3232, 16, nmix, (bf16*)(ws + W_IN), 1024, 0, scr, gw, NGW, lane, off);
    conv_job(p->in[I_WUQ] + (size_t)l * 256 * 768, 768, 0, 768, 4, p->in[I_QN] + l * 256, (bf16*)(ws + W_MQ), 256, 0, scr, gw, NGW, lane, off);
    conv_job(p->in[I_WUKV] + (size_t)l * 128 * 1024, 1024, 0, 1024, 2, p->in[I_KVN] + l * 128, (bf16*)(ws + W_MKV), 128, 0, scr, gw, NGW, lane, off);
    conv_job(p->in[I_WUP] + (size_t)l * 64 * 512, 512, 0, 512, 1, nullptr, (bf16*)(ws + W_BWA), 128, 0, scr, gw, NGW, lane, off);
    conv_job(p->in[I_AUP] + (size_t)l * 64 * 512, 512, 0, 512, 1, nullptr, (bf16*)(ws + W_BWA) + 512 * 128 + 64, 128, 0, scr, gw, NGW, lane, off);
    conv_job(p->in[I_GUP] + (size_t)l * 128 * 512, 512, 0, 512, 2, nullptr, (bf16*)(ws + W_GUP), 128, 0, scr, gw, NGW, lane, off);
    { unsigned zz = 0u; asm volatile("" : "+v"(zz)); const u32x4 zv = {zz, zz, zz, zz};
      for (int i = blockIdx.x * 512 + tid; i < 1024 * 8; i += gridDim.x * 512) { const int row = i >> 3, ch = i & 7; *(u32x4*)((bf16*)(ws + W_BWA) + row * 128 + (row < 512 ? 64 : 0) + ch * 8) = zv; } }
    { u32x4* z = (u32x4*)((bf16*)(ws + W_IN) + (size_t)3232 * 1024); const int n16 = 96 * 1024 * 2 / 16;
      unsigned zz = 0u; asm volatile("" : "+v"(zz)); const u32x4 zv = {zz, zz, zz, zz};
      for (int i = blockIdx.x * 512 + tid; i < n16; i += gridDim.x * 512) z[i] = zv; }
    if (l == 0) {
        const float* x = p->in[I_X]; bf16* xb = (bf16*)(ws + WS_XB); float* part = (float*)(ws + WS_PART);
        for (int row = gw; row < T; row += NGW) {
            const f32x4* xr = (const f32x4*)(x + (size_t)row * 1024) + lane; float s = 0.f;
#pragma unroll
            for (int j = 0; j < 4; ++j) { const f32x4 v = xr[64 * j]; s += (v.x * v.x + v.y * v.y) + (v.z * v.z + v.w * v.w);
                u32x2 w; w.x = pk2(v.x, v.y); w.y = pk2(v.z, v.w); *((u32x2*)(xb + (size_t)row * 1024) + lane + 64 * j) = w; }
            s = wave_sum(s);
            if (lane < 16) part[(size_t)row * 16 + lane] = lane == 0 ? s : 0.f;
        }
    }
}

__device__ __forceinline__ void phase_convert_mid(int wid_s, KP p_, int l, float* ldsf, int gw, int NGW) {
    KP p = p_; asm volatile("" : "+s"(p));
    unsigned char* ws = p->ws;
    const int tid_ = mk_tid(wid_s);
    const int tid = tid_, lane = tid & 63, wv = tid >> 6;
    float* scr = ldsf + wv * (64 * 65); int off = 0;
    const float* nmix = p->in[I_NMIX] + l * 1024;
    conv_job(p->in[I_WIN] + (size_t)l * 1024 * DIN, DIN, 3232, 3072, 16, nmix, (bf16*)(ws + W_GATE), 1024, 0, scr, gw, NGW, lane, off);
    for (int n = 0; n < 3; ++n) conv_job(p->in[I_WBR] + ((size_t)l * 3 + n) * 512 * 1024, 1024, 0, 1024, 8, nullptr, (bf16*)(ws + W_BR) + (size_t)n * 1024 * 512, 512, 0, scr, gw, NGW, lane, off);
    conv_job(p->in[I_WOUT] + (size_t)l * 1024 * 1024, 1024, 0, 1024, 16, nullptr, (bf16*)(ws + W_OUT), 1024, 0, scr, gw, NGW, lane, off);
    conv_job(p->in[I_XWQ] + (size_t)l * 1024 * 512, 512, 0, 512, 16, p->in[I_NXA] + l * 1024, (bf16*)(ws + W_XQ), 1024, 0, scr, gw, NGW, lane, off);
    conv_job(p->in[I_XWKV] + (size_t)l * 1024 * 1024, 1024, 0, 1024, 16, p->in[I_NMEM] + l * 1024, (bf16*)(ws + W_XKV), 1024, 0, scr, gw, NGW, lane, off);
    conv_job(p->in[I_XWO] + (size_t)l * 512 * 1024, 1024, 0, 1024, 8, nullptr, (bf16*)(ws + W_XO), 512, 0, scr, gw, NGW, lane, off);
}
__device__ __forceinline__ void phase_convert_ffn(int wid_s, KP p_, int l, float* ldsf, int gw, int NGW) {
    KP p = p_; asm volatile("" : "+s"(p));
    unsigned char* ws = p->ws;
    const int tid_ = mk_tid(wid_s);
    const int tid = tid_, lane = tid & 63, wv = tid >> 6;
    float* scr = ldsf + wv * (64 * 65); int off = 0;
    conv_job(p->in[I_W1] + (size_t)l * 1024 * DFF, DFF, 0, 2816, 16, p->in[I_NFFN] + l * 1024, (bf16*)(ws + W_13), 1024, 1, scr, gw, NGW, lane, off);
    conv_job(p->in[I_W3] + (size_t)l * 1024 * DFF, DFF, 0, 2816, 16, p->in[I_NFFN] + l * 1024, (bf16*)(ws + W_13), 1024, 2, scr, gw, NGW, lane, off);
    conv_job(p->in[I_W2] + (size_t)l * DFF * 1024, 1024, 0, 1024, 44, nullptr, (bf16*)(ws + W_2), DFF, 0, scr, gw, NGW, lane, off);
}
__device__ __forceinline__ void rope_cs(int pos, int i, float& c, float& s) {
    const float invf = exp2f(-(float)i * 0.8304820237218406f);
    const float ang = (float)pos * invf;
    const double x = (double)ang * 0.15915494309189535; const float f = (float)(x - rint(x));
    c = __builtin_amdgcn_cosf(f); s = __builtin_amdgcn_sinf(f);
}
template <int DQK, int DV, bool CAUSAL, bool MLA>
__device__ __forceinline__ void attn_unit(int wid_s, unsigned char* lds, const bf16* Qb_, int ldq, const bf16* Kb_, int ldk, const bf16* Vtb_, int ldv, bf16* Ob_, int ldo,
                                          int q0, int nkt, const float* qgain_, const int* pos_, float qscale) {
    const GAS bf16* Qb = (const GAS bf16*)Qb_; const GAS bf16* Kb = (const GAS bf16*)Kb_; const GAS bf16* Vtb = (const GAS bf16*)Vtb_; GAS bf16* Ob = (GAS bf16*)Ob_;
    const GAS float* qgain = (const GAS float*)qgain_; const GAS int* pos = (const GAS int*)pos_;
    constexpr int KS = DQK * 2 + 16, VS = 144, NKS = DQK / 32, NDT = DV / 16, KCH = DQK / 8, NKC = (64 * KCH + 511) / 512, NVC = DV * 8 / 512;
    unsigned char* Ks = lds; unsigned char* Vs = lds + 64 * KS;
    const int tid_ = mk_tid(wid_s);
    const int tid = tid_, lane = tid & 63, wv = tid >> 6, g = lane >> 4, j = lane & 15;
    const int qrow = q0 + wv * 16 + j;
    bf16x8 qf[NKS];
    {
        float qv[NKS][8]; float ss = 0.f;
#pragma unroll
        for (int ks = 0; ks < NKS; ++ks) { const u32x4 w = *(const GAS u32x4*)(Qb + (size_t)qrow * ldq + 32 * ks + 8 * g);
            qv[ks][0] = bflo(w.x); qv[ks][1] = bfhi(w.x); qv[ks][2] = bflo(w.y); qv[ks][3] = bfhi(w.y); qv[ks][4] = bflo(w.z); qv[ks][5] = bfhi(w.z); qv[ks][6] = bflo(w.w); qv[ks][7] = bfhi(w.w);
#pragma unroll
            for (int e = 0; e < 8; ++e) ss += qv[ks][e] * qv[ks][e]; }
        ss += __shfl_xor(ss, 16); ss += __shfl_xor(ss, 32);
        const float rs = rsqrtf(ss * (1.f / DQK) + 1e-6f);
#pragma unroll
        for (int ks = 0; ks < NKS; ++ks)
#pragma unroll
            for (int e = 0; e < 8; ++e) qv[ks][e] *= rs * qgain[32 * ks + 8 * g + e];
        if (MLA) {
            const int ps = pos[qrow];
#pragma unroll
            for (int e = 0; e < 8; ++e) { const float mine = qv[2][e], other = __shfl_xor(mine, 32); float c, s; rope_cs(ps, 8 * (g & 1) + e, c, s);
                qv[2][e] = (g < 2) ? (mine * c - other * s) : (mine * c + other * s); }
        }
#pragma unroll
        for (int ks = 0; ks < NKS; ++ks) { u32x4 w; w.x = pk2(qv[ks][0] * qscale, qv[ks][1] * qscale); w.y = pk2(qv[ks][2] * qscale, qv[ks][3] * qscale);
            w.z = pk2(qv[ks][4] * qscale, qv[ks][5] * qscale); w.w = pk2(qv[ks][6] * qscale, qv[ks][7] * qscale); qf[ks] = __builtin_bit_cast(bf16x8, w); }
    }
    f32x4 oT[NDT];
#pragma unroll
    for (int d = 0; d < NDT; ++d) oT[d] = (f32x4){0.f, 0.f, 0.f, 0.f};
    float mrun = -INFINITY, lsum = 0.f;
    u32x4 kreg[NKC], vreg[NVC];
#define ATT_PREFETCH(kt) do { _Pragma("unroll") for (int i = 0; i < NKC; ++i) { const int idx = tid + 512 * i; if (idx < 64 * KCH) { const int key = idx / KCH, ch = idx % KCH; \
            kreg[i] = *(const GAS u32x4*)(Kb + (size_t)(64 * (kt) + key) * ldk + ch * 8); } } \
        _Pragma("unroll") for (int i = 0; i < NVC; ++i) { const int idx = tid + 512 * i; const int dv = idx >> 3, ch = idx & 7; vreg[i] = *(const GAS u32x4*)(Vtb + (size_t)dv * ldv + 64 * (kt) + ch * 8); } } while (0)
    ATT_PREFETCH(0);
    for (int kt = 0; kt < nkt; ++kt) {
        LBAR();
#pragma unroll
        for (int i = 0; i < NKC; ++i) { const int idx = tid + 512 * i; if (idx < 64 * KCH) { const int key = idx / KCH, ch = idx % KCH; *(u32x4*)(Ks + key * KS + ch * 16) = kreg[i]; } }
#pragma unroll
        for (int i = 0; i < NVC; ++i) { const int idx = tid + 512 * i; const int dv = idx >> 3, ch = idx & 7; *(u32x4*)(Vs + dv * VS + ch * 16) = vreg[i]; }
        LBAR();
        if (kt + 1 < nkt) ATT_PREFETCH(kt + 1);
        const int qw0 = q0 + wv * 16;
        if (CAUSAL && 64 * kt > qw0 + 15) continue;
        f32x4 sT[4];
#pragma unroll
        for (int k4 = 0; k4 < 4; ++k4) { sT[k4] = (f32x4){0.f, 0.f, 0.f, 0.f};
#pragma unroll
            for (int ks = 0; ks < NKS; ++ks) { const bf16x8 a = *(const bf16x8*)(Ks + (16 * k4 + j) * KS + (32 * ks + 8 * g) * 2);
                sT[k4] = __builtin_amdgcn_mfma_f32_16x16x32_bf16(a, qf[ks], sT[k4], 0, 0, 0); } }
        if (CAUSAL && 64 * kt + 63 > qw0) {
#pragma unroll
            for (int k4 = 0; k4 < 4; ++k4)
#pragma unroll
                for (int r = 0; r < 4; ++r) if (64 * kt + 16 * k4 + 4 * g + r > qrow) sT[k4][r] = -INFINITY;
        }
        float mx = -INFINITY;
#pragma unroll
        for (int k4 = 0; k4 < 4; ++k4) mx = fmaxf(mx, fmaxf(fmaxf(sT[k4][0], sT[k4][1]), fmaxf(sT[k4][2], sT[k4][3])));
        mx = fmaxf(mx, __shfl_xor(mx, 16)); mx = fmaxf(mx, __shfl_xor(mx, 32));
        const float mnew = fmaxf(mrun, mx); const float alpha = __builtin_amdgcn_exp2f(mrun - mnew); mrun = mnew;
        float psum = 0.f;
#pragma unroll
        for (int k4 = 0; k4 < 4; ++k4)
#pragma unroll
            for (int r = 0; r < 4; ++r) { const float pv = __builtin_amdgcn_exp2f(sT[k4][r] - mnew); sT[k4][r] = pv; psum += pv; }
        lsum = lsum * alpha + psum;
#pragma unroll
        for (int d = 0; d < NDT; ++d) oT[d] *= alpha;
#pragma unroll
        for (int kc = 0; kc < 2; ++kc) {
            const bf16x8 pb = __builtin_bit_cast(bf16x8, pk8(sT[2 * kc], sT[2 * kc + 1]));
#pragma unroll
            for (int d = 0; d < NDT; ++d) { const unsigned char* vp = Vs + (16 * d + j) * VS + (32 * kc + 4 * g) * 2;
                const u32x2 lo = *(const u32x2*)vp, hi = *(const u32x2*)(vp + 32); u32x4 w; w.x = lo.x; w.y = lo.y; w.z = hi.x; w.w = hi.y;
                oT[d] = __builtin_amdgcn_mfma_f32_16x16x32_bf16(__builtin_bit_cast(bf16x8, w), pb, oT[d], 0, 0, 0); }
        }
    }
#undef ATT_PREFETCH
    lsum += __shfl_xor(lsum, 16); lsum += __shfl_xor(lsum, 32);
    const float inv = 1.f / lsum;
#pragma unroll
    for (int d = 0; d < NDT; ++d) { u32x2 w; w.x = pk2(oT[d][0] * inv, oT[d][1] * inv); w.y = pk2(oT[d][2] * inv, oT[d][3] * inv);
        *(GAS u32x2*)(Ob + (size_t)qrow * ldo + 16 * d + 4 * g) = w; }
}

__device__ __forceinline__ void lora_act_rows(int wid_s, KP p_, int l, int r) {
    KP p = p_; asm volatile("" : "+s"(p));
    unsigned char* ws = p->ws;
    const int tid_ = mk_tid(wid_s);
    const int tid = tid_;
    const bf16* P = (const bf16*)(ws + R_P); bf16* Awa = (bf16*)(ws + WS_Y) + (size_t)r * TH * 1536 + 1024; bf16* Ag = (bf16*)(ws + WS_AG);
    const float* mu = p->in[I_MU] + l * 1792 + 1536;
    const int sub = tid & 31, j0 = sub * 8;
    f32x4 m0 = *(const f32x4*)(mu + j0), m1 = *(const f32x4*)(mu + j0 + 4);
    for (int row = blockIdx.x * 16 + (tid >> 5); row < TH; row += gridDim.x * 16) {
        const u32x4 cw = *(const u32x4*)(P + (size_t)row * NP + 1536 + j0);
        u32x4 pw = {0u, 0u, 0u, 0u}; if ((row & 2047) != 0) pw = *(const u32x4*)(P + (size_t)(row - 1) * NP + 1536 + j0);
        float c[8] = {bflo(cw.x), bfhi(cw.x), bflo(cw.y), bfhi(cw.y), bflo(cw.z), bfhi(cw.z), bflo(cw.w), bfhi(cw.w)};
        const float q[8] = {bflo(pw.x), bfhi(pw.x), bflo(pw.y), bfhi(pw.y), bflo(pw.z), bfhi(pw.z), bflo(pw.w), bfhi(pw.w)};
        const float mm[8] = {m0.x, m0.y, m0.z, m0.w, m1.x, m1.y, m1.z, m1.w};
#pragma unroll
        for (int e = 0; e < 8; ++e) { float v = c[e] + (q[e] - c[e]) * mm[e];
            if (j0 < 64) v = 2.f * fsig(2.f * v) - 1.f;
            else if (j0 >= 128) v = fsig(v);
            c[e] = v; }
        u32x4 o; o.x = pk2(c[0], c[1]); o.y = pk2(c[2], c[3]); o.z = pk2(c[4], c[5]); o.w = pk2(c[6], c[7]);
        if (j0 < 128) *(u32x4*)(Awa + (size_t)row * 1536 + j0) = o; else *(u32x4*)(Ag + (size_t)row * 128 + (j0 - 128)) = o;
    }
}
__device__ __forceinline__ void si_build_tile(int wid_s, KP p_, int l, int r, int tile) {
    KP p = p_; asm volatile("" : "+s"(p));
    unsigned char* ws = p->ws;
    const int tid_ = mk_tid(wid_s);
    const int tid = tid_, lane = tid & 63, wv = tid >> 6;
    const GAS bf16* P = (const GAS bf16*)(ws + R_P); GAS bf16* SI = (GAS bf16*)(ws + R_SI); const GAS bf16* LW = (const GAS bf16*)(ws + WS_Y) + (size_t)r * TH * 1536;
    const float* mu = p->in[I_MU] + l * 1792;
    const int row0 = tile * 32;
    const int c = tid, h = wv;
    const float w0c = p->in[I_W0][l * 512 + c], a0c = p->in[I_A0][l * 512 + c], kkc = p->in[I_KK][l * 512 + c], kac = p->in[I_KA][l * 512 + c];
    const float mur = mu[c], muk = mu[512 + c], muv = mu[1024 + c];
#pragma unroll 4
    for (int t = 0; t < 32; ++t) {
        const int row = row0 + t; const bool first = (row & 2047) == 0;
        const GAS bf16* pr = P + (size_t)row * NP; const GAS bf16* pp = pr - NP;
        const float rc = bf2f(pr[c]), kc = bf2f(pr[512 + c]), vc = bf2f(pr[1024 + c]);
        const float rp = first ? 0.f : bf2f(pp[c]), kp = first ? 0.f : bf2f(pp[512 + c]), vp = first ? 0.f : bf2f(pp[1024 + c]);
        const float wl = bf2f(LW[(size_t)row * 1536 + c]), al = bf2f(LW[(size_t)row * 1536 + 512 + c]);
        const float rr = rc + (rp - rc) * mur, k = kc + (kp - kc) * muk, v = vc + (vp - vc) * muv;
        const float om = 1.f - __expf(-0.6065306597126334f * fsig(w0c + wl));
        const float a = fsig(a0c + al);
        const float kkr = k * kkc; const float ss = wave_sum(kkr * kkr); const float kk = kkr / fmaxf(sqrtf(ss), 1e-12f);
        const float k2 = k * (1.f + (a - 1.f) * kac);
        GAS bf16* o = SI + ((size_t)((row >> 11) * 8 + h) * 2048 + (row & 2047)) * 384 + lane;
        o[0] = (bf16)f2bf(rr); o[64] = (bf16)f2bf(om); o[128] = (bf16)f2bf(k2); o[192] = (bf16)f2bf(kk); o[256] = (bf16)f2bf(kk * a); o[320] = (bf16)f2bf(v);
    }
}

template <int CTRL> __device__ __forceinline__ float dppf(float x) { return __builtin_bit_cast(float, __builtin_amdgcn_update_dpp(0, __builtin_bit_cast(int, x), CTRL, 0xF, 0xF, true)); }
__device__ __forceinline__ float allreduce8(float x);
__device__ __forceinline__ float allreduce16(float x) { x += dppf<0xB1>(x); x += dppf<0x4E>(x); x += dppf<0x141>(x); x += dppf<0x140>(x); return x; }
template <int MODE>
__device__ __forceinline__ void rwkv_scan_unit(int wid_s, const bf16* SIbh_, bf16* Yb_, int ystride, int quarter, float* ldsf) {
    const int tid_ = mk_tid(wid_s);
    const GAS bf16* SIbh = (const GAS bf16*)SIbh_; GAS bf16* Yb = (GAS bf16*)Yb_;
    const int tid = tid_, lane = tid & 63, wv = tid >> 6, hw = wv - 4;
    float* PYb = ldsf + 4 * (16 * 384);
    u32x4 hreg[12];
    if (wv >= 4 && wv < 7) {
#pragma unroll
        for (int i = 0; i < 12; ++i) hreg[i] = *(const GAS u32x4*)(SIbh + (size_t)hw * (16 * 384) + (size_t)(lane + 64 * i) * 8);
    }
    f32x2 Sa = {0.f, 0.f}, Sb = {0.f, 0.f};
    const int rowl = quarter * 16 + (wv & 3) * 4 + (lane >> 4), c4 = (lane & 15) * 4;
    __syncthreads();
#define SCAN_CONVERT(cn) do { float* Bd = ldsf + ((cn) & 3) * (16 * 384); \
        _Pragma("unroll") for (int i = 0; i < 12; ++i) { float* d = Bd + (lane + 64 * i) * 8; const u32x4 w = hreg[i]; \
            *(f32x4*)d = (f32x4){bflo(w.x), bfhi(w.x), bflo(w.y), bfhi(w.y)}; *(f32x4*)(d + 4) = (f32x4){bflo(w.z), bfhi(w.z), bflo(w.w), bfhi(w.w)}; } \
        if ((cn) + 3 < 128) { _Pragma("unroll") for (int i = 0; i < 12; ++i) hreg[i] = *(const GAS u32x4*)(SIbh + (size_t)((cn) + 3) * (16 * 384) + (size_t)(lane + 64 * i) * 8); } } while (0)
    if (wv == 4) SCAN_CONVERT(0);
    for (int ch = 0; ch <= 128; ++ch) {
        LBAR();
        if (wv < 4) {
            if (ch < 128) {
                const float* B = ldsf + (ch & 3) * (16 * 384);
                float* PY = PYb + (ch & 1) * (16 * 256) + wv * 64 + lane;
                const float* q = B;
                f32x4 r4 = *(const f32x4*)(q + c4), om4 = *(const f32x4*)(q + 64 + c4), k4 = *(const f32x4*)(q + 128 + c4), kk4 = *(const f32x4*)(q + 192 + c4), ka4 = *(const f32x4*)(q + 256 + c4);
                float v = q[320 + rowl];
                __builtin_amdgcn_s_setprio(3);
#pragma unroll
                for (int s = 0; s < 16; ++s) {
                    const float* qn = B + ((MODE & 2) ? 0 : ((s + 1) & 15)) * 384;
                    const f32x4 nr4 = *(const f32x4*)(qn + c4), nom4 = *(const f32x4*)(qn + 64 + c4), nk4 = *(const f32x4*)(qn + 128 + c4), nkk4 = *(const f32x4*)(qn + 192 + c4), nka4 = *(const f32x4*)(qn + 256 + c4);
                    const float nv = qn[320 + rowl];
                    const f32x2 pa = Sa * (f32x2){kk4.x, kk4.y} + Sb * (f32x2){kk4.z, kk4.w};
                    const float sa = (MODE & 1) ? (pa.x + pa.y) : allreduce16(pa.x + pa.y);
                    Sa = Sa - Sa * (f32x2){om4.x, om4.y} + (f32x2){k4.x, k4.y} * v; Sb = Sb - Sb * (f32x2){om4.z, om4.w} + (f32x2){k4.z, k4.w} * v;
                    Sa = Sa - (f32x2){ka4.x, ka4.y} * sa; Sb = Sb - (f32x2){ka4.z, ka4.w} * sa;
                    const f32x2 py = Sa * (f32x2){r4.x, r4.y} + Sb * (f32x2){r4.z, r4.w};
                    PY[s * 256] = py.x + py.y;
                    r4 = nr4; om4 = nom4; k4 = nk4; kk4 = nkk4; ka4 = nka4; v = nv;
                }
                __builtin_amdgcn_s_setprio(0);
            }
        } else if (wv == 7) {
            if (ch > 0) {
                const int s = lane >> 2, rr = lane & 3;
#pragma unroll
                for (int mw = 0; mw < 4; ++mw) {
                    const float* src = PYb + ((ch - 1) & 1) * (16 * 256) + s * 256 + mw * 64 + rr * 16;
                    const f32x4 a = *(const f32x4*)src, b = *(const f32x4*)(src + 4), c = *(const f32x4*)(src + 8), d = *(const f32x4*)(src + 12);
                    const float y = ((a.x + a.y) + (a.z + a.w)) + ((b.x + b.y) + (b.z + b.w)) + ((c.x + c.y) + (c.z + c.w)) + ((d.x + d.y) + (d.z + d.w));
                    Yb[(size_t)((ch - 1) * 16 + s) * ystride + quarter * 16 + mw * 4 + rr] = (bf16)f2bf(y);
                }
            }
        } else {
            const int cn = ch + 1;
            if (cn < 128 && (cn % 3) == hw) SCAN_CONVERT(cn);
        }
    }
#undef SCAN_CONVERT
    __syncthreads();
}

__device__ __forceinline__ void rwkv_post_tile(int wid_s, KP p_, int l, int r, int tile, int dummy) {
    KP p = p_; asm volatile("" : "+s"(p));
    unsigned char* ws = p->ws;
    const int tid_ = mk_tid(wid_s);
    const int tid = tid_, lane = tid & 63, wv = tid >> 6;
    const GAS bf16* P = (const GAS bf16*)(ws + R_P); const GAS bf16* SI = (const GAS bf16*)(ws + R_SI); GAS bf16* Y = (GAS bf16*)(ws + WS_Y) + (size_t)r * TH * 1536;
    const int row0 = tile * 32;
    const int c = tid, h = wv;
    const float rkc = p->in[I_RK][l * 512 + c], lng = p->in[I_LNG][l * 512 + c], lnb = p->in[I_LNB][l * 512 + c];
#pragma unroll 4
    for (int t = 0; t < 32; ++t) {
        const int row = row0 + t;
        const GAS bf16* si = SI + ((size_t)((row >> 11) * 8 + h) * 2048 + (row & 2047)) * 384 + lane;
        const float rr = bf2f(si[0]), k2 = bf2f(si[128]), v = bf2f(si[320]);
        const float gg = bf2f(P[(size_t)row * NP + c]);
        GAS bf16* yp = Y + (size_t)row * 1536 + c;
        const float y = bf2f(*yp);
        const float mean = wave_sum(y) * (1.f / 64.f); const float d = y - mean; const float var = wave_sum(d * d) * (1.f / 64.f);
        const float yn = d * rsqrtf(var + 64e-5f) * lng + lnb;
        const float bonus = wave_sum(rr * k2 * rkc) * v;
        if (dummy) yp = (GAS bf16*)(ws + R_P) + (size_t)row * NP + 600 + c;
        *yp = (bf16)f2bf((yn + bonus) * gg);
    }
}

__device__ __forceinline__ float allreduce8(float x) { x += dppf<0xB1>(x); x += dppf<0x4E>(x); x += dppf<0x141>(x); return x; }
__device__ __forceinline__ void unpack8(const u32x4 w, float* f) { f[0] = bflo(w.x); f[1] = bfhi(w.x); f[2] = bflo(w.y); f[3] = bfhi(w.y); f[4] = bflo(w.z); f[5] = bfhi(w.z); f[6] = bflo(w.w); f[7] = bfhi(w.w); }
__device__ __forceinline__ u32x4 pack8(const float* f) { u32x4 o; o.x = pk2(f[0], f[1]); o.y = pk2(f[2], f[3]); o.z = pk2(f[4], f[5]); o.w = pk2(f[6], f[7]); return o; }
__device__ __forceinline__ void ld8f(const GAS float* q, float* f) { const f32x4 a = *(const GAS f32x4*)q, b = *(const GAS f32x4*)(q + 4); f[0] = a.x; f[1] = a.y; f[2] = a.z; f[3] = a.w; f[4] = b.x; f[5] = b.y; f[6] = b.z; f[7] = b.w; }
__device__ __forceinline__ void si_build_rows(int wid_s, KP p_, int l, int r) {
    KP p = p_; asm volatile("" : "+s"(p));
    unsigned char* ws = p->ws;
    const int tid_ = mk_tid(wid_s);
    const int tid = tid_, lane = tid & 63, wv = tid >> 6, c0 = lane * 8, h = lane >> 3;
    const GAS bf16* P = (const GAS bf16*)(ws + R_P); GAS bf16* SI = (GAS bf16*)(ws + R_SI); const GAS bf16* LW = (const GAS bf16*)(ws + WS_Y) + (size_t)r * TH * 1536;
    float w0c[8], a0c[8], kkc[8], kac[8], mur[8], muk[8], muv[8];
    ld8f((const GAS float*)p->in[I_W0] + l * 512 + c0, w0c); ld8f((const GAS float*)p->in[I_A0] + l * 512 + c0, a0c); ld8f((const GAS float*)p->in[I_KK] + l * 512 + c0, kkc); ld8f((const GAS float*)p->in[I_KA] + l * 512 + c0, kac);
    ld8f((const GAS float*)p->in[I_MU] + l * 1792 + c0, mur); ld8f((const GAS float*)p->in[I_MU] + l * 1792 + 512 + c0, muk); ld8f((const GAS float*)p->in[I_MU] + l * 1792 + 1024 + c0, muv);
    for (int row = blockIdx.x * 8 + wv; row < TH; row += gridDim.x * 8) {
        const bool first = (row & 2047) == 0;
        const GAS bf16* pr = P + (size_t)row * NP + c0; const GAS bf16* pp = pr - NP;
        const u32x4 z4 = {0u, 0u, 0u, 0u};
        const u32x4 rcw = *(const GAS u32x4*)pr, kcw = *(const GAS u32x4*)(pr + 512), vcw = *(const GAS u32x4*)(pr + 1024);
        const u32x4 rpw = first ? z4 : *(const GAS u32x4*)pp, kpw = first ? z4 : *(const GAS u32x4*)(pp + 512), vpw = first ? z4 : *(const GAS u32x4*)(pp + 1024);
        const u32x4 wlw = *(const GAS u32x4*)(LW + (size_t)row * 1536 + c0), alw = *(const GAS u32x4*)(LW + (size_t)row * 1536 + 512 + c0);
        float rc[8], kc[8], vc[8], rp[8], kp[8], vp[8], wl[8], al[8];
        unpack8(rcw, rc); unpack8(kcw, kc); unpack8(vcw, vc); unpack8(rpw, rp); unpack8(kpw, kp); unpack8(vpw, vp); unpack8(wlw, wl); unpack8(alw, al);
        float rr[8], om[8], k2[8], kk[8], ka[8], vv[8]; float ss = 0.f;
#pragma unroll
        for (int e = 0; e < 8; ++e) { rr[e] = rc[e] + (rp[e] - rc[e]) * mur[e]; const float k = kc[e] + (kp[e] - kc[e]) * muk[e]; vv[e] = vc[e] + (vp[e] - vc[e]) * muv[e];
            om[e] = 1.f - __expf(-0.6065306597126334f * fsig(w0c[e] + wl[e]));
            const float a = fsig(a0c[e] + al[e]);
            kk[e] = k * kkc[e]; ss += kk[e] * kk[e]; k2[e] = k * (1.f + (a - 1.f) * kac[e]); ka[e] = a; }
        ss = allreduce8(ss);
        const float inv = 1.f / fmaxf(sqrtf(ss), 1e-12f);
#pragma unroll
        for (int e = 0; e < 8; ++e) { kk[e] *= inv; ka[e] *= kk[e]; }
        GAS bf16* o = SI + ((size_t)((row >> 11) * 8 + h) * 2048 + (row & 2047)) * 384 + (lane & 7) * 8;
        *(GAS u32x4*)o = pack8(rr); *(GAS u32x4*)(o + 64) = pack8(om); *(GAS u32x4*)(o + 128) = pack8(k2); *(GAS u32x4*)(o + 192) = pack8(kk); *(GAS u32x4*)(o + 256) = pack8(ka); *(GAS u32x4*)(o + 320) = pack8(vv);
    }
}
__device__ __forceinline__ void rwkv_post_rows(int wid_s, KP p_, int l, int r, int dummy) {
    KP p = p_; asm volatile("" : "+s"(p));
    unsigned char* ws = p->ws;
    const int tid_ = mk_tid(wid_s);
    const int tid = tid_, lane = tid & 63, wv = tid >> 6, c0 = lane * 8, h = lane >> 3;
    const GAS bf16* P = (const GAS bf16*)(ws + R_P); const GAS bf16* SI = (const GAS bf16*)(ws + R_SI); GAS bf16* Y = (GAS bf16*)(ws + WS_Y) + (size_t)r * TH * 1536;
    float rkc[8], lng[8], lnb[8];
    ld8f((const GAS float*)p->in[I_RK] + l * 512 + c0, rkc); ld8f((const GAS float*)p->in[I_LNG] + l * 512 + c0, lng); ld8f((const GAS float*)p->in[I_LNB] + l * 512 + c0, lnb);
    for (int row = blockIdx.x * 8 + wv; row < TH; row += gridDim.x * 8) {
        const GAS bf16* si = SI + ((size_t)((row >> 11) * 8 + h) * 2048 + (row & 2047)) * 384 + (lane & 7) * 8;
        const u32x4 rw = *(const GAS u32x4*)si, kw = *(const GAS u32x4*)(si + 128), vw = *(const GAS u32x4*)(si + 320);
        const u32x4 gw = *(const GAS u32x4*)(P + (size_t)row * NP + c0);
        GAS bf16* yp = Y + (size_t)row * 1536 + c0;
        const u32x4 yw = *(const GAS u32x4*)yp;
        float rr[8], k2[8], vv[8], gg[8], y[8];
        unpack8(rw, rr); unpack8(kw, k2); unpack8(vw, vv); unpack8(gw, gg); unpack8(yw, y);
        float sy = 0.f, sb = 0.f;
#pragma unroll
        for (int e = 0; e < 8; ++e) { sy += y[e]; sb += rr[e] * k2[e] * rkc[e]; }
        const float mean = allreduce8(sy) * (1.f / 64.f); const float bonus = allreduce8(sb);
        float sv = 0.f;
#pragma unroll
        for (int e = 0; e < 8; ++e) { y[e] -= mean; sv += y[e] * y[e]; }
        const float rs = rsqrtf(allreduce8(sv) * (1.f / 64.f) + 64e-5f);
#pragma unroll
        for (int e = 0; e < 8; ++e) y[e] = (y[e] * rs * lng[e] + lnb[e] + bonus * vv[e]) * gg[e];
        if (dummy) yp = (GAS bf16*)(ws + R_P) + (size_t)row * NP + 600 + c0;
        *(GAS u32x4*)yp = pack8(y);
    }
}

__device__ __forceinline__ float gelu_tanh(float x) { const float u = 0.7978845608028654f * (x + 0.044715f * x * x * x); return x * fsig(2.f * u); }
__device__ __forceinline__ void lru_unit(int wid_s, KP p_, int l, int r, int bl, int n, float* ldsf) {
    KP p = p_; asm volatile("" : "+s"(p));
    unsigned char* ws = p->ws;
    const int tid_ = mk_tid(wid_s);
    const int tid = tid_, lane = tid & 63, wv = tid >> 6, g = lane >> 4, j = lane & 15;
    const GAS bf16* P = (const GAS bf16*)(ws + R_P) + (size_t)bl * 2048 * NP; GAS bf16* Yb = (GAS bf16*)(ws + WS_Y) + ((size_t)(r * 4 + bl) * 2048) * 1536 + 512;
    const int cg_ = n * 64 + lane;
    float* s_xc = ldsf;
    float* s_a = ldsf + 8192;
    float* s_u = ldsf + 16384;
    float* s_AH = ldsf + 24576;
    unsigned char* s_xb16 = (unsigned char*)ldsf + 102400;
    unsigned char* s_wt16 = (unsigned char*)ldsf + 120832;
    LBAR();
    for (int e = tid; e < 8192; e += 512) { const int jj = e >> 6, ii = e & 63;
        const float w = (jj < 64) ? p->in[I_WA][((size_t)l * 8 + n) * 4096 + ii * 64 + jj] : p->in[I_WX][((size_t)l * 8 + n) * 4096 + ii * 64 + (jj - 64)];
        *(bf16*)(s_wt16 + (jj * 72 + ii) * 2) = (bf16)f2bf(w); }
    const float cw0 = p->in[I_CW][(l * 4 + 0) * 512 + cg_], cw1 = p->in[I_CW][(l * 4 + 1) * 512 + cg_], cw2 = p->in[I_CW][(l * 4 + 2) * 512 + cg_], cw3 = p->in[I_CW][(l * 4 + 3) * 512 + cg_];
    const float cb = p->in[I_CB][l * 512 + cg_];
    float ba4[4], bx4[4], sp4[4];
#pragma unroll
    for (int n4 = 0; n4 < 4; ++n4) { const int c = n * 64 + 16 * n4 + j; ba4[n4] = p->in[I_BA][l * 512 + c]; bx4[n4] = p->in[I_BX][l * 512 + c];
        sp4[n4] = -8.f * 1.4426950408889634f * log1pf(__expf(-p->in[I_LAM][l * 512 + c])); }
    float hcar = 0.f;
    for (int tile = 0; tile < 16; ++tile) {
        const int t0 = tile * 128 + wv * 16;
        float xc[16]; unsigned short gbr[16];
        {
            float x3 = (t0 >= 3) ? bf2f(P[(size_t)(t0 - 3) * NP + 1792 + cg_]) : 0.f, x2 = (t0 >= 2) ? bf2f(P[(size_t)(t0 - 2) * NP + 1792 + cg_]) : 0.f, x1 = (t0 >= 1) ? bf2f(P[(size_t)(t0 - 1) * NP + 1792 + cg_]) : 0.f;
#pragma unroll
            for (int i = 0; i < 16; ++i) { const float x0 = bf2f(P[(size_t)(t0 + i) * NP + 1792 + cg_]);
                xc[i] = cw0 * x3 + cw1 * x2 + cw2 * x1 + cw3 * x0 + cb; x3 = x2; x2 = x1; x1 = x0; }
#pragma unroll
            for (int i = 0; i < 16; ++i) gbr[i] = P[(size_t)(t0 + i) * NP + 2304 + cg_];
        }
        LBAR();
#pragma unroll
        for (int i = 0; i < 16; ++i) { s_xc[(wv * 16 + i) * 64 + lane] = xc[i]; *(bf16*)(s_xb16 + ((wv * 16 + i) * 72 + lane) * 2) = (bf16)f2bf(xc[i]); }
        LBAR();
        {
            f32x4 acc[8];
            const bf16x8 a0 = *(const bf16x8*)(s_xb16 + ((16 * wv + j) * 72 + 8 * g) * 2), a1 = *(const bf16x8*)(s_xb16 + ((16 * wv + j) * 72 + 32 + 8 * g) * 2);
#pragma unroll
            for (int nn = 0; nn < 8; ++nn) { acc[nn] = (f32x4){0.f, 0.f, 0.f, 0.f};
                const bf16x8 b0 = *(const bf16x8*)(s_wt16 + ((16 * nn + j) * 72 + 8 * g) * 2), b1 = *(const bf16x8*)(s_wt16 + ((16 * nn + j) * 72 + 32 + 8 * g) * 2);
                acc[nn] = __builtin_amdgcn_mfma_f32_16x16x32_bf16(a0, b0, acc[nn], 0, 0, 0); acc[nn] = __builtin_amdgcn_mfma_f32_16x16x32_bf16(a1, b1, acc[nn], 0, 0, 0); }
#pragma unroll
            for (int n4 = 0; n4 < 4; ++n4)
#pragma unroll
                for (int rr = 0; rr < 4; ++rr) { const int tk = 16 * wv + 4 * g + rr, c = 16 * n4 + j;
                    const float rg = fsig(acc[n4][rr] + ba4[n4]), ig = fsig(acc[n4 + 4][rr] + bx4[n4]);
                    const float a = __builtin_amdgcn_exp2f(sp4[n4] * rg);
                    const float uu = __builtin_amdgcn_sqrtf(fmaxf(1.f - a * a, 0.f)) * (ig * s_xc[tk * 64 + c]);
                    s_a[tk * 64 + c] = a; s_u[tk * 64 + c] = uu; }
        }
        LBAR();
        float av[16], uv[16]; float A = 1.f, H = 0.f;
#pragma unroll
        for (int i = 0; i < 16; ++i) { av[i] = s_a[(wv * 16 + i) * 64 + lane]; uv[i] = s_u[(wv * 16 + i) * 64 + lane]; A *= av[i]; H = av[i] * H + uv[i]; }
        s_AH[(wv * 64 + lane) * 2] = A; s_AH[(wv * 64 + lane) * 2 + 1] = H;
        LBAR();
        float hin = hcar, hall = hcar;
#pragma unroll
        for (int w = 0; w < 8; ++w) { const float Aw = s_AH[(w * 64 + lane) * 2], Hw = s_AH[(w * 64 + lane) * 2 + 1]; hall = Aw * hall + Hw; if (w < wv) hin = hall; }
        hcar = hall;
        float hh = hin;
#pragma unroll
        for (int i = 0; i < 16; ++i) { hh = av[i] * hh + uv[i];
            Yb[(size_t)(t0 + i) * 1536 + cg_] = (bf16)f2bf(hh * gelu_tanh(bf2f(gbr[i]))); }
    }
    LBAR();
}

__device__ __forceinline__ void kfix_rows(int wid_s, KP p_, int l, int r) {
    KP p = p_; asm volatile("" : "+s"(p));
    unsigned char* ws = p->ws;
    const int tid_ = mk_tid(wid_s);
    const int tid = tid_, lane = tid & 63, wv = tid >> 6, h = lane >> 3, sub = lane & 7;
    const GAS bf16* P = (const GAS bf16*)(ws + R_P); GAS bf16* Km = (GAS bf16*)(ws + R_KM);
    const float* kg = p->in[I_KG] + l * 96; const int* pos = (const int*)p->in[I_POS] + r * TH;
    for (int row = blockIdx.x * 8 + wv; row < TH; row += gridDim.x * 8) {
        GAS bf16* kp = Km + (size_t)row * 768 + h * 96;
        const u32x4 w = *(const GAS u32x4*)(kp + 8 * sub);
        float nv[8] = {bflo(w.x), bfhi(w.x), bflo(w.y), bfhi(w.y), bflo(w.z), bfhi(w.z), bflo(w.w), bfhi(w.w)};
        const unsigned k1 = *(const GAS unsigned*)(P + (size_t)row * NP + 3200 + 2 * sub), k2 = *(const GAS unsigned*)(P + (size_t)row * NP + 3216 + 2 * sub);
        float x1a = bflo(k1), x1b = bfhi(k1), x2a = bflo(k2), x2b = bfhi(k2);
        float ss = x1a * x1a + x1b * x1b + x2a * x2a + x2b * x2b;
#pragma unroll
        for (int e = 0; e < 8; ++e) ss += nv[e] * nv[e];
        ss += __shfl_xor(ss, 1); ss += __shfl_xor(ss, 2); ss += __shfl_xor(ss, 4);
        const float rs = rsqrtf(ss * (1.f / 96.f) + 1e-6f);
#pragma unroll
        for (int e = 0; e < 8; ++e) nv[e] *= rs * kg[8 * sub + e];
        x1a *= rs * kg[64 + 2 * sub]; x1b *= rs * kg[65 + 2 * sub]; x2a *= rs * kg[80 + 2 * sub]; x2b *= rs * kg[81 + 2 * sub];
        const int ps = pos[row]; float ca, sa, cb, sb; rope_cs(ps, 2 * sub, ca, sa); rope_cs(ps, 2 * sub + 1, cb, sb);
        u32x4 o; o.x = pk2(nv[0], nv[1]); o.y = pk2(nv[2], nv[3]); o.z = pk2(nv[4], nv[5]); o.w = pk2(nv[6], nv[7]);
        *(GAS u32x4*)(kp + 8 * sub) = o;
        *(GAS unsigned*)(kp + 64 + 2 * sub) = pk2(x1a * ca - x2a * sa, x1b * cb - x2b * sb);
        *(GAS unsigned*)(kp + 80 + 2 * sub) = pk2(x2a * ca + x1a * sa, x2b * cb + x1b * sb);
    }
}
__device__ __forceinline__ void mkfix_rows(int wid_s, KP p_, int l) {
    KP p = p_; asm volatile("" : "+s"(p));
    unsigned char* ws = p->ws;
    const int tid_ = mk_tid(wid_s);
    const int tid = tid_, lane = tid & 63, wv = tid >> 6, h = lane >> 4, sub = lane & 15;
    bf16* mk = (bf16*)(ws + R_MK); const float* kg = p->in[I_XKG] + l * 128;
    for (int row = blockIdx.x * 8 + wv; row < 2048; row += gridDim.x * 8) {
        bf16* kp = mk + (size_t)row * 512 + h * 128 + 8 * sub;
        const u32x4 w = *(const u32x4*)kp;
        float nv[8] = {bflo(w.x), bfhi(w.x), bflo(w.y), bfhi(w.y), bflo(w.z), bfhi(w.z), bflo(w.w), bfhi(w.w)};
        float ss = 0.f;
#pragma unroll
        for (int e = 0; e < 8; ++e) ss += nv[e] * nv[e];
        ss += __shfl_xor(ss, 1); ss += __shfl_xor(ss, 2); ss += __shfl_xor(ss, 4); ss += __shfl_xor(ss, 8);
        const float rs = rsqrtf(ss * (1.f / 128.f) + 1e-6f);
#pragma unroll
        for (int e = 0; e < 8; ++e) nv[e] *= rs * kg[8 * sub + e];
        u32x4 o; o.x = pk2(nv[0], nv[1]); o.y = pk2(nv[2], nv[3]); o.z = pk2(nv[4], nv[5]); o.w = pk2(nv[6], nv[7]);
        *(u32x4*)kp = o;
    }
}
__device__ __forceinline__ void memb_rows(int wid_s, KP p_) {
    KP p = p_; asm volatile("" : "+s"(p));
    unsigned char* ws = p->ws;
    const int tid_ = mk_tid(wid_s);
    const int tid = tid_, lane = tid & 63, wv = tid >> 6;
    const float* mem = p->in[I_MEM]; bf16* memb = (bf16*)(ws + R_MEMB);
    for (int row = blockIdx.x * 8 + wv; row < 2048; row += gridDim.x * 8) {
        const f32x4* xr = (const f32x4*)(mem + (size_t)row * 1024) + lane; f32x4 v[4]; float s = 0.f;
#pragma unroll
        for (int jq = 0; jq < 4; ++jq) { v[jq] = xr[64 * jq]; s += (v[jq].x * v[jq].x + v[jq].y * v[jq].y) + (v[jq].z * v[jq].z + v[jq].w * v[jq].w); }
        const float rs = rsqrtf(wave_sum(s) * (1.f / 1024.f) + 1e-6f);
#pragma unroll
        for (int jq = 0; jq < 4; ++jq) { u32x2 w; w.x = pk2(v[jq].x * rs, v[jq].y * rs); w.y = pk2(v[jq].z * rs, v[jq].w * rs); *((u32x2*)(memb + (size_t)row * 1024) + lane + 64 * jq) = w; }
    }
}

#define XB_TMO      128
#define XB_XCNT(j)  (256  + 64 * (j))
#define XB_XSUB(j)  (1280 + 64 * (j))
#define XB_XGEN(j)  (2304 + 64 * (j))
#define XB_TOP      3328
#define XB_TOPGEN   3392
#define XCD_BAR_WORDS 3456
#define XB_SPIN_CAP (1u << 22)
__device__ __forceinline__ unsigned xb_ld(unsigned* p)              { return __hip_atomic_load(p, __ATOMIC_RELAXED, __HIP_MEMORY_SCOPE_AGENT); }
__device__ __forceinline__ unsigned xb_add(unsigned* p, unsigned v) { return __hip_atomic_fetch_add(p, v, __ATOMIC_RELAXED, __HIP_MEMORY_SCOPE_AGENT); }
__device__ __forceinline__ unsigned xb_xcc_id() { return (unsigned)__builtin_amdgcn_s_getreg((3 << 11) | 20) & 0xFu; }
#define XB_SPIN(cond, bar) do { unsigned _sp = 0; while (cond) { __builtin_amdgcn_s_sleep(1); \
    if ((++_sp & 255u) == 0u) { if (xb_ld(&(bar)[XB_TMO])) break; if (_sp > XB_SPIN_CAP) { atomicAdd(&(bar)[XB_TMO], 1u); break; } } } } while (0)
__device__ __forceinline__ void xcd_barrier_complete(unsigned* bar, unsigned x, unsigned& nloc, unsigned& nx) {
    const unsigned G = gridDim.x;
    unsigned sum, cnt, mine, sp = 0u;
    for (;;) {
        sum = 0u; cnt = 0u; mine = 0u;
#pragma unroll
        for (unsigned j = 0; j < 16; ++j) { const unsigned c = xb_ld(&bar[XB_XCNT(j)]); sum += c; cnt += (c > 0u) ? 1u : 0u; mine = (j == x) ? c : mine; }
        if (sum == G) break;
        __builtin_amdgcn_s_sleep(1);
        if ((++sp & 255u) == 0u) { if (xb_ld(&bar[XB_TMO])) break; if (sp > XB_SPIN_CAP) { atomicAdd(&bar[XB_TMO], 1u); break; } }
    }
    nloc = mine > 0u ? mine : 1u; nx = cnt > 0u ? cnt : 1u;
}
__device__ __forceinline__ void grid_barrier1(int wid_s, unsigned* bar, volatile unsigned* st) {
    asm volatile("s_waitcnt vmcnt(0)" ::: "memory");
    __syncthreads();
    if (mk_tid(wid_s) == 0) {
        const unsigned x = xb_xcc_id();
        __builtin_amdgcn_s_waitcnt(0);
        unsigned nloc = st[0], nx = st[1];
        if (nloc == 0u) { xcd_barrier_complete(bar, x, nloc, nx); st[0] = nloc; st[1] = nx; }
        const unsigned old = xb_add(&bar[XB_XSUB(x)], 1u);
        const unsigned gen = old / nloc;
        if (old + 1u == (gen + 1u) * nloc) {
            __builtin_amdgcn_fence(__ATOMIC_RELEASE, "agent");
            asm volatile("s_waitcnt vmcnt(0)" ::: "memory");
            const unsigned og = xb_add(&bar[XB_TOP], 1u);
            const unsigned tg = og / nx;
            if (og + 1u == (tg + 1u) * nx) xb_add(&bar[XB_TOPGEN], 1u);
            else XB_SPIN(xb_ld(&bar[XB_TOPGEN]) == tg, bar);
            __builtin_amdgcn_fence(__ATOMIC_ACQUIRE, "agent");
            xb_add(&bar[XB_XGEN(x)], 1u);
            asm volatile("s_waitcnt vmcnt(0)" ::: "memory");
        } else {
            XB_SPIN(xb_ld(&bar[XB_XGEN(x)]) == gen, bar);
            __builtin_amdgcn_fence(__ATOMIC_ACQUIRE, "agent");
            asm volatile("s_waitcnt vmcnt(0)" ::: "memory");
        }
    }
    __syncthreads();
}
__device__ __forceinline__ void grid_barrier(int wid_s, unsigned* bar, volatile unsigned* st) { int nb = 1 + RB(8); asm volatile("" : "+s"(nb)); for (int q = 0; q < nb; ++q) grid_barrier1(wid_s, bar, st); }
template <class Epi>
__device__ __forceinline__ void run_gemm(int wid_s, LAS unsigned char* lds, const bf16* A, int lda, const bf16* Bt, int M, int N, int K, const Epi& E, int shift = 0) {
    int bx_ = blockIdx.x, gx_ = gridDim.x; asm volatile("" : "+s"(bx_), "+s"(gx_), "+s"(K), "+s"(lda));
    pg8::Gemm g{A, Bt, M, N, K, lda}; pg8::StaticOrder S; S.init(M, N, gx_, (bx_ + shift) % gx_);
    if (ON(1)) pg8::gemm_phase<Epi, pg8::StaticOrder>(wid_s, lds, g, S, E);
}

__device__ __forceinline__ unsigned char* wsl_(KP p) { unsigned char* w = p->ws; asm volatile("" : "+s"(w)); return w; }
__global__ void __launch_bounds__(512, 2) fwd_kernel(Params parg) {
    KP p = (KP)__builtin_amdgcn_kernarg_segment_ptr();
    extern __shared__ __attribute__((aligned(16))) unsigned char lds_raw[];
    const int wid_s = __builtin_amdgcn_readfirstlane((int)threadIdx.x >> 6);
    LAS unsigned char* lds3 = (LAS unsigned char*)lds_raw;
    unsigned char* lds = lds_raw; float* ldsf = (float*)lds_raw;
    unsigned char* ws = p->ws;
    const int bid = blockIdx.x;
    unsigned* ctl = (unsigned*)(wsl_(p) + WS_CTL);
    bf16* xb = (bf16*)(wsl_(p) + WS_XB); float* part = (float*)(wsl_(p) + WS_PART); float* pq = (float*)(wsl_(p) + WS_PQ); float* pkv = (float*)(wsl_(p) + WS_PKV);
    bf16* Y = (bf16*)(wsl_(p) + WS_Y);
    float* xcur = p->out;
    volatile unsigned* bst = (volatile unsigned*)(lds + QIDX_OFF + 16);
    if (threadIdx.x == 0) { bst[0] = 0u; bst[1] = 0u; (void)xb_add(&ctl[1024 + XB_XCNT(xb_xcc_id())], 1u); }
    __syncthreads();

    for (int l_ = 0; l_ < 2; ++l_) {
        int l = l_; asm volatile("" : "+s"(l));
        { REPLOOP(0) { if (ON(0)) phase_convert(wid_s, p, l, ldsf);
        grid_barrier(wid_s, ctl + 1024, bst); } }
        for (int r_ = 0; r_ < 2; ++r_) {
            int r = r_; asm volatile("" : "+s"(r));
            { REPLOOP(1) { EpiP E{(bf16*)(wsl_(p) + R_P), part + (size_t)r * TH * 16, pq, pkv};
              run_gemm(wid_s, lds3, xb + (size_t)r * TH * 1024, 1024, (const bf16*)(wsl_(p) + W_IN), TH, NP, 1024, E);
              if (r == 0 && q == 0 && bid >= 160) { __syncthreads(); phase_convert_mid(wid_s, p, l, ldsf, (bid - 160) * 8 + (mk_tid(wid_s) >> 6), (int)(gridDim.x - 160) * 8); __syncthreads(); }
            grid_barrier(wid_s, ctl + 1024, bst); } }
            { REPLOOP(2) {
            if (ON(2)) lora_act_rows(wid_s, p, l, r);
            { EpiQ E{(bf16*)(wsl_(p) + R_Q), pq}; run_gemm(wid_s, lds3, (const bf16*)(wsl_(p) + R_P) + 2816, NP, (const bf16*)(wsl_(p) + W_MQ), TH, 768, 256, E); }
            { EpiKV E{(bf16*)(wsl_(p) + R_KM), (bf16*)(wsl_(p) + R_VT), pkv}; run_gemm(wid_s, lds3, (const bf16*)(wsl_(p) + R_P) + 3072, NP, (const bf16*)(wsl_(p) + W_MKV), TH, 1024, 128, E, 128); }
            grid_barrier(wid_s, ctl + 1024, bst); } }
            { REPLOOP(9) { EpiBf E{Y + (size_t)r * TH * 1536, 1536}; run_gemm(wid_s, lds3, Y + (size_t)r * TH * 1536 + 1024, 1536, (const bf16*)(wsl_(p) + W_BWA), TH, 1024, 128, E);
            grid_barrier(wid_s, ctl + 1024, bst); } }
            { REPLOOP(13) { if (ON(2)) si_build_rows(wid_s, p, l, r); } }
            if (ON(7)) kfix_rows(wid_s, p, l, r);
            grid_barrier(wid_s, ctl + 1024, bst);
            { REPLOOP(3) {
            if (ON(3) && !(q && RB(10)) && bid < 128) { const int xcd = bid & 7, idx = bid >> 3, hh = xcd * 4 + (idx >> 2), quarter = idx & 3;
                if (q == 0 || SCANMODE == 0) rwkv_scan_unit<0>(wid_s, (const bf16*)(wsl_(p) + R_SI) + (size_t)hh * 2048 * 384, Y + ((size_t)(r * 4 + (hh >> 3)) * 2048) * 1536 + (hh & 7) * 64, 1536, quarter, ldsf);
                else rwkv_scan_unit<SCANMODE>(wid_s, (const bf16*)(wsl_(p) + R_SI) + (size_t)hh * 2048 * 384, (bf16*)(wsl_(p) + R_P) + ((size_t)(hh >> 3) * 2048) * NP + 600 + (hh & 7) * 64, NP, quarter, ldsf); }
            else if (ON(4) && !(q && RB(11)) && bid >= 128 && bid < 160) { const int uu = bid - 128; lru_unit(wid_s, p, l, r, uu >> 3, uu & 7, ldsf); }
            else if (q == 0) { EpiBf E{(bf16*)(wsl_(p) + R_P), NP}; run_gemm(wid_s, lds3, (const bf16*)(wsl_(p) + WS_AG), 128, (const bf16*)(wsl_(p) + W_GUP), TH, 512, 128, E, 96); }
            {
                unsigned* ctr = ctl + q * 4 + l * 2 + r; volatile int* qidx = (volatile int*)(lds + QIDX_OFF);
                for (;;) {
                    __syncthreads();
                    if (mk_tid(wid_s) == 0) *qidx = (int)atomicAdd(ctr, 1u);
                    __syncthreads();
                    const int u = *qidx;
                    if (u >= 512 || !ON(5) || (q && RB(12))) break;
                    const int qb = 15 - (u >> 5), bh = u & 31, bl = bh >> 3, h = bh & 7;
                    attn_unit<96, 64, true, true>(wid_s, lds, (const bf16*)(wsl_(p) + R_Q) + (size_t)bl * 2048 * 768 + h * 96, 768, (const bf16*)(wsl_(p) + R_KM) + (size_t)bl * 2048 * 768 + h * 96, 768,
                        (const bf16*)(wsl_(p) + R_VT) + (size_t)(bl * 8 + h) * 64 * 2048, 2048, Y + ((size_t)(r * 4 + bl) * 2048) * 1536 + 1024 + h * 64, 1536,
                        qb * 128, 2 * qb + 2, p->in[I_QG] + l * 96, (const int*)p->in[I_POS] + (r * 4 + bl) * 2048, 0.14724444527f  );
                }
            }
            grid_barrier(wid_s, ctl + 1024, bst); } }
            { REPLOOP(16) { if (ON(6)) rwkv_post_rows(wid_s, p, l, r, q); } }
            grid_barrier(wid_s, ctl + 1024, bst);
        }
        if (ON(7)) memb_rows(wid_s, p);
        { REPLOOP(4) {
        for (int n = 0; n < 3; ++n) {
            { EpiGate E{(bf16*)(wsl_(p) + R_GS), part, p->in[I_BGATE] + l * 3072 + n * 1024}; run_gemm(wid_s, lds3, xb, 1024, (const bf16*)(wsl_(p) + W_GATE) + (size_t)n * 1024 * 1024, T, 1024, 1024, E); }
            { EpiProj E{(const bf16*)(wsl_(p) + R_GS), (float*)(wsl_(p) + R_MS), (bf16*)(wsl_(p) + R_MG), n}; run_gemm(wid_s, lds3, Y + n * 512, 1536, (const bf16*)(wsl_(p) + W_BR) + (size_t)n * 1024 * 512, T, 1024, 512, E); }
        }
        grid_barrier(wid_s, ctl + 1024, bst); } }
        { int nw = 1 + RB(15); asm volatile("" : "+s"(nw)); for (int q = 0; q < nw; ++q) { EpiRes E{l == 0 ? p->in[I_X] : xcur, xcur, xb, part, q + 1 < nw}; run_gemm(wid_s, lds3, (const bf16*)(wsl_(p) + R_MG), 1024, (const bf16*)(wsl_(p) + W_OUT), T, 1024, 1024, E); if (q + 1 < nw) grid_barrier(wid_s, ctl + 1024, bst); } }
        { REPLOOP(19) { EpiMemKV E{(bf16*)(wsl_(p) + R_MK), (bf16*)(wsl_(p) + R_MVT)}; run_gemm(wid_s, lds3, (const bf16*)(wsl_(p) + R_MEMB), 1024, (const bf16*)(wsl_(p) + W_XKV), 2048, 1024, 1024, E); } }
        grid_barrier(wid_s, ctl + 1024, bst);
        if (ON(7)) mkfix_rows(wid_s, p, l);
        if (bid >= 128) { __syncthreads(); phase_convert_ffn(wid_s, p, l, ldsf, (bid - 128) * 8 + (mk_tid(wid_s) >> 6), (int)(gridDim.x - 128) * 8); __syncthreads(); }
        { REPLOOP(5) { EpiXQ E{(bf16*)(wsl_(p) + R_XQ), part}; run_gemm(wid_s, lds3, xb, 1024, (const bf16*)(wsl_(p) + W_XQ), T, 512, 1024, E);
        grid_barrier(wid_s, ctl + 1024, bst); } }
        { REPLOOP(6) {
        if (ON(8)) for (int u = bid; u < 512; u += gridDim.x) { const int qb = u & 15, bh = u >> 4, b = bh >> 2, h = bh & 3;
            attn_unit<128, 128, false, false>(wid_s, lds, (const bf16*)(wsl_(p) + R_XQ) + (size_t)b * 2048 * 512 + h * 128, 512, (const bf16*)(wsl_(p) + R_MK) + (size_t)b * 256 * 512 + h * 128, 512,
                (const bf16*)(wsl_(p) + R_MVT) + (size_t)(b * 4 + h) * 128 * 256, 256, (bf16*)(wsl_(p) + R_XO) + (size_t)b * 2048 * 512 + h * 128, 512,
                qb * 128, 4, p->in[I_XQG] + l * 128, nullptr, 0.12751743082f  ); }
        grid_barrier(wid_s, ctl + 1024, bst); } }
        { int nw = 1 + RB(17); asm volatile("" : "+s"(nw)); for (int q = 0; q < nw; ++q) { EpiRes E{xcur, xcur, xb, part, q + 1 < nw}; run_gemm(wid_s, lds3, (const bf16*)(wsl_(p) + R_XO), 512, (const bf16*)(wsl_(p) + W_XO), T, 1024, 512, E); if (q + 1 < nw) grid_barrier(wid_s, ctl + 1024, bst); } }
        grid_barrier(wid_s, ctl + 1024, bst);
        { REPLOOP(7) { EpiFFN1 E{(bf16*)(wsl_(p) + R_H), part}; run_gemm(wid_s, lds3, xb, 1024, (const bf16*)(wsl_(p) + W_13), T, 5632, 1024, E);
        grid_barrier(wid_s, ctl + 1024, bst); } }
        { int nw = 1 + RB(18); asm volatile("" : "+s"(nw)); for (int q = 0; q < nw; ++q) { EpiRes E{xcur, xcur, xb, part, q + 1 < nw}; run_gemm(wid_s, lds3, (const bf16*)(wsl_(p) + R_H), DFF, (const bf16*)(wsl_(p) + W_2), T, 1024, DFF, E); if (q + 1 < nw) grid_barrier(wid_s, ctl + 1024, bst); } }
        grid_barrier(wid_s, ctl + 1024, bst);
    }
}

extern "C" void kernel_launch(void* const* d_in, const int* in_sizes, int n_in, void* d_out, int out_size, void* d_ws, size_t ws_size, hipStream_t stream) {
    static int grid = 0;
    if (grid == 0) {
        int dev = 0, cus = 0, per_cu = 0;
        if (n_in != 43 || ws_size < WS_END) { fprintf(stderr, "kernel_launch: unexpected n_in %d / ws %zu\n", n_in, ws_size); grid = -1; return; }
        (void)hipGetDevice(&dev);
        (void)hipDeviceGetAttribute(&cus, hipDeviceAttributeMultiprocessorCount, dev);
        (void)hipFuncSetAttribute((const void*)fwd_kernel, hipFuncAttributeMaxDynamicSharedMemorySize, LDS_BYTES);
        (void)hipOccupancyMaxActiveBlocksPerMultiprocessor(&per_cu, (const void*)fwd_kernel, 512, LDS_BYTES);
        fprintf(stderr, "cus %d per_cu %d ws %zu\n", cus, per_cu, ws_size);
        grid = cus * (per_cu >= 1 ? 1 : 0);
        if (grid <= 0) { grid = -1; return; }
    }
    if (grid < 0) return;
    Params p{};
    for (int i = 0; i < 43; ++i) p.in[i] = (const float*)d_in[i];
    p.out = (float*)d_out; p.ws = (unsigned char*)d_ws;
    (void)hipMemsetAsync((char*)d_ws + WS_CTL, 0, 32768, stream);
    void* args[] = {&p};
    hipError_t e = hipLaunchCooperativeKernel((const void*)fwd_kernel, dim3(grid), dim3(512), args, LDS_BYTES, stream);
    if (e != hipSuccess) fprintf(stderr, "cooperative launch failed: %s (grid %d)\n", hipGetErrorString(e), grid);
}
```

```cpp
#include <hip/hip_runtime.h>
#include <cstdio>
#include <cstdint>

#define LAS __attribute__((address_space(3)))
#define GAS __attribute__((address_space(1)))
typedef unsigned short bf16;
typedef short bf16x8 __attribute__((ext_vector_type(8)));
typedef float f32x4 __attribute__((ext_vector_type(4)));
typedef float f32x2 __attribute__((ext_vector_type(2)));
typedef unsigned u32x4 __attribute__((ext_vector_type(4)));
typedef unsigned u32x2 __attribute__((ext_vector_type(2)));

__device__ __forceinline__ unsigned f2bf(float f) { unsigned u = __builtin_bit_cast(unsigned, f); return (u + 0x7fffu + ((u >> 16) & 1u)) >> 16; }
typedef __bf16 bf16x2_t __attribute__((ext_vector_type(2)));
__device__ __forceinline__ unsigned pk2(float lo, float hi) { const f32x2 v = {lo, hi}; const bf16x2_t b = __builtin_convertvector(v, bf16x2_t); return __builtin_bit_cast(unsigned, b); }
__device__ __forceinline__ float bf2f(bf16 b) { return __builtin_bit_cast(float, (unsigned)b << 16); }
__device__ __forceinline__ float bflo(unsigned u) { return __builtin_bit_cast(float, u << 16); }
__device__ __forceinline__ float bfhi(unsigned u) { return __builtin_bit_cast(float, u & 0xffff0000u); }
__device__ __forceinline__ u32x4 pk8(f32x4 a, f32x4 b) { u32x4 w; w.x = pk2(a.x, a.y); w.y = pk2(a.z, a.w); w.z = pk2(b.x, b.y); w.w = pk2(b.z, b.w); return w; }
__device__ __forceinline__ float sigmoidf_(float x) { return 1.f / (1.f + __expf(-x)); }
__device__ __forceinline__ float fsig(float x) { return __builtin_amdgcn_rcpf(1.f + __builtin_amdgcn_exp2f(-1.4426950408889634f * x)); }
__device__ __forceinline__ int mk_tid(int wid_s) { int t = wid_s * 64 + (int)__builtin_amdgcn_mbcnt_hi(~0u, __builtin_amdgcn_mbcnt_lo(~0u, 0u)); asm volatile("" : "+v"(t)); return t; }
#define LBAR() asm volatile("s_waitcnt lgkmcnt(0)\n\ts_barrier" ::: "memory")
__device__ __forceinline__ float wave_sum(float v) {
#pragma unroll
    for (int o = 1; o < 64; o <<= 1) v += __shfl_xor(v, o);
    return v;
}

namespace pg8 {
#define PG8_LAS __attribute__((address_space(3)))
typedef unsigned short bf16_t;
constexpr int BM = 256, BK = 64, HALF = 128, HTB = HALF * BK * 2, STAGE_BYTES = 8 * HTB, NXCD = 8, WGM = 8;
__host__ __device__ __forceinline__ int lds_byte(int r, int c) { const int st = (r >> 4) * 2 + (c >> 5), rr = r & 15, cc = c & 31, ob = rr * 64 + cc * 2; return st * 1024 + (ob ^ (((ob >> 9) & 1) << 5)); }
__host__ __device__ __forceinline__ void stage_rc(int b, int& R, int& C) { const int st = b / 1024, sb = b % 1024, swz = sb ^ (((sb >> 9) & 1) << 5); R = (st >> 1) * 16 + swz / 64; C = (st & 1) * 32 + (swz % 64) / 2; }
__host__ __device__ __forceinline__ int perm32(int rho) { const int n = rho >> 4, i = rho & 15; return 8 * (i >> 2) + 4 * n + (i & 3); }
struct Unit { int pm, pn; };
struct Gemm { const bf16_t* A; const bf16_t* Bt; int M, N, K, lda; };
struct StaticOrder {
    int nM, nN, nwg, G, c;
    __host__ __device__ void init(int M, int N, int G_, int c_) { nM = M / BM; nN = N / BM; nwg = nM * nN; G = G_; c = c_; }
    __host__ __device__ bool next(int i, Unit& u) const {
        const long L = (long)i * G + c; if (L >= nwg) return false;
        int wgid = (int)L; { const int q = nwg / NXCD, r = nwg % NXCD, xcd = wgid % NXCD, off = wgid / NXCD; wgid = (xcd < r ? xcd * (q + 1) : r * (q + 1) + (xcd - r) * q) + off; }
        const int nig = WGM * nN, gid = wgid / nig, fm = gid * WGM, gsz = (nM - fm) < WGM ? (nM - fm) : WGM;
        u.pm = fm + ((wgid % nig) % gsz); u.pn = (wgid % nig) / gsz; return true;
    }
};
template <class Epi, class Sched>
__device__ __forceinline__ void gemm_phase(int wid_s, PG8_LAS unsigned char* lds, const Gemm g, const Sched& S, const Epi& E) {
    const int tid_ = mk_tid(wid_s);
    const int tid = tid_, wid = __builtin_amdgcn_readfirstlane(tid >> 6), lane = tid & 63, wr = wid >> 2, wc = wid & 3, fr = lane & 15, fq = lane >> 4;
    const int K = g.K, nt = K / BK, lda = g.lda;
    unsigned voffA[2], voffB[2];
#pragma unroll
    for (int i = 0; i < 2; ++i) { int R, C; stage_rc(tid * 16 + i * 8192, R, C); const int Rb = (R & ~31) + perm32(R & 31);
        voffA[i] = (unsigned)(R * lda + C) * 2u; voffB[i] = (unsigned)(Rb * K + C) * 2u; }
    const size_t kstep = (size_t)(BK * 2);
    const size_t hstepA = (size_t)HALF * lda * 2, hstepB = (size_t)HALF * K * 2;
    const size_t tstepA = 2 * hstepA, tstepB = 2 * hstepB;
    const unsigned ldsw = (unsigned)wid * 1024u;
    const int aoff = lds_byte(wr * 64 + fr, fq * 8), boff = lds_byte(wc * 32 + fr, fq * 8);
#define PG8_SA(b, h) (((b) * 2 + (h)) * HTB)
#define PG8_SB(b, h) ((4 + (b) * 2 + (h)) * HTB)
#define PG8_STAGE(bufoff, gbase, voff) do { _Pragma("unroll") for (int _i = 0; _i < 2; ++_i) \
        __builtin_amdgcn_global_load_lds((const unsigned*)((const char*)(gbase) + (voff)[_i]), (PG8_LAS unsigned*)(lds + (bufoff) + ldsw + _i * 8192), 16, 0, 0); } while (0)
#define PG8_LDA(dst, b, h) do { _Pragma("unroll") for (int m = 0; m < 4; ++m) _Pragma("unroll") for (int k = 0; k < 2; ++k) dst[m][k] = *(const PG8_LAS bf16x8*)(lds + PG8_SA(b, h) + aoff + m * 2048 + k * 1024); } while (0)
#define PG8_LDB(dst, b, h) do { _Pragma("unroll") for (int n = 0; n < 2; ++n) _Pragma("unroll") for (int k = 0; k < 2; ++k) dst[n][k] = *(const PG8_LAS bf16x8*)(lds + PG8_SB(b, h) + boff + n * 2048 + k * 1024); } while (0)
#define PG8_MMA(ai, bj, At, Bt) do { __builtin_amdgcn_s_setprio(1); _Pragma("unroll") for (int m = 0; m < 4; ++m) _Pragma("unroll") for (int n = 0; n < 2; ++n) _Pragma("unroll") for (int k = 0; k < 2; ++k) \
        acc[ai][bj][m][n] = __builtin_amdgcn_mfma_f32_16x16x32_bf16(Bt[n][k], At[m][k], acc[ai][bj][m][n], 0, 0, 0); __builtin_amdgcn_s_setprio(0); } while (0)
#define PG8_WAIT_V(n) asm volatile("s_waitcnt vmcnt(" #n ")" ::: "memory")
#define PG8_WAIT_L(n) asm volatile("s_waitcnt lgkmcnt(" #n ")" ::: "memory")
#define PG8_BAR __builtin_amdgcn_s_barrier()
#define PG8_SCHED __builtin_amdgcn_sched_barrier(0)
    Unit cur, nxt; int ui = 0;
    if (!S.next(0, cur)) return;
    f32x4 acc[2][2][4][2];
#pragma unroll
    for (int a = 0; a < 2; ++a)
#pragma unroll
        for (int b = 0; b < 2; ++b)
#pragma unroll
            for (int m = 0; m < 4; ++m)
#pragma unroll
                for (int n = 0; n < 2; ++n) acc[a][b][m][n] = (f32x4){0.f, 0.f, 0.f, 0.f};
    bf16x8 At[4][2], B0[2][2], B1[2][2];
    const char* cA = (const char*)g.A + (size_t)cur.pm * tstepA; const char* cB = (const char*)g.Bt + (size_t)cur.pn * tstepB;
    PG8_STAGE(PG8_SB(0, 0), cB, voffB); PG8_STAGE(PG8_SB(0, 1), cB + hstepB, voffB); PG8_STAGE(PG8_SA(0, 0), cA, voffA); PG8_STAGE(PG8_SA(0, 1), cA + hstepA, voffA);
    if (wr == 1) PG8_BAR;
    PG8_WAIT_V(2); PG8_BAR;
    PG8_STAGE(PG8_SB(1, 0), cB + kstep, voffB); PG8_STAGE(PG8_SA(1, 0), cA + kstep, voffA); PG8_STAGE(PG8_SB(1, 1), cB + hstepB + kstep, voffB);
    PG8_WAIT_V(6); PG8_BAR;
    for (;;) {
        const bool has_next = S.next(ui + 1, nxt);
        const char* nA = has_next ? (const char*)g.A + (size_t)nxt.pm * tstepA : cA; const char* nB = has_next ? (const char*)g.Bt + (size_t)nxt.pn * tstepB : cB;
#pragma unroll 1
        for (int t = 0; t < nt; t += 2) {
            const bool last = (t == nt - 2);
            const char* a1 = cA + (size_t)(t + 1) * kstep;
            const char* a2 = last ? nA : cA + (size_t)(t + 2) * kstep; const char* b2 = last ? nB : cB + (size_t)(t + 2) * kstep;
            const char* a3 = a2 + kstep; const char* b3 = b2 + kstep;
            PG8_LDB(B0, 0, 0); PG8_LDB(B1, 0, 1); PG8_SCHED; PG8_LDA(At, 0, 0); PG8_STAGE(PG8_SA(1, 1), a1 + hstepA, voffA);
            PG8_WAIT_V(8); PG8_WAIT_L(0); PG8_BAR; PG8_MMA(0, 0, At, B0); PG8_MMA(0, 1, At, B1); PG8_BAR; PG8_SCHED;
            PG8_LDA(At, 0, 1); PG8_STAGE(PG8_SB(0, 0), b2, voffB); PG8_STAGE(PG8_SB(0, 1), b2 + hstepB, voffB); PG8_STAGE(PG8_SA(0, 0), a2, voffA);
            PG8_WAIT_V(8); PG8_WAIT_L(0); PG8_BAR; PG8_MMA(1, 0, At, B0); PG8_MMA(1, 1, At, B1); PG8_BAR; PG8_SCHED;
            PG8_LDB(B0, 1, 0); PG8_LDB(B1, 1, 1); PG8_SCHED; PG8_LDA(At, 1, 0); PG8_STAGE(PG8_SA(0, 1), a2 + hstepA, voffA);
            PG8_WAIT_V(8); PG8_WAIT_L(0); PG8_BAR; PG8_MMA(0, 0, At, B0); PG8_MMA(0, 1, At, B1); PG8_BAR; PG8_SCHED;
            PG8_LDA(At, 1, 1); PG8_STAGE(PG8_SB(1, 0), b3, voffB); PG8_STAGE(PG8_SB(1, 1), b3 + hstepB, voffB); PG8_STAGE(PG8_SA(1, 0), a3, voffA);
            PG8_WAIT_V(8); PG8_WAIT_L(0); PG8_BAR; PG8_MMA(1, 0, At, B0); PG8_MMA(1, 1, At, B1); PG8_BAR; PG8_SCHED;
        }
        if (wr == 0) PG8_BAR;
        E(acc, cur, wr, wc, fr, fq);
        if (!has_next) break;
#pragma unroll
        for (int a = 0; a < 2; ++a)
#pragma unroll
            for (int b = 0; b < 2; ++b)
#pragma unroll
                for (int m = 0; m < 4; ++m)
#pragma unroll
                    for (int n = 0; n < 2; ++n) acc[a][b][m][n] = (f32x4){0.f, 0.f, 0.f, 0.f};
        cur = nxt; cA = nA; cB = nB; ++ui;
        if (wr == 1) PG8_BAR;
    }
    PG8_WAIT_V(0);
    PG8_BAR;
#undef PG8_SA
#undef PG8_SB
#undef PG8_STAGE
#undef PG8_LDA
#undef PG8_LDB
#undef PG8_MMA
#undef PG8_WAIT_V
#undef PG8_WAIT_L
#undef PG8_BAR
#undef PG8_SCHED
}
}

#ifndef EN
#define EN 0xFFFF
#endif
#define ON(b) ((EN >> (b)) & 1)
#ifndef REP
#define REP 0
#endif
#ifndef SCANMODE
#define SCANMODE 0
#endif
#define RB(b) ((REP >> (b)) & 1)
#define REPLOOP(b) int nrep##b = 1 + RB(b); asm volatile("" : "+s"(nrep##b)); for (int q = 0; q < nrep##b; ++q)
constexpr int T = 16384, TH = 8192, SEQ = 2048, DM = 1024, DIN = 6304, NP = 3328, DFF = 2816;
constexpr int LDS_BYTES = 147456, QIDX_OFF = 140000;
constexpr size_t MiB = 1u << 20;
constexpr size_t WS_CTL = 0;
constexpr size_t WS_WT = 1 * MiB;
constexpr size_t W_IN = WS_WT, W_GATE = W_IN + (size_t)NP * 1024 * 2, W_BR = W_GATE + (size_t)3072 * 1024 * 2, W_OUT = W_BR + (size_t)3 * 1024 * 512 * 2,
                 W_MQ = W_OUT + (size_t)1024 * 1024 * 2, W_MKV = W_MQ + (size_t)768 * 256 * 2, W_XQ = W_MKV + (size_t)1024 * 128 * 2, W_XKV = W_XQ + (size_t)512 * 1024 * 2,
                 W_XO = W_XKV + (size_t)1024 * 1024 * 2, W_13 = W_XO + (size_t)1024 * 512 * 2, W_2 = W_13 + (size_t)5632 * 1024 * 2, W_BWA = W_2 + (size_t)1024 * 2816 * 2, W_GUP = W_BWA + (size_t)1024 * 128 * 2, W_END = W_GUP + (size_t)512 * 128 * 2;
static_assert(W_END <= 40 * MiB, "weights");
constexpr size_t WS_XB = 40 * MiB, WS_PART = 72 * MiB, WS_PQ = 73 * MiB, WS_PKV = WS_PQ + 256 * 1024, WS_Y = 74 * MiB, WS_R = 122 * MiB;
constexpr size_t R_P = WS_R, R_SI = WS_R + 52 * MiB, R_Q = WS_R + 100 * MiB, R_KM = WS_R + 112 * MiB, R_VT = WS_R + 124 * MiB;
constexpr size_t R_GS = WS_R, R_MS = WS_R + 32 * MiB, R_MG = WS_R + 96 * MiB, R_MEMB = WS_R + 128 * MiB;
constexpr size_t R_MK = WS_R, R_MVT = WS_R + 2 * MiB, R_XQ = WS_R + 32 * MiB, R_XO = WS_R + 48 * MiB, R_H = WS_R;
constexpr size_t WS_AG = WS_R + 132 * MiB;
constexpr size_t WS_END = WS_AG + 2 * MiB;
static_assert(WS_END <= 256 * MiB, "ws");

struct Params { const float* in[43]; float* out; unsigned char* ws; };
typedef const __attribute__((address_space(4))) Params* KP;
enum { I_X = 0, I_MEM, I_POS, I_NMIX, I_NXA, I_NMEM, I_NFFN, I_WIN, I_BGATE, I_MU, I_W0, I_WUP, I_A0, I_AUP, I_GUP, I_KK, I_KA, I_RK, I_LNG, I_LNB,
       I_CW, I_CB, I_WA, I_BA, I_WX, I_BX, I_LAM, I_QN, I_WUQ, I_KVN, I_WUKV, I_QG, I_KG, I_WBR, I_WOUT, I_XWQ, I_XWKV, I_XQG, I_XKG, I_XWO, I_W1, I_W3, I_W2 };

__device__ __forceinline__ float rstd16(const float* part, int row) {
    const f32x4* p = (const f32x4*)(part + (size_t)row * 16); const f32x4 a = p[0], b = p[1], c = p[2], d = p[3];
    const float s = ((a.x + a.y) + (a.z + a.w)) + ((b.x + b.y) + (b.z + b.w)) + ((c.x + c.y) + (c.z + c.w)) + ((d.x + d.y) + (d.z + d.w));
    return rsqrtf(s * (1.f / 1024.f) + 1e-6f);
}
__device__ __forceinline__ float rstd4(const float* pp, int row, float invn) { const f32x4 a = *(const f32x4*)(pp + (size_t)row * 4); return rsqrtf(((a.x + a.y) + (a.z + a.w)) * invn + 1e-6f); }
__device__ __forceinline__ float sumsq8(f32x4 a, f32x4 b) { return (a.x * a.x + a.y * a.y) + (a.z * a.z + a.w * a.w) + (b.x * b.x + b.y * b.y) + (b.z * b.z + b.w * b.w); }
#define EPI_HEAD static constexpr bool PERM = true; \
    __device__ __forceinline__ void operator()(const f32x4 (&acc)[2][2][4][2], const pg8::Unit& u, int wr, int wc, int fr, int fq) const
#define EPI_ROWS _Pragma("unroll") for (int ai = 0; ai < 2; ++ai) _Pragma("unroll") for (int m = 0; m < 4; ++m) if ((__builtin_amdgcn_sched_barrier(0), true))
#define EPI_ROW (u.pm * 256 + ai * 128 + wr * 64 + m * 16 + fr)

struct EpiP {
    bf16* P; const float* part; float* pq; float* pkv;
    EPI_HEAD {
        const int col0 = u.pn * 256 + wc * 32 + 8 * fq;
        EPI_ROWS { const int row = EPI_ROW; const float rs = rstd16(part, row); float ss = 0.f;
#pragma unroll
            for (int bj = 0; bj < 2; ++bj) { const f32x4 v0 = acc[ai][bj][m][0] * rs, v1 = acc[ai][bj][m][1] * rs;
                *(u32x4*)(P + (size_t)row * NP + col0 + bj * 128) = pk8(v0, v1);
                if (u.pn == 11 || bj == 0) ss += sumsq8(v0, v1); }
            if (u.pn == 11 || u.pn == 12) { ss += __shfl_xor(ss, 16); ss += __shfl_xor(ss, 32); if (fq == 0) (u.pn == 11 ? pq : pkv)[(size_t)row * 4 + wc] = ss; } }
    }
};
struct EpiQ {
    bf16* Q; const float* pq;
    EPI_HEAD {
        const int col0 = u.pn * 256 + wc * 32 + 8 * fq;
        EPI_ROWS { const int row = EPI_ROW; const float rs = rstd4(pq, row, 1.f / 256.f);
#pragma unroll
            for (int bj = 0; bj < 2; ++bj) *(u32x4*)(Q + (size_t)row * 768 + col0 + bj * 128) = pk8(acc[ai][bj][m][0] * rs, acc[ai][bj][m][1] * rs); }
    }
};
struct EpiKV {
    bf16* Km; bf16* Vt; const float* pkv;
    EPI_HEAD {
        const int j0 = wc * 32 + 8 * fq;
        EPI_ROWS { const int row = EPI_ROW; const float rs = rstd4(pkv, row, 1.f / 128.f);
#pragma unroll
            for (int bj = 0; bj < 2; ++bj) { const int h = 2 * u.pn + bj; const f32x4 v0 = acc[ai][bj][m][0] * rs, v1 = acc[ai][bj][m][1] * rs;
                if (wc < 2) *(u32x4*)(Km + (size_t)row * 768 + h * 96 + j0) = pk8(v0, v1);
                else { const int bl = row >> 11, t = row & 2047; bf16* vp = Vt + ((size_t)(bl * 8 + h) * 64 + (j0 - 64)) * 2048 + t;
                    vp[0 * 2048] = (bf16)f2bf(v0.x); vp[1 * 2048] = (bf16)f2bf(v0.y); vp[2 * 2048] = (bf16)f2bf(v0.z); vp[3 * 2048] = (bf16)f2bf(v0.w);
                    vp[4 * 2048] = (bf16)f2bf(v1.x); vp[5 * 2048] = (bf16)f2bf(v1.y); vp[6 * 2048] = (bf16)f2bf(v1.z); vp[7 * 2048] = (bf16)f2bf(v1.w); } } }
    }
};
struct EpiGate {
    bf16* GS; const float* part; const float* bg;
    EPI_HEAD {
        const int col0 = u.pn * 256 + wc * 32 + 8 * fq;
        f32x4 b0[2], b1[2];
#pragma unroll
        for (int bj = 0; bj < 2; ++bj) { b0[bj] = *(const f32x4*)(bg + col0 + bj * 128); b1[bj] = *(const f32x4*)(bg + col0 + bj * 128 + 4); }
        EPI_ROWS { const int row = EPI_ROW; const float rs = rstd16(part, row);
#pragma unroll
            for (int bj = 0; bj < 2; ++bj) { f32x4 v0 = acc[ai][bj][m][0] * rs + b0[bj], v1 = acc[ai][bj][m][1] * rs + b1[bj];
#pragma unroll
                for (int e = 0; e < 4; ++e) { v0[e] = fsig(v0[e]); v1[e] = fsig(v1[e]); }
                *(u32x4*)(GS + (size_t)row * 1024 + col0 + bj * 128) = pk8(v0, v1); } }
    }
};
struct EpiProj {
    const bf16* GS; float* MS; bf16* MG; int n;
    EPI_HEAD {
        const int col0 = u.pn * 256 + wc * 32 + 8 * fq;
        EPI_ROWS { const int row = EPI_ROW;
#pragma unroll
            for (int bj = 0; bj < 2; ++bj) { const size_t o = (size_t)row * 1024 + col0 + bj * 128; const u32x4 gw = *(const u32x4*)(GS + o);
                f32x4 v0 = acc[ai][bj][m][0], v1 = acc[ai][bj][m][1];
                v0.x *= bflo(gw.x); v0.y *= bfhi(gw.x); v0.z *= bflo(gw.y); v0.w *= bfhi(gw.y); v1.x *= bflo(gw.z); v1.y *= bfhi(gw.z); v1.z *= bflo(gw.w); v1.w *= bfhi(gw.w);
                bf16* MSb = (bf16*)MS;
                if (n > 0) { const u32x4 mw = *(const u32x4*)(MSb + o); v0.x += bflo(mw.x); v0.y += bfhi(mw.x); v0.z += bflo(mw.y); v0.w += bfhi(mw.y); v1.x += bflo(mw.z); v1.y += bfhi(mw.z); v1.z += bflo(mw.w); v1.w += bfhi(mw.w); }
                if (n < 2) *(u32x4*)(MSb + o) = pk8(v0, v1); else *(u32x4*)(MG + o) = pk8(v0, v1); } }
    }
};
struct EpiRes {
    float* xout; bf16* xb; float* part; int nowrite = 0;
    EPI_HEAD {
        const int col0 = u.pn * 256 + wc * 32 + 8 * fq;
        EPI_ROWS { const int row = EPI_ROW; float ss = 0.f;
#pragma unroll
            for (int bj = 0; bj < 2; ++bj) { const size_t o = (size_t)row * 1024 + col0 + bj * 128; const u32x4 xw = *(const u32x4*)(xb + o);
                f32x4 v0 = acc[ai][bj][m][0], v1 = acc[ai][bj][m][1];
                v0.x += bflo(xw.x); v0.y += bfhi(xw.x); v0.z += bflo(xw.y); v0.w += bfhi(xw.y); v1.x += bflo(xw.z); v1.y += bfhi(xw.z); v1.z += bflo(xw.w); v1.w += bfhi(xw.w);
                if (!nowrite) { if (xout) { *(f32x4*)(xout + o) = v0; *(f32x4*)(xout + o + 4) = v1; } *(u32x4*)(xb + o) = pk8(v0, v1); } ss += sumsq8(v0, v1); }
            ss += __shfl_xor(ss, 16); ss += __shfl_xor(ss, 32); if (fq == 0 && !nowrite) part[(size_t)row * 16 + u.pn * 4 + wc] = ss; }
    }
};
struct EpiXQ {
    bf16* Q; const float* part;
    EPI_HEAD {
        const int col0 = u.pn * 256 + wc * 32 + 8 * fq;
        EPI_ROWS { const int row = EPI_ROW; const float rs = rstd16(part, row);
#pragma unroll
            for (int bj = 0; bj < 2; ++bj) *(u32x4*)(Q + (size_t)row * 512 + col0 + bj * 128) = pk8(acc[ai][bj][m][0] * rs, acc[ai][bj][m][1] * rs); }
    }
};
struct EpiBf {
    bf16* O; int ld;
    EPI_HEAD {
        const int col0 = u.pn * 256 + wc * 32 + 8 * fq;
        EPI_ROWS { const int row = EPI_ROW;
#pragma unroll
            for (int bj = 0; bj < 2; ++bj) *(u32x4*)(O + (size_t)row * ld + col0 + bj * 128) = pk8(acc[ai][bj][m][0], acc[ai][bj][m][1]); }
    }
};
struct EpiMemKV {
    bf16* mk; bf16* mVt;
    EPI_HEAD {
        const int j0 = wc * 32 + 8 * fq, h = u.pn;
        EPI_ROWS { const int row = EPI_ROW;
            *(u32x4*)(mk + (size_t)row * 512 + h * 128 + j0) = pk8(acc[ai][0][m][0], acc[ai][0][m][1]);
            const f32x4 v0 = acc[ai][1][m][0], v1 = acc[ai][1][m][1]; const int b = row >> 8, key = row & 255;
            bf16* vp = mVt + ((size_t)(b * 4 + h) * 128 + j0) * 256 + key;
            vp[0 * 256] = (bf16)f2bf(v0.x); vp[1 * 256] = (bf16)f2bf(v0.y); vp[2 * 256] = (bf16)f2bf(v0.z); vp[3 * 256] = (bf16)f2bf(v0.w);
            vp[4 * 256] = (bf16)f2bf(v1.x); vp[5 * 256] = (bf16)f2bf(v1.y); vp[6 * 256] = (bf16)f2bf(v1.z); vp[7 * 256] = (bf16)f2bf(v1.w); }
    }
};
struct EpiFFN1 {
    bf16* H; const float* part;
    EPI_HEAD {
        const int hc0 = (u.pn * 256 + wc * 32 + 8 * fq) >> 1;
        EPI_ROWS { const int row = EPI_ROW; const float rs = rstd16(part, row);
#pragma unroll
            for (int bj = 0; bj < 2; ++bj) { const f32x4 a1 = acc[ai][bj][m][0] * rs, a3 = acc[ai][bj][m][1] * rs; f32x4 hv;
#pragma unroll
                for (int e = 0; e < 4; ++e) hv[e] = a1[e] * fsig(a1[e]) * a3[e];
                u32x2 w; w.x = pk2(hv.x, hv.y); w.y = pk2(hv.z, hv.w);
                *(u32x2*)(H + (size_t)row * DFF + hc0 + bj * 64) = w; } }
    }
};

__device__ __forceinline__ void conv_job(const float* W, int ldw, int c0, int ncols, int kblk, const float* gain, bf16* WT, int K, int mode, float* scr, int gw, int NGW, int lane, int& off) {
    const int nblk = (ncols + 63) >> 6, nitems = nblk * kblk;
    int it0 = (gw - off) % NGW; if (it0 < 0) it0 += NGW;
    off = (off + nitems) % NGW;
    const int kq = lane >> 4, nq = lane & 15;
    for (int it = it0; it < nitems; it += NGW) {
        const int kb = it / nblk, nb = it % nblk, k0 = 64 * kb, n0 = 64 * nb;
        const bool ld_ok = (n0 + 4 * nq) < ncols;
        f32x4 v[16];
#pragma unroll
        for (int i = 0; i < 16; ++i) { v[i] = (f32x4){0.f, 0.f, 0.f, 0.f}; if (ld_ok) v[i] = *(const f32x4*)(W + (size_t)(k0 + 4 * i + kq) * ldw + c0 + n0 + 4 * nq); }
#pragma unroll
        for (int i = 0; i < 16; ++i) { const int kk = 4 * i + kq; const float gg = gain ? gain[k0 + kk] : 1.f; float* d = scr + kk * 65 + 4 * nq;
            d[0] = v[i].x * gg; d[1] = v[i].y * gg; d[2] = v[i].z * gg; d[3] = v[i].w * gg; }
        __builtin_amdgcn_wave_barrier(); asm volatile("s_waitcnt lgkmcnt(0)" ::: "memory");
        const int c = lane & 7;
#pragma unroll
        for (int jx = 0; jx < 8; ++jx) { const int nl = (lane >> 3) + 8 * jx, n = n0 + nl; const float* sp = scr + (8 * c) * 65 + nl;
            u32x4 o; o.x = pk2(sp[0 * 65], sp[1 * 65]); o.y = pk2(sp[2 * 65], sp[3 * 65]); o.z = pk2(sp[4 * 65], sp[5 * 65]); o.w = pk2(sp[6 * 65], sp[7 * 65]);
            const int dr = mode == 0 ? n : (8 * (n >> 2) + (n & 3) + (mode == 2 ? 4 : 0));
            if (n < ncols) *(u32x4*)(WT + (size_t)dr * K + k0 + 8 * c) = o; }
        __builtin_amdgcn_wave_barrier(); asm volatile("s_waitcnt lgkmcnt(0)" ::: "memory");
    }
}

__device__ __forceinline__ void phase_convert(int wid_s, KP p_, int l, float* ldsf) {
    KP p = p_; asm volatile("" : "+s"(p));
    unsigned char* ws = p->ws;
    const int tid_ = mk_tid(wid_s);
    const int tid = tid_, lane = tid & 63, wv = tid >> 6;
    const int gw = blockIdx.x * 8 + wv, NGW = gridDim.x * 8;
    float* scr = ldsf + wv * (64 * 65); int off = 0;
    const float* nmix = p->in[I_NMIX] + l * 1024;
    conv_job(p->in[I_WIN] + (size_t)l * 1024 * DIN, DIN, 0, 3232, 16, nmix, (bf16*)(ws + W_IN), 1024, 0, scr, gw, NGW, lane, off);
    conv_job(p->in[I_WUQ] + (size_t)l * 256 * 768, 768, 0, 768, 4, p->in[I_QN] + l * 256, (bf16*)(ws + W_MQ), 256, 0, scr, gw, NGW, lane, off);
    conv_job(p->in[I_WUKV] + (size_t)l * 128 * 1024, 1024, 0, 1024, 2, p->in[I_KVN] + l * 128, (bf16*)(ws + W_MKV), 128, 0, scr, gw, NGW, lane, off);
    conv_job(p->in[I_WUP] + (size_t)l * 64 * 512, 512, 0, 512, 1, nullptr, (bf16*)(ws + W_BWA), 128, 0, scr, gw, NGW, lane, off);
    conv_job(p->in[I_AUP] + (size_t)l * 64 * 512, 512, 0, 512, 1, nullptr, (bf16*)(ws + W_BWA) + 512 * 128 + 64, 128, 0, scr, gw, NGW, lane, off);
    conv_job(p->in[I_GUP] + (size_t)l * 128 * 512, 512, 0, 512, 2, nullptr, (bf16*)(ws + W_GUP), 128, 0, scr, gw, NGW, lane, off);
    { unsigned zz = 0u; asm volatile("" : "+v"(zz)); const u32x4 zv = {zz, zz, zz, zz};
      for (int i = blockIdx.x * 512 + tid; i < 1024 * 8; i += gridDim.x * 512) { const int row = i >> 3, ch = i & 7; *(u32x4*)((bf16*)(ws + W_BWA) + row * 128 + (row < 512 ? 64 : 0) + ch * 8) = zv; } }
    { u32x4* z = (u32x4*)((bf16*)(ws + W_IN) + (size_t)3232 * 1024); const int n16 = 96 * 1024 * 2 / 16;
      unsigned zz = 0u; asm volatile("" : "+v"(zz)); const u32x4 zv = {zz, zz, zz, zz};
      for (int i = blockIdx.x * 512 + tid; i < n16; i += gridDim.x * 512) z[i] = zv; }
    if (l == 0) {
        const float* x = p->in[I_X]; bf16* xb = (bf16*)(ws + WS_XB); float* part = (float*)(ws + WS_PART);
        for (int row = gw; row < T; row += NGW) {
            const f32x4* xr = (const f32x4*)(x + (size_t)row * 1024) + lane; float s = 0.f;
#pragma unroll
            for (int j = 0; j < 4; ++j) { const f32x4 v = xr[64 * j]; s += (v.x * v.x + v.y * v.y) + (v.z * v.z + v.w * v.w);
                u32x2 w; w.x = pk2(v.x, v.y); w.y = pk2(v.z, v.w); *((u32x2*)(xb + (size_t)row * 1024) + lane + 64 * j) = w; }
            s = wave_sum(s);
            if (lane < 16) part[(size_t)row * 16 + lane] = lane == 0 ? s : 0.f;
        }
    }
}

__device__ __forceinline__ void phase_convert_mid(int wid_s, KP p_, int l, float* ldsf, int gw, int NGW) {
    KP p = p_; asm volatile("" : "+s"(p));
    unsigned char* ws = p->ws;
    const int tid_ = mk_tid(wid_s);
    const int tid = tid_, lane = tid & 63, wv = tid >> 6;
    float* scr = ldsf + wv * (64 * 65); int off = 0;
    const float* nmix = p->in[I_NMIX] + l * 1024;
    conv_job(p->in[I_WIN] + (size_t)l * 1024 * DIN, DIN, 3232, 3072, 16, nmix, (bf16*)(ws + W_GATE), 1024, 0, scr, gw, NGW, lane, off);
    for (int n = 0; n < 3; ++n) conv_job(p->in[I_WBR] + ((size_t)l * 3 + n) * 512 * 1024, 1024, 0, 1024, 8, nullptr, (bf16*)(ws + W_BR) + (size_t)n * 1024 * 512, 512, 0, scr, gw, NGW, lane, off);
    conv_job(p->in[I_WOUT] + (size_t)l * 1024 * 1024, 1024, 0, 1024, 16, nullptr, (bf16*)(ws + W_OUT), 1024, 0, scr, gw, NGW, lane, off);
    conv_job(p->in[I_XWQ] + (size_t)l * 1024 * 512, 512, 0, 512, 16, p->in[I_NXA] + l * 1024, (bf16*)(ws + W_XQ), 1024, 0, scr, gw, NGW, lane, off);
    conv_job(p->in[I_XWKV] + (size_t)l * 1024 * 1024, 1024, 0, 1024, 16, p->in[I_NMEM] + l * 1024, (bf16*)(ws + W_XKV), 1024, 0, scr, gw, NGW, lane, off);
    conv_job(p->in[I_XWO] + (size_t)l * 512 * 1024, 1024, 0, 1024, 8, nullptr, (bf16*)(ws + W_XO), 512, 0, scr, gw, NGW, lane, off);
}
__device__ __forceinline__ void phase_convert_ffn(int wid_s, KP p_, int l, float* ldsf, int gw, int NGW) {
    KP p = p_; asm volatile("" : "+s"(p));
    unsigned char* ws = p->ws;
    const int tid_ = mk_tid(wid_s);
    const int tid = tid_, lane = tid & 63, wv = tid >> 6;
    float* scr = ldsf + wv * (64 * 65); int off = 0;
    conv_job(p->in[I_W1] + (size_t)l * 1024 * DFF, DFF, 0, 2816, 16, p->in[I_NFFN] + l * 1024, (bf16*)(ws + W_13), 1024, 1, scr, gw, NGW, lane, off);
    conv_job(p->in[I_W3] + (size_t)l * 1024 * DFF, DFF, 0, 2816, 16, p->in[I_NFFN] + l * 1024, (bf16*)(ws + W_13), 1024, 2, scr, gw, NGW, lane, off);
    conv_job(p->in[I_W2] + (size_t)l * DFF * 1024, 1024, 0, 1024, 44, nullptr, (bf16*)(ws + W_2), DFF, 0, scr, gw, NGW, lane, off);
}
__device__ __forceinline__ void rope_cs(int pos, int i, float& c, float& s) {
    const float invf = exp2f(-(float)i * 0.8304820237218406f);
    const float ang = (float)pos * invf;
    const double x = (double)ang * 0.15915494309189535; const float f = (float)(x - rint(x));
    c = __builtin_amdgcn_cosf(f); s = __builtin_amdgcn_sinf(f);
}
template <int DQK, int DV, bool CAUSAL, bool MLA>
__device__ __forceinline__ void attn_unit(int wid_s, unsigned char* lds, const bf16* Qb_, int ldq, const bf16* Kb_, int ldk, const bf16* Vtb_, int ldv, bf16* Ob_, int ldo,
                                          int q0, int nkt, const float* qgain_, const int* pos_, float qscale) {
    const GAS bf16* Qb = (const GAS bf16*)Qb_; const GAS bf16* Kb = (const GAS bf16*)Kb_; const GAS bf16* Vtb = (const GAS bf16*)Vtb_; GAS bf16* Ob = (GAS bf16*)Ob_;
    const GAS float* qgain = (const GAS float*)qgain_; const GAS int* pos = (const GAS int*)pos_;
    constexpr int KS = DQK * 2 + 16, VS = 144, NKS = DQK / 32, NDT = DV / 16, KCH = DQK / 8, NKC = (64 * KCH + 511) / 512, NVC = DV * 8 / 512;
    unsigned char* Ks = lds; unsigned char* Vs = lds + 64 * KS;
    const int tid_ = mk_tid(wid_s);
    const int tid = tid_, lane = tid & 63, wv = tid >> 6, g = lane >> 4, j = lane & 15;
    const int qrow = q0 + wv * 16 + j;
    bf16x8 qf[NKS];
    {
        float qv[NKS][8]; float ss = 0.f;
#pragma unroll
        for (int ks = 0; ks < NKS; ++ks) { const u32x4 w = *(const GAS u32x4*)(Qb + (size_t)qrow * ldq + 32 * ks + 8 * g);
            qv[ks][0] = bflo(w.x); qv[ks][1] = bfhi(w.x); qv[ks][2] = bflo(w.y); qv[ks][3] = bfhi(w.y); qv[ks][4] = bflo(w.z); qv[ks][5] = bfhi(w.z); qv[ks][6] = bflo(w.w); qv[ks][7] = bfhi(w.w);
#pragma unroll
            for (int e = 0; e < 8; ++e) ss += qv[ks][e] * qv[ks][e]; }
        ss += __shfl_xor(ss, 16); ss += __shfl_xor(ss, 32);
        const float rs = rsqrtf(ss * (1.f / DQK) + 1e-6f);
#pragma unroll
        for (int ks = 0; ks < NKS; ++ks)
#pragma unroll
            for (int e = 0; e < 8; ++e) qv[ks][e] *= rs * qgain[32 * ks + 8 * g + e];
        if (MLA) {
            const int ps = pos[qrow];
#pragma unroll
            for (int e = 0; e < 8; ++e) { const float mine = qv[2][e], other = __shfl_xor(mine, 32); float c, s; rope_cs(ps, 8 * (g & 1) + e, c, s);
                qv[2][e] = (g < 2) ? (mine * c - other * s) : (mine * c + other * s); }
        }
#pragma unroll
        for (int ks = 0; ks < NKS; ++ks) { u32x4 w; w.x = pk2(qv[ks][0] * qscale, qv[ks][1] * qscale); w.y = pk2(qv[ks][2] * qscale, qv[ks][3] * qscale);
            w.z = pk2(qv[ks][4] * qscale, qv[ks][5] * qscale); w.w = pk2(qv[ks][6] * qscale, qv[ks][7] * qscale); qf[ks] = __builtin_bit_cast(bf16x8, w); }
    }
    f32x4 oT[NDT];
#pragma unroll
    for (int d = 0; d < NDT; ++d) oT[d] = (f32x4){0.f, 0.f, 0.f, 0.f};
    float mrun = -INFINITY, lsum = 0.f;
    u32x4 kreg[NKC], vreg[NVC];
#define ATT_PREFETCH(kt) do { _Pragma("unroll") for (int i = 0; i < NKC; ++i) { const int idx = tid + 512 * i; if (idx < 64 * KCH) { const int key = idx / KCH, ch = idx % KCH; \
            kreg[i] = *(const GAS u32x4*)(Kb + (size_t)(64 * (kt) + key) * ldk + ch * 8); } } \
        _Pragma("unroll") for (int i = 0; i < NVC; ++i) { const int idx = tid + 512 * i; const int dv = idx >> 3, ch = idx & 7; vreg[i] = *(const GAS u32x4*)(Vtb + (size_t)dv * ldv + 64 * (kt) + ch * 8); } } while (0)
    ATT_PREFETCH(0);
    for (int kt = 0; kt < nkt; ++kt) {
        LBAR();
#pragma unroll
        for (int i = 0; i < NKC; ++i) { const int idx = tid + 512 * i; if (idx < 64 * KCH) { const int key = idx / KCH, ch = idx % KCH; *(u32x4*)(Ks + key * KS + ch * 16) = kreg[i]; } }
#pragma unroll
        for (int i = 0; i < NVC; ++i) { const int idx = tid + 512 * i; const int dv = idx >> 3, ch = idx & 7; *(u32x4*)(Vs + dv * VS + ch * 16) = vreg[i]; }
        LBAR();
        if (kt + 1 < nkt) ATT_PREFETCH(kt + 1);
        const int qw0 = q0 + wv * 16;
        if (CAUSAL && 64 * kt > qw0 + 15) continue;
        f32x4 sT[4];
#pragma unroll
        for (int k4 = 0; k4 < 4; ++k4) { sT[k4] = (f32x4){0.f, 0.f, 0.f, 0.f};
#pragma unroll
            for (int ks = 0; ks < NKS; ++ks) { const bf16x8 a = *(const bf16x8*)(Ks + (16 * k4 + j) * KS + (32 * ks + 8 * g) * 2);
                sT[k4] = __builtin_amdgcn_mfma_f32_16x16x32_bf16(a, qf[ks], sT[k4], 0, 0, 0); } }
        if (CAUSAL && 64 * kt + 63 > qw0) {
#pragma unroll
            for (int k4 = 0; k4 < 4; ++k4)
#pragma unroll
                for (int r = 0; r < 4; ++r) if (64 * kt + 16 * k4 + 4 * g + r > qrow) sT[k4][r] = -INFINITY;
        }
        float mx = -INFINITY;
#pragma unroll
        for (int k4 = 0; k4 < 4; ++k4) mx = fmaxf(mx, fmaxf(fmaxf(sT[k4][0], sT[k4][1]), fmaxf(sT[k4][2], sT[k4][3])));
        mx = fmaxf(mx, __shfl_xor(mx, 16)); mx = fmaxf(mx, __shfl_xor(mx, 32));
        const float mnew = fmaxf(mrun, mx); const float alpha = __builtin_amdgcn_exp2f(mrun - mnew); mrun = mnew;
        float psum = 0.f;
#pragma unroll
        for (int k4 = 0; k4 < 4; ++k4)
#pragma unroll
            for (int r = 0; r < 4; ++r) { const float pv = __builtin_amdgcn_exp2f(sT[k4][r] - mnew); sT[k4][r] = pv; psum += pv; }
        lsum = lsum * alpha + psum;
#pragma unroll
        for (int d = 0; d < NDT; ++d) oT[d] *= alpha;
#pragma unroll
        for (int kc = 0; kc < 2; ++kc) {
            const bf16x8 pb = __builtin_bit_cast(bf16x8, pk8(sT[2 * kc], sT[2 * kc + 1]));
#pragma unroll
            for (int d = 0; d < NDT; ++d) { const unsigned char* vp = Vs + (16 * d + j) * VS + (32 * kc + 4 * g) * 2;
                const u32x2 lo = *(const u32x2*)vp, hi = *(const u32x2*)(vp + 32); u32x4 w; w.x = lo.x; w.y = lo.y; w.z = hi.x; w.w = hi.y;
                oT[d] = __builtin_amdgcn_mfma_f32_16x16x32_bf16(__builtin_bit_cast(bf16x8, w), pb, oT[d], 0, 0, 0); }
        }
    }
#undef ATT_PREFETCH
    lsum += __shfl_xor(lsum, 16); lsum += __shfl_xor(lsum, 32);
    const float inv = 1.f / lsum;
#pragma unroll
    for (int d = 0; d < NDT; ++d) { u32x2 w; w.x = pk2(oT[d][0] * inv, oT[d][1] * inv); w.y = pk2(oT[d][2] * inv, oT[d][3] * inv);
        *(GAS u32x2*)(Ob + (size_t)qrow * ldo + 16 * d + 4 * g) = w; }
}

__device__ __forceinline__ void lora_act_rows(int wid_s, KP p_, int l, int r) {
    KP p = p_; asm volatile("" : "+s"(p));
    unsigned char* ws = p->ws;
    const int tid_ = mk_tid(wid_s);
    const int tid = tid_;
    const bf16* P = (const bf16*)(ws + R_P); bf16* Awa = (bf16*)(ws + WS_Y) + (size_t)r * TH * 1536 + 1024; bf16* Ag = (bf16*)(ws + WS_AG);
    const float* mu = p->in[I_MU] + l * 1792 + 1536;
    const int sub = tid & 31, j0 = sub * 8;
    f32x4 m0 = *(const f32x4*)(mu + j0), m1 = *(const f32x4*)(mu + j0 + 4);
    for (int row = blockIdx.x * 16 + (tid >> 5); row < TH; row += gridDim.x * 16) {
        const u32x4 cw = *(const u32x4*)(P + (size_t)row * NP + 1536 + j0);
        u32x4 pw = {0u, 0u, 0u, 0u}; if ((row & 2047) != 0) pw = *(const u32x4*)(P + (size_t)(row - 1) * NP + 1536 + j0);
        float c[8] = {bflo(cw.x), bfhi(cw.x), bflo(cw.y), bfhi(cw.y), bflo(cw.z), bfhi(cw.z), bflo(cw.w), bfhi(cw.w)};
        const float q[8] = {bflo(pw.x), bfhi(pw.x), bflo(pw.y), bfhi(pw.y), bflo(pw.z), bfhi(pw.z), bflo(pw.w), bfhi(pw.w)};
        const float mm[8] = {m0.x, m0.y, m0.z, m0.w, m1.x, m1.y, m1.z, m1.w};
#pragma unroll
        for (int e = 0; e < 8; ++e) { float v = c[e] + (q[e] - c[e]) * mm[e];
            if (j0 < 64) v = 2.f * fsig(2.f * v) - 1.f;
            else if (j0 >= 128) v = fsig(v);
            c[e] = v; }
        u32x4 o; o.x = pk2(c[0], c[1]); o.y = pk2(c[2], c[3]); o.z = pk2(c[4], c[5]); o.w = pk2(c[6], c[7]);
        if (j0 < 128) *(u32x4*)(Awa + (size_t)row * 1536 + j0) = o; else *(u32x4*)(Ag + (size_t)row * 128 + (j0 - 128)) = o;
    }
}
__device__ __forceinline__ void si_build_tile(int wid_s, KP p_, int l, int r, int tile) {
    KP p = p_; asm volatile("" : "+s"(p));
    unsigned char* ws = p->ws;
    const int tid_ = mk_tid(wid_s);
    const int tid = tid_, lane = tid & 63, wv = tid >> 6;
    const GAS bf16* P = (const GAS bf16*)(ws + R_P); GAS bf16* SI = (GAS bf16*)(ws + R_SI); const GAS bf16* LW = (const GAS bf16*)(ws + WS_Y) + (size_t)r * TH * 1536;
    const float* mu = p->in[I_MU] + l * 1792;
    const int row0 = tile * 32;
    const int c = tid, h = wv;
    const float w0c = p->in[I_W0][l * 512 + c], a0c = p->in[I_A0][l * 512 + c], kkc = p->in[I_KK][l * 512 + c], kac = p->in[I_KA][l * 512 + c];
    const float mur = mu[c], muk = mu[512 + c], muv = mu[1024 + c];
#pragma unroll 4
    for (int t = 0; t < 32; ++t) {
        const int row = row0 + t; const bool first = (row & 2047) == 0;
        const GAS bf16* pr = P + (size_t)row * NP; const GAS bf16* pp = pr - NP;
        const float rc = bf2f(pr[c]), kc = bf2f(pr[512 + c]), vc = bf2f(pr[1024 + c]);
        const float rp = first ? 0.f : bf2f(pp[c]), kp = first ? 0.f : bf2f(pp[512 + c]), vp = first ? 0.f : bf2f(pp[1024 + c]);
        const float wl = bf2f(LW[(size_t)row * 1536 + c]), al = bf2f(LW[(size_t)row * 1536 + 512 + c]);
        const float rr = rc + (rp - rc) * mur, k = kc + (kp - kc) * muk, v = vc + (vp - vc) * muv;
        const float om = 1.f - __expf(-0.6065306597126334f * fsig(w0c + wl));
        const float a = fsig(a0c + al);
        const float kkr = k * kkc; const float ss = wave_sum(kkr * kkr); const float kk = kkr / fmaxf(sqrtf(ss), 1e-12f);
        const float k2 = k * (1.f + (a - 1.f) * kac);
        GAS bf16* o = SI + ((size_t)((row >> 11) * 8 + h) * 2048 + (row & 2047)) * 384 + lane;
        o[0] = (bf16)f2bf(rr); o[64] = (bf16)f2bf(om); o[128] = (bf16)f2bf(k2); o[192] = (bf16)f2bf(kk); o[256] = (bf16)f2bf(kk * a); o[320] = (bf16)f2bf(v);
    }
}

template <int CTRL> __device__ __forceinline__ float dppf(float x) { return __builtin_bit_cast(float, __builtin_amdgcn_update_dpp(0, __builtin_bit_cast(int, x), CTRL, 0xF, 0xF, true)); }
__device__ __forceinline__ float allreduce8(float x);
__device__ __forceinline__ float allreduce16(float x) { x += dppf<0xB1>(x); x += dppf<0x4E>(x); x += dppf<0x141>(x); x += dppf<0x140>(x); return x; }
template <int MODE>
__device__ __forceinline__ void rwkv_scan_unit(int wid_s, const bf16* SIbh_, bf16* Yb_, int ystride, int quarter, float* ldsf) {
    const int tid_ = mk_tid(wid_s);
    const GAS bf16* SIbh = (const GAS bf16*)SIbh_; GAS bf16* Yb = (GAS bf16*)Yb_;
    const int tid = tid_, lane = tid & 63, wv = tid >> 6, hw = wv - 4;
    float* PYb = ldsf + 4 * (16 * 384);
    u32x4 hreg[12];
    if (wv >= 4 && wv < 7) {
#pragma unroll
        for (int i = 0; i < 12; ++i) hreg[i] = *(const GAS u32x4*)(SIbh + (size_t)hw * (16 * 384) + (size_t)(lane + 64 * i) * 8);
    }
    f32x2 Sa = {0.f, 0.f}, Sb = {0.f, 0.f};
    const int rowl = quarter * 16 + (wv & 3) * 4 + (lane >> 4), c4 = (lane & 15) * 4;
    __syncthreads();
#define SCAN_CONVERT(cn) do { float* Bd = ldsf + ((cn) & 3) * (16 * 384); \
        _Pragma("unroll") for (int i = 0; i < 12; ++i) { float* d = Bd + (lane + 64 * i) * 8; const u32x4 w = hreg[i]; \
            *(f32x4*)d = (f32x4){bflo(w.x), bfhi(w.x), bflo(w.y), bfhi(w.y)}; *(f32x4*)(d + 4) = (f32x4){bflo(w.z), bfhi(w.z), bflo(w.w), bfhi(w.w)}; } \
        if ((cn) + 3 < 128) { _Pragma("unroll") for (int i = 0; i < 12; ++i) hreg[i] = *(const GAS u32x4*)(SIbh + (size_t)((cn) + 3) * (16 * 384) + (size_t)(lane + 64 * i) * 8); } } while (0)
    if (wv == 4) SCAN_CONVERT(0);
    for (int ch = 0; ch <= 128; ++ch) {
        LBAR();
        if (wv < 4) {
            if (ch < 128) {
                const float* B = ldsf + (ch & 3) * (16 * 384);
                float* PY = PYb + (ch & 1) * (16 * 260) + wv * 64 + lane;
                const float* q = B;
                f32x4 r4 = *(const f32x4*)(q + c4), om4 = *(const f32x4*)(q + 64 + c4), k4 = *(const f32x4*)(q + 128 + c4), kk4 = *(const f32x4*)(q + 192 + c4), ka4 = *(const f32x4*)(q + 256 + c4);
                float v = q[320 + rowl];
                __builtin_amdgcn_s_setprio(3);
#pragma unroll
                for (int s = 0; s < 16; ++s) {
                    const float* qn = B + ((MODE & 2) ? 0 : ((s + 1) & 15)) * 384;
                    const f32x4 nr4 = *(const f32x4*)(qn + c4), nom4 = *(const f32x4*)(qn + 64 + c4), nk4 = *(const f32x4*)(qn + 128 + c4), nkk4 = *(const f32x4*)(qn + 192 + c4), nka4 = *(const f32x4*)(qn + 256 + c4);
                    const float nv = qn[320 + rowl];
                    const f32x2 pa = Sa * (f32x2){kk4.x, kk4.y} + Sb * (f32x2){kk4.z, kk4.w};
                    const float sa = (MODE & 1) ? (pa.x + pa.y) : allreduce16(pa.x + pa.y);
                    Sa = Sa - Sa * (f32x2){om4.x, om4.y} + (f32x2){k4.x, k4.y} * v; Sb = Sb - Sb * (f32x2){om4.z, om4.w} + (f32x2){k4.z, k4.w} * v;
                    Sa = Sa - (f32x2){ka4.x, ka4.y} * sa; Sb = Sb - (f32x2){ka4.z, ka4.w} * sa;
                    const f32x2 py = Sa * (f32x2){r4.x, r4.y} + Sb * (f32x2){r4.z, r4.w};
                    PY[s * 260] = py.x + py.y;
                    r4 = nr4; om4 = nom4; k4 = nk4; kk4 = nkk4; ka4 = nka4; v = nv;
                }
                __builtin_amdgcn_s_setprio(0);
            }
        } else if (wv == 7) {
            if (ch > 0) {
                const int s = lane >> 2, rr = lane & 3;
#pragma unroll
                for (int mw = 0; mw < 4; ++mw) {
                    const float* src = PYb + ((ch - 1) & 1) * (16 * 260) + s * 260 + mw * 64 + rr * 16;
                    const f32x4 a = *(const f32x4*)src, b = *(const f32x4*)(src + 4), c = *(const f32x4*)(src + 8), d = *(const f32x4*)(src + 12);
                    const float y = ((a.x + a.y) + (a.z + a.w)) + ((b.x + b.y) + (b.z + b.w)) + ((c.x + c.y) + (c.z + c.w)) + ((d.x + d.y) + (d.z + d.w));
                    Yb[(size_t)((ch - 1) * 16 + s) * ystride + quarter * 16 + mw * 4 + rr] = (bf16)f2bf(y);
                }
            }
        } else {
            const int cn = ch + 1;
            if (cn < 128 && (cn % 3) == hw) SCAN_CONVERT(cn);
        }
    }
#undef SCAN_CONVERT
    __syncthreads();
}

__device__ __forceinline__ void rwkv_post_tile(int wid_s, KP p_, int l, int r, int tile, int dummy) {
    KP p = p_; asm volatile("" : "+s"(p));
    unsigned char* ws = p->ws;
    const int tid_ = mk_tid(wid_s);
    const int tid = tid_, lane = tid & 63, wv = tid >> 6;
    const GAS bf16* P = (const GAS bf16*)(ws + R_P); const GAS bf16* SI = (const GAS bf16*)(ws + R_SI); GAS bf16* Y = (GAS bf16*)(ws + WS_Y) + (size_t)r * TH * 1536;
    const int row0 = tile * 32;
    const int c = tid, h = wv;
    const float rkc = p->in[I_RK][l * 512 + c], lng = p->in[I_LNG][l * 512 + c], lnb = p->in[I_LNB][l * 512 + c];
#pragma unroll 4
    for (int t = 0; t < 32; ++t) {
        const int row = row0 + t;
        const GAS bf16* si = SI + ((size_t)((row >> 11) * 8 + h) * 2048 + (row & 2047)) * 384 + lane;
        const float rr = bf2f(si[0]), k2 = bf2f(si[128]), v = bf2f(si[320]);
        const float gg = bf2f(P[(size_t)row * NP + c]);
        GAS bf16* yp = Y + (size_t)row * 1536 + c;
        const float y = bf2f(*yp);
        const float mean = wave_sum(y) * (1.f / 64.f); const float d = y - mean; const float var = wave_sum(d * d) * (1.f / 64.f);
        const float yn = d * rsqrtf(var + 64e-5f) * lng + lnb;
        const float bonus = wave_sum(rr * k2 * rkc) * v;
        if (dummy) yp = (GAS bf16*)(ws + R_P) + (size_t)row * NP + 600 + c;
        *yp = (bf16)f2bf((yn + bonus) * gg);
    }
}

__device__ __forceinline__ float allreduce8(float x) { x += dppf<0xB1>(x); x += dppf<0x4E>(x); x += dppf<0x141>(x); return x; }
__device__ __forceinline__ void unpack8(const u32x4 w, float* f) { f[0] = bflo(w.x); f[1] = bfhi(w.x); f[2] = bflo(w.y); f[3] = bfhi(w.y); f[4] = bflo(w.z); f[5] = bfhi(w.z); f[6] = bflo(w.w); f[7] = bfhi(w.w); }
__device__ __forceinline__ u32x4 pack8(const float* f) { u32x4 o; o.x = pk2(f[0], f[1]); o.y = pk2(f[2], f[3]); o.z = pk2(f[4], f[5]); o.w = pk2(f[6], f[7]); return o; }
__device__ __forceinline__ void ld8f(const GAS float* q, float* f) { const f32x4 a = *(const GAS f32x4*)q, b = *(const GAS f32x4*)(q + 4); f[0] = a.x; f[1] = a.y; f[2] = a.z; f[3] = a.w; f[4] = b.x; f[5] = b.y; f[6] = b.z; f[7] = b.w; }
__device__ __forceinline__ void si_build_rows(int wid_s, KP p_, int l, int r) {
    KP p = p_; asm volatile("" : "+s"(p));
    unsigned char* ws = p->ws;
    const int tid_ = mk_tid(wid_s);
    const int tid = tid_, lane = tid & 63, wv = tid >> 6, c0 = lane * 8, h = lane >> 3;
    const GAS bf16* P = (const GAS bf16*)(ws + R_P); GAS bf16* SI = (GAS bf16*)(ws + R_SI); const GAS bf16* LW = (const GAS bf16*)(ws + WS_Y) + (size_t)r * TH * 1536;
    float w0c[8], a0c[8], kkc[8], kac[8], mur[8], muk[8], muv[8];
    ld8f((const GAS float*)p->in[I_W0] + l * 512 + c0, w0c); ld8f((const GAS float*)p->in[I_A0] + l * 512 + c0, a0c); ld8f((const GAS float*)p->in[I_KK] + l * 512 + c0, kkc); ld8f((const GAS float*)p->in[I_KA] + l * 512 + c0, kac);
    ld8f((const GAS float*)p->in[I_MU] + l * 1792 + c0, mur); ld8f((const GAS float*)p->in[I_MU] + l * 1792 + 512 + c0, muk); ld8f((const GAS float*)p->in[I_MU] + l * 1792 + 1024 + c0, muv);
    for (int row = blockIdx.x * 8 + wv; row < TH; row += gridDim.x * 8) {
        const bool first = (row & 2047) == 0;
        const GAS bf16* pr = P + (size_t)row * NP + c0; const GAS bf16* pp = pr - NP;
        const u32x4 z4 = {0u, 0u, 0u, 0u};
        const u32x4 rcw = *(const GAS u32x4*)pr, kcw = *(const GAS u32x4*)(pr + 512), vcw = *(const GAS u32x4*)(pr + 1024);
        const u32x4 rpw = first ? z4 : *(const GAS u32x4*)pp, kpw = first ? z4 : *(const GAS u32x4*)(pp + 512), vpw = first ? z4 : *(const GAS u32x4*)(pp + 1024);
        const u32x4 wlw = *(const GAS u32x4*)(LW + (size_t)row * 1536 + c0), alw = *(const GAS u32x4*)(LW + (size_t)row * 1536 + 512 + c0);
        float rc[8], kc[8], vc[8], rp[8], kp[8], vp[8], wl[8], al[8];
        unpack8(rcw, rc); unpack8(kcw, kc); unpack8(vcw, vc); unpack8(rpw, rp); unpack8(kpw, kp); unpack8(vpw, vp); unpack8(wlw, wl); unpack8(alw, al);
        float rr[8], om[8], k2[8], kk[8], ka[8], vv[8]; float ss = 0.f;
#pragma unroll
        for (int e = 0; e < 8; ++e) { rr[e] = rc[e] + (rp[e] - rc[e]) * mur[e]; const float k = kc[e] + (kp[e] - kc[e]) * muk[e]; vv[e] = vc[e] + (vp[e] - vc[e]) * muv[e];
            om[e] = 1.f - __expf(-0.6065306597126334f * fsig(w0c[e] + wl[e]));
            const float a = fsig(a0c[e] + al[e]);
            kk[e] = k * kkc[e]; ss += kk[e] * kk[e]; k2[e] = k * (1.f + (a - 1.f) * kac[e]); ka[e] = a; }
        ss = allreduce8(ss);
        const float inv = 1.f / fmaxf(sqrtf(ss), 1e-12f);
#pragma unroll
        for (int e = 0; e < 8; ++e) { kk[e] *= inv; ka[e] *= kk[e]; }
        GAS bf16* o = SI + ((size_t)((row >> 11) * 8 + h) * 2048 + (row & 2047)) * 384 + (lane & 7) * 8;
        *(GAS u32x4*)o = pack8(rr); *(GAS u32x4*)(o + 64) = pack8(om); *(GAS u32x4*)(o + 128) = pack8(k2); *(GAS u32x4*)(o + 192) = pack8(kk); *(GAS u32x4*)(o + 256) = pack8(ka); *(GAS u32x4*)(o + 320) = pack8(vv);
    }
}
__device__ __forceinline__ void rwkv_post_rows(int wid_s, KP p_, int l, int r, int dummy) {
    KP p = p_; asm volatile("" : "+s"(p));
    unsigned char* ws = p->ws;
    const int tid_ = mk_tid(wid_s);
    const int tid = tid_, lane = tid & 63, wv = tid >> 6, c0 = lane * 8, h = lane >> 3;
    const GAS bf16* P = (const GAS bf16*)(ws + R_P); const GAS bf16* SI = (const GAS bf16*)(ws + R_SI); GAS bf16* Y = (GAS bf16*)(ws + WS_Y) + (size_t)r * TH * 1536;
    float rkc[8], lng[8], lnb[8];
    ld8f((const GAS float*)p->in[I_RK] + l * 512 + c0, rkc); ld8f((const GAS float*)p->in[I_LNG] + l * 512 + c0, lng); ld8f((const GAS float*)p->in[I_LNB] + l * 512 + c0, lnb);
    for (int row = blockIdx.x * 8 + wv; row < TH; row += gridDim.x * 8) {
        const GAS bf16* si = SI + ((size_t)((row >> 11) * 8 + h) * 2048 + (row & 2047)) * 384 + (lane & 7) * 8;
        const u32x4 rw = *(const GAS u32x4*)si, kw = *(const GAS u32x4*)(si + 128), vw = *(const GAS u32x4*)(si + 320);
        const u32x4 gw = *(const GAS u32x4*)(P + (size_t)row * NP + c0);
        GAS bf16* yp = Y + (size_t)row * 1536 + c0;
        const u32x4 yw = *(const GAS u32x4*)yp;
        float rr[8], k2[8], vv[8], gg[8], y[8];
        unpack8(rw, rr); unpack8(kw, k2); unpack8(vw, vv); unpack8(gw, gg); unpack8(yw, y);
        float sy = 0.f, sb = 0.f;
#pragma unroll
        for (int e = 0; e < 8; ++e) { sy += y[e]; sb += rr[e] * k2[e] * rkc[e]; }
        const float mean = allreduce8(sy) * (1.f / 64.f); const float bonus = allreduce8(sb);
        float sv = 0.f;
#pragma unroll
        for (int e = 0; e < 8; ++e) { y[e] -= mean; sv += y[e] * y[e]; }
        const float rs = rsqrtf(allreduce8(sv) * (1.f / 64.f) + 64e-5f);
#pragma unroll
        for (int e = 0; e < 8; ++e) y[e] = (y[e] * rs * lng[e] + lnb[e] + bonus * vv[e]) * gg[e];
        if (dummy) yp = (GAS bf16*)(ws + R_P) + (size_t)row * NP + 600 + c0;
        *(GAS u32x4*)yp = pack8(y);
    }
}

__device__ __forceinline__ float gelu_tanh(float x) { const float u = 0.7978845608028654f * (x + 0.044715f * x * x * x); return x * fsig(2.f * u); }
__device__ __forceinline__ void lru_unit(int wid_s, KP p_, int l, int r, int bl, int n, float* ldsf) {
    KP p = p_; asm volatile("" : "+s"(p));
    unsigned char* ws = p->ws;
    const int tid_ = mk_tid(wid_s);
    const int tid = tid_, lane = tid & 63, wv = tid >> 6, g = lane >> 4, j = lane & 15;
    const GAS bf16* P = (const GAS bf16*)(ws + R_P) + (size_t)bl * 2048 * NP; GAS bf16* Yb = (GAS bf16*)(ws + WS_Y) + ((size_t)(r * 4 + bl) * 2048) * 1536 + 512;
    const int cg_ = n * 64 + lane;
    float* s_xc = ldsf;
    float* s_a = ldsf + 8192;
    float* s_u = ldsf + 16384;
    float* s_AH = ldsf + 24576;
    unsigned char* s_xb16 = (unsigned char*)ldsf + 102400;
    unsigned char* s_wt16 = (unsigned char*)ldsf + 120832;
    LBAR();
    for (int e = tid; e < 8192; e += 512) { const int jj = e >> 6, ii = e & 63;
        const float w = (jj < 64) ? p->in[I_WA][((size_t)l * 8 + n) * 4096 + ii * 64 + jj] : p->in[I_WX][((size_t)l * 8 + n) * 4096 + ii * 64 + (jj - 64)];
        *(bf16*)(s_wt16 + (jj * 72 + ii) * 2) = (bf16)f2bf(w); }
    const float cw0 = p->in[I_CW][(l * 4 + 0) * 512 + cg_], cw1 = p->in[I_CW][(l * 4 + 1) * 512 + cg_], cw2 = p->in[I_CW][(l * 4 + 2) * 512 + cg_], cw3 = p->in[I_CW][(l * 4 + 3) * 512 + cg_];
    const float cb = p->in[I_CB][l * 512 + cg_];
    float ba4[4], bx4[4], sp4[4];
#pragma unroll
    for (int n4 = 0; n4 < 4; ++n4) { const int c = n * 64 + 16 * n4 + j; ba4[n4] = p->in[I_BA][l * 512 + c]; bx4[n4] = p->in[I_BX][l * 512 + c];
        sp4[n4] = -8.f * 1.4426950408889634f * log1pf(__expf(-p->in[I_LAM][l * 512 + c])); }
    float hcar = 0.f;
    for (int tile = 0; tile < 16; ++tile) {
        const int t0 = tile * 128 + wv * 16;
        float xc[16]; unsigned short gbr[16];
        {
            float x3 = (t0 >= 3) ? bf2f(P[(size_t)(t0 - 3) * NP + 1792 + cg_]) : 0.f, x2 = (t0 >= 2) ? bf2f(P[(size_t)(t0 - 2) * NP + 1792 + cg_]) : 0.f, x1 = (t0 >= 1) ? bf2f(P[(size_t)(t0 - 1) * NP + 1792 + cg_]) : 0.f;
#pragma unroll
            for (int i = 0; i < 16; ++i) { const float x0 = bf2f(P[(size_t)(t0 + i) * NP + 1792 + cg_]);
                xc[i] = cw0 * x3 + cw1 * x2 + cw2 * x1 + cw3 * x0 + cb; x3 = x2; x2 = x1; x1 = x0; }
#pragma unroll
            for (int i = 0; i < 16; ++i) gbr[i] = P[(size_t)(t0 + i) * NP + 2304 + cg_];
        }
        LBAR();
#pragma unroll
        for (int i = 0; i < 16; ++i) { s_xc[(wv * 16 + i) * 64 + lane] = xc[i]; *(bf16*)(s_xb16 + ((wv * 16 + i) * 72 + lane) * 2) = (bf16)f2bf(xc[i]); }
        LBAR();
        {
            f32x4 acc[8];
            const bf16x8 a0 = *(const bf16x8*)(s_xb16 + ((16 * wv + j) * 72 + 8 * g) * 2), a1 = *(const bf16x8*)(s_xb16 + ((16 * wv + j) * 72 + 32 + 8 * g) * 2);
#pragma unroll
            for (int nn = 0; nn < 8; ++nn) { acc[nn] = (f32x4){0.f, 0.f, 0.f, 0.f};
                const bf16x8 b0 = *(const bf16x8*)(s_wt16 + ((16 * nn + j) * 72 + 8 * g) * 2), b1 = *(const bf16x8*)(s_wt16 + ((16 * nn + j) * 72 + 32 + 8 * g) * 2);
                acc[nn] = __builtin_amdgcn_mfma_f32_16x16x32_bf16(a0, b0, acc[nn], 0, 0, 0); acc[nn] = __builtin_amdgcn_mfma_f32_16x16x32_bf16(a1, b1, acc[nn], 0, 0, 0); }
#pragma unroll
            for (int n4 = 0; n4 < 4; ++n4)
#pragma unroll
                for (int rr = 0; rr < 4; ++rr) { const int tk = 16 * wv + 4 * g + rr, c = 16 * n4 + j;
                    const float rg = fsig(acc[n4][rr] + ba4[n4]), ig = fsig(acc[n4 + 4][rr] + bx4[n4]);
                    const float a = __builtin_amdgcn_exp2f(sp4[n4] * rg);
                    const float uu = __builtin_amdgcn_sqrtf(fmaxf(1.f - a * a, 0.f)) * (ig * s_xc[tk * 64 + c]);
                    s_a[tk * 64 + c] = a; s_u[tk * 64 + c] = uu; }
        }
        LBAR();
        float av[16], uv[16]; float A = 1.f, H = 0.f;
#pragma unroll
        for (int i = 0; i < 16; ++i) { av[i] = s_a[(wv * 16 + i) * 64 + lane]; uv[i] = s_u[(wv * 16 + i) * 64 + lane]; A *= av[i]; H = av[i] * H + uv[i]; }
        s_AH[(wv * 64 + lane) * 2] = A; s_AH[(wv * 64 + lane) * 2 + 1] = H;
        LBAR();
        float hin = hcar, hall = hcar;
#pragma unroll
        for (int w = 0; w < 8; ++w) { const float Aw = s_AH[(w * 64 + lane) * 2], Hw = s_AH[(w * 64 + lane) * 2 + 1]; hall = Aw * hall + Hw; if (w < wv) hin = hall; }
        hcar = hall;
        float hh = hin;
#pragma unroll
        for (int i = 0; i < 16; ++i) { hh = av[i] * hh + uv[i];
            Yb[(size_t)(t0 + i) * 1536 + cg_] = (bf16)f2bf(hh * gelu_tanh(bf2f(gbr[i]))); }
    }
    LBAR();
}

__device__ __forceinline__ void kfix_rows(int wid_s, KP p_, int l, int r) {
    KP p = p_; asm volatile("" : "+s"(p));
    unsigned char* ws = p->ws;
    const int tid_ = mk_tid(wid_s);
    const int tid = tid_, lane = tid & 63, wv = tid >> 6, h = lane >> 3, sub = lane & 7;
    const GAS bf16* P = (const GAS bf16*)(ws + R_P); GAS bf16* Km = (GAS bf16*)(ws + R_KM);
    const float* kg = p->in[I_KG] + l * 96; const int* pos = (const int*)p->in[I_POS] + r * TH;
    for (int row = blockIdx.x * 8 + wv; row < TH; row += gridDim.x * 8) {
        GAS bf16* kp = Km + (size_t)row * 768 + h * 96;
        const u32x4 w = *(const GAS u32x4*)(kp + 8 * sub);
        float nv[8] = {bflo(w.x), bfhi(w.x), bflo(w.y), bfhi(w.y), bflo(w.z), bfhi(w.z), bflo(w.w), bfhi(w.w)};
        const unsigned k1 = *(const GAS unsigned*)(P + (size_t)row * NP + 3200 + 2 * sub), k2 = *(const GAS unsigned*)(P + (size_t)row * NP + 3216 + 2 * sub);
        float x1a = bflo(k1), x1b = bfhi(k1), x2a = bflo(k2), x2b = bfhi(k2);
        float ss = x1a * x1a + x1b * x1b + x2a * x2a + x2b * x2b;
#pragma unroll
        for (int e = 0; e < 8; ++e) ss += nv[e] * nv[e];
        ss += __shfl_xor(ss, 1); ss += __shfl_xor(ss, 2); ss += __shfl_xor(ss, 4);
        const float rs = rsqrtf(ss * (1.f / 96.f) + 1e-6f);
#pragma unroll
        for (int e = 0; e < 8; ++e) nv[e] *= rs * kg[8 * sub + e];
        x1a *= rs * kg[64 + 2 * sub]; x1b *= rs * kg[65 + 2 * sub]; x2a *= rs * kg[80 + 2 * sub]; x2b *= rs * kg[81 + 2 * sub];
        const int ps = pos[row]; float ca, sa, cb, sb; rope_cs(ps, 2 * sub, ca, sa); rope_cs(ps, 2 * sub + 1, cb, sb);
        u32x4 o; o.x = pk2(nv[0], nv[1]); o.y = pk2(nv[2], nv[3]); o.z = pk2(nv[4], nv[5]); o.w = pk2(nv[6], nv[7]);
        *(GAS u32x4*)(kp + 8 * sub) = o;
        *(GAS unsigned*)(kp + 64 + 2 * sub) = pk2(x1a * ca - x2a * sa, x1b * cb - x2b * sb);
        *(GAS unsigned*)(kp + 80 + 2 * sub) = pk2(x2a * ca + x1a * sa, x2b * cb + x1b * sb);
    }
}
__device__ __forceinline__ void mkfix_rows(int wid_s, KP p_, int l) {
    KP p = p_; asm volatile("" : "+s"(p));
    unsigned char* ws = p->ws;
    const int tid_ = mk_tid(wid_s);
    const int tid = tid_, lane = tid & 63, wv = tid >> 6, h = lane >> 4, sub = lane & 15;
    bf16* mk = (bf16*)(ws + R_MK); const float* kg = p->in[I_XKG] + l * 128;
    for (int row = blockIdx.x * 8 + wv; row < 2048; row += gridDim.x * 8) {
        bf16* kp = mk + (size_t)row * 512 + h * 128 + 8 * sub;
        const u32x4 w = *(const u32x4*)kp;
        float nv[8] = {bflo(w.x), bfhi(w.x), bflo(w.y), bfhi(w.y), bflo(w.z), bfhi(w.z), bflo(w.w), bfhi(w.w)};
        float ss = 0.f;
#pragma unroll
        for (int e = 0; e < 8; ++e) ss += nv[e] * nv[e];
        ss += __shfl_xor(ss, 1); ss += __shfl_xor(ss, 2); ss += __shfl_xor(ss, 4); ss += __shfl_xor(ss, 8);
        const float rs = rsqrtf(ss * (1.f / 128.f) + 1e-6f);
#pragma unroll
        for (int e = 0; e < 8; ++e) nv[e] *= rs * kg[8 * sub + e];
        u32x4 o; o.x = pk2(nv[0], nv[1]); o.y = pk2(nv[2], nv[3]); o.z = pk2(nv[4], nv[5]); o.w = pk2(nv[6], nv[7]);
        *(u32x4*)kp = o;
    }
}
__device__ __forceinline__ void memb_rows(int wid_s, KP p_) {
    KP p = p_; asm volatile("" : "+s"(p));
    unsigned char* ws = p->ws;
    const int tid_ = mk_tid(wid_s);
    const int tid = tid_, lane = tid & 63, wv = tid >> 6;
    const float* mem = p->in[I_MEM]; bf16* memb = (bf16*)(ws + R_MEMB);
    for (int row = blockIdx.x * 8 + wv; row < 2048; row += gridDim.x * 8) {
        const f32x4* xr = (const f32x4*)(mem + (size_t)row * 1024) + lane; f32x4 v[4]; float s = 0.f;
#pragma unroll
        for (int jq = 0; jq < 4; ++jq) { v[jq] = xr[64 * jq]; s += (v[jq].x * v[jq].x + v[jq].y * v[jq].y) + (v[jq].z * v[jq].z + v[jq].w * v[jq].w); }
        const float rs = rsqrtf(wave_sum(s) * (1.f / 1024.f) + 1e-6f);
#pragma unroll
        for (int jq = 0; jq < 4; ++jq) { u32x2 w; w.x = pk2(v[jq].x * rs, v[jq].y * rs); w.y = pk2(v[jq].z * rs, v[jq].w * rs); *((u32x2*)(memb + (size_t)row * 1024) + lane + 64 * jq) = w; }
    }
}

#define XB_TMO      128
#define XB_XCNT(j)  (256  + 64 * (j))
#define XB_XSUB(j)  (1280 + 64 * (j))
#define XB_XGEN(j)  (2304 + 64 * (j))
#define XB_TOP      3328
#define XB_TOPGEN   3392
#define XCD_BAR_WORDS 3456
#define XB_SPIN_CAP (1u << 22)
__device__ __forceinline__ unsigned xb_ld(unsigned* p)              { return __hip_atomic_load(p, __ATOMIC_RELAXED, __HIP_MEMORY_SCOPE_AGENT); }
__device__ __forceinline__ unsigned xb_add(unsigned* p, unsigned v) { return __hip_atomic_fetch_add(p, v, __ATOMIC_RELAXED, __HIP_MEMORY_SCOPE_AGENT); }
__device__ __forceinline__ unsigned xb_xcc_id() { return (unsigned)__builtin_amdgcn_s_getreg((3 << 11) | 20) & 0xFu; }
#define XB_SPIN(cond, bar) do { unsigned _sp = 0; while (cond) { __builtin_amdgcn_s_sleep(1); \
    if ((++_sp & 255u) == 0u) { if (xb_ld(&(bar)[XB_TMO])) break; if (_sp > XB_SPIN_CAP) { atomicAdd(&(bar)[XB_TMO], 1u); break; } } } } while (0)
__device__ __forceinline__ void xcd_barrier_complete(unsigned* bar, unsigned x, unsigned& nloc, unsigned& nx) {
    const unsigned G = gridDim.x;
    unsigned sum, cnt, mine, sp = 0u;
    for (;;) {
        sum = 0u; cnt = 0u; mine = 0u;
#pragma unroll
        for (unsigned j = 0; j < 16; ++j) { const unsigned c = xb_ld(&bar[XB_XCNT(j)]); sum += c; cnt += (c > 0u) ? 1u : 0u; mine = (j == x) ? c : mine; }
        if (sum == G) break;
        __builtin_amdgcn_s_sleep(1);
        if ((++sp & 255u) == 0u) { if (xb_ld(&bar[XB_TMO])) break; if (sp > XB_SPIN_CAP) { atomicAdd(&bar[XB_TMO], 1u); break; } }
    }
    nloc = mine > 0u ? mine : 1u; nx = cnt > 0u ? cnt : 1u;
}
__device__ __forceinline__ void grid_barrier1(int wid_s, unsigned* bar, volatile unsigned* st) {
    asm volatile("s_waitcnt vmcnt(0)" ::: "memory");
    __syncthreads();
    if (mk_tid(wid_s) == 0) {
        const unsigned x = xb_xcc_id();
        __builtin_amdgcn_s_waitcnt(0);
        unsigned nloc = st[0], nx = st[1];
        if (nloc == 0u) { xcd_barrier_complete(bar, x, nloc, nx); st[0] = nloc; st[1] = nx; }
        const unsigned old = xb_add(&bar[XB_XSUB(x)], 1u);
        const unsigned gen = old / nloc;
        if (old + 1u == (gen + 1u) * nloc) {
            __builtin_amdgcn_fence(__ATOMIC_RELEASE, "agent");
            asm volatile("s_waitcnt vmcnt(0)" ::: "memory");
            const unsigned og = xb_add(&bar[XB_TOP], 1u);
            const unsigned tg = og / nx;
            if (og + 1u == (tg + 1u) * nx) xb_add(&bar[XB_TOPGEN], 1u);
            else XB_SPIN(xb_ld(&bar[XB_TOPGEN]) == tg, bar);
            __builtin_amdgcn_fence(__ATOMIC_ACQUIRE, "agent");
            xb_add(&bar[XB_XGEN(x)], 1u);
            asm volatile("s_waitcnt vmcnt(0)" ::: "memory");
        } else {
            XB_SPIN(xb_ld(&bar[XB_XGEN(x)]) == gen, bar);
            __builtin_amdgcn_fence(__ATOMIC_ACQUIRE, "agent");
            asm volatile("s_waitcnt vmcnt(0)" ::: "memory");
        }
    }
    __syncthreads();
}
__device__ __forceinline__ void grid_barrier(int wid_s, unsigned* bar, volatile unsigned* st) { int nb = 1 + RB(8); asm volatile("" : "+s"(nb)); for (int q = 0; q < nb; ++q) grid_barrier1(wid_s, bar, st); }
template <class Epi>
__device__ __forceinline__ void run_gemm(int wid_s, LAS unsigned char* lds, const bf16* A, int lda, const bf16* Bt, int M, int N, int K, const Epi& E, int shift = 0) {
    int bx_ = blockIdx.x, gx_ = gridDim.x; asm volatile("" : "+s"(bx_), "+s"(gx_), "+s"(K), "+s"(lda));
    pg8::Gemm g{A, Bt, M, N, K, lda}; pg8::StaticOrder S; S.init(M, N, gx_, (bx_ + shift) % gx_);
    if (ON(1)) pg8::gemm_phase<Epi, pg8::StaticOrder>(wid_s, lds, g, S, E);
}

__device__ __forceinline__ unsigned char* wsl_(KP p) { unsigned char* w = p->ws; asm volatile("" : "+s"(w)); return w; }
__global__ void __launch_bounds__(512, 2) fwd_kernel(Params parg) {
    KP p = (KP)__builtin_amdgcn_kernarg_segment_ptr();
    extern __shared__ __attribute__((aligned(16))) unsigned char lds_raw[];
    const int wid_s = __builtin_amdgcn_readfirstlane((int)threadIdx.x >> 6);
    LAS unsigned char* lds3 = (LAS unsigned char*)lds_raw;
    unsigned char* lds = lds_raw; float* ldsf = (float*)lds_raw;
    unsigned char* ws = p->ws;
    const int bid = blockIdx.x;
    unsigned* ctl = (unsigned*)(wsl_(p) + WS_CTL);
    bf16* xb = (bf16*)(wsl_(p) + WS_XB); float* part = (float*)(wsl_(p) + WS_PART); float* pq = (float*)(wsl_(p) + WS_PQ); float* pkv = (float*)(wsl_(p) + WS_PKV);
    bf16* Y = (bf16*)(wsl_(p) + WS_Y);
    float* xcur = p->out;
    volatile unsigned* bst = (volatile unsigned*)(lds + QIDX_OFF + 16);
    if (threadIdx.x == 0) { bst[0] = 0u; bst[1] = 0u; (void)xb_add(&ctl[1024 + XB_XCNT(xb_xcc_id())], 1u); }
    __syncthreads();

    for (int l_ = 0; l_ < 2; ++l_) {
        int l = l_; asm volatile("" : "+s"(l));
        { REPLOOP(0) { if (ON(0)) phase_convert(wid_s, p, l, ldsf);
        grid_barrier(wid_s, ctl + 1024, bst); } }
        for (int r_ = 0; r_ < 2; ++r_) {
            int r = r_; asm volatile("" : "+s"(r));
            { REPLOOP(1) { EpiP E{(bf16*)(wsl_(p) + R_P), part + (size_t)r * TH * 16, pq, pkv};
              run_gemm(wid_s, lds3, xb + (size_t)r * TH * 1024, 1024, (const bf16*)(wsl_(p) + W_IN), TH, NP, 1024, E);
              if (r == 0 && q == 0 && bid >= 160) { __syncthreads(); phase_convert_mid(wid_s, p, l, ldsf, (bid - 160) * 8 + (mk_tid(wid_s) >> 6), (int)(gridDim.x - 160) * 8); __syncthreads(); }
            grid_barrier(wid_s, ctl + 1024, bst); } }
            { REPLOOP(2) {
            if (ON(2)) lora_act_rows(wid_s, p, l, r);
            { EpiQ E{(bf16*)(wsl_(p) + R_Q), pq}; run_gemm(wid_s, lds3, (const bf16*)(wsl_(p) + R_P) + 2816, NP, (const bf16*)(wsl_(p) + W_MQ), TH, 768, 256, E); }
            { EpiKV E{(bf16*)(wsl_(p) + R_KM), (bf16*)(wsl_(p) + R_VT), pkv}; run_gemm(wid_s, lds3, (const bf16*)(wsl_(p) + R_P) + 3072, NP, (const bf16*)(wsl_(p) + W_MKV), TH, 1024, 128, E, 128); }
            grid_barrier(wid_s, ctl + 1024, bst); } }
            { REPLOOP(9) { EpiBf E{Y + (size_t)r * TH * 1536, 1536}; run_gemm(wid_s, lds3, Y + (size_t)r * TH * 1536 + 1024, 1536, (const bf16*)(wsl_(p) + W_BWA), TH, 1024, 128, E);
            grid_barrier(wid_s, ctl + 1024, bst); } }
            { REPLOOP(13) { if (ON(2)) si_build_rows(wid_s, p, l, r); } }
            if (ON(7)) kfix_rows(wid_s, p, l, r);
            grid_barrier(wid_s, ctl + 1024, bst);
            { REPLOOP(3) {
            if (ON(3) && !(q && RB(10)) && bid < 128) { const int xcd = bid & 7, idx = bid >> 3, hh = xcd * 4 + (idx >> 2), quarter = idx & 3;
                if (q == 0 || SCANMODE == 0) rwkv_scan_unit<0>(wid_s, (const bf16*)(wsl_(p) + R_SI) + (size_t)hh * 2048 * 384, Y + ((size_t)(r * 4 + (hh >> 3)) * 2048) * 1536 + (hh & 7) * 64, 1536, quarter, ldsf);
                else rwkv_scan_unit<SCANMODE>(wid_s, (const bf16*)(wsl_(p) + R_SI) + (size_t)hh * 2048 * 384, (bf16*)(wsl_(p) + R_P) + ((size_t)(hh >> 3) * 2048) * NP + 600 + (hh & 7) * 64, NP, quarter, ldsf); }
            else if (ON(4) && !(q && RB(11)) && bid >= 128 && bid < 160) { const int uu = bid - 128; lru_unit(wid_s, p, l, r, uu >> 3, uu & 7, ldsf); }
            else if (q == 0) { EpiBf E{(bf16*)(wsl_(p) + R_P), NP}; run_gemm(wid_s, lds3, (const bf16*)(wsl_(p) + WS_AG), 128, (const bf16*)(wsl_(p) + W_GUP), TH, 512, 128, E, 96); }
            {
                unsigned* ctr = ctl + q * 4 + l * 2 + r; volatile int* qidx = (volatile int*)(lds + QIDX_OFF);
                for (;;) {
                    __syncthreads();
                    if (mk_tid(wid_s) == 0) *qidx = (int)atomicAdd(ctr, 1u);
                    __syncthreads();
                    const int u = *qidx;
                    if (u >= 512 || !ON(5) || (q && RB(12))) break;
                    const int qb = 15 - (u >> 5), bh = u & 31, bl = bh >> 3, h = bh & 7;
                    attn_unit<96, 64, true, true>(wid_s, lds, (const bf16*)(wsl_(p) + R_Q) + (size_t)bl * 2048 * 768 + h * 96, 768, (const bf16*)(wsl_(p) + R_KM) + (size_t)bl * 2048 * 768 + h * 96, 768,
                        (const bf16*)(wsl_(p) + R_VT) + (size_t)(bl * 8 + h) * 64 * 2048, 2048, Y + ((size_t)(r * 4 + bl) * 2048) * 1536 + 1024 + h * 64, 1536,
                        qb * 128, 2 * qb + 2, p->in[I_QG] + l * 96, (const int*)p->in[I_POS] + (r * 4 + bl) * 2048, 0.14724444527f  );
                }
            }
            grid_barrier(wid_s, ctl + 1024, bst); } }
            { REPLOOP(16) { if (ON(6)) rwkv_post_rows(wid_s, p, l, r, q); } }
            grid_barrier(wid_s, ctl + 1024, bst);
        }
        if (ON(7)) memb_rows(wid_s, p);
        { REPLOOP(4) {
        for (int n = 0; n < 3; ++n) {
            { EpiGate E{(bf16*)(wsl_(p) + R_GS), part, p->in[I_BGATE] + l * 3072 + n * 1024}; run_gemm(wid_s, lds3, xb, 1024, (const bf16*)(wsl_(p) + W_GATE) + (size_t)n * 1024 * 1024, T, 1024, 1024, E); }
            { EpiProj E{(const bf16*)(wsl_(p) + R_GS), (float*)(wsl_(p) + R_MS), (bf16*)(wsl_(p) + R_MG), n}; run_gemm(wid_s, lds3, Y + n * 512, 1536, (const bf16*)(wsl_(p) + W_BR) + (size_t)n * 1024 * 512, T, 1024, 512, E); }
        }
        grid_barrier(wid_s, ctl + 1024, bst); } }
        { int nw = 1 + RB(15); asm volatile("" : "+s"(nw)); for (int q = 0; q < nw; ++q) { EpiRes E{nullptr, xb, part, q + 1 < nw}; run_gemm(wid_s, lds3, (const bf16*)(wsl_(p) + R_MG), 1024, (const bf16*)(wsl_(p) + W_OUT), T, 1024, 1024, E); if (q + 1 < nw) grid_barrier(wid_s, ctl + 1024, bst); } }
        { REPLOOP(19) { EpiMemKV E{(bf16*)(wsl_(p) + R_MK), (bf16*)(wsl_(p) + R_MVT)}; run_gemm(wid_s, lds3, (const bf16*)(wsl_(p) + R_MEMB), 1024, (const bf16*)(wsl_(p) + W_XKV), 2048, 1024, 1024, E); } }
        grid_barrier(wid_s, ctl + 1024, bst);
        if (ON(7)) mkfix_rows(wid_s, p, l);
        if (bid >= 128) { __syncthreads(); phase_convert_ffn(wid_s, p, l, ldsf, (bid - 128) * 8 + (mk_tid(wid_s) >> 6), (int)(gridDim.x - 128) * 8); __syncthreads(); }
        { REPLOOP(5) { EpiXQ E{(bf16*)(wsl_(p) + R_XQ), part}; run_gemm(wid_s, lds3, xb, 1024, (const bf16*)(wsl_(p) + W_XQ), T, 512, 1024, E);
        grid_barrier(wid_s, ctl + 1024, bst); } }
        { REPLOOP(6) {
        if (ON(8)) for (int u = bid; u < 512; u += gridDim.x) { const int qb = u & 15, bh = u >> 4, b = bh >> 2, h = bh & 3;
            attn_unit<128, 128, false, false>(wid_s, lds, (const bf16*)(wsl_(p) + R_XQ) + (size_t)b * 2048 * 512 + h * 128, 512, (const bf16*)(wsl_(p) + R_MK) + (size_t)b * 256 * 512 + h * 128, 512,
                (const bf16*)(wsl_(p) + R_MVT) + (size_t)(b * 4 + h) * 128 * 256, 256, (bf16*)(wsl_(p) + R_XO) + (size_t)b * 2048 * 512 + h * 128, 512,
                qb * 128, 4, p->in[I_XQG] + l * 128, nullptr, 0.12751743082f  ); }
        grid_barrier(wid_s, ctl + 1024, bst); } }
        { int nw = 1 + RB(17); asm volatile("" : "+s"(nw)); for (int q = 0; q < nw; ++q) { EpiRes E{nullptr, xb, part, q + 1 < nw}; run_gemm(wid_s, lds3, (const bf16*)(wsl_(p) + R_XO), 512, (const bf16*)(wsl_(p) + W_XO), T, 1024, 512, E); if (q + 1 < nw) grid_barrier(wid_s, ctl + 1024, bst); } }
        grid_barrier(wid_s, ctl + 1024, bst);
        { REPLOOP(7) { EpiFFN1 E{(bf16*)(wsl_(p) + R_H), part}; run_gemm(wid_s, lds3, xb, 1024, (const bf16*)(wsl_(p) + W_13), T, 5632, 1024, E);
        grid_barrier(wid_s, ctl + 1024, bst); } }
        { int nw = 1 + RB(18); asm volatile("" : "+s"(nw)); for (int q = 0; q < nw; ++q) { EpiRes E{l == 1 ? xcur : nullptr, xb, part, q + 1 < nw}; run_gemm(wid_s, lds3, (const bf16*)(wsl_(p) + R_H), DFF, (const bf16*)(wsl_(p) + W_2), T, 1024, DFF, E); if (q + 1 < nw) grid_barrier(wid_s, ctl + 1024, bst); } }
        grid_barrier(wid_s, ctl + 1024, bst);
    }
}

extern "C" void kernel_launch(void* const* d_in, const int* in_sizes, int n_in, void* d_out, int out_size, void* d_ws, size_t ws_size, hipStream_t stream) {
    static int grid = 0;
    if (grid == 0) {
        int dev = 0, cus = 0, per_cu = 0;
        if (n_in != 43 || ws_size < WS_END) { fprintf(stderr, "kernel_launch: unexpected n_in %d / ws %zu\n", n_in, ws_size); grid = -1; return; }
        (void)hipGetDevice(&dev);
        (void)hipDeviceGetAttribute(&cus, hipDeviceAttributeMultiprocessorCount, dev);
        (void)hipFuncSetAttribute((const void*)fwd_kernel, hipFuncAttributeMaxDynamicSharedMemorySize, LDS_BYTES);
        (void)hipOccupancyMaxActiveBlocksPerMultiprocessor(&per_cu, (const void*)fwd_kernel, 512, LDS_BYTES);
        fprintf(stderr, "cus %d per_cu %d ws %zu\n", cus, per_cu, ws_size);
        grid = cus * (per_cu >= 1 ? 1 : 0);
        if (grid <= 0) { grid = -1; return; }
    }
    if (grid < 0) return;
    Params p{};
    for (int i = 0; i < 43; ++i) p.in[i] = (const float*)d_in[i];
    p.out = (float*)d_out; p.ws = (unsigned char*)d_ws;
    (void)hipMemsetAsync((char*)d_ws + WS_CTL, 0, 32768, stream);
    void* args[] = {&p};
    hipError_t e = hipLaunchCooperativeKernel((const void*)fwd_kernel, dim3(grid), dim3(512), args, LDS_BYTES, stream);
    if (e != hipSuccess) fprintf(stderr, "cooperative launch failed: %s (grid %d)\n", hipGetErrorString(e), grid);
}
```

```cpp
#include <hip/hip_runtime.h>
#include <cstdio>
#include <cstdint>

#define LAS __attribute__((address_space(3)))
#define GAS __attribute__((address_space(1)))
typedef unsigned short bf16;
typedef short bf16x8 __attribute__((ext_vector_type(8)));
typedef float f32x4 __attribute__((ext_vector_type(4)));
typedef float f32x2 __attribute__((ext_vector_type(2)));
typedef unsigned u32x4 __attribute__((ext_vector_type(4)));
typedef unsigned u32x2 __attribute__((ext_vector_type(2)));

__device__ __forceinline__ unsigned f2bf(float f) { unsigned u = __builtin_bit_cast(unsigned, f); return (u + 0x7fffu + ((u >> 16) & 1u)) >> 16; }
typedef __bf16 bf16x2_t __attribute__((ext_vector_type(2)));
__device__ __forceinline__ unsigned pk2(float lo, float hi) { const f32x2 v = {lo, hi}; const bf16x2_t b = __builtin_convertvector(v, bf16x2_t); return __builtin_bit_cast(unsigned, b); }
__device__ __forceinline__ float bf2f(bf16 b) { return __builtin_bit_cast(float, (unsigned)b << 16); }
__device__ __forceinline__ float bflo(unsigned u) { return __builtin_bit_cast(float, u << 16); }
__device__ __forceinline__ float bfhi(unsigned u) { return __builtin_bit_cast(float, u & 0xffff0000u); }
__device__ __forceinline__ u32x4 pk8(f32x4 a, f32x4 b) { u32x4 w; w.x = pk2(a.x, a.y); w.y = pk2(a.z, a.w); w.z = pk2(b.x, b.y); w.w = pk2(b.z, b.w); return w; }
__device__ __forceinline__ float sigmoidf_(float x) { return 1.f / (1.f + __expf(-x)); }
__device__ __forceinline__ float fsig(float x) { return __builtin_amdgcn_rcpf(1.f + __builtin_amdgcn_exp2f(-1.4426950408889634f * x)); }
__device__ __forceinline__ int mk_tid(int wid_s) { int t = wid_s * 64 + (int)__builtin_amdgcn_mbcnt_hi(~0u, __builtin_amdgcn_mbcnt_lo(~0u, 0u)); asm volatile("" : "+v"(t)); return t; }
#define LBAR() asm volatile("s_waitcnt lgkmcnt(0)\n\ts_barrier" ::: "memory")
__device__ __forceinline__ float wave_sum(float v) {
#pragma unroll
    for (int o = 1; o < 64; o <<= 1) v += __shfl_xor(v, o);
    return v;
}

namespace pg8 {
#define PG8_LAS __attribute__((address_space(3)))
typedef unsigned short bf16_t;
constexpr int BM = 256, BK = 64, HALF = 128, HTB = HALF * BK * 2, STAGE_BYTES = 8 * HTB, NXCD = 8, WGM = 8;
__host__ __device__ __forceinline__ int lds_byte(int r, int c) { const int st = (r >> 4) * 2 + (c >> 5), rr = r & 15, cc = c & 31, ob = rr * 64 + cc * 2; return st * 1024 + (ob ^ (((ob >> 9) & 1) << 5)); }
__host__ __device__ __forceinline__ void stage_rc(int b, int& R, int& C) { const int st = b / 1024, sb = b % 1024, swz = sb ^ (((sb >> 9) & 1) << 5); R = (st >> 1) * 16 + swz / 64; C = (st & 1) * 32 + (swz % 64) / 2; }
__host__ __device__ __forceinline__ int perm32(int rho) { const int n = rho >> 4, i = rho & 15; return 8 * (i >> 2) + 4 * n + (i & 3); }
struct Unit { int pm, pn; };
struct Gemm { const bf16_t* A; const bf16_t* Bt; int M, N, K, lda; };
struct StaticOrder {
    int nM, nN, nwg, G, c;
    __host__ __device__ void init(int M, int N, int G_, int c_) { nM = M / BM; nN = N / BM; nwg = nM * nN; G = G_; c = c_; }
    __host__ __device__ bool next(int i, Unit& u) const {
        const long L = (long)i * G + c; if (L >= nwg) return false;
        int wgid = (int)L; { const int q = nwg / NXCD, r = nwg % NXCD, xcd = wgid % NXCD, off = wgid / NXCD; wgid = (xcd < r ? xcd * (q + 1) : r * (q + 1) + (xcd - r) * q) + off; }
        const int nig = WGM * nN, gid = wgid / nig, fm = gid * WGM, gsz = (nM - fm) < WGM ? (nM - fm) : WGM;
        u.pm = fm + ((wgid % nig) % gsz); u.pn = (wgid % nig) / gsz; return true;
    }
};
template <class Epi, class Sched>
__device__ __forceinline__ void gemm_phase(int wid_s, PG8_LAS unsigned char* lds, const Gemm g, const Sched& S, const Epi& E) {
    const int tid_ = mk_tid(wid_s);
    const int tid = tid_, wid = __builtin_amdgcn_readfirstlane(tid >> 6), lane = tid & 63, wr = wid >> 2, wc = wid & 3, fr = lane & 15, fq = lane >> 4;
    const int K = g.K, nt = K / BK, lda = g.lda;
    unsigned voffA[2], voffB[2];
#pragma unroll
    for (int i = 0; i < 2; ++i) { int R, C; stage_rc(tid * 16 + i * 8192, R, C); const int Rb = (R & ~31) + perm32(R & 31);
        voffA[i] = (unsigned)(R * lda + C) * 2u; voffB[i] = (unsigned)(Rb * K + C) * 2u; }
    const size_t kstep = (size_t)(BK * 2);
    const size_t hstepA = (size_t)HALF * lda * 2, hstepB = (size_t)HALF * K * 2;
    const size_t tstepA = 2 * hstepA, tstepB = 2 * hstepB;
    const unsigned ldsw = (unsigned)wid * 1024u;
    const int aoff = lds_byte(wr * 64 + fr, fq * 8), boff = lds_byte(wc * 32 + fr, fq * 8);
#define PG8_SA(b, h) (((b) * 2 + (h)) * HTB)
#define PG8_SB(b, h) ((4 + (b) * 2 + (h)) * HTB)
#define PG8_STAGE(bufoff, gbase, voff) do { _Pragma("unroll") for (int _i = 0; _i < 2; ++_i) \
        __builtin_amdgcn_global_load_lds((const unsigned*)((const char*)(gbase) + (voff)[_i]), (PG8_LAS unsigned*)(lds + (bufoff) + ldsw + _i * 8192), 16, 0, 0); } while (0)
#define PG8_LDA(dst, b, h) do { _Pragma("unroll") for (int m = 0; m < 4; ++m) _Pragma("unroll") for (int k = 0; k < 2; ++k) dst[m][k] = *(const PG8_LAS bf16x8*)(lds + PG8_SA(b, h) + aoff + m * 2048 + k * 1024); } while (0)
#define PG8_LDB(dst, b, h) do { _Pragma("unroll") for (int n = 0; n < 2; ++n) _Pragma("unroll") for (int k = 0; k < 2; ++k) dst[n][k] = *(const PG8_LAS bf16x8*)(lds + PG8_SB(b, h) + boff + n * 2048 + k * 1024); } while (0)
#define PG8_MMA(ai, bj, At, Bt) do { __builtin_amdgcn_s_setprio(1); _Pragma("unroll") for (int m = 0; m < 4; ++m) _Pragma("unroll") for (int n = 0; n < 2; ++n) _Pragma("unroll") for (int k = 0; k < 2; ++k) \
        acc[ai][bj][m][n] = __builtin_amdgcn_mfma_f32_16x16x32_bf16(Bt[n][k], At[m][k], acc[ai][bj][m][n], 0, 0, 0); __builtin_amdgcn_s_setprio(0); } while (0)
#define PG8_WAIT_V(n) asm volatile("s_waitcnt vmcnt(" #n ")" ::: "memory")
#define PG8_WAIT_L(n) asm volatile("s_waitcnt lgkmcnt(" #n ")" ::: "memory")
#define PG8_BAR __builtin_amdgcn_s_barrier()
#define PG8_SCHED __builtin_amdgcn_sched_barrier(0)
    Unit cur, nxt; int ui = 0;
    if (!S.next(0, cur)) return;
    f32x4 acc[2][2][4][2];
#pragma unroll
    for (int a = 0; a < 2; ++a)
#pragma unroll
        for (int b = 0; b < 2; ++b)
#pragma unroll
            for (int m = 0; m < 4; ++m)
#pragma unroll
                for (int n = 0; n < 2; ++n) acc[a][b][m][n] = (f32x4){0.f, 0.f, 0.f, 0.f};
    bf16x8 At[4][2], B0[2][2], B1[2][2];
    const char* cA = (const char*)g.A + (size_t)cur.pm * tstepA; const char* cB = (const char*)g.Bt + (size_t)cur.pn * tstepB;
    PG8_STAGE(PG8_SB(0, 0), cB, voffB); PG8_STAGE(PG8_SB(0, 1), cB + hstepB, voffB); PG8_STAGE(PG8_SA(0, 0), cA, voffA); PG8_STAGE(PG8_SA(0, 1), cA + hstepA, voffA);
    if (wr == 1) PG8_BAR;
    PG8_WAIT_V(2); PG8_BAR;
    PG8_STAGE(PG8_SB(1, 0), cB + kstep, voffB); PG8_STAGE(PG8_SA(1, 0), cA + kstep, voffA); PG8_STAGE(PG8_SB(1, 1), cB + hstepB + kstep, voffB);
    PG8_WAIT_V(6); PG8_BAR;
    for (;;) {
        const bool has_next = S.next(ui + 1, nxt);
        const char* nA = has_next ? (const char*)g.A + (size_t)nxt.pm * tstepA : cA; const char* nB = has_next ? (const char*)g.Bt + (size_t)nxt.pn * tstepB : cB;
#pragma unroll 1
        for (int t = 0; t < nt; t += 2) {
            const bool last = (t == nt - 2);
            const char* a1 = cA + (size_t)(t + 1) * kstep;
            const char* a2 = last ? nA : cA + (size_t)(t + 2) * kstep; const char* b2 = last ? nB : cB + (size_t)(t + 2) * kstep;
            const char* a3 = a2 + kstep; const char* b3 = b2 + kstep;
            PG8_LDB(B0, 0, 0); PG8_LDB(B1, 0, 1); PG8_SCHED; PG8_LDA(At, 0, 0); PG8_STAGE(PG8_SA(1, 1), a1 + hstepA, voffA);
            PG8_WAIT_V(8); PG8_WAIT_L(0); PG8_BAR; PG8_MMA(0, 0, At, B0); PG8_MMA(0, 1, At, B1); PG8_BAR; PG8_SCHED;
            PG8_LDA(At, 0, 1); PG8_STAGE(PG8_SB(0, 0), b2, voffB); PG8_STAGE(PG8_SB(0, 1), b2 + hstepB, voffB); PG8_STAGE(PG8_SA(0, 0), a2, voffA);
            PG8_WAIT_V(8); PG8_WAIT_L(0); PG8_BAR; PG8_MMA(1, 0, At, B0); PG8_MMA(1, 1, At, B1); PG8_BAR; PG8_SCHED;
            PG8_LDB(B0, 1, 0); PG8_LDB(B1, 1, 1); PG8_SCHED; PG8_LDA(At, 1, 0); PG8_STAGE(PG8_SA(0, 1), a2 + hstepA, voffA);
            PG8_WAIT_V(8); PG8_WAIT_L(0); PG8_BAR; PG8_MMA(0, 0, At, B0); PG8_MMA(0, 1, At, B1); PG8_BAR; PG8_SCHED;
            PG8_LDA(At, 1, 1); PG8_STAGE(PG8_SB(1, 0), b3, voffB); PG8_STAGE(PG8_SB(1, 1), b3 + hstepB, voffB); PG8_STAGE(PG8_SA(1, 0), a3, voffA);
            PG8_WAIT_V(8); PG8_WAIT_L(0); PG8_BAR; PG8_MMA(1, 0, At, B0); PG8_MMA(1, 1, At, B1); PG8_BAR; PG8_SCHED;
        }
        if (wr == 0) PG8_BAR;
        E(acc, cur, wr, wc, fr, fq);
        if (!has_next) break;
#pragma unroll
        for (int a = 0; a < 2; ++a)
#pragma unroll
            for (int b = 0; b < 2; ++b)
#pragma unroll
                for (int m = 0; m < 4; ++m)
#pragma unroll
                    for (int n = 0; n < 2; ++n) acc[a][b][m][n] = (f32x4){0.f, 0.f, 0.f, 0.f};
        cur = nxt; cA = nA; cB = nB; ++ui;
        if (wr == 1) PG8_BAR;
    }
    PG8_WAIT_V(0);
    PG8_BAR;
#undef PG8_SA
#undef PG8_SB
#undef PG8_STAGE
#undef PG8_LDA
#undef PG8_LDB
#undef PG8_MMA
#undef PG8_WAIT_V
#undef PG8_WAIT_L
#undef PG8_BAR
#undef PG8_SCHED
}
}

#ifndef EN
#define EN 0xFFFF
#endif
#define ON(b) ((EN >> (b)) & 1)
#ifndef REP
#define REP 0
#endif
#ifndef SCANMODE
#define SCANMODE 0
#endif
#define RB(b) ((REP >> (b)) & 1)
#define REPLOOP(b) int nrep##b = 1 + RB(b); asm volatile("" : "+s"(nrep##b)); for (int q = 0; q < nrep##b; ++q)
constexpr int T = 16384, TH = 8192, SEQ = 2048, DM = 1024, DIN = 6304, NP = 3328, DFF = 2816;
constexpr int LDS_BYTES = 147456, QIDX_OFF = 140000;
constexpr size_t MiB = 1u << 20;
constexpr size_t WS_CTL = 0;
constexpr size_t WS_WT = 1 * MiB;
constexpr size_t W_IN = WS_WT, W_GATE = W_IN + (size_t)NP * 1024 * 2, W_BR = W_GATE + (size_t)3072 * 1024 * 2, W_OUT = W_BR + (size_t)3 * 1024 * 512 * 2,
                 W_MQ = W_OUT + (size_t)1024 * 1024 * 2, W_MKV = W_MQ + (size_t)768 * 256 * 2, W_XQ = W_MKV + (size_t)1024 * 128 * 2, W_XKV = W_XQ + (size_t)512 * 1024 * 2,
                 W_XO = W_XKV + (size_t)1024 * 1024 * 2, W_13 = W_XO + (size_t)1024 * 512 * 2, W_2 = W_13 + (size_t)5632 * 1024 * 2, W_BWA = W_2 + (size_t)1024 * 2816 * 2, W_GUP = W_BWA + (size_t)1024 * 128 * 2, W_END = W_GUP + (size_t)512 * 128 * 2;
static_assert(W_END <= 40 * MiB, "weights");
constexpr size_t WS_XB = 40 * MiB, WS_PART = 72 * MiB, WS_PQ = 73 * MiB, WS_PKV = WS_PQ + 256 * 1024, WS_Y = 74 * MiB, WS_R = 122 * MiB;
constexpr size_t R_P = WS_R, R_SI = WS_R + 52 * MiB, R_Q = WS_R + 100 * MiB, R_KM = WS_R + 112 * MiB, R_VT = WS_R + 124 * MiB;
constexpr size_t R_GS = WS_R, R_MS = WS_R + 32 * MiB, R_MG = WS_R + 96 * MiB, R_MEMB = WS_R + 128 * MiB;
constexpr size_t R_MK = WS_R, R_MVT = WS_R + 2 * MiB, R_XQ = WS_R + 32 * MiB, R_XO = WS_R + 48 * MiB, R_H = WS_R;
constexpr size_t WS_AG = WS_R + 132 * MiB;
constexpr size_t WS_END = WS_AG + 2 * MiB;
static_assert(WS_END <= 256 * MiB, "ws");

struct Params { const float* in[43]; float* out; unsigned char* ws; };
typedef const __attribute__((address_space(4))) Params* KP;
enum { I_X = 0, I_MEM, I_POS, I_NMIX, I_NXA, I_NMEM, I_NFFN, I_WIN, I_BGATE, I_MU, I_W0, I_WUP, I_A0, I_AUP, I_GUP, I_KK, I_KA, I_RK, I_LNG, I_LNB,
       I_CW, I_CB, I_WA, I_BA, I_WX, I_BX, I_LAM, I_QN, I_WUQ, I_KVN, I_WUKV, I_QG, I_KG, I_WBR, I_WOUT, I_XWQ, I_XWKV, I_XQG, I_XKG, I_XWO, I_W1, I_W3, I_W2 };

__device__ __forceinline__ float rstd16(const float* part, int row) {
    const f32x4* p = (const f32x4*)(part + (size_t)row * 16); const f32x4 a = p[0], b = p[1], c = p[2], d = p[3];
    const float s = ((a.x + a.y) + (a.z + a.w)) + ((b.x + b.y) + (b.z + b.w)) + ((c.x + c.y) + (c.z + c.w)) + ((d.x + d.y) + (d.z + d.w));
    return rsqrtf(s * (1.f / 1024.f) + 1e-6f);
}
__device__ __forceinline__ float rstd4(const float* pp, int row, float invn) { const f32x4 a = *(const f32x4*)(pp + (size_t)row * 4); return rsqrtf(((a.x + a.y) + (a.z + a.w)) * invn + 1e-6f); }
__device__ __forceinline__ float sumsq8(f32x4 a, f32x4 b) { return (a.x * a.x + a.y * a.y) + (a.z * a.z + a.w * a.w) + (b.x * b.x + b.y * b.y) + (b.z * b.z + b.w * b.w); }
#define EPI_HEAD static constexpr bool PERM = true; \
    __device__ __forceinline__ void operator()(const f32x4 (&acc)[2][2][4][2], const pg8::Unit& u, int wr, int wc, int fr, int fq) const
#define EPI_ROWS _Pragma("unroll") for (int ai = 0; ai < 2; ++ai) _Pragma("unroll") for (int m = 0; m < 4; ++m) if ((__builtin_amdgcn_sched_barrier(0), true))
#define EPI_ROW (u.pm * 256 + ai * 128 + wr * 64 + m * 16 + fr)

struct EpiP {
    bf16* P; const float* part; float* pq; float* pkv;
    EPI_HEAD {
        const int col0 = u.pn * 256 + wc * 32 + 8 * fq;
        EPI_ROWS { const int row = EPI_ROW; const float rs = rstd16(part, row); float ss = 0.f;
#pragma unroll
            for (int bj = 0; bj < 2; ++bj) { const f32x4 v0 = acc[ai][bj][m][0] * rs, v1 = acc[ai][bj][m][1] * rs;
                *(u32x4*)(P + (size_t)row * NP + col0 + bj * 128) = pk8(v0, v1);
                if (u.pn == 11 || bj == 0) ss += sumsq8(v0, v1); }
            if (u.pn == 11 || u.pn == 12) { ss += __shfl_xor(ss, 16); ss += __shfl_xor(ss, 32); if (fq == 0) (u.pn == 11 ? pq : pkv)[(size_t)row * 4 + wc] = ss; } }
    }
};
struct EpiQ {
    bf16* Q; const float* pq;
    EPI_HEAD {
        const int col0 = u.pn * 256 + wc * 32 + 8 * fq;
        EPI_ROWS { const int row = EPI_ROW; const float rs = rstd4(pq, row, 1.f / 256.f);
#pragma unroll
            for (int bj = 0; bj < 2; ++bj) *(u32x4*)(Q + (size_t)row * 768 + col0 + bj * 128) = pk8(acc[ai][bj][m][0] * rs, acc[ai][bj][m][1] * rs); }
    }
};
struct EpiKV {
    bf16* Km; bf16* Vt; const float* pkv;
    EPI_HEAD {
        const int j0 = wc * 32 + 8 * fq;
        EPI_ROWS { const int row = EPI_ROW; const float rs = rstd4(pkv, row, 1.f / 128.f);
#pragma unroll
            for (int bj = 0; bj < 2; ++bj) { const int h = 2 * u.pn + bj; const f32x4 v0 = acc[ai][bj][m][0] * rs, v1 = acc[ai][bj][m][1] * rs;
                if (wc < 2) *(u32x4*)(Km + (size_t)row * 768 + h * 96 + j0) = pk8(v0, v1);
                else { const int bl = row >> 11, t = row & 2047; bf16* vp = Vt + ((size_t)(bl * 8 + h) * 64 + (j0 - 64)) * 2048 + t;
                    vp[0 * 2048] = (bf16)f2bf(v0.x); vp[1 * 2048] = (bf16)f2bf(v0.y); vp[2 * 2048] = (bf16)f2bf(v0.z); vp[3 * 2048] = (bf16)f2bf(v0.w);
                    vp[4 * 2048] = (bf16)f2bf(v1.x); vp[5 * 2048] = (bf16)f2bf(v1.y); vp[6 * 2048] = (bf16)f2bf(v1.z); vp[7 * 2048] = (bf16)f2bf(v1.w); } } }
    }
};
struct EpiGate {
    bf16* GS; const float* part; const float* bg;
    EPI_HEAD {
        const int col0 = u.pn * 256 + wc * 32 + 8 * fq;
        f32x4 b0[2], b1[2];
#pragma unroll
        for (int bj = 0; bj < 2; ++bj) { b0[bj] = *(const f32x4*)(bg + col0 + bj * 128); b1[bj] = *(const f32x4*)(bg + col0 + bj * 128 + 4); }
        EPI_ROWS { const int row = EPI_ROW; const float rs = rstd16(part, row);
#pragma unroll
            for (int bj = 0; bj < 2; ++bj) { f32x4 v0 = acc[ai][bj][m][0] * rs + b0[bj], v1 = acc[ai][bj][m][1] * rs + b1[bj];
#pragma unroll
                for (int e = 0; e < 4; ++e) { v0[e] = fsig(v0[e]); v1[e] = fsig(v1[e]); }
                *(u32x4*)(GS + (size_t)row * 1024 + col0 + bj * 128) = pk8(v0, v1); } }
    }
};
struct EpiProj {
    const bf16* GS; float* MS; bf16* MG; int n;
    EPI_HEAD {
        const int col0 = u.pn * 256 + wc * 32 + 8 * fq;
        EPI_ROWS { const int row = EPI_ROW;
#pragma unroll
            for (int bj = 0; bj < 2; ++bj) { const size_t o = (size_t)row * 1024 + col0 + bj * 128; const u32x4 gw = *(const u32x4*)(GS + o);
                f32x4 v0 = acc[ai][bj][m][0], v1 = acc[ai][bj][m][1];
                v0.x *= bflo(gw.x); v0.y *= bfhi(gw.x); v0.z *= bflo(gw.y); v0.w *= bfhi(gw.y); v1.x *= bflo(gw.z); v1.y *= bfhi(gw.z); v1.z *= bflo(gw.w); v1.w *= bfhi(gw.w);
                bf16* MSb = (bf16*)MS;
                if (n > 0) { const u32x4 mw = *(const u32x4*)(MSb + o); v0.x += bflo(mw.x); v0.y += bfhi(mw.x); v0.z += bflo(mw.y); v0.w += bfhi(mw.y); v1.x += bflo(mw.z); v1.y += bfhi(mw.z); v1.z += bflo(mw.w); v1.w += bfhi(mw.w); }
                if (n < 2) *(u32x4*)(MSb + o) = pk8(v0, v1); else *(u32x4*)(MG + o) = pk8(v0, v1); } }
    }
};
struct EpiRes {
    float* xout; bf16* xb; float* part; int nowrite = 0;
    EPI_HEAD {
        const int col0 = u.pn * 256 + wc * 32 + 8 * fq;
        EPI_ROWS { const int row = EPI_ROW; float ss = 0.f;
#pragma unroll
            for (int bj = 0; bj < 2; ++bj) { const size_t o = (size_t)row * 1024 + col0 + bj * 128; const u32x4 xw = *(const u32x4*)(xb + o);
                f32x4 v0 = acc[ai][bj][m][0], v1 = acc[ai][bj][m][1];
                v0.x += bflo(xw.x); v0.y += bfhi(xw.x); v0.z += bflo(xw.y); v0.w += bfhi(xw.y); v1.x += bflo(xw.z); v1.y += bfhi(xw.z); v1.z += bflo(xw.w); v1.w += bfhi(xw.w);
                if (!nowrite) { if (xout) { *(f32x4*)(xout + o) = v0; *(f32x4*)(xout + o + 4) = v1; } *(u32x4*)(xb + o) = pk8(v0, v1); } ss += sumsq8(v0, v1); }
            ss += __shfl_xor(ss, 16); ss += __shfl_xor(ss, 32); if (fq == 0 && !nowrite) part[(size_t)row * 16 + u.pn * 4 + wc] = ss; }
    }
};
struct EpiXQ {
    bf16* Q; const float* part;
    EPI_HEAD {
        const int col0 = u.pn * 256 + wc * 32 + 8 * fq;
        EPI_ROWS { const int row = EPI_ROW; const float rs = rstd16(part, row);
#pragma unroll
            for (int bj = 0; bj < 2; ++bj) *(u32x4*)(Q + (size_t)row * 512 + col0 + bj * 128) = pk8(acc[ai][bj][m][0] * rs, acc[ai][bj][m][1] * rs); }
    }
};
struct EpiBf {
    bf16* O; int ld;
    EPI_HEAD {
        const int col0 = u.pn * 256 + wc * 32 + 8 * fq;
        EPI_ROWS { const int row = EPI_ROW;
#pragma unroll
            for (int bj = 0; bj < 2; ++bj) *(u32x4*)(O + (size_t)row * ld + col0 + bj * 128) = pk8(acc[ai][bj][m][0], acc[ai][bj][m][1]); }
    }
};
struct EpiMemKV {
    bf16* mk; bf16* mVt;
    EPI_HEAD {
        const int j0 = wc * 32 + 8 * fq, h = u.pn;
        EPI_ROWS { const int row = EPI_ROW;
            *(u32x4*)(mk + (size_t)row * 512 + h * 128 + j0) = pk8(acc[ai][0][m][0], acc[ai][0][m][1]);
            const f32x4 v0 = acc[ai][1][m][0], v1 = acc[ai][1][m][1]; const int b = row >> 8, key = row & 255;
            bf16* vp = mVt + ((size_t)(b * 4 + h) * 128 + j0) * 256 + key;
            vp[0 * 256] = (bf16)f2bf(v0.x); vp[1 * 256] = (bf16)f2bf(v0.y); vp[2 * 256] = (bf16)f2bf(v0.z); vp[3 * 256] = (bf16)f2bf(v0.w);
            vp[4 * 256] = (bf16)f2bf(v1.x); vp[5 * 256] = (bf16)f2bf(v1.y); vp[6 * 256] = (bf16)f2bf(v1.z); vp[7 * 256] = (bf16)f2bf(v1.w); }
    }
};
struct EpiFFN1 {
    bf16* H; const float* part;
    EPI_HEAD {
        const int hc0 = (u.pn * 256 + wc * 32 + 8 * fq) >> 1;
        EPI_ROWS { const int row = EPI_ROW; const float rs = rstd16(part, row);
#pragma unroll
            for (int bj = 0; bj < 2; ++bj) { const f32x4 a1 = acc[ai][bj][m][0] * rs, a3 = acc[ai][bj][m][1] * rs; f32x4 hv;
#pragma unroll
                for (int e = 0; e < 4; ++e) hv[e] = a1[e] * fsig(a1[e]) * a3[e];
                u32x2 w; w.x = pk2(hv.x, hv.y); w.y = pk2(hv.z, hv.w);
                *(u32x2*)(H + (size_t)row * DFF + hc0 + bj * 64) = w; } }
    }
};

__device__ __forceinline__ void conv_job(const float* W, int ldw, int c0, int ncols, int kblk, const float* gain, bf16* WT, int K, int mode, float* scr, int gw, int NGW, int lane, int& off) {
    const int nblk = (ncols + 63) >> 6, nitems = nblk * kblk;
    int it0 = (gw - off) % NGW; if (it0 < 0) it0 += NGW;
    off = (off + nitems) % NGW;
    const int kq = lane >> 4, nq = lane & 15;
    for (int it = it0; it < nitems; it += NGW) {
        const int kb = it / nblk, nb = it % nblk, k0 = 64 * kb, n0 = 64 * nb;
        const bool ld_ok = (n0 + 4 * nq) < ncols;
        f32x4 v[16];
#pragma unroll
        for (int i = 0; i < 16; ++i) { v[i] = (f32x4){0.f, 0.f, 0.f, 0.f}; if (ld_ok) v[i] = *(const f32x4*)(W + (size_t)(k0 + 4 * i + kq) * ldw + c0 + n0 + 4 * nq); }
#pragma unroll
        for (int i = 0; i < 16; ++i) { const int kk = 4 * i + kq; const float gg = gain ? gain[k0 + kk] : 1.f; float* d = scr + kk * 65 + 4 * nq;
            d[0] = v[i].x * gg; d[1] = v[i].y * gg; d[2] = v[i].z * gg; d[3] = v[i].w * gg; }
        __builtin_amdgcn_wave_barrier(); asm volatile("s_waitcnt lgkmcnt(0)" ::: "memory");
        const int c = lane & 7;
#pragma unroll
        for (int jx = 0; jx < 8; ++jx) { const int nl = (lane >> 3) + 8 * jx, n = n0 + nl; const float* sp = scr + (8 * c) * 65 + nl;
            u32x4 o; o.x = pk2(sp[0 * 65], sp[1 * 65]); o.y = pk2(sp[2 * 65], sp[3 * 65]); o.z = pk2(sp[4 * 65], sp[5 * 65]); o.w = pk2(sp[6 * 65], sp[7 * 65]);
            const int dr = mode == 0 ? n : (8 * (n >> 2) + (n & 3) + (mode == 2 ? 4 : 0));
            if (n < ncols) *(u32x4*)(WT + (size_t)dr * K + k0 + 8 * c) = o; }
        __builtin_amdgcn_wave_barrier(); asm volatile("s_waitcnt lgkmcnt(0)" ::: "memory");
    }
}

__device__ __forceinline__ void phase_convert(int wid_s, KP p_, int l, float* ldsf, int bsub, int nb) {
    KP p = p_; asm volatile("" : "+s"(p));
    unsigned char* ws = p->ws;
    const int tid_ = mk_tid(wid_s);
    const int tid = tid_, lane = tid & 63, wv = tid >> 6;
    const int gw = bsub * 8 + wv, NGW = nb * 8;
    float* scr = ldsf + wv * (64 * 65); int off = 0;
    const float* nmix = p->in[I_NMIX] + l * 1024;
    conv_job(p->in[I_WIN] + (size_t)l * 1024 * DIN, DIN, 0, 3232, 16, nmix, (bf16*)(ws + W_IN), 1024, 0, scr, gw, NGW, lane, off);
    conv_job(p->in[I_WUQ] + (size_t)l * 256 * 768, 768, 0, 768, 4, p->in[I_QN] + l * 256, (bf16*)(ws + W_MQ), 256, 0, scr, gw, NGW, lane, off);
    conv_job(p->in[I_WUKV] + (size_t)l * 128 * 1024, 1024, 0, 1024, 2, p->in[I_KVN] + l * 128, (bf16*)(ws + W_MKV), 128, 0, scr, gw, NGW, lane, off);
    conv_job(p->in[I_WUP] + (size_t)l * 64 * 512, 512, 0, 512, 1, nullptr, (bf16*)(ws + W_BWA), 128, 0, scr, gw, NGW, lane, off);
    conv_job(p->in[I_AUP] + (size_t)l * 64 * 512, 512, 0, 512, 1, nullptr, (bf16*)(ws + W_BWA) + 512 * 128 + 64, 128, 0, scr, gw, NGW, lane, off);
    conv_job(p->in[I_GUP] + (size_t)l * 128 * 512, 512, 0, 512, 2, nullptr, (bf16*)(ws + W_GUP), 128, 0, scr, gw, NGW, lane, off);
    { unsigned zz = 0u; asm volatile("" : "+v"(zz)); const u32x4 zv = {zz, zz, zz, zz};
      for (int i = bsub * 512 + tid; i < 1024 * 8; i += nb * 512) { const int row = i >> 3, ch = i & 7; *(u32x4*)((bf16*)(ws + W_BWA) + row * 128 + (row < 512 ? 64 : 0) + ch * 8) = zv; } }
    { u32x4* z = (u32x4*)((bf16*)(ws + W_IN) + (size_t)3232 * 1024); const int n16 = 96 * 1024 * 2 / 16;
      unsigned zz = 0u; asm volatile("" : "+v"(zz)); const u32x4 zv = {zz, zz, zz, zz};
      for (int i = bsub * 512 + tid; i < n16; i += nb * 512) z[i] = zv; }
    if (l == 0) {
        const float* x = p->in[I_X]; bf16* xb = (bf16*)(ws + WS_XB); float* part = (float*)(ws + WS_PART);
        for (int row = gw; row < T; row += NGW) {
            const f32x4* xr = (const f32x4*)(x + (size_t)row * 1024) + lane; float s = 0.f;
#pragma unroll
            for (int j = 0; j < 4; ++j) { const f32x4 v = xr[64 * j]; s += (v.x * v.x + v.y * v.y) + (v.z * v.z + v.w * v.w);
                u32x2 w; w.x = pk2(v.x, v.y); w.y = pk2(v.z, v.w); *((u32x2*)(xb + (size_t)row * 1024) + lane + 64 * j) = w; }
            s = wave_sum(s);
            if (lane < 16) part[(size_t)row * 16 + lane] = lane == 0 ? s : 0.f;
        }
    }
}

__device__ __forceinline__ void phase_convert_mid(int wid_s, KP p_, int l, float* ldsf, int gw, int NGW) {
    KP p = p_; asm volatile("" : "+s"(p));
    unsigned char* ws = p->ws;
    const int tid_ = mk_tid(wid_s);
    const int tid = tid_, lane = tid & 63, wv = tid >> 6;
    float* scr = ldsf + wv * (64 * 65); int off = 0;
    const float* nmix = p->in[I_NMIX] + l * 1024;
    conv_job(p->in[I_WIN] + (size_t)l * 1024 * DIN, DIN, 3232, 3072, 16, nmix, (bf16*)(ws + W_GATE), 1024, 0, scr, gw, NGW, lane, off);
    for (int n = 0; n < 3; ++n) conv_job(p->in[I_WBR] + ((size_t)l * 3 + n) * 512 * 1024, 1024, 0, 1024, 8, nullptr, (bf16*)(ws + W_BR) + (size_t)n * 1024 * 512, 512, 0, scr, gw, NGW, lane, off);
    conv_job(p->in[I_WOUT] + (size_t)l * 1024 * 1024, 1024, 0, 1024, 16, nullptr, (bf16*)(ws + W_OUT), 1024, 0, scr, gw, NGW, lane, off);
    conv_job(p->in[I_XWQ] + (size_t)l * 1024 * 512, 512, 0, 512, 16, p->in[I_NXA] + l * 1024, (bf16*)(ws + W_XQ), 1024, 0, scr, gw, NGW, lane, off);
    conv_job(p->in[I_XWKV] + (size_t)l * 1024 * 1024, 1024, 0, 1024, 16, p->in[I_NMEM] + l * 1024, (bf16*)(ws + W_XKV), 1024, 0, scr, gw, NGW, lane, off);
    conv_job(p->in[I_XWO] + (size_t)l * 512 * 1024, 1024, 0, 1024, 8, nullptr, (bf16*)(ws + W_XO), 512, 0, scr, gw, NGW, lane, off);
}
__device__ __forceinline__ void phase_convert_ffn(int wid_s, KP p_, int l, float* ldsf, int gw, int NGW) {
    KP p = p_; asm volatile("" : "+s"(p));
    unsigned char* ws = p->ws;
    const int tid_ = mk_tid(wid_s);
    const int tid = tid_, lane = tid & 63, wv = tid >> 6;
    float* scr = ldsf + wv * (64 * 65); int off = 0;
    conv_job(p->in[I_W1] + (size_t)l * 1024 * DFF, DFF, 0, 2816, 16, p->in[I_NFFN] + l * 1024, (bf16*)(ws + W_13), 1024, 1, scr, gw, NGW, lane, off);
    conv_job(p->in[I_W3] + (size_t)l * 1024 * DFF, DFF, 0, 2816, 16, p->in[I_NFFN] + l * 1024, (bf16*)(ws + W_13), 1024, 2, scr, gw, NGW, lane, off);
    conv_job(p->in[I_W2] + (size_t)l * DFF * 1024, 1024, 0, 1024, 44, nullptr, (bf16*)(ws + W_2), DFF, 0, scr, gw, NGW, lane, off);
}
__device__ __forceinline__ void rope_cs(int pos, int i, float& c, float& s) {
    const float invf = exp2f(-(float)i * 0.8304820237218406f);
    const float ang = (float)pos * invf;
    const double x = (double)ang * 0.15915494309189535; const float f = (float)(x - rint(x));
    c = __builtin_amdgcn_cosf(f); s = __builtin_amdgcn_sinf(f);
}
template <int DQK, int DV, bool CAUSAL, bool MLA>
__device__ __forceinline__ void attn_unit(int wid_s, unsigned char* lds, const bf16* Qb_, int ldq, const bf16* Kb_, int ldk, const bf16* Vtb_, int ldv, bf16* Ob_, int ldo,
                                          int q0, int nkt, const float* qgain_, const int* pos_, float qscale) {
    const GAS bf16* Qb = (const GAS bf16*)Qb_; const GAS bf16* Kb = (const GAS bf16*)Kb_; const GAS bf16* Vtb = (const GAS bf16*)Vtb_; GAS bf16* Ob = (GAS bf16*)Ob_;
    const GAS float* qgain = (const GAS float*)qgain_; const GAS int* pos = (const GAS int*)pos_;
    constexpr int KS = DQK * 2 + 16, VS = 144, NKS = DQK / 32, NDT = DV / 16, KCH = DQK / 8, NKC = (64 * KCH + 511) / 512, NVC = DV * 8 / 512;
    unsigned char* Ks = lds; unsigned char* Vs = lds + 64 * KS;
    const int tid_ = mk_tid(wid_s);
    const int tid = tid_, lane = tid & 63, wv = tid >> 6, g = lane >> 4, j = lane & 15;
    const int qrow = q0 + wv * 16 + j;
    bf16x8 qf[NKS];
    {
        float qv[NKS][8]; float ss = 0.f;
#pragma unroll
        for (int ks = 0; ks < NKS; ++ks) { const u32x4 w = *(const GAS u32x4*)(Qb + (size_t)qrow * ldq + 32 * ks + 8 * g);
            qv[ks][0] = bflo(w.x); qv[ks][1] = bfhi(w.x); qv[ks][2] = bflo(w.y); qv[ks][3] = bfhi(w.y); qv[ks][4] = bflo(w.z); qv[ks][5] = bfhi(w.z); qv[ks][6] = bflo(w.w); qv[ks][7] = bfhi(w.w);
#pragma unroll
            for (int e = 0; e < 8; ++e) ss += qv[ks][e] * qv[ks][e]; }
        ss += __shfl_xor(ss, 16); ss += __shfl_xor(ss, 32);
        const float rs = rsqrtf(ss * (1.f / DQK) + 1e-6f);
#pragma unroll
        for (int ks = 0; ks < NKS; ++ks)
#pragma unroll
            for (int e = 0; e < 8; ++e) qv[ks][e] *= rs * qgain[32 * ks + 8 * g + e];
        if (MLA) {
            const int ps = pos[qrow];
#pragma unroll
            for (int e = 0; e < 8; ++e) { const float mine = qv[2][e], other = __shfl_xor(mine, 32); float c, s; rope_cs(ps, 8 * (g & 1) + e, c, s);
                qv[2][e] = (g < 2) ? (mine * c - other * s) : (mine * c + other * s); }
        }
#pragma unroll
        for (int ks = 0; ks < NKS; ++ks) { u32x4 w; w.x = pk2(qv[ks][0] * qscale, qv[ks][1] * qscale); w.y = pk2(qv[ks][2] * qscale, qv[ks][3] * qscale);
            w.z = pk2(qv[ks][4] * qscale, qv[ks][5] * qscale); w.w = pk2(qv[ks][6] * qscale, qv[ks][7] * qscale); qf[ks] = __builtin_bit_cast(bf16x8, w); }
    }
    f32x4 oT[NDT];
#pragma unroll
    for (int d = 0; d < NDT; ++d) oT[d] = (f32x4){0.f, 0.f, 0.f, 0.f};
    float mrun = -INFINITY, lsum = 0.f;
    u32x4 kreg[NKC], vreg[NVC];
#define ATT_PREFETCH(kt) do { _Pragma("unroll") for (int i = 0; i < NKC; ++i) { const int idx = tid + 512 * i; if (idx < 64 * KCH) { const int key = idx / KCH, ch = idx % KCH; \
            kreg[i] = *(const GAS u32x4*)(Kb + (size_t)(64 * (kt) + key) * ldk + ch * 8); } } \
        _Pragma("unroll") for (int i = 0; i < NVC; ++i) { const int idx = tid + 512 * i; const int dv = idx >> 3, ch = idx & 7; vreg[i] = *(const GAS u32x4*)(Vtb + (size_t)dv * ldv + 64 * (kt) + ch * 8); } } while (0)
    ATT_PREFETCH(0);
    for (int kt = 0; kt < nkt; ++kt) {
        LBAR();
#pragma unroll
        for (int i = 0; i < NKC; ++i) { const int idx = tid + 512 * i; if (idx < 64 * KCH) { const int key = idx / KCH, ch = idx % KCH; *(u32x4*)(Ks + key * KS + ch * 16) = kreg[i]; } }
#pragma unroll
        for (int i = 0; i < NVC; ++i) { const int idx = tid + 512 * i; const int dv = idx >> 3, ch = idx & 7; *(u32x4*)(Vs + dv * VS + ch * 16) = vreg[i]; }
        LBAR();
        if (kt + 1 < nkt) ATT_PREFETCH(kt + 1);
        const int qw0 = q0 + wv * 16;
        if (CAUSAL && 64 * kt > qw0 + 15) continue;
        f32x4 sT[4];
#pragma unroll
        for (int k4 = 0; k4 < 4; ++k4) { sT[k4] = (f32x4){0.f, 0.f, 0.f, 0.f};
#pragma unroll
            for (int ks = 0; ks < NKS; ++ks) { const bf16x8 a = *(const bf16x8*)(Ks + (16 * k4 + j) * KS + (32 * ks + 8 * g) * 2);
                sT[k4] = __builtin_amdgcn_mfma_f32_16x16x32_bf16(a, qf[ks], sT[k4], 0, 0, 0); } }
        if (CAUSAL && 64 * kt + 63 > qw0) {
#pragma unroll
            for (int k4 = 0; k4 < 4; ++k4)
#pragma unroll
                for (int r = 0; r < 4; ++r) if (64 * kt + 16 * k4 + 4 * g + r > qrow) sT[k4][r] = -INFINITY;
        }
        float mx = -INFINITY;
#pragma unroll
        for (int k4 = 0; k4 < 4; ++k4) mx = fmaxf(mx, fmaxf(fmaxf(sT[k4][0], sT[k4][1]), fmaxf(sT[k4][2], sT[k4][3])));
        mx = fmaxf(mx, __shfl_xor(mx, 16)); mx = fmaxf(mx, __shfl_xor(mx, 32));
        const float mnew = fmaxf(mrun, mx); const float alpha = __builtin_amdgcn_exp2f(mrun - mnew); mrun = mnew;
        float psum = 0.f;
#pragma unroll
        for (int k4 = 0; k4 < 4; ++k4)
#pragma unroll
            for (int r = 0; r < 4; ++r) { const float pv = __builtin_amdgcn_exp2f(sT[k4][r] - mnew); sT[k4][r] = pv; psum += pv; }
        lsum = lsum * alpha + psum;
#pragma unroll
        for (int d = 0; d < NDT; ++d) oT[d] *= alpha;
#pragma unroll
        for (int kc = 0; kc < 2; ++kc) {
            const bf16x8 pb = __builtin_bit_cast(bf16x8, pk8(sT[2 * kc], sT[2 * kc + 1]));
#pragma unroll
            for (int d = 0; d < NDT; ++d) { const unsigned char* vp = Vs + (16 * d + j) * VS + (32 * kc + 4 * g) * 2;
                const u32x2 lo = *(const u32x2*)vp, hi = *(const u32x2*)(vp + 32); u32x4 w; w.x = lo.x; w.y = lo.y; w.z = hi.x; w.w = hi.y;
                oT[d] = __builtin_amdgcn_mfma_f32_16x16x32_bf16(__builtin_bit_cast(bf16x8, w), pb, oT[d], 0, 0, 0); }
        }
    }
#undef ATT_PREFETCH
    lsum += __shfl_xor(lsum, 16); lsum += __shfl_xor(lsum, 32);
    const float inv = 1.f / lsum;
#pragma unroll
    for (int d = 0; d < NDT; ++d) { u32x2 w; w.x = pk2(oT[d][0] * inv, oT[d][1] * inv); w.y = pk2(oT[d][2] * inv, oT[d][3] * inv);
        *(GAS u32x2*)(Ob + (size_t)qrow * ldo + 16 * d + 4 * g) = w; }
}

__device__ __forceinline__ void lora_act_rows(int wid_s, KP p_, int l, int r) {
    KP p = p_; asm volatile("" : "+s"(p));
    unsigned char* ws = p->ws;
    const int tid_ = mk_tid(wid_s);
    const int tid = tid_;
    const bf16* P = (const bf16*)(ws + R_P); bf16* Awa = (bf16*)(ws + WS_Y) + (size_t)r * TH * 1536 + 1024; bf16* Ag = (bf16*)(ws + WS_AG);
    const float* mu = p->in[I_MU] + l * 1792 + 1536;
    const int sub = tid & 31, j0 = sub * 8;
    f32x4 m0 = *(const f32x4*)(mu + j0), m1 = *(const f32x4*)(mu + j0 + 4);
    for (int row = blockIdx.x * 16 + (tid >> 5); row < TH; row += gridDim.x * 16) {
        const u32x4 cw = *(const u32x4*)(P + (size_t)row * NP + 1536 + j0);
        u32x4 pw = {0u, 0u, 0u, 0u}; if ((row & 2047) != 0) pw = *(const u32x4*)(P + (size_t)(row - 1) * NP + 1536 + j0);
        float c[8] = {bflo(cw.x), bfhi(cw.x), bflo(cw.y), bfhi(cw.y), bflo(cw.z), bfhi(cw.z), bflo(cw.w), bfhi(cw.w)};
        const float q[8] = {bflo(pw.x), bfhi(pw.x), bflo(pw.y), bfhi(pw.y), bflo(pw.z), bfhi(pw.z), bflo(pw.w), bfhi(pw.w)};
        const float mm[8] = {m0.x, m0.y, m0.z, m0.w, m1.x, m1.y, m1.z, m1.w};
#pragma unroll
        for (int e = 0; e < 8; ++e) { float v = c[e] + (q[e] - c[e]) * mm[e];
            if (j0 < 64) v = 2.f * fsig(2.f * v) - 1.f;
            else if (j0 >= 128) v = fsig(v);
            c[e] = v; }
        u32x4 o; o.x = pk2(c[0], c[1]); o.y = pk2(c[2], c[3]); o.z = pk2(c[4], c[5]); o.w = pk2(c[6], c[7]);
        if (j0 < 128) *(u32x4*)(Awa + (size_t)row * 1536 + j0) = o; else *(u32x4*)(Ag + (size_t)row * 128 + (j0 - 128)) = o;
    }
}
__device__ __forceinline__ void si_build_tile(int wid_s, KP p_, int l, int r, int tile) {
    KP p = p_; asm volatile("" : "+s"(p));
    unsigned char* ws = p->ws;
    const int tid_ = mk_tid(wid_s);
    const int tid = tid_, lane = tid & 63, wv = tid >> 6;
    const GAS bf16* P = (const GAS bf16*)(ws + R_P); GAS bf16* SI = (GAS bf16*)(ws + R_SI); const GAS bf16* LW = (const GAS bf16*)(ws + WS_Y) + (size_t)r * TH * 1536;
    const float* mu = p->in[I_MU] + l * 1792;
    const int row0 = tile * 32;
    const int c = tid, h = wv;
    const float w0c = p->in[I_W0][l * 512 + c], a0c = p->in[I_A0][l * 512 + c], kkc = p->in[I_KK][l * 512 + c], kac = p->in[I_KA][l * 512 + c];
    const float mur = mu[c], muk = mu[512 + c], muv = mu[1024 + c];
#pragma unroll 4
    for (int t = 0; t < 32; ++t) {
        const int row = row0 + t; const bool first = (row & 2047) == 0;
        const GAS bf16* pr = P + (size_t)row * NP; const GAS bf16* pp = pr - NP;
        const float rc = bf2f(pr[c]), kc = bf2f(pr[512 + c]), vc = bf2f(pr[1024 + c]);
        const float rp = first ? 0.f : bf2f(pp[c]), kp = first ? 0.f : bf2f(pp[512 + c]), vp = first ? 0.f : bf2f(pp[1024 + c]);
        const float wl = bf2f(LW[(size_t)row * 1536 + c]), al = bf2f(LW[(size_t)row * 1536 + 512 + c]);
        const float rr = rc + (rp - rc) * mur, k = kc + (kp - kc) * muk, v = vc + (vp - vc) * muv;
        const float om = 1.f - __expf(-0.6065306597126334f * fsig(w0c + wl));
        const float a = fsig(a0c + al);
        const float kkr = k * kkc; const float ss = wave_sum(kkr * kkr); const float kk = kkr / fmaxf(sqrtf(ss), 1e-12f);
        const float k2 = k * (1.f + (a - 1.f) * kac);
        GAS bf16* o = SI + ((size_t)((row >> 11) * 8 + h) * 2048 + (row & 2047)) * 384 + lane;
        o[0] = (bf16)f2bf(rr); o[64] = (bf16)f2bf(om); o[128] = (bf16)f2bf(k2); o[192] = (bf16)f2bf(kk); o[256] = (bf16)f2bf(kk * a); o[320] = (bf16)f2bf(v);
    }
}

template <int CTRL> __device__ __forceinline__ float dppf(float x) { return __builtin_bit_cast(float, __builtin_amdgcn_update_dpp(0, __builtin_bit_cast(int, x), CTRL, 0xF, 0xF, true)); }
__device__ __forceinline__ float allreduce8(float x);
__device__ __forceinline__ float allreduce16(float x) { x += dppf<0xB1>(x); x += dppf<0x4E>(x); x += dppf<0x141>(x); x += dppf<0x140>(x); return x; }
template <int MODE>
__device__ __forceinline__ void rwkv_scan_unit(int wid_s, const bf16* SIbh_, bf16* Yb_, int ystride, int quarter, float* ldsf) {
    const int tid_ = mk_tid(wid_s);
    const GAS bf16* SIbh = (const GAS bf16*)SIbh_; GAS bf16* Yb = (GAS bf16*)Yb_;
    const int tid = tid_, lane = tid & 63, wv = tid >> 6, hw = wv - 4;
    float* PYb = ldsf + 4 * (16 * 384);
    u32x4 hreg[12];
    if (wv >= 4 && wv < 7) {
#pragma unroll
        for (int i = 0; i < 12; ++i) hreg[i] = *(const GAS u32x4*)(SIbh + (size_t)hw * (16 * 384) + (size_t)(lane + 64 * i) * 8);
    }
    f32x2 Sa = {0.f, 0.f}, Sb = {0.f, 0.f};
    const int rowl = quarter * 16 + (wv & 3) * 4 + (lane >> 4), c4 = (lane & 15) * 4;
    __syncthreads();
#define SCAN_CONVERT(cn) do { float* Bd = ldsf + ((cn) & 3) * (16 * 384); \
        _Pragma("unroll") for (int i = 0; i < 12; ++i) { float* d = Bd + (lane + 64 * i) * 8; const u32x4 w = hreg[i]; \
            *(f32x4*)d = (f32x4){bflo(w.x), bfhi(w.x), bflo(w.y), bfhi(w.y)}; *(f32x4*)(d + 4) = (f32x4){bflo(w.z), bfhi(w.z), bflo(w.w), bfhi(w.w)}; } \
        if ((cn) + 3 < 128) { _Pragma("unroll") for (int i = 0; i < 12; ++i) hreg[i] = *(const GAS u32x4*)(SIbh + (size_t)((cn) + 3) * (16 * 384) + (size_t)(lane + 64 * i) * 8); } } while (0)
    if (wv == 4) SCAN_CONVERT(0);
    for (int ch = 0; ch <= 128; ++ch) {
        LBAR();
        if (wv < 4) {
            if (ch < 128) {
                const float* B = ldsf + (ch & 3) * (16 * 384);
                float* PY = PYb + (ch & 1) * (16 * 260) + wv * 64 + lane;
                const float* q = B;
                f32x4 r4 = *(const f32x4*)(q + c4), om4 = *(const f32x4*)(q + 64 + c4), k4 = *(const f32x4*)(q + 128 + c4), kk4 = *(const f32x4*)(q + 192 + c4), ka4 = *(const f32x4*)(q + 256 + c4);
                float v = q[320 + rowl];
                __builtin_amdgcn_s_setprio(3);
#pragma unroll
                for (int s = 0; s < 16; ++s) {
                    const float* qn = B + ((MODE & 2) ? 0 : ((s + 1) & 15)) * 384;
                    const f32x4 nr4 = *(const f32x4*)(qn + c4), nom4 = *(const f32x4*)(qn + 64 + c4), nk4 = *(const f32x4*)(qn + 128 + c4), nkk4 = *(const f32x4*)(qn + 192 + c4), nka4 = *(const f32x4*)(qn + 256 + c4);
                    const float nv = qn[320 + rowl];
                    const f32x2 pa = Sa * (f32x2){kk4.x, kk4.y} + Sb * (f32x2){kk4.z, kk4.w};
                    const float sa = (MODE & 1) ? (pa.x + pa.y) : allreduce16(pa.x + pa.y);
                    Sa = Sa - Sa * (f32x2){om4.x, om4.y} + (f32x2){k4.x, k4.y} * v; Sb = Sb - Sb * (f32x2){om4.z, om4.w} + (f32x2){k4.z, k4.w} * v;
                    Sa = Sa - (f32x2){ka4.x, ka4.y} * sa; Sb = Sb - (f32x2){ka4.z, ka4.w} * sa;
                    const f32x2 py = Sa * (f32x2){r4.x, r4.y} + Sb * (f32x2){r4.z, r4.w};
                    PY[s * 260] = py.x + py.y;
                    r4 = nr4; om4 = nom4; k4 = nk4; kk4 = nkk4; ka4 = nka4; v = nv;
                }
                __builtin_amdgcn_s_setprio(0);
            }
        } else if (wv == 7) {
            if (ch > 0) {
                const int s = lane >> 2, rr = lane & 3;
#pragma unroll
                for (int mw = 0; mw < 4; ++mw) {
                    const float* src = PYb + ((ch - 1) & 1) * (16 * 260) + s * 260 + mw * 64 + rr * 16;
                    const f32x4 a = *(const f32x4*)src, b = *(const f32x4*)(src + 4), c = *(const f32x4*)(src + 8), d = *(const f32x4*)(src + 12);
                    const float y = ((a.x + a.y) + (a.z + a.w)) + ((b.x + b.y) + (b.z + b.w)) + ((c.x + c.y) + (c.z + c.w)) + ((d.x + d.y) + (d.z + d.w));
                    Yb[(size_t)((ch - 1) * 16 + s) * ystride + quarter * 16 + mw * 4 + rr] = (bf16)f2bf(y);
                }
            }
        } else {
            const int cn = ch + 1;
            if (cn < 128 && (cn % 3) == hw) SCAN_CONVERT(cn);
        }
    }
#undef SCAN_CONVERT
    __syncthreads();
}

__device__ __forceinline__ void rwkv_post_tile(int wid_s, KP p_, int l, int r, int tile, int dummy) {
    KP p = p_; asm volatile("" : "+s"(p));
    unsigned char* ws = p->ws;
    const int tid_ = mk_tid(wid_s);
    const int tid = tid_, lane = tid & 63, wv = tid >> 6;
    const GAS bf16* P = (const GAS bf16*)(ws + R_P); const GAS bf16* SI = (const GAS bf16*)(ws + R_SI); GAS bf16* Y = (GAS bf16*)(ws + WS_Y) + (size_t)r * TH * 1536;
    const int row0 = tile * 32;
    const int c = tid, h = wv;
    const float rkc = p->in[I_RK][l * 512 + c], lng = p->in[I_LNG][l * 512 + c], lnb = p->in[I_LNB][l * 512 + c];
#pragma unroll 4
    for (int t = 0; t < 32; ++t) {
        const int row = row0 + t;
        const GAS bf16* si = SI + ((size_t)((row >> 11) * 8 + h) * 2048 + (row & 2047)) * 384 + lane;
        const float rr = bf2f(si[0]), k2 = bf2f(si[128]), v = bf2f(si[320]);
        const float gg = bf2f(P[(size_t)row * NP + c]);
        GAS bf16* yp = Y + (size_t)row * 1536 + c;
        const float y = bf2f(*yp);
        const float mean = wave_sum(y) * (1.f / 64.f); const float d = y - mean; const float var = wave_sum(d * d) * (1.f / 64.f);
        const float yn = d * rsqrtf(var + 64e-5f) * lng + lnb;
        const float bonus = wave_sum(rr * k2 * rkc) * v;
        if (dummy) yp = (GAS bf16*)(ws + R_P) + (size_t)row * NP + 600 + c;
        *yp = (bf16)f2bf((yn + bonus) * gg);
    }
}

__device__ __forceinline__ float allreduce8(float x) { x += dppf<0xB1>(x); x += dppf<0x4E>(x); x += dppf<0x141>(x); return x; }
__device__ __forceinline__ void unpack8(const u32x4 w, float* f) { f[0] = bflo(w.x); f[1] = bfhi(w.x); f[2] = bflo(w.y); f[3] = bfhi(w.y); f[4] = bflo(w.z); f[5] = bfhi(w.z); f[6] = bflo(w.w); f[7] = bfhi(w.w); }
__device__ __forceinline__ u32x4 pack8(const float* f) { u32x4 o; o.x = pk2(f[0], f[1]); o.y = pk2(f[2], f[3]); o.z = pk2(f[4], f[5]); o.w = pk2(f[6], f[7]); return o; }
__device__ __forceinline__ void ld8f(const GAS float* q, float* f) { const f32x4 a = *(const GAS f32x4*)q, b = *(const GAS f32x4*)(q + 4); f[0] = a.x; f[1] = a.y; f[2] = a.z; f[3] = a.w; f[4] = b.x; f[5] = b.y; f[6] = b.z; f[7] = b.w; }
__device__ __forceinline__ void si_build_rows(int wid_s, KP p_, int l, int r) {
    KP p = p_; asm volatile("" : "+s"(p));
    unsigned char* ws = p->ws;
    const int tid_ = mk_tid(wid_s);
    const int tid = tid_, lane = tid & 63, wv = tid >> 6, c0 = lane * 8, h = lane >> 3;
    const GAS bf16* P = (const GAS bf16*)(ws + R_P); GAS bf16* SI = (GAS bf16*)(ws + R_SI); const GAS bf16* LW = (const GAS bf16*)(ws + WS_Y) + (size_t)r * TH * 1536;
    float w0c[8], a0c[8], kkc[8], kac[8], mur[8], muk[8], muv[8];
    ld8f((const GAS float*)p->in[I_W0] + l * 512 + c0, w0c); ld8f((const GAS float*)p->in[I_A0] + l * 512 + c0, a0c); ld8f((const GAS float*)p->in[I_KK] + l * 512 + c0, kkc); ld8f((const GAS float*)p->in[I_KA] + l * 512 + c0, kac);
    ld8f((const GAS float*)p->in[I_MU] + l * 1792 + c0, mur); ld8f((const GAS float*)p->in[I_MU] + l * 1792 + 512 + c0, muk); ld8f((const GAS float*)p->in[I_MU] + l * 1792 + 1024 + c0, muv);
    for (int row = blockIdx.x * 8 + wv; row < TH; row += gridDim.x * 8) {
        const bool first = (row & 2047) == 0;
        const GAS bf16* pr = P + (size_t)row * NP + c0; const GAS bf16* pp = pr - NP;
        const u32x4 z4 = {0u, 0u, 0u, 0u};
        const u32x4 rcw = *(const GAS u32x4*)pr, kcw = *(const GAS u32x4*)(pr + 512), vcw = *(const GAS u32x4*)(pr + 1024);
        const u32x4 rpw = first ? z4 : *(const GAS u32x4*)pp, kpw = first ? z4 : *(const GAS u32x4*)(pp + 512), vpw = first ? z4 : *(const GAS u32x4*)(pp + 1024);
        const u32x4 wlw = *(const GAS u32x4*)(LW + (size_t)row * 1536 + c0), alw = *(const GAS u32x4*)(LW + (size_t)row * 1536 + 512 + c0);
        float rc[8], kc[8], vc[8], rp[8], kp[8], vp[8], wl[8], al[8];
        unpack8(rcw, rc); unpack8(kcw, kc); unpack8(vcw, vc); unpack8(rpw, rp); unpack8(kpw, kp); unpack8(vpw, vp); unpack8(wlw, wl); unpack8(alw, al);
        float rr[8], om[8], k2[8], kk[8], ka[8], vv[8]; float ss = 0.f;
#pragma unroll
        for (int e = 0; e < 8; ++e) { rr[e] = rc[e] + (rp[e] - rc[e]) * mur[e]; const float k = kc[e] + (kp[e] - kc[e]) * muk[e]; vv[e] = vc[e] + (vp[e] - vc[e]) * muv[e];
            om[e] = 1.f - __expf(-0.6065306597126334f * fsig(w0c[e] + wl[e]));
            const float a = fsig(a0c[e] + al[e]);
            kk[e] = k * kkc[e]; ss += kk[e] * kk[e]; k2[e] = k * (1.f + (a - 1.f) * kac[e]); ka[e] = a; }
        ss = allreduce8(ss);
        const float inv = 1.f / fmaxf(sqrtf(ss), 1e-12f);
#pragma unroll
        for (int e = 0; e < 8; ++e) { kk[e] *= inv; ka[e] *= kk[e]; }
        GAS bf16* o = SI + ((size_t)((row >> 11) * 8 + h) * 2048 + (row & 2047)) * 384 + (lane & 7) * 8;
        *(GAS u32x4*)o = pack8(rr); *(GAS u32x4*)(o + 64) = pack8(om); *(GAS u32x4*)(o + 128) = pack8(k2); *(GAS u32x4*)(o + 192) = pack8(kk); *(GAS u32x4*)(o + 256) = pack8(ka); *(GAS u32x4*)(o + 320) = pack8(vv);
    }
}
__device__ __forceinline__ void rwkv_post_rows(int wid_s, KP p_, int l, int r, int dummy) {
    KP p = p_; asm volatile("" : "+s"(p));
    unsigned char* ws = p->ws;
    const int tid_ = mk_tid(wid_s);
    const int tid = tid_, lane = tid & 63, wv = tid >> 6, c0 = lane * 8, h = lane >> 3;
    const GAS bf16* P = (const GAS bf16*)(ws + R_P); const GAS bf16* SI = (const GAS bf16*)(ws + R_SI); GAS bf16* Y = (GAS bf16*)(ws + WS_Y) + (size_t)r * TH * 1536;
    float rkc[8], lng[8], lnb[8];
    ld8f((const GAS float*)p->in[I_RK] + l * 512 + c0, rkc); ld8f((const GAS float*)p->in[I_LNG] + l * 512 + c0, lng); ld8f((const GAS float*)p->in[I_LNB] + l * 512 + c0, lnb);
    for (int row = blockIdx.x * 8 + wv; row < TH; row += gridDim.x * 8) {
        const GAS bf16* si = SI + ((size_t)((row >> 11) * 8 + h) * 2048 + (row & 2047)) * 384 + (lane & 7) * 8;
        const u32x4 rw = *(const GAS u32x4*)si, kw = *(const GAS u32x4*)(si + 128), vw = *(const GAS u32x4*)(si + 320);
        const u32x4 gw = *(const GAS u32x4*)(P + (size_t)row * NP + c0);
        GAS bf16* yp = Y + (size_t)row * 1536 + c0;
        const u32x4 yw = *(const GAS u32x4*)yp;
        float rr[8], k2[8], vv[8], gg[8], y[8];
        unpack8(rw, rr); unpack8(kw, k2); unpack8(vw, vv); unpack8(gw, gg); unpack8(yw, y);
        float sy = 0.f, sb = 0.f;
#pragma unroll
        for (int e = 0; e < 8; ++e) { sy += y[e]; sb += rr[e] * k2[e] * rkc[e]; }
        const float mean = allreduce8(sy) * (1.f / 64.f); const float bonus = allreduce8(sb);
        float sv = 0.f;
#pragma unroll
        for (int e = 0; e < 8; ++e) { y[e] -= mean; sv += y[e] * y[e]; }
        const float rs = rsqrtf(allreduce8(sv) * (1.f / 64.f) + 64e-5f);
#pragma unroll
        for (int e = 0; e < 8; ++e) y[e] = (y[e] * rs * lng[e] + lnb[e] + bonus * vv[e]) * gg[e];
        if (dummy) yp = (GAS bf16*)(ws + R_P) + (size_t)row * NP + 600 + c0;
        *(GAS u32x4*)yp = pack8(y);
    }
}

__device__ __forceinline__ float gelu_tanh(float x) { const float u = 0.7978845608028654f * (x + 0.044715f * x * x * x); return x * fsig(2.f * u); }
__device__ __forceinline__ void lru_unit(int wid_s, KP p_, int l, int r, int bl, int n, float* ldsf) {
    KP p = p_; asm volatile("" : "+s"(p));
    unsigned char* ws = p->ws;
    const int tid_ = mk_tid(wid_s);
    const int tid = tid_, lane = tid & 63, wv = tid >> 6, g = lane >> 4, j = lane & 15;
    const GAS bf16* P = (const GAS bf16*)(ws + R_P) + (size_t)bl * 2048 * NP; GAS bf16* Yb = (GAS bf16*)(ws + WS_Y) + ((size_t)(r * 4 + bl) * 2048) * 1536 + 512;
    const int cg_ = n * 64 + lane;
    float* s_xc = ldsf;
    float* s_a = ldsf + 8192;
    float* s_u = ldsf + 16384;
    float* s_AH = ldsf + 24576;
    unsigned char* s_xb16 = (unsigned char*)ldsf + 102400;
    unsigned char* s_wt16 = (unsigned char*)ldsf + 120832;
    LBAR();
    for (int e = tid; e < 8192; e += 512) { const int jj = e >> 6, ii = e & 63;
        const float w = (jj < 64) ? p->in[I_WA][((size_t)l * 8 + n) * 4096 + ii * 64 + jj] : p->in[I_WX][((size_t)l * 8 + n) * 4096 + ii * 64 + (jj - 64)];
        *(bf16*)(s_wt16 + (jj * 72 + ii) * 2) = (bf16)f2bf(w); }
    const float cw0 = p->in[I_CW][(l * 4 + 0) * 512 + cg_], cw1 = p->in[I_CW][(l * 4 + 1) * 512 + cg_], cw2 = p->in[I_CW][(l * 4 + 2) * 512 + cg_], cw3 = p->in[I_CW][(l * 4 + 3) * 512 + cg_];
    const float cb = p->in[I_CB][l * 512 + cg_];
    float ba4[4], bx4[4], sp4[4];
#pragma unroll
    for (int n4 = 0; n4 < 4; ++n4) { const int c = n * 64 + 16 * n4 + j; ba4[n4] = p->in[I_BA][l * 512 + c]; bx4[n4] = p->in[I_BX][l * 512 + c];
        sp4[n4] = -8.f * 1.4426950408889634f * log1pf(__expf(-p->in[I_LAM][l * 512 + c])); }
    float hcar = 0.f;
    for (int tile = 0; tile < 16; ++tile) {
        const int t0 = tile * 128 + wv * 16;
        float xc[16]; unsigned short gbr[16];
        {
            float x3 = (t0 >= 3) ? bf2f(P[(size_t)(t0 - 3) * NP + 1792 + cg_]) : 0.f, x2 = (t0 >= 2) ? bf2f(P[(size_t)(t0 - 2) * NP + 1792 + cg_]) : 0.f, x1 = (t0 >= 1) ? bf2f(P[(size_t)(t0 - 1) * NP + 1792 + cg_]) : 0.f;
#pragma unroll
            for (int i = 0; i < 16; ++i) { const float x0 = bf2f(P[(size_t)(t0 + i) * NP + 1792 + cg_]);
                xc[i] = cw0 * x3 + cw1 * x2 + cw2 * x1 + cw3 * x0 + cb; x3 = x2; x2 = x1; x1 = x0; }
#pragma unroll
            for (int i = 0; i < 16; ++i) gbr[i] = P[(size_t)(t0 + i) * NP + 2304 + cg_];
        }
        LBAR();
#pragma unroll
        for (int i = 0; i < 16; ++i) { s_xc[(wv * 16 + i) * 64 + lane] = xc[i]; *(bf16*)(s_xb16 + ((wv * 16 + i) * 72 + lane) * 2) = (bf16)f2bf(xc[i]); }
        LBAR();
        {
            f32x4 acc[8];
            const bf16x8 a0 = *(const bf16x8*)(s_xb16 + ((16 * wv + j) * 72 + 8 * g) * 2), a1 = *(const bf16x8*)(s_xb16 + ((16 * wv + j) * 72 + 32 + 8 * g) * 2);
#pragma unroll
            for (int nn = 0; nn < 8; ++nn) { acc[nn] = (f32x4){0.f, 0.f, 0.f, 0.f};
                const bf16x8 b0 = *(const bf16x8*)(s_wt16 + ((16 * nn + j) * 72 + 8 * g) * 2), b1 = *(const bf16x8*)(s_wt16 + ((16 * nn + j) * 72 + 32 + 8 * g) * 2);
                acc[nn] = __builtin_amdgcn_mfma_f32_16x16x32_bf16(a0, b0, acc[nn], 0, 0, 0); acc[nn] = __builtin_amdgcn_mfma_f32_16x16x32_bf16(a1, b1, acc[nn], 0, 0, 0); }
#pragma unroll
            for (int n4 = 0; n4 < 4; ++n4)
#pragma unroll
                for (int rr = 0; rr < 4; ++rr) { const int tk = 16 * wv + 4 * g + rr, c = 16 * n4 + j;
                    const float rg = fsig(acc[n4][rr] + ba4[n4]), ig = fsig(acc[n4 + 4][rr] + bx4[n4]);
                    const float a = __builtin_amdgcn_exp2f(sp4[n4] * rg);
                    const float uu = __builtin_amdgcn_sqrtf(fmaxf(1.f - a * a, 0.f)) * (ig * s_xc[tk * 64 + c]);
                    s_a[tk * 64 + c] = a; s_u[tk * 64 + c] = uu; }
        }
        LBAR();
        float av[16], uv[16]; float A = 1.f, H = 0.f;
#pragma unroll
        for (int i = 0; i < 16; ++i) { av[i] = s_a[(wv * 16 + i) * 64 + lane]; uv[i] = s_u[(wv * 16 + i) * 64 + lane]; A *= av[i]; H = av[i] * H + uv[i]; }
        s_AH[(wv * 64 + lane) * 2] = A; s_AH[(wv * 64 + lane) * 2 + 1] = H;
        LBAR();
        float hin = hcar, hall = hcar;
#pragma unroll
        for (int w = 0; w < 8; ++w) { const float Aw = s_AH[(w * 64 + lane) * 2], Hw = s_AH[(w * 64 + lane) * 2 + 1]; hall = Aw * hall + Hw; if (w < wv) hin = hall; }
        hcar = hall;
        float hh = hin;
#pragma unroll
        for (int i = 0; i < 16; ++i) { hh = av[i] * hh + uv[i];
            Yb[(size_t)(t0 + i) * 1536 + cg_] = (bf16)f2bf(hh * gelu_tanh(bf2f(gbr[i]))); }
    }
    LBAR();
}

__device__ __forceinline__ void kfix_rows(int wid_s, KP p_, int l, int r) {
    KP p = p_; asm volatile("" : "+s"(p));
    unsigned char* ws = p->ws;
    const int tid_ = mk_tid(wid_s);
    const int tid = tid_, lane = tid & 63, wv = tid >> 6, h = lane >> 3, sub = lane & 7;
    const GAS bf16* P = (const GAS bf16*)(ws + R_P); GAS bf16* Km = (GAS bf16*)(ws + R_KM);
    const float* kg = p->in[I_KG] + l * 96; const int* pos = (const int*)p->in[I_POS] + r * TH;
    for (int row = blockIdx.x * 8 + wv; row < TH; row += gridDim.x * 8) {
        GAS bf16* kp = Km + (size_t)row * 768 + h * 96;
        const u32x4 w = *(const GAS u32x4*)(kp + 8 * sub);
        float nv[8] = {bflo(w.x), bfhi(w.x), bflo(w.y), bfhi(w.y), bflo(w.z), bfhi(w.z), bflo(w.w), bfhi(w.w)};
        const unsigned k1 = *(const GAS unsigned*)(P + (size_t)row * NP + 3200 + 2 * sub), k2 = *(const GAS unsigned*)(P + (size_t)row * NP + 3216 + 2 * sub);
        float x1a = bflo(k1), x1b = bfhi(k1), x2a = bflo(k2), x2b = bfhi(k2);
        float ss = x1a * x1a + x1b * x1b + x2a * x2a + x2b * x2b;
#pragma unroll
        for (int e = 0; e < 8; ++e) ss += nv[e] * nv[e];
        ss += __shfl_xor(ss, 1); ss += __shfl_xor(ss, 2); ss += __shfl_xor(ss, 4);
        const float rs = rsqrtf(ss * (1.f / 96.f) + 1e-6f);
#pragma unroll
        for (int e = 0; e < 8; ++e) nv[e] *= rs * kg[8 * sub + e];
        x1a *= rs * kg[64 + 2 * sub]; x1b *= rs * kg[65 + 2 * sub]; x2a *= rs * kg[80 + 2 * sub]; x2b *= rs * kg[81 + 2 * sub];
        const int ps = pos[row]; float ca, sa, cb, sb; rope_cs(ps, 2 * sub, ca, sa); rope_cs(ps, 2 * sub + 1, cb, sb);
        u32x4 o; o.x = pk2(nv[0], nv[1]); o.y = pk2(nv[2], nv[3]); o.z = pk2(nv[4], nv[5]); o.w = pk2(nv[6], nv[7]);
        *(GAS u32x4*)(kp + 8 * sub) = o;
        *(GAS unsigned*)(kp + 64 + 2 * sub) = pk2(x1a * ca - x2a * sa, x1b * cb - x2b * sb);
        *(GAS unsigned*)(kp + 80 + 2 * sub) = pk2(x2a * ca + x1a * sa, x2b * cb + x1b * sb);
    }
}
__device__ __forceinline__ void mkfix_rows(int wid_s, KP p_, int l) {
    KP p = p_; asm volatile("" : "+s"(p));
    unsigned char* ws = p->ws;
    const int tid_ = mk_tid(wid_s);
    const int tid = tid_, lane = tid & 63, wv = tid >> 6, h = lane >> 4, sub = lane & 15;
    bf16* mk = (bf16*)(ws + R_MK); const float* kg = p->in[I_XKG] + l * 128;
    for (int row = blockIdx.x * 8 + wv; row < 2048; row += gridDim.x * 8) {
        bf16* kp = mk + (size_t)row * 512 + h * 128 + 8 * sub;
        const u32x4 w = *(const u32x4*)kp;
        float nv[8] = {bflo(w.x), bfhi(w.x), bflo(w.y), bfhi(w.y), bflo(w.z), bfhi(w.z), bflo(w.w), bfhi(w.w)};
        float ss = 0.f;
#pragma unroll
        for (int e = 0; e < 8; ++e) ss += nv[e] * nv[e];
        ss += __shfl_xor(ss, 1); ss += __shfl_xor(ss, 2); ss += __shfl_xor(ss, 4); ss += __shfl_xor(ss, 8);
        const float rs = rsqrtf(ss * (1.f / 128.f) + 1e-6f);
#pragma unroll
        for (int e = 0; e < 8; ++e) nv[e] *= rs * kg[8 * sub + e];
        u32x4 o; o.x = pk2(nv[0], nv[1]); o.y = pk2(nv[2], nv[3]); o.z = pk2(nv[4], nv[5]); o.w = pk2(nv[6], nv[7]);
        *(u32x4*)kp = o;
    }
}
__device__ __forceinline__ void memb_rows(int wid_s, KP p_) {
    KP p = p_; asm volatile("" : "+s"(p));
    unsigned char* ws = p->ws;
    const int tid_ = mk_tid(wid_s);
    const int tid = tid_, lane = tid & 63, wv = tid >> 6;
    const float* mem = p->in[I_MEM]; bf16* memb = (bf16*)(ws + R_MEMB);
    for (int row = blockIdx.x * 8 + wv; row < 2048; row += gridDim.x * 8) {
        const f32x4* xr = (const f32x4*)(mem + (size_t)row * 1024) + lane; f32x4 v[4]; float s = 0.f;
#pragma unroll
        for (int jq = 0; jq < 4; ++jq) { v[jq] = xr[64 * jq]; s += (v[jq].x * v[jq].x + v[jq].y * v[jq].y) + (v[jq].z * v[jq].z + v[jq].w * v[jq].w); }
        const float rs = rsqrtf(wave_sum(s) * (1.f / 1024.f) + 1e-6f);
#pragma unroll
        for (int jq = 0; jq < 4; ++jq) { u32x2 w; w.x = pk2(v[jq].x * rs, v[jq].y * rs); w.y = pk2(v[jq].z * rs, v[jq].w * rs); *((u32x2*)(memb + (size_t)row * 1024) + lane + 64 * jq) = w; }
    }
}

#define XB_TMO      128
#define XB_XCNT(j)  (256  + 64 * (j))
#define XB_XSUB(j)  (1280 + 64 * (j))
#define XB_XGEN(j)  (2304 + 64 * (j))
#define XB_TOP      3328
#define XB_TOPGEN   3392
#define XCD_BAR_WORDS 3456
#define XB_SPIN_CAP (1u << 22)
__device__ __forceinline__ unsigned xb_ld(unsigned* p)              { return __hip_atomic_load(p, __ATOMIC_RELAXED, __HIP_MEMORY_SCOPE_AGENT); }
__device__ __forceinline__ unsigned xb_add(unsigned* p, unsigned v) { return __hip_atomic_fetch_add(p, v, __ATOMIC_RELAXED, __HIP_MEMORY_SCOPE_AGENT); }
__device__ __forceinline__ unsigned xb_xcc_id() { return (unsigned)__builtin_amdgcn_s_getreg((3 << 11) | 20) & 0xFu; }
#define XB_SPIN(cond, bar) do { unsigned _sp = 0; while (cond) { __builtin_amdgcn_s_sleep(1); \
    if ((++_sp & 255u) == 0u) { if (xb_ld(&(bar)[XB_TMO])) break; if (_sp > XB_SPIN_CAP) { atomicAdd(&(bar)[XB_TMO], 1u); break; } } } } while (0)
__device__ __forceinline__ void xcd_barrier_complete(unsigned* bar, unsigned x, unsigned& nloc, unsigned& nx) {
    const unsigned G = gridDim.x;
    unsigned sum, cnt, mine, sp = 0u;
    for (;;) {
        sum = 0u; cnt = 0u; mine = 0u;
#pragma unroll
        for (unsigned j = 0; j < 16; ++j) { const unsigned c = xb_ld(&bar[XB_XCNT(j)]); sum += c; cnt += (c > 0u) ? 1u : 0u; mine = (j == x) ? c : mine; }
        if (sum == G) break;
        __builtin_amdgcn_s_sleep(1);
        if ((++sp & 255u) == 0u) { if (xb_ld(&bar[XB_TMO])) break; if (sp > XB_SPIN_CAP) { atomicAdd(&bar[XB_TMO], 1u); break; } }
    }
    nloc = mine > 0u ? mine : 1u; nx = cnt > 0u ? cnt : 1u;
}
__device__ __forceinline__ void grid_barrier1(int wid_s, unsigned* bar, volatile unsigned* st) {
    asm volatile("s_waitcnt vmcnt(0)" ::: "memory");
    __syncthreads();
    if (mk_tid(wid_s) == 0) {
        const unsigned x = xb_xcc_id();
        __builtin_amdgcn_s_waitcnt(0);
        unsigned nloc = st[0], nx = st[1];
        if (nloc == 0u) { xcd_barrier_complete(bar, x, nloc, nx); st[0] = nloc; st[1] = nx; }
        const unsigned old = xb_add(&bar[XB_XSUB(x)], 1u);
        const unsigned gen = old / nloc;
        if (old + 1u == (gen + 1u) * nloc) {
            __builtin_amdgcn_fence(__ATOMIC_RELEASE, "agent");
            asm volatile("s_waitcnt vmcnt(0)" ::: "memory");
            const unsigned og = xb_add(&bar[XB_TOP], 1u);
            const unsigned tg = og / nx;
            if (og + 1u == (tg + 1u) * nx) xb_add(&bar[XB_TOPGEN], 1u);
            else XB_SPIN(xb_ld(&bar[XB_TOPGEN]) == tg, bar);
            __builtin_amdgcn_fence(__ATOMIC_ACQUIRE, "agent");
            xb_add(&bar[XB_XGEN(x)], 1u);
            asm volatile("s_waitcnt vmcnt(0)" ::: "memory");
        } else {
            XB_SPIN(xb_ld(&bar[XB_XGEN(x)]) == gen, bar);
            __builtin_amdgcn_fence(__ATOMIC_ACQUIRE, "agent");
            asm volatile("s_waitcnt vmcnt(0)" ::: "memory");
        }
    }
    __syncthreads();
}
__device__ __forceinline__ void grid_barrier(int wid_s, unsigned* bar, volatile unsigned* st) { int nb = 1 + RB(8); asm volatile("" : "+s"(nb)); for (int q = 0; q < nb; ++q) grid_barrier1(wid_s, bar, st); }
template <class Epi>
__device__ __forceinline__ void run_gemm(int wid_s, LAS unsigned char* lds, const bf16* A, int lda, const bf16* Bt, int M, int N, int K, const Epi& E, int shift = 0) {
    int bx_ = blockIdx.x, gx_ = gridDim.x; asm volatile("" : "+s"(bx_), "+s"(gx_), "+s"(K), "+s"(lda));
    pg8::Gemm g{A, Bt, M, N, K, lda}; pg8::StaticOrder S; S.init(M, N, gx_, (bx_ + shift) % gx_);
    if (ON(1)) pg8::gemm_phase<Epi, pg8::StaticOrder>(wid_s, lds, g, S, E);
}

__device__ __forceinline__ unsigned char* wsl_(KP p) { unsigned char* w = p->ws; asm volatile("" : "+s"(w)); return w; }
__global__ void __launch_bounds__(512, 2) fwd_kernel(Params parg) {
    KP p = (KP)__builtin_amdgcn_kernarg_segment_ptr();
    extern __shared__ __attribute__((aligned(16))) unsigned char lds_raw[];
    const int wid_s = __builtin_amdgcn_readfirstlane((int)threadIdx.x >> 6);
    LAS unsigned char* lds3 = (LAS unsigned char*)lds_raw;
    unsigned char* lds = lds_raw; float* ldsf = (float*)lds_raw;
    unsigned char* ws = p->ws;
    const int bid = blockIdx.x;
    unsigned* ctl = (unsigned*)(wsl_(p) + WS_CTL);
    bf16* xb = (bf16*)(wsl_(p) + WS_XB); float* part = (float*)(wsl_(p) + WS_PART); float* pq = (float*)(wsl_(p) + WS_PQ); float* pkv = (float*)(wsl_(p) + WS_PKV);
    bf16* Y = (bf16*)(wsl_(p) + WS_Y);
    float* xcur = p->out;
    volatile unsigned* bst = (volatile unsigned*)(lds + QIDX_OFF + 16);
    if (threadIdx.x == 0) { bst[0] = 0u; bst[1] = 0u; (void)xb_add(&ctl[1024 + XB_XCNT(xb_xcc_id())], 1u); }
    __syncthreads();

    for (int l_ = 0; l_ < 2; ++l_) {
        int l = l_; asm volatile("" : "+s"(l));
        if (l == 0) { REPLOOP(0) { if (ON(0)) phase_convert(wid_s, p, l, ldsf, bid, (int)gridDim.x);
        grid_barrier(wid_s, ctl + 1024, bst); } }
        for (int r_ = 0; r_ < 2; ++r_) {
            int r = r_; asm volatile("" : "+s"(r));
            { REPLOOP(1) { EpiP E{(bf16*)(wsl_(p) + R_P), part + (size_t)r * TH * 16, pq, pkv};
              run_gemm(wid_s, lds3, xb + (size_t)r * TH * 1024, 1024, (const bf16*)(wsl_(p) + W_IN), TH, NP, 1024, E);
              if (r == 0 && q == 0 && bid >= 160) { __syncthreads(); phase_convert_mid(wid_s, p, l, ldsf, (bid - 160) * 8 + (mk_tid(wid_s) >> 6), (int)(gridDim.x - 160) * 8); __syncthreads(); }
            grid_barrier(wid_s, ctl + 1024, bst); } }
            { REPLOOP(2) {
            if (ON(2)) lora_act_rows(wid_s, p, l, r);
            { EpiQ E{(bf16*)(wsl_(p) + R_Q), pq}; run_gemm(wid_s, lds3, (const bf16*)(wsl_(p) + R_P) + 2816, NP, (const bf16*)(wsl_(p) + W_MQ), TH, 768, 256, E); }
            { EpiKV E{(bf16*)(wsl_(p) + R_KM), (bf16*)(wsl_(p) + R_VT), pkv}; run_gemm(wid_s, lds3, (const bf16*)(wsl_(p) + R_P) + 3072, NP, (const bf16*)(wsl_(p) + W_MKV), TH, 1024, 128, E, 128); }
            grid_barrier(wid_s, ctl + 1024, bst); } }
            { REPLOOP(9) { EpiBf E{Y + (size_t)r * TH * 1536, 1536}; run_gemm(wid_s, lds3, Y + (size_t)r * TH * 1536 + 1024, 1536, (const bf16*)(wsl_(p) + W_BWA), TH, 1024, 128, E);
            grid_barrier(wid_s, ctl + 1024, bst); } }
            { REPLOOP(13) { if (ON(2)) si_build_rows(wid_s, p, l, r); } }
            if (ON(7)) kfix_rows(wid_s, p, l, r);
            grid_barrier(wid_s, ctl + 1024, bst);
            { REPLOOP(3) {
            if (ON(3) && !(q && RB(10)) && bid < 128) { const int xcd = bid & 7, idx = bid >> 3, hh = xcd * 4 + (idx >> 2), quarter = idx & 3;
                if (q == 0 || SCANMODE == 0) rwkv_scan_unit<0>(wid_s, (const bf16*)(wsl_(p) + R_SI) + (size_t)hh * 2048 * 384, Y + ((size_t)(r * 4 + (hh >> 3)) * 2048) * 1536 + (hh & 7) * 64, 1536, quarter, ldsf);
                else rwkv_scan_unit<SCANMODE>(wid_s, (const bf16*)(wsl_(p) + R_SI) + (size_t)hh * 2048 * 384, (bf16*)(wsl_(p) + R_P) + ((size_t)(hh >> 3) * 2048) * NP + 600 + (hh & 7) * 64, NP, quarter, ldsf); }
            else if (ON(4) && !(q && RB(11)) && bid >= 128 && bid < 160) { const int uu = bid - 128; lru_unit(wid_s, p, l, r, uu >> 3, uu & 7, ldsf); }
            else if (q == 0) { EpiBf E{(bf16*)(wsl_(p) + R_P), NP}; run_gemm(wid_s, lds3, (const bf16*)(wsl_(p) + WS_AG), 128, (const bf16*)(wsl_(p) + W_GUP), TH, 512, 128, E, 96); }
            {
                unsigned* ctr = ctl + q * 4 + l * 2 + r; volatile int* qidx = (volatile int*)(lds + QIDX_OFF);
                for (;;) {
                    __syncthreads();
                    if (mk_tid(wid_s) == 0) *qidx = (int)atomicAdd(ctr, 1u);
                    __syncthreads();
                    const int u = *qidx;
                    if (u >= 512 || !ON(5) || (q && RB(12))) break;
                    const int qb = 15 - (u >> 5), bh = u & 31, bl = bh >> 3, h = bh & 7;
                    attn_unit<96, 64, true, true>(wid_s, lds, (const bf16*)(wsl_(p) + R_Q) + (size_t)bl * 2048 * 768 + h * 96, 768, (const bf16*)(wsl_(p) + R_KM) + (size_t)bl * 2048 * 768 + h * 96, 768,
                        (const bf16*)(wsl_(p) + R_VT) + (size_t)(bl * 8 + h) * 64 * 2048, 2048, Y + ((size_t)(r * 4 + bl) * 2048) * 1536 + 1024 + h * 64, 1536,
                        qb * 128, 2 * qb + 2, p->in[I_QG] + l * 96, (const int*)p->in[I_POS] + (r * 4 + bl) * 2048, 0.14724444527f  );
                }
            }
            grid_barrier(wid_s, ctl + 1024, bst); } }
            { REPLOOP(16) { if (ON(6)) rwkv_post_rows(wid_s, p, l, r, q); } }
            grid_barrier(wid_s, ctl + 1024, bst);
        }
        if (ON(7)) memb_rows(wid_s, p);
        { REPLOOP(4) {
        for (int n = 0; n < 3; ++n) {
            { EpiGate E{(bf16*)(wsl_(p) + R_GS), part, p->in[I_BGATE] + l * 3072 + n * 1024}; run_gemm(wid_s, lds3, xb, 1024, (const bf16*)(wsl_(p) + W_GATE) + (size_t)n * 1024 * 1024, T, 1024, 1024, E); }
            { EpiProj E{(const bf16*)(wsl_(p) + R_GS), (float*)(wsl_(p) + R_MS), (bf16*)(wsl_(p) + R_MG), n}; run_gemm(wid_s, lds3, Y + n * 512, 1536, (const bf16*)(wsl_(p) + W_BR) + (size_t)n * 1024 * 512, T, 1024, 512, E); }
        }
        grid_barrier(wid_s, ctl + 1024, bst); } }
        { int nw = 1 + RB(15); asm volatile("" : "+s"(nw)); for (int q = 0; q < nw; ++q) { EpiRes E{nullptr, xb, part, q + 1 < nw}; run_gemm(wid_s, lds3, (const bf16*)(wsl_(p) + R_MG), 1024, (const bf16*)(wsl_(p) + W_OUT), T, 1024, 1024, E); if (q + 1 < nw) grid_barrier(wid_s, ctl + 1024, bst); } }
        { REPLOOP(19) { EpiMemKV E{(bf16*)(wsl_(p) + R_MK), (bf16*)(wsl_(p) + R_MVT)}; run_gemm(wid_s, lds3, (const bf16*)(wsl_(p) + R_MEMB), 1024, (const bf16*)(wsl_(p) + W_XKV), 2048, 1024, 1024, E); } }
        grid_barrier(wid_s, ctl + 1024, bst);
        if (ON(7)) mkfix_rows(wid_s, p, l);
        if (bid >= 128) { __syncthreads(); phase_convert_ffn(wid_s, p, l, ldsf, (bid - 128) * 8 + (mk_tid(wid_s) >> 6), (int)(gridDim.x - 128) * 8); __syncthreads(); }
        { REPLOOP(5) { EpiXQ E{(bf16*)(wsl_(p) + R_XQ), part}; run_gemm(wid_s, lds3, xb, 1024, (const bf16*)(wsl_(p) + W_XQ), T, 512, 1024, E);
        grid_barrier(wid_s, ctl + 1024, bst); } }
        { REPLOOP(6) {
        if (ON(8)) for (int u = bid; u < 512; u += gridDim.x) { const int qb = u & 15, bh = u >> 4, b = bh >> 2, h = bh & 3;
            attn_unit<128, 128, false, false>(wid_s, lds, (const bf16*)(wsl_(p) + R_XQ) + (size_t)b * 2048 * 512 + h * 128, 512, (const bf16*)(wsl_(p) + R_MK) + (size_t)b * 256 * 512 + h * 128, 512,
                (const bf16*)(wsl_(p) + R_MVT) + (size_t)(b * 4 + h) * 128 * 256, 256, (bf16*)(wsl_(p) + R_XO) + (size_t)b * 2048 * 512 + h * 128, 512,
                qb * 128, 4, p->in[I_XQG] + l * 128, nullptr, 0.12751743082f  ); }
        grid_barrier(wid_s, ctl + 1024, bst); } }
        { int nw = 1 + RB(17); asm volatile("" : "+s"(nw)); for (int q = 0; q < nw; ++q) { EpiRes E{nullptr, xb, part, q + 1 < nw}; run_gemm(wid_s, lds3, (const bf16*)(wsl_(p) + R_XO), 512, (const bf16*)(wsl_(p) + W_XO), T, 1024, 512, E); if (q + 1 < nw) grid_barrier(wid_s, ctl + 1024, bst); } }
        grid_barrier(wid_s, ctl + 1024, bst);
        { REPLOOP(7) { EpiFFN1 E{(bf16*)(wsl_(p) + R_H), part}; run_gemm(wid_s, lds3, xb, 1024, (const bf16*)(wsl_(p) + W_13), T, 5632, 1024, E);
        if (l == 0 && q == 0 && bid >= 128) { __syncthreads(); phase_convert(wid_s, p, 1, ldsf, bid - 128, (int)gridDim.x - 128); __syncthreads(); }
        grid_barrier(wid_s, ctl + 1024, bst); } }
        { int nw = 1 + RB(18); asm volatile("" : "+s"(nw)); for (int q = 0; q < nw; ++q) { EpiRes E{l == 1 ? xcur : nullptr, xb, part, q + 1 < nw}; run_gemm(wid_s, lds3, (const bf16*)(wsl_(p) + R_H), DFF, (const bf16*)(wsl_(p) + W_2), T, 1024, DFF, E); if (q + 1 < nw) grid_barrier(wid_s, ctl + 1024, bst); } }
        grid_barrier(wid_s, ctl + 1024, bst);
    }
}

extern "C" void kernel_launch(void* const* d_in, const int* in_sizes, int n_in, void* d_out, int out_size, void* d_ws, size_t ws_size, hipStream_t stream) {
    static int grid = 0;
    if (grid == 0) {
        int dev = 0, cus = 0, per_cu = 0;
        if (n_in != 43 || ws_size < WS_END) { fprintf(stderr, "kernel_launch: unexpected n_in %d / ws %zu\n", n_in, ws_size); grid = -1; return; }
        (void)hipGetDevice(&dev);
        (void)hipDeviceGetAttribute(&cus, hipDeviceAttributeMultiprocessorCount, dev);
        (void)hipFuncSetAttribute((const void*)fwd_kernel, hipFuncAttributeMaxDynamicSharedMemorySize, LDS_BYTES);
        (void)hipOccupancyMaxActiveBlocksPerMultiprocessor(&per_cu, (const void*)fwd_kernel, 512, LDS_BYTES);
        fprintf(stderr, "cus %d per_cu %d ws %zu\n", cus, per_cu, ws_size);
        grid = cus * (per_cu >= 1 ? 1 : 0);
        if (grid <= 0) { grid = -1; return; }
    }
    if (grid < 0) return;
    Params p{};
    for (int i = 0; i < 43; ++i) p.in[i] = (const float*)d_in[i];
    p.out = (float*)d_out; p.ws = (unsigned char*)d_ws;
    (void)hipMemsetAsync((char*)d_ws + WS_CTL, 0, 32768, stream);
    void* args[] = {&p};
    hipError_t e = hipLaunchCooperativeKernel((const void*)fwd_kernel, dim3(grid), dim3(512), args, LDS_BYTES, stream);
    if (e != hipSuccess) fprintf(stderr, "cooperative launch failed: %s (grid %d)\n", hipGetErrorString(e), grid);
}
```

```cpp
#include <hip/hip_runtime.h>
#include <cstdio>
#include <cstdint>

#define LAS __attribute__((address_space(3)))
#define GAS __attribute__((address_space(1)))
typedef unsigned short bf16;
typedef short bf16x8 __attribute__((ext_vector_type(8)));
typedef float f32x4 __attribute__((ext_vector_type(4)));
typedef float f32x2 __attribute__((ext_vector_type(2)));
typedef unsigned u32x4 __attribute__((ext_vector_type(4)));
typedef unsigned u32x2 __attribute__((ext_vector_type(2)));

__device__ __forceinline__ unsigned f2bf(float f) { unsigned u = __builtin_bit_cast(unsigned, f); return (u + 0x7fffu + ((u >> 16) & 1u)) >> 16; }
typedef __bf16 bf16x2_t __attribute__((ext_vector_type(2)));
__device__ __forceinline__ unsigned pk2(float lo, float hi) { const f32x2 v = {lo, hi}; const bf16x2_t b = __builtin_convertvector(v, bf16x2_t); return __builtin_bit_cast(unsigned, b); }
__device__ __forceinline__ float bf2f(bf16 b) { return __builtin_bit_cast(float, (unsigned)b << 16); }
__device__ __forceinline__ float bflo(unsigned u) { return __builtin_bit_cast(float, u << 16); }
__device__ __forceinline__ float bfhi(unsigned u) { return __builtin_bit_cast(float, u & 0xffff0000u); }
__device__ __forceinline__ u32x4 pk8(f32x4 a, f32x4 b) { u32x4 w; w.x = pk2(a.x, a.y); w.y = pk2(a.z, a.w); w.z = pk2(b.x, b.y); w.w = pk2(b.z, b.w); return w; }
__device__ __forceinline__ float sigmoidf_(float x) { return 1.f / (1.f + __expf(-x)); }
__device__ __forceinline__ float fsig(float x) { return __builtin_amdgcn_rcpf(1.f + __builtin_amdgcn_exp2f(-1.4426950408889634f * x)); }
__device__ __forceinline__ int mk_tid(int wid_s) { int t = wid_s * 64 + (int)__builtin_amdgcn_mbcnt_hi(~0u, __builtin_amdgcn_mbcnt_lo(~0u, 0u)); asm volatile("" : "+v"(t)); return t; }
#define LBAR() asm volatile("s_waitcnt lgkmcnt(0)\n\ts_barrier" ::: "memory")
__device__ __forceinline__ float wave_sum(float v) {
#pragma unroll
    for (int o = 1; o < 64; o <<= 1) v += __shfl_xor(v, o);
    return v;
}

namespace pg8 {
#define PG8_LAS __attribute__((address_space(3)))
typedef unsigned short bf16_t;
constexpr int BM = 256, BK = 64, HALF = 128, HTB = HALF * BK * 2, STAGE_BYTES = 8 * HTB, NXCD = 8, WGM = 8;
__host__ __device__ __forceinline__ int lds_byte(int r, int c) { const int st = (r >> 4) * 2 + (c >> 5), rr = r & 15, cc = c & 31, ob = rr * 64 + cc * 2; return st * 1024 + (ob ^ (((ob >> 9) & 1) << 5)); }
__host__ __device__ __forceinline__ void stage_rc(int b, int& R, int& C) { const int st = b / 1024, sb = b % 1024, swz = sb ^ (((sb >> 9) & 1) << 5); R = (st >> 1) * 16 + swz / 64; C = (st & 1) * 32 + (swz % 64) / 2; }
__host__ __device__ __forceinline__ int perm32(int rho) { const int n = rho >> 4, i = rho & 15; return 8 * (i >> 2) + 4 * n + (i & 3); }
struct Unit { int pm, pn; };
struct Gemm { const bf16_t* A; const bf16_t* Bt; int M, N, K, lda; };
struct StaticOrder {
    int nM, nN, nwg, G, c;
    __host__ __device__ void init(int M, int N, int G_, int c_) { nM = M / BM; nN = N / BM; nwg = nM * nN; G = G_; c = c_; }
    __host__ __device__ bool next(int i, Unit& u) const {
        const long L = (long)i * G + c; if (L >= nwg) return false;
        int wgid = (int)L; { const int q = nwg / NXCD, r = nwg % NXCD, xcd = wgid % NXCD, off = wgid / NXCD; wgid = (xcd < r ? xcd * (q + 1) : r * (q + 1) + (xcd - r) * q) + off; }
        const int nig = WGM * nN, gid = wgid / nig, fm = gid * WGM, gsz = (nM - fm) < WGM ? (nM - fm) : WGM;
        u.pm = fm + ((wgid % nig) % gsz); u.pn = (wgid % nig) / gsz; return true;
    }
};
template <class Epi, class Sched>
__device__ __forceinline__ void gemm_phase(int wid_s, PG8_LAS unsigned char* lds, const Gemm g, const Sched& S, const Epi& E) {
    const int tid_ = mk_tid(wid_s);
    const int tid = tid_, wid = __builtin_amdgcn_readfirstlane(tid >> 6), lane = tid & 63, wr = wid >> 2, wc = wid & 3, fr = lane & 15, fq = lane >> 4;
    const int K = g.K, nt = K / BK, lda = g.lda;
    unsigned voffA[2], voffB[2];
#pragma unroll
    for (int i = 0; i < 2; ++i) { int R, C; stage_rc(tid * 16 + i * 8192, R, C); const int Rb = (R & ~31) + perm32(R & 31);
        voffA[i] = (unsigned)(R * lda + C) * 2u; voffB[i] = (unsigned)(Rb * K + C) * 2u; }
    const size_t kstep = (size_t)(BK * 2);
    const size_t hstepA = (size_t)HALF * lda * 2, hstepB = (size_t)HALF * K * 2;
    const size_t tstepA = 2 * hstepA, tstepB = 2 * hstepB;
    const unsigned ldsw = (unsigned)wid * 1024u;
    const int aoff = lds_byte(wr * 64 + fr, fq * 8), boff = lds_byte(wc * 32 + fr, fq * 8);
#define PG8_SA(b, h) (((b) * 2 + (h)) * HTB)
#define PG8_SB(b, h) ((4 + (b) * 2 + (h)) * HTB)
#define PG8_STAGE(bufoff, gbase, voff) do { _Pragma("unroll") for (int _i = 0; _i < 2; ++_i) \
        __builtin_amdgcn_global_load_lds((const unsigned*)((const char*)(gbase) + (voff)[_i]), (PG8_LAS unsigned*)(lds + (bufoff) + ldsw + _i * 8192), 16, 0, 0); } while (0)
#define PG8_LDA(dst, b, h) do { _Pragma("unroll") for (int m = 0; m < 4; ++m) _Pragma("unroll") for (int k = 0; k < 2; ++k) dst[m][k] = *(const PG8_LAS bf16x8*)(lds + PG8_SA(b, h) + aoff + m * 2048 + k * 1024); } while (0)
#define PG8_LDB(dst, b, h) do { _Pragma("unroll") for (int n = 0; n < 2; ++n) _Pragma("unroll") for (int k = 0; k < 2; ++k) dst[n][k] = *(const PG8_LAS bf16x8*)(lds + PG8_SB(b, h) + boff + n * 2048 + k * 1024); } while (0)
#define PG8_MMA(ai, bj, At, Bt) do { __builtin_amdgcn_s_setprio(1); _Pragma("unroll") for (int m = 0; m < 4; ++m) _Pragma("unroll") for (int n = 0; n < 2; ++n) _Pragma("unroll") for (int k = 0; k < 2; ++k) \
        acc[ai][bj][m][n] = __builtin_amdgcn_mfma_f32_16x16x32_bf16(Bt[n][k], At[m][k], acc[ai][bj][m][n], 0, 0, 0); __builtin_amdgcn_s_setprio(0); } while (0)
#define PG8_WAIT_V(n) asm volatile("s_waitcnt vmcnt(" #n ")" ::: "memory")
#define PG8_WAIT_L(n) asm volatile("s_waitcnt lgkmcnt(" #n ")" ::: "memory")
#define PG8_BAR __builtin_amdgcn_s_barrier()
#define PG8_SCHED __builtin_amdgcn_sched_barrier(0)
    Unit cur, nxt; int ui = 0;
    if (!S.next(0, cur)) return;
    f32x4 acc[2][2][4][2];
#pragma unroll
    for (int a = 0; a < 2; ++a)
#pragma unroll
        for (int b = 0; b < 2; ++b)
#pragma unroll
            for (int m = 0; m < 4; ++m)
#pragma unroll
                for (int n = 0; n < 2; ++n) acc[a][b][m][n] = (f32x4){0.f, 0.f, 0.f, 0.f};
    bf16x8 At[4][2], B0[2][2], B1[2][2];
    const char* cA = (const char*)g.A + (size_t)cur.pm * tstepA; const char* cB = (const char*)g.Bt + (size_t)cur.pn * tstepB;
    PG8_STAGE(PG8_SB(0, 0), cB, voffB); PG8_STAGE(PG8_SB(0, 1), cB + hstepB, voffB); PG8_STAGE(PG8_SA(0, 0), cA, voffA); PG8_STAGE(PG8_SA(0, 1), cA + hstepA, voffA);
    if (wr == 1) PG8_BAR;
    PG8_WAIT_V(2); PG8_BAR;
    PG8_STAGE(PG8_SB(1, 0), cB + kstep, voffB); PG8_STAGE(PG8_SA(1, 0), cA + kstep, voffA); PG8_STAGE(PG8_SB(1, 1), cB + hstepB + kstep, voffB);
    PG8_WAIT_V(6); PG8_BAR;
    for (;;) {
        const bool has_next = S.next(ui + 1, nxt);
        const char* nA = has_next ? (const char*)g.A + (size_t)nxt.pm * tstepA : cA; const char* nB = has_next ? (const char*)g.Bt + (size_t)nxt.pn * tstepB : cB;
#pragma unroll 1
        for (int t = 0; t < nt; t += 2) {
            const bool last = (t == nt - 2);
            const char* a1 = cA + (size_t)(t + 1) * kstep;
            const char* a2 = last ? nA : cA + (size_t)(t + 2) * kstep; const char* b2 = last ? nB : cB + (size_t)(t + 2) * kstep;
            const char* a3 = a2 + kstep; const char* b3 = b2 + kstep;
            PG8_LDB(B0, 0, 0); PG8_LDB(B1, 0, 1); PG8_SCHED; PG8_LDA(At, 0, 0); PG8_STAGE(PG8_SA(1, 1), a1 + hstepA, voffA);
            PG8_WAIT_V(8); PG8_WAIT_L(0); PG8_BAR; PG8_MMA(0, 0, At, B0); PG8_MMA(0, 1, At, B1); PG8_BAR; PG8_SCHED;
            PG8_LDA(At, 0, 1); PG8_STAGE(PG8_SB(0, 0), b2, voffB); PG8_STAGE(PG8_SB(0, 1), b2 + hstepB, voffB); PG8_STAGE(PG8_SA(0, 0), a2, voffA);
            PG8_WAIT_V(8); PG8_WAIT_L(0); PG8_BAR; PG8_MMA(1, 0, At, B0); PG8_MMA(1, 1, At, B1); PG8_BAR; PG8_SCHED;
            PG8_LDB(B0, 1, 0); PG8_LDB(B1, 1, 1); PG8_SCHED; PG8_LDA(At, 1, 0); PG8_STAGE(PG8_SA(0, 1), a2 + hstepA, voffA);
            PG8_WAIT_V(8); PG8_WAIT_L(0); PG8_BAR; PG8_MMA(0, 0, At, B0); PG8_MMA(0, 1, At, B1); PG8_BAR; PG8_SCHED;
            PG8_LDA(At, 1, 1); PG8_STAGE(PG8_SB(1, 0), b3, voffB); PG8_STAGE(PG8_SB(1, 1), b3 + hstepB, voffB); PG8_STAGE(PG8_SA(1, 0), a3, voffA);
            PG8_WAIT_V(8); PG8_WAIT_L(0); PG8_BAR; PG8_MMA(1, 0, At, B0); PG8_MMA(1, 1, At, B1); PG8_BAR; PG8_SCHED;
        }
        if (wr == 0) PG8_BAR;
        E(acc, cur, wr, wc, fr, fq);
        if (!has_next) break;
#pragma unroll
        for (int a = 0; a < 2; ++a)
#pragma unroll
            for (int b = 0; b < 2; ++b)
#pragma unroll
                for (int m = 0; m < 4; ++m)
#pragma unroll
                    for (int n = 0; n < 2; ++n) acc[a][b][m][n] = (f32x4){0.f, 0.f, 0.f, 0.f};
        cur = nxt; cA = nA; cB = nB; ++ui;
        if (wr == 1) PG8_BAR;
    }
    PG8_WAIT_V(0);
    PG8_BAR;
#undef PG8_SA
#undef PG8_SB
#undef PG8_STAGE
#undef PG8_LDA
#undef PG8_LDB
#undef PG8_MMA
#undef PG8_WAIT_V
#undef PG8_WAIT_L
#undef PG8_BAR
#undef PG8_SCHED
}
}

#ifndef EN
#define EN 0xFFFF
#endif
#define ON(b) ((EN >> (b)) & 1)
#ifndef REP
#define REP 0
#endif
#ifndef SCANMODE
#define SCANMODE 0
#endif
#define RB(b) ((REP >> (b)) & 1)
#define REPLOOP(b) int nrep##b = 1 + RB(b); asm volatile("" : "+s"(nrep##b)); for (int q = 0; q < nrep##b; ++q)
constexpr int T = 16384, TH = 8192, SEQ = 2048, DM = 1024, DIN = 6304, NP = 3328, DFF = 2816;
constexpr int LDS_BYTES = 147456, QIDX_OFF = 140000;
constexpr size_t MiB = 1u << 20;
constexpr size_t WS_CTL = 0;
constexpr size_t WS_WT = 1 * MiB;
constexpr size_t W_IN = WS_WT, W_GATE = W_IN + (size_t)NP * 1024 * 2, W_BR = W_GATE + (size_t)3072 * 1024 * 2, W_OUT = W_BR + (size_t)3 * 1024 * 512 * 2,
                 W_MQ = W_OUT + (size_t)1024 * 1024 * 2, W_MKV = W_MQ + (size_t)768 * 256 * 2, W_XQ = W_MKV + (size_t)1024 * 128 * 2, W_XKV = W_XQ + (size_t)512 * 1024 * 2,
                 W_XO = W_XKV + (size_t)1024 * 1024 * 2, W_13 = W_XO + (size_t)1024 * 512 * 2, W_2 = W_13 + (size_t)5632 * 1024 * 2, W_BWA = W_2 + (size_t)1024 * 2816 * 2, W_GUP = W_BWA + (size_t)1024 * 128 * 2, W_END = W_GUP + (size_t)512 * 128 * 2;
static_assert(W_END <= 40 * MiB, "weights");
constexpr size_t WS_XB = 40 * MiB, WS_PART = 72 * MiB, WS_PQ = 73 * MiB, WS_PKV = WS_PQ + 256 * 1024, WS_Y = 74 * MiB, WS_R = 122 * MiB;
constexpr size_t R_P = WS_R, R_SI = WS_R + 52 * MiB, R_Q = WS_R + 100 * MiB, R_KM = WS_R + 112 * MiB, R_VT = WS_R + 124 * MiB;
constexpr size_t R_GS = WS_R  , R_MS = WS_R + 48 * MiB  , R_MG = WS_R + 96 * MiB, R_MEMB = WS_R + 128 * MiB;
constexpr size_t R_MK = WS_R, R_MVT = WS_R + 2 * MiB, R_XQ = WS_R + 32 * MiB, R_XO = WS_R + 48 * MiB, R_H = WS_R;
constexpr size_t WS_AG = WS_R + 132 * MiB;
constexpr size_t WS_END = WS_AG + 2 * MiB;
static_assert(WS_END <= 256 * MiB, "ws");

struct Params { const float* in[43]; float* out; unsigned char* ws; };
typedef const __attribute__((address_space(4))) Params* KP;
enum { I_X = 0, I_MEM, I_POS, I_NMIX, I_NXA, I_NMEM, I_NFFN, I_WIN, I_BGATE, I_MU, I_W0, I_WUP, I_A0, I_AUP, I_GUP, I_KK, I_KA, I_RK, I_LNG, I_LNB,
       I_CW, I_CB, I_WA, I_BA, I_WX, I_BX, I_LAM, I_QN, I_WUQ, I_KVN, I_WUKV, I_QG, I_KG, I_WBR, I_WOUT, I_XWQ, I_XWKV, I_XQG, I_XKG, I_XWO, I_W1, I_W3, I_W2 };

__device__ __forceinline__ float rstd16(const float* part, int row) {
    const f32x4* p = (const f32x4*)(part + (size_t)row * 16); const f32x4 a = p[0], b = p[1], c = p[2], d = p[3];
    const float s = ((a.x + a.y) + (a.z + a.w)) + ((b.x + b.y) + (b.z + b.w)) + ((c.x + c.y) + (c.z + c.w)) + ((d.x + d.y) + (d.z + d.w));
    return rsqrtf(s * (1.f / 1024.f) + 1e-6f);
}
__device__ __forceinline__ float rstd4(const float* pp, int row, float invn) { const f32x4 a = *(const f32x4*)(pp + (size_t)row * 4); return rsqrtf(((a.x + a.y) + (a.z + a.w)) * invn + 1e-6f); }
__device__ __forceinline__ float sumsq8(f32x4 a, f32x4 b) { return (a.x * a.x + a.y * a.y) + (a.z * a.z + a.w * a.w) + (b.x * b.x + b.y * b.y) + (b.z * b.z + b.w * b.w); }
#define EPI_HEAD static constexpr bool PERM = true; \
    __device__ __forceinline__ void operator()(const f32x4 (&acc)[2][2][4][2], const pg8::Unit& u, int wr, int wc, int fr, int fq) const
#define EPI_ROWS _Pragma("unroll") for (int ai = 0; ai < 2; ++ai) _Pragma("unroll") for (int m = 0; m < 4; ++m) if ((__builtin_amdgcn_sched_barrier(0), true))
#define EPI_ROW (u.pm * 256 + ai * 128 + wr * 64 + m * 16 + fr)

struct EpiP {
    bf16* P; const float* part; float* pq; float* pkv;
    EPI_HEAD {
        const int col0 = u.pn * 256 + wc * 32 + 8 * fq;
        EPI_ROWS { const int row = EPI_ROW; const float rs = rstd16(part, row); float ss = 0.f;
#pragma unroll
            for (int bj = 0; bj < 2; ++bj) { const f32x4 v0 = acc[ai][bj][m][0] * rs, v1 = acc[ai][bj][m][1] * rs;
                *(u32x4*)(P + (size_t)row * NP + col0 + bj * 128) = pk8(v0, v1);
                if (u.pn == 11 || bj == 0) ss += sumsq8(v0, v1); }
            if (u.pn == 11 || u.pn == 12) { ss += __shfl_xor(ss, 16); ss += __shfl_xor(ss, 32); if (fq == 0) (u.pn == 11 ? pq : pkv)[(size_t)row * 4 + wc] = ss; } }
    }
};
struct EpiQ {
    bf16* Q; const float* pq;
    EPI_HEAD {
        const int col0 = u.pn * 256 + wc * 32 + 8 * fq;
        EPI_ROWS { const int row = EPI_ROW; const float rs = rstd4(pq, row, 1.f / 256.f);
#pragma unroll
            for (int bj = 0; bj < 2; ++bj) *(u32x4*)(Q + (size_t)row * 768 + col0 + bj * 128) = pk8(acc[ai][bj][m][0] * rs, acc[ai][bj][m][1] * rs); }
    }
};
struct EpiKV {
    bf16* Km; bf16* Vt; const float* pkv;
    EPI_HEAD {
        const int j0 = wc * 32 + 8 * fq;
        EPI_ROWS { const int row = EPI_ROW; const float rs = rstd4(pkv, row, 1.f / 128.f);
#pragma unroll
            for (int bj = 0; bj < 2; ++bj) { const int h = 2 * u.pn + bj; const f32x4 v0 = acc[ai][bj][m][0] * rs, v1 = acc[ai][bj][m][1] * rs;
                if (wc < 2) *(u32x4*)(Km + (size_t)row * 768 + h * 96 + j0) = pk8(v0, v1);
                else { const int bl = row >> 11, t = row & 2047; bf16* vp = Vt + ((size_t)(bl * 8 + h) * 64 + (j0 - 64)) * 2048 + t;
                    vp[0 * 2048] = (bf16)f2bf(v0.x); vp[1 * 2048] = (bf16)f2bf(v0.y); vp[2 * 2048] = (bf16)f2bf(v0.z); vp[3 * 2048] = (bf16)f2bf(v0.w);
                    vp[4 * 2048] = (bf16)f2bf(v1.x); vp[5 * 2048] = (bf16)f2bf(v1.y); vp[6 * 2048] = (bf16)f2bf(v1.z); vp[7 * 2048] = (bf16)f2bf(v1.w); } } }
    }
};
struct EpiGate {
    unsigned char* GS; const float* part; const float* bg;
    EPI_HEAD {
        const int col0 = u.pn * 256 + wc * 32 + 8 * fq;
        f32x4 b0[2], b1[2];
#pragma unroll
        for (int bj = 0; bj < 2; ++bj) { b0[bj] = *(const f32x4*)(bg + col0 + bj * 128); b1[bj] = *(const f32x4*)(bg + col0 + bj * 128 + 4); }
        EPI_ROWS { const int row = EPI_ROW; const float rs = rstd16(part, row);
#pragma unroll
            for (int bj = 0; bj < 2; ++bj) { const f32x4 v0 = acc[ai][bj][m][0] * rs + b0[bj], v1 = acc[ai][bj][m][1] * rs + b1[bj];
                unsigned q[8];
#pragma unroll
                for (int e = 0; e < 4; ++e) { q[e] = (unsigned)(fsig(v0[e]) * 255.f + 0.5f); q[4 + e] = (unsigned)(fsig(v1[e]) * 255.f + 0.5f); }
                u32x2 w; w.x = q[0] | (q[1] << 8) | (q[2] << 16) | (q[3] << 24); w.y = q[4] | (q[5] << 8) | (q[6] << 16) | (q[7] << 24);
                *(u32x2*)(GS + (size_t)row * 3072 + col0 + bj * 128) = w; } }
    }
};
struct EpiProj {
    const unsigned char* GS; float* MS; bf16* MG; int n;
    EPI_HEAD {
        const int col0 = u.pn * 256 + wc * 32 + 8 * fq;
        EPI_ROWS { const int row = EPI_ROW;
#pragma unroll
            for (int bj = 0; bj < 2; ++bj) { const size_t o = (size_t)row * 1024 + col0 + bj * 128; const u32x2 gw = *(const u32x2*)(GS + (size_t)row * 3072 + n * 1024 + col0 + bj * 128);
                f32x4 v0 = acc[ai][bj][m][0], v1 = acc[ai][bj][m][1]; const float sc = 1.f / 255.f;
                v0.x *= (float)(gw.x & 255u) * sc; v0.y *= (float)((gw.x >> 8) & 255u) * sc; v0.z *= (float)((gw.x >> 16) & 255u) * sc; v0.w *= (float)(gw.x >> 24) * sc;
                v1.x *= (float)(gw.y & 255u) * sc; v1.y *= (float)((gw.y >> 8) & 255u) * sc; v1.z *= (float)((gw.y >> 16) & 255u) * sc; v1.w *= (float)(gw.y >> 24) * sc;
                bf16* MSb = (bf16*)MS;
                if (n > 0) { const u32x4 mw = *(const u32x4*)(MSb + o); v0.x += bflo(mw.x); v0.y += bfhi(mw.x); v0.z += bflo(mw.y); v0.w += bfhi(mw.y); v1.x += bflo(mw.z); v1.y += bfhi(mw.z); v1.z += bflo(mw.w); v1.w += bfhi(mw.w); }
                if (n < 2) *(u32x4*)(MSb + o) = pk8(v0, v1); else *(u32x4*)(MG + o) = pk8(v0, v1); } }
    }
};
struct EpiRes {
    float* xout; bf16* xb; float* part; int nowrite = 0;
    EPI_HEAD {
        const int col0 = u.pn * 256 + wc * 32 + 8 * fq;
        EPI_ROWS { const int row = EPI_ROW; float ss = 0.f;
#pragma unroll
            for (int bj = 0; bj < 2; ++bj) { const size_t o = (size_t)row * 1024 + col0 + bj * 128; const u32x4 xw = *(const u32x4*)(xb + o);
                f32x4 v0 = acc[ai][bj][m][0], v1 = acc[ai][bj][m][1];
                v0.x += bflo(xw.x); v0.y += bfhi(xw.x); v0.z += bflo(xw.y); v0.w += bfhi(xw.y); v1.x += bflo(xw.z); v1.y += bfhi(xw.z); v1.z += bflo(xw.w); v1.w += bfhi(xw.w);
                if (!nowrite) { if (xout) { *(f32x4*)(xout + o) = v0; *(f32x4*)(xout + o + 4) = v1; } *(u32x4*)(xb + o) = pk8(v0, v1); } ss += sumsq8(v0, v1); }
            ss += __shfl_xor(ss, 16); ss += __shfl_xor(ss, 32); if (fq == 0 && !nowrite) part[(size_t)row * 16 + u.pn * 4 + wc] = ss; }
    }
};
struct EpiXQ {
    bf16* Q; const float* part;
    EPI_HEAD {
        const int col0 = u.pn * 256 + wc * 32 + 8 * fq;
        EPI_ROWS { const int row = EPI_ROW; const float rs = rstd16(part, row);
#pragma unroll
            for (int bj = 0; bj < 2; ++bj) *(u32x4*)(Q + (size_t)row * 512 + col0 + bj * 128) = pk8(acc[ai][bj][m][0] * rs, acc[ai][bj][m][1] * rs); }
    }
};
struct EpiBf {
    bf16* O; int ld;
    EPI_HEAD {
        const int col0 = u.pn * 256 + wc * 32 + 8 * fq;
        EPI_ROWS { const int row = EPI_ROW;
#pragma unroll
            for (int bj = 0; bj < 2; ++bj) *(u32x4*)(O + (size_t)row * ld + col0 + bj * 128) = pk8(acc[ai][bj][m][0], acc[ai][bj][m][1]); }
    }
};
struct EpiMemKV {
    bf16* mk; bf16* mVt;
    EPI_HEAD {
        const int j0 = wc * 32 + 8 * fq, h = u.pn;
        EPI_ROWS { const int row = EPI_ROW;
            *(u32x4*)(mk + (size_t)row * 512 + h * 128 + j0) = pk8(acc[ai][0][m][0], acc[ai][0][m][1]);
            const f32x4 v0 = acc[ai][1][m][0], v1 = acc[ai][1][m][1]; const int b = row >> 8, key = row & 255;
            bf16* vp = mVt + ((size_t)(b * 4 + h) * 128 + j0) * 256 + key;
            vp[0 * 256] = (bf16)f2bf(v0.x); vp[1 * 256] = (bf16)f2bf(v0.y); vp[2 * 256] = (bf16)f2bf(v0.z); vp[3 * 256] = (bf16)f2bf(v0.w);
            vp[4 * 256] = (bf16)f2bf(v1.x); vp[5 * 256] = (bf16)f2bf(v1.y); vp[6 * 256] = (bf16)f2bf(v1.z); vp[7 * 256] = (bf16)f2bf(v1.w); }
    }
};
struct EpiFFN1 {
    bf16* H; const float* part;
    EPI_HEAD {
        const int hc0 = (u.pn * 256 + wc * 32 + 8 * fq) >> 1;
        EPI_ROWS { const int row = EPI_ROW; const float rs = rstd16(part, row);
#pragma unroll
            for (int bj = 0; bj < 2; ++bj) { const f32x4 a1 = acc[ai][bj][m][0] * rs, a3 = acc[ai][bj][m][1] * rs; f32x4 hv;
#pragma unroll
                for (int e = 0; e < 4; ++e) hv[e] = a1[e] * fsig(a1[e]) * a3[e];
                u32x2 w; w.x = pk2(hv.x, hv.y); w.y = pk2(hv.z, hv.w);
                *(u32x2*)(H + (size_t)row * DFF + hc0 + bj * 64) = w; } }
    }
};

__device__ __forceinline__ void conv_job(const float* W, int ldw, int c0, int ncols, int kblk, const float* gain, bf16* WT, int K, int mode, float* scr, int gw, int NGW, int lane, int& off) {
    const int nblk = (ncols + 63) >> 6, nitems = nblk * kblk;
    int it0 = (gw - off) % NGW; if (it0 < 0) it0 += NGW;
    off = (off + nitems) % NGW;
    const int kq = lane >> 4, nq = lane & 15;
    for (int it = it0; it < nitems; it += NGW) {
        const int kb = it / nblk, nb = it % nblk, k0 = 64 * kb, n0 = 64 * nb;
        const bool ld_ok = (n0 + 4 * nq) < ncols;
        f32x4 v[16];
#pragma unroll
        for (int i = 0; i < 16; ++i) { v[i] = (f32x4){0.f, 0.f, 0.f, 0.f}; if (ld_ok) v[i] = *(const f32x4*)(W + (size_t)(k0 + 4 * i + kq) * ldw + c0 + n0 + 4 * nq); }
#pragma unroll
        for (int i = 0; i < 16; ++i) { const int kk = 4 * i + kq; const float gg = gain ? gain[k0 + kk] : 1.f; float* d = scr + kk * 65 + 4 * nq;
            d[0] = v[i].x * gg; d[1] = v[i].y * gg; d[2] = v[i].z * gg; d[3] = v[i].w * gg; }
        __builtin_amdgcn_wave_barrier(); asm volatile("s_waitcnt lgkmcnt(0)" ::: "memory");
        const int c = lane & 7;
#pragma unroll
        for (int jx = 0; jx < 8; ++jx) { const int nl = (lane >> 3) + 8 * jx, n = n0 + nl; const float* sp = scr + (8 * c) * 65 + nl;
            u32x4 o; o.x = pk2(sp[0 * 65], sp[1 * 65]); o.y = pk2(sp[2 * 65], sp[3 * 65]); o.z = pk2(sp[4 * 65], sp[5 * 65]); o.w = pk2(sp[6 * 65], sp[7 * 65]);
            const int dr = mode == 0 ? n : (8 * (n >> 2) + (n & 3) + (mode == 2 ? 4 : 0));
            if (n < ncols) *(u32x4*)(WT + (size_t)dr * K + k0 + 8 * c) = o; }
        __builtin_amdgcn_wave_barrier(); asm volatile("s_waitcnt lgkmcnt(0)" ::: "memory");
    }
}

__device__ __forceinline__ void phase_convert(int wid_s, KP p_, int l, float* ldsf, int bsub, int nb) {
    KP p = p_; asm volatile("" : "+s"(p));
    unsigned char* ws = p->ws;
    const int tid_ = mk_tid(wid_s);
    const int tid = tid_, lane = tid & 63, wv = tid >> 6;
    const int gw = bsub * 8 + wv, NGW = nb * 8;
    float* scr = ldsf + wv * (64 * 65); int off = 0;
    const float* nmix = p->in[I_NMIX] + l * 1024;
    conv_job(p->in[I_WIN] + (size_t)l * 1024 * DIN, DIN, 0, 3232, 16, nmix, (bf16*)(ws + W_IN), 1024, 0, scr, gw, NGW, lane, off);
    conv_job(p->in[I_WUQ] + (size_t)l * 256 * 768, 768, 0, 768, 4, p->in[I_QN] + l * 256, (bf16*)(ws + W_MQ), 256, 0, scr, gw, NGW, lane, off);
    conv_job(p->in[I_WUKV] + (size_t)l * 128 * 1024, 1024, 0, 1024, 2, p->in[I_KVN] + l * 128, (bf16*)(ws + W_MKV), 128, 0, scr, gw, NGW, lane, off);
    conv_job(p->in[I_WUP] + (size_t)l * 64 * 512, 512, 0, 512, 1, nullptr, (bf16*)(ws + W_BWA), 128, 0, scr, gw, NGW, lane, off);
    conv_job(p->in[I_AUP] + (size_t)l * 64 * 512, 512, 0, 512, 1, nullptr, (bf16*)(ws + W_BWA) + 512 * 128 + 64, 128, 0, scr, gw, NGW, lane, off);
    conv_job(p->in[I_GUP] + (size_t)l * 128 * 512, 512, 0, 512, 2, nullptr, (bf16*)(ws + W_GUP), 128, 0, scr, gw, NGW, lane, off);
    { unsigned zz = 0u; asm volatile("" : "+v"(zz)); const u32x4 zv = {zz, zz, zz, zz};
      for (int i = bsub * 512 + tid; i < 1024 * 8; i += nb * 512) { const int row = i >> 3, ch = i & 7; *(u32x4*)((bf16*)(ws + W_BWA) + row * 128 + (row < 512 ? 64 : 0) + ch * 8) = zv; } }
    { u32x4* z = (u32x4*)((bf16*)(ws + W_IN) + (size_t)3232 * 1024); const int n16 = 96 * 1024 * 2 / 16;
      unsigned zz = 0u; asm volatile("" : "+v"(zz)); const u32x4 zv = {zz, zz, zz, zz};
      for (int i = bsub * 512 + tid; i < n16; i += nb * 512) z[i] = zv; }
    if (l == 0) {
        const float* x = p->in[I_X]; bf16* xb = (bf16*)(ws + WS_XB); float* part = (float*)(ws + WS_PART);
        for (int row = gw; row < T; row += NGW) {
            const f32x4* xr = (const f32x4*)(x + (size_t)row * 1024) + lane; float s = 0.f;
#pragma unroll
            for (int j = 0; j < 4; ++j) { const f32x4 v = xr[64 * j]; s += (v.x * v.x + v.y * v.y) + (v.z * v.z + v.w * v.w);
                u32x2 w; w.x = pk2(v.x, v.y); w.y = pk2(v.z, v.w); *((u32x2*)(xb + (size_t)row * 1024) + lane + 64 * j) = w; }
            s = wave_sum(s);
            if (lane < 16) part[(size_t)row * 16 + lane] = lane == 0 ? s : 0.f;
        }
    }
}

__device__ __forceinline__ void phase_convert_mid(int wid_s, KP p_, int l, float* ldsf, int gw, int NGW) {
    KP p = p_; asm volatile("" : "+s"(p));
    unsigned char* ws = p->ws;
    const int tid_ = mk_tid(wid_s);
    const int tid = tid_, lane = tid & 63, wv = tid >> 6;
    float* scr = ldsf + wv * (64 * 65); int off = 0;
    const float* nmix = p->in[I_NMIX] + l * 1024;
    conv_job(p->in[I_WIN] + (size_t)l * 1024 * DIN, DIN, 3232, 3072, 16, nmix, (bf16*)(ws + W_GATE), 1024, 0, scr, gw, NGW, lane, off);
    for (int n = 0; n < 3; ++n) conv_job(p->in[I_WBR] + ((size_t)l * 3 + n) * 512 * 1024, 1024, 0, 1024, 8, nullptr, (bf16*)(ws + W_BR) + (size_t)n * 1024 * 512, 512, 0, scr, gw, NGW, lane, off);
    conv_job(p->in[I_WOUT] + (size_t)l * 1024 * 1024, 1024, 0, 1024, 16, nullptr, (bf16*)(ws + W_OUT), 1024, 0, scr, gw, NGW, lane, off);
    conv_job(p->in[I_XWQ] + (size_t)l * 1024 * 512, 512, 0, 512, 16, p->in[I_NXA] + l * 1024, (bf16*)(ws + W_XQ), 1024, 0, scr, gw, NGW, lane, off);
    conv_job(p->in[I_XWKV] + (size_t)l * 1024 * 1024, 1024, 0, 1024, 16, p->in[I_NMEM] + l * 1024, (bf16*)(ws + W_XKV), 1024, 0, scr, gw, NGW, lane, off);
    conv_job(p->in[I_XWO] + (size_t)l * 512 * 1024, 1024, 0, 1024, 8, nullptr, (bf16*)(ws + W_XO), 512, 0, scr, gw, NGW, lane, off);
}
__device__ __forceinline__ void phase_convert_ffn(int wid_s, KP p_, int l, float* ldsf, int gw, int NGW) {
    KP p = p_; asm volatile("" : "+s"(p));
    unsigned char* ws = p->ws;
    const int tid_ = mk_tid(wid_s);
    const int tid = tid_, lane = tid & 63, wv = tid >> 6;
    float* scr = ldsf + wv * (64 * 65); int off = 0;
    conv_job(p->in[I_W1] + (size_t)l * 1024 * DFF, DFF, 0, 2816, 16, p->in[I_NFFN] + l * 1024, (bf16*)(ws + W_13), 1024, 1, scr, gw, NGW, lane, off);
    conv_job(p->in[I_W3] + (size_t)l * 1024 * DFF, DFF, 0, 2816, 16, p->in[I_NFFN] + l * 1024, (bf16*)(ws + W_13), 1024, 2, scr, gw, NGW, lane, off);
    conv_job(p->in[I_W2] + (size_t)l * DFF * 1024, 1024, 0, 1024, 44, nullptr, (bf16*)(ws + W_2), DFF, 0, scr, gw, NGW, lane, off);
}
__device__ __forceinline__ void rope_cs(int pos, int i, float& c, float& s) {
    const float invf = exp2f(-(float)i * 0.8304820237218406f);
    const float ang = (float)pos * invf;
    const double x = (double)ang * 0.15915494309189535; const float f = (float)(x - rint(x));
    c = __builtin_amdgcn_cosf(f); s = __builtin_amdgcn_sinf(f);
}
template <int DQK, int DV, bool CAUSAL, bool MLA>
__device__ __forceinline__ void attn_unit(int wid_s, unsigned char* lds, const bf16* Qb_, int ldq, const bf16* Kb_, int ldk, const bf16* Vtb_, int ldv, bf16* Ob_, int ldo,
                                          int q0, int nkt, const float* qgain_, const int* pos_, float qscale) {
    const GAS bf16* Qb = (const GAS bf16*)Qb_; const GAS bf16* Kb = (const GAS bf16*)Kb_; const GAS bf16* Vtb = (const GAS bf16*)Vtb_; GAS bf16* Ob = (GAS bf16*)Ob_;
    const GAS float* qgain = (const GAS float*)qgain_; const GAS int* pos = (const GAS int*)pos_;
    constexpr int KS = DQK * 2 + 16, VS = 144, NKS = DQK / 32, NDT = DV / 16, KCH = DQK / 8, NKC = (64 * KCH + 511) / 512, NVC = DV * 8 / 512;
    unsigned char* Ks = lds; unsigned char* Vs = lds + 64 * KS;
    const int tid_ = mk_tid(wid_s);
    const int tid = tid_, lane = tid & 63, wv = tid >> 6, g = lane >> 4, j = lane & 15;
    const int qrow = q0 + wv * 16 + j;
    bf16x8 qf[NKS];
    {
        float qv[NKS][8]; float ss = 0.f;
#pragma unroll
        for (int ks = 0; ks < NKS; ++ks) { const u32x4 w = *(const GAS u32x4*)(Qb + (size_t)qrow * ldq + 32 * ks + 8 * g);
            qv[ks][0] = bflo(w.x); qv[ks][1] = bfhi(w.x); qv[ks][2] = bflo(w.y); qv[ks][3] = bfhi(w.y); qv[ks][4] = bflo(w.z); qv[ks][5] = bfhi(w.z); qv[ks][6] = bflo(w.w); qv[ks][7] = bfhi(w.w);
#pragma unroll
            for (int e = 0; e < 8; ++e) ss += qv[ks][e] * qv[ks][e]; }
        ss += __shfl_xor(ss, 16); ss += __shfl_xor(ss, 32);
        const float rs = rsqrtf(ss * (1.f / DQK) + 1e-6f);
#pragma unroll
        for (int ks = 0; ks < NKS; ++ks)
#pragma unroll
            for (int e = 0; e < 8; ++e) qv[ks][e] *= rs * qgain[32 * ks + 8 * g + e];
        if (MLA) {
            const int ps = pos[qrow];
#pragma unroll
            for (int e = 0; e < 8; ++e) { const float mine = qv[2][e], other = __shfl_xor(mine, 32); float c, s; rope_cs(ps, 8 * (g & 1) + e, c, s);
                qv[2][e] = (g < 2) ? (mine * c - other * s) : (mine * c + other * s); }
        }
#pragma unroll
        for (int ks = 0; ks < NKS; ++ks) { u32x4 w; w.x = pk2(qv[ks][0] * qscale, qv[ks][1] * qscale); w.y = pk2(qv[ks][2] * qscale, qv[ks][3] * qscale);
            w.z = pk2(qv[ks][4] * qscale, qv[ks][5] * qscale); w.w = pk2(qv[ks][6] * qscale, qv[ks][7] * qscale); qf[ks] = __builtin_bit_cast(bf16x8, w); }
    }
    f32x4 oT[NDT];
#pragma unroll
    for (int d = 0; d < NDT; ++d) oT[d] = (f32x4){0.f, 0.f, 0.f, 0.f};
    float mrun = -INFINITY, lsum = 0.f;
    u32x4 kreg[NKC], vreg[NVC];
#define ATT_PREFETCH(kt) do { _Pragma("unroll") for (int i = 0; i < NKC; ++i) { const int idx = tid + 512 * i; if (idx < 64 * KCH) { const int key = idx / KCH, ch = idx % KCH; \
            kreg[i] = *(const GAS u32x4*)(Kb + (size_t)(64 * (kt) + key) * ldk + ch * 8); } } \
        _Pragma("unroll") for (int i = 0; i < NVC; ++i) { const int idx = tid + 512 * i; const int dv = idx >> 3, ch = idx & 7; vreg[i] = *(const GAS u32x4*)(Vtb + (size_t)dv * ldv + 64 * (kt) + ch * 8); } } while (0)
    ATT_PREFETCH(0);
    for (int kt = 0; kt < nkt; ++kt) {
        LBAR();
#pragma unroll
        for (int i = 0; i < NKC; ++i) { const int idx = tid + 512 * i; if (idx < 64 * KCH) { const int key = idx / KCH, ch = idx % KCH; *(u32x4*)(Ks + key * KS + ch * 16) = kreg[i]; } }
#pragma unroll
        for (int i = 0; i < NVC; ++i) { const int idx = tid + 512 * i; const int dv = idx >> 3, ch = idx & 7; *(u32x4*)(Vs + dv * VS + ch * 16) = vreg[i]; }
        LBAR();
        if (kt + 1 < nkt) ATT_PREFETCH(kt + 1);
        const int qw0 = q0 + wv * 16;
        if (CAUSAL && 64 * kt > qw0 + 15) continue;
        f32x4 sT[4];
#pragma unroll
        for (int k4 = 0; k4 < 4; ++k4) { sT[k4] = (f32x4){0.f, 0.f, 0.f, 0.f};
#pragma unroll
            for (int ks = 0; ks < NKS; ++ks) { const bf16x8 a = *(const bf16x8*)(Ks + (16 * k4 + j) * KS + (32 * ks + 8 * g) * 2);
                sT[k4] = __builtin_amdgcn_mfma_f32_16x16x32_bf16(a, qf[ks], sT[k4], 0, 0, 0); } }
        if (CAUSAL && 64 * kt + 63 > qw0) {
#pragma unroll
            for (int k4 = 0; k4 < 4; ++k4)
#pragma unroll
                for (int r = 0; r < 4; ++r) if (64 * kt + 16 * k4 + 4 * g + r > qrow) sT[k4][r] = -INFINITY;
        }
        float mx = -INFINITY;
#pragma unroll
        for (int k4 = 0; k4 < 4; ++k4) mx = fmaxf(mx, fmaxf(fmaxf(sT[k4][0], sT[k4][1]), fmaxf(sT[k4][2], sT[k4][3])));
        mx = fmaxf(mx, __shfl_xor(mx, 16)); mx = fmaxf(mx, __shfl_xor(mx, 32));
        const float mnew = fmaxf(mrun, mx); const float alpha = __builtin_amdgcn_exp2f(mrun - mnew); mrun = mnew;
        float psum = 0.f;
#pragma unroll
        for (int k4 = 0; k4 < 4; ++k4)
#pragma unroll
            for (int r = 0; r < 4; ++r) { const float pv = __builtin_amdgcn_exp2f(sT[k4][r] - mnew); sT[k4][r] = pv; psum += pv; }
        lsum = lsum * alpha + psum;
#pragma unroll
        for (int d = 0; d < NDT; ++d) oT[d] *= alpha;
#pragma unroll
        for (int kc = 0; kc < 2; ++kc) {
            const bf16x8 pb = __builtin_bit_cast(bf16x8, pk8(sT[2 * kc], sT[2 * kc + 1]));
#pragma unroll
            for (int d = 0; d < NDT; ++d) { const unsigned char* vp = Vs + (16 * d + j) * VS + (32 * kc + 4 * g) * 2;
                const u32x2 lo = *(const u32x2*)vp, hi = *(const u32x2*)(vp + 32); u32x4 w; w.x = lo.x; w.y = lo.y; w.z = hi.x; w.w = hi.y;
                oT[d] = __builtin_amdgcn_mfma_f32_16x16x32_bf16(__builtin_bit_cast(bf16x8, w), pb, oT[d], 0, 0, 0); }
        }
    }
#undef ATT_PREFETCH
    lsum += __shfl_xor(lsum, 16); lsum += __shfl_xor(lsum, 32);
    const float inv = 1.f / lsum;
#pragma unroll
    for (int d = 0; d < NDT; ++d) { u32x2 w; w.x = pk2(oT[d][0] * inv, oT[d][1] * inv); w.y = pk2(oT[d][2] * inv, oT[d][3] * inv);
        *(GAS u32x2*)(Ob + (size_t)qrow * ldo + 16 * d + 4 * g) = w; }
}

__device__ __forceinline__ void lora_act_rows(int wid_s, KP p_, int l, int r) {
    KP p = p_; asm volatile("" : "+s"(p));
    unsigned char* ws = p->ws;
    const int tid_ = mk_tid(wid_s);
    const int tid = tid_;
    const bf16* P = (const bf16*)(ws + R_P); bf16* Awa = (bf16*)(ws + WS_Y) + (size_t)r * TH * 1536 + 1024; bf16* Ag = (bf16*)(ws + WS_AG);
    const float* mu = p->in[I_MU] + l * 1792 + 1536;
    const int sub = tid & 31, j0 = sub * 8;
    f32x4 m0 = *(const f32x4*)(mu + j0), m1 = *(const f32x4*)(mu + j0 + 4);
    for (int row = blockIdx.x * 16 + (tid >> 5); row < TH; row += gridDim.x * 16) {
        const u32x4 cw = *(const u32x4*)(P + (size_t)row * NP + 1536 + j0);
        u32x4 pw = {0u, 0u, 0u, 0u}; if ((row & 2047) != 0) pw = *(const u32x4*)(P + (size_t)(row - 1) * NP + 1536 + j0);
        float c[8] = {bflo(cw.x), bfhi(cw.x), bflo(cw.y), bfhi(cw.y), bflo(cw.z), bfhi(cw.z), bflo(cw.w), bfhi(cw.w)};
        const float q[8] = {bflo(pw.x), bfhi(pw.x), bflo(pw.y), bfhi(pw.y), bflo(pw.z), bfhi(pw.z), bflo(pw.w), bfhi(pw.w)};
        const float mm[8] = {m0.x, m0.y, m0.z, m0.w, m1.x, m1.y, m1.z, m1.w};
#pragma unroll
        for (int e = 0; e < 8; ++e) { float v = c[e] + (q[e] - c[e]) * mm[e];
            if (j0 < 64) v = 2.f * fsig(2.f * v) - 1.f;
            else if (j0 >= 128) v = fsig(v);
            c[e] = v; }
        u32x4 o; o.x = pk2(c[0], c[1]); o.y = pk2(c[2], c[3]); o.z = pk2(c[4], c[5]); o.w = pk2(c[6], c[7]);
        if (j0 < 128) *(u32x4*)(Awa + (size_t)row * 1536 + j0) = o; else *(u32x4*)(Ag + (size_t)row * 128 + (j0 - 128)) = o;
    }
}
__device__ __forceinline__ void si_build_tile(int wid_s, KP p_, int l, int r, int tile) {
    KP p = p_; asm volatile("" : "+s"(p));
    unsigned char* ws = p->ws;
    const int tid_ = mk_tid(wid_s);
    const int tid = tid_, lane = tid & 63, wv = tid >> 6;
    const GAS bf16* P = (const GAS bf16*)(ws + R_P); GAS bf16* SI = (GAS bf16*)(ws + R_SI); const GAS bf16* LW = (const GAS bf16*)(ws + WS_Y) + (size_t)r * TH * 1536;
    const float* mu = p->in[I_MU] + l * 1792;
    const int row0 = tile * 32;
    const int c = tid, h = wv;
    const float w0c = p->in[I_W0][l * 512 + c], a0c = p->in[I_A0][l * 512 + c], kkc = p->in[I_KK][l * 512 + c], kac = p->in[I_KA][l * 512 + c];
    const float mur = mu[c], muk = mu[512 + c], muv = mu[1024 + c];
#pragma unroll 4
    for (int t = 0; t < 32; ++t) {
        const int row = row0 + t; const bool first = (row & 2047) == 0;
        const GAS bf16* pr = P + (size_t)row * NP; const GAS bf16* pp = pr - NP;
        const float rc = bf2f(pr[c]), kc = bf2f(pr[512 + c]), vc = bf2f(pr[1024 + c]);
        const float rp = first ? 0.f : bf2f(pp[c]), kp = first ? 0.f : bf2f(pp[512 + c]), vp = first ? 0.f : bf2f(pp[1024 + c]);
        const float wl = bf2f(LW[(size_t)row * 1536 + c]), al = bf2f(LW[(size_t)row * 1536 + 512 + c]);
        const float rr = rc + (rp - rc) * mur, k = kc + (kp - kc) * muk, v = vc + (vp - vc) * muv;
        const float om = 1.f - __expf(-0.6065306597126334f * fsig(w0c + wl));
        const float a = fsig(a0c + al);
        const float kkr = k * kkc; const float ss = wave_sum(kkr * kkr); const float kk = kkr / fmaxf(sqrtf(ss), 1e-12f);
        const float k2 = k * (1.f + (a - 1.f) * kac);
        GAS bf16* o = SI + ((size_t)((row >> 11) * 8 + h) * 2048 + (row & 2047)) * 384 + lane;
        o[0] = (bf16)f2bf(rr); o[64] = (bf16)f2bf(om); o[128] = (bf16)f2bf(k2); o[192] = (bf16)f2bf(kk); o[256] = (bf16)f2bf(kk * a); o[320] = (bf16)f2bf(v);
    }
}

template <int CTRL> __device__ __forceinline__ float dppf(float x) { return __builtin_bit_cast(float, __builtin_amdgcn_update_dpp(0, __builtin_bit_cast(int, x), CTRL, 0xF, 0xF, true)); }
__device__ __forceinline__ float allreduce8(float x);
__device__ __forceinline__ float allreduce16(float x) { x += dppf<0xB1>(x); x += dppf<0x4E>(x); x += dppf<0x141>(x); x += dppf<0x140>(x); return x; }
template <int MODE>
__device__ __forceinline__ void rwkv_scan_unit(int wid_s, const bf16* SIbh_, bf16* Yb_, int ystride, int quarter, float* ldsf) {
    const int tid_ = mk_tid(wid_s);
    const GAS bf16* SIbh = (const GAS bf16*)SIbh_; GAS bf16* Yb = (GAS bf16*)Yb_;
    const int tid = tid_, lane = tid & 63, wv = tid >> 6, hw = wv - 4;
    float* PYb = ldsf + 4 * (16 * 384);
    u32x4 hreg[12];
    if (wv >= 4 && wv < 7) {
#pragma unroll
        for (int i = 0; i < 12; ++i) hreg[i] = *(const GAS u32x4*)(SIbh + (size_t)hw * (16 * 384) + (size_t)(lane + 64 * i) * 8);
    }
    f32x2 Sa = {0.f, 0.f}, Sb = {0.f, 0.f};
    const int rowl = quarter * 16 + (wv & 3) * 4 + (lane >> 4), c4 = (lane & 15) * 4;
    __syncthreads();
#define SCAN_CONVERT(cn) do { float* Bd = ldsf + ((cn) & 3) * (16 * 384); \
        _Pragma("unroll") for (int i = 0; i < 12; ++i) { float* d = Bd + (lane + 64 * i) * 8; const u32x4 w = hreg[i]; \
            *(f32x4*)d = (f32x4){bflo(w.x), bfhi(w.x), bflo(w.y), bfhi(w.y)}; *(f32x4*)(d + 4) = (f32x4){bflo(w.z), bfhi(w.z), bflo(w.w), bfhi(w.w)}; } \
        if ((cn) + 3 < 128) { _Pragma("unroll") for (int i = 0; i < 12; ++i) hreg[i] = *(const GAS u32x4*)(SIbh + (size_t)((cn) + 3) * (16 * 384) + (size_t)(lane + 64 * i) * 8); } } while (0)
    if (wv == 4) SCAN_CONVERT(0);
    for (int ch = 0; ch <= 128; ++ch) {
        LBAR();
        if (wv < 4) {
            if (ch < 128) {
                const float* B = ldsf + (ch & 3) * (16 * 384);
                float* PY = PYb + (ch & 1) * (16 * 260) + wv * 64 + lane;
                const float* q = B;
                f32x4 r4 = *(const f32x4*)(q + c4), om4 = *(const f32x4*)(q + 64 + c4), k4 = *(const f32x4*)(q + 128 + c4), kk4 = *(const f32x4*)(q + 192 + c4), ka4 = *(const f32x4*)(q + 256 + c4);
                float v = q[320 + rowl];
                __builtin_amdgcn_s_setprio(3);
#pragma unroll
                for (int s = 0; s < 16; ++s) {
                    const float* qn = B + ((MODE & 2) ? 0 : ((s + 1) & 15)) * 384;
                    const f32x4 nr4 = *(const f32x4*)(qn + c4), nom4 = *(const f32x4*)(qn + 64 + c4), nk4 = *(const f32x4*)(qn + 128 + c4), nkk4 = *(const f32x4*)(qn + 192 + c4), nka4 = *(const f32x4*)(qn + 256 + c4);
                    const float nv = qn[320 + rowl];
                    const f32x2 pa = Sa * (f32x2){kk4.x, kk4.y} + Sb * (f32x2){kk4.z, kk4.w};
                    const float sa = (MODE & 1) ? (pa.x + pa.y) : allreduce16(pa.x + pa.y);
                    Sa = Sa - Sa * (f32x2){om4.x, om4.y} + (f32x2){k4.x, k4.y} * v; Sb = Sb - Sb * (f32x2){om4.z, om4.w} + (f32x2){k4.z, k4.w} * v;
                    Sa = Sa - (f32x2){ka4.x, ka4.y} * sa; Sb = Sb - (f32x2){ka4.z, ka4.w} * sa;
                    const f32x2 py = Sa * (f32x2){r4.x, r4.y} + Sb * (f32x2){r4.z, r4.w};
                    PY[s * 260] = py.x + py.y;
                    r4 = nr4; om4 = nom4; k4 = nk4; kk4 = nkk4; ka4 = nka4; v = nv;
                }
                __builtin_amdgcn_s_setprio(0);
            }
        } else if (wv == 7) {
            if (ch > 0) {
                const int s = lane >> 2, rr = lane & 3;
#pragma unroll
                for (int mw = 0; mw < 4; ++mw) {
                    const float* src = PYb + ((ch - 1) & 1) * (16 * 260) + s * 260 + mw * 64 + rr * 16;
                    const f32x4 a = *(const f32x4*)src, b = *(const f32x4*)(src + 4), c = *(const f32x4*)(src + 8), d = *(const f32x4*)(src + 12);
                    const float y = ((a.x + a.y) + (a.z + a.w)) + ((b.x + b.y) + (b.z + b.w)) + ((c.x + c.y) + (c.z + c.w)) + ((d.x + d.y) + (d.z + d.w));
                    Yb[(size_t)((ch - 1) * 16 + s) * ystride + quarter * 16 + mw * 4 + rr] = (bf16)f2bf(y);
                }
            }
        } else {
            const int cn = ch + 1;
            if (cn < 128 && (cn % 3) == hw) SCAN_CONVERT(cn);
        }
    }
#undef SCAN_CONVERT
    __syncthreads();
}

__device__ __forceinline__ void rwkv_post_tile(int wid_s, KP p_, int l, int r, int tile, int dummy) {
    KP p = p_; asm volatile("" : "+s"(p));
    unsigned char* ws = p->ws;
    const int tid_ = mk_tid(wid_s);
    const int tid = tid_, lane = tid & 63, wv = tid >> 6;
    const GAS bf16* P = (const GAS bf16*)(ws + R_P); const GAS bf16* SI = (const GAS bf16*)(ws + R_SI); GAS bf16* Y = (GAS bf16*)(ws + WS_Y) + (size_t)r * TH * 1536;
    const int row0 = tile * 32;
    const int c = tid, h = wv;
    const float rkc = p->in[I_RK][l * 512 + c], lng = p->in[I_LNG][l * 512 + c], lnb = p->in[I_LNB][l * 512 + c];
#pragma unroll 4
    for (int t = 0; t < 32; ++t) {
        const int row = row0 + t;
        const GAS bf16* si = SI + ((size_t)((row >> 11) * 8 + h) * 2048 + (row & 2047)) * 384 + lane;
        const float rr = bf2f(si[0]), k2 = bf2f(si[128]), v = bf2f(si[320]);
        const float gg = bf2f(P[(size_t)row * NP + c]);
        GAS bf16* yp = Y + (size_t)row * 1536 + c;
        const float y = bf2f(*yp);
        const float mean = wave_sum(y) * (1.f / 64.f); const float d = y - mean; const float var = wave_sum(d * d) * (1.f / 64.f);
        const float yn = d * rsqrtf(var + 64e-5f) * lng + lnb;
        const float bonus = wave_sum(rr * k2 * rkc) * v;
        if (dummy) yp = (GAS bf16*)(ws + R_P) + (size_t)row * NP + 600 + c;
        *yp = (bf16)f2bf((yn + bonus) * gg);
    }
}

__device__ __forceinline__ float allreduce8(float x) { x += dppf<0xB1>(x); x += dppf<0x4E>(x); x += dppf<0x141>(x); return x; }
__device__ __forceinline__ void unpack8(const u32x4 w, float* f) { f[0] = bflo(w.x); f[1] = bfhi(w.x); f[2] = bflo(w.y); f[3] = bfhi(w.y); f[4] = bflo(w.z); f[5] = bfhi(w.z); f[6] = bflo(w.w); f[7] = bfhi(w.w); }
__device__ __forceinline__ u32x4 pack8(const float* f) { u32x4 o; o.x = pk2(f[0], f[1]); o.y = pk2(f[2], f[3]); o.z = pk2(f[4], f[5]); o.w = pk2(f[6], f[7]); return o; }
__device__ __forceinline__ void ld8f(const GAS float* q, float* f) { const f32x4 a = *(const GAS f32x4*)q, b = *(const GAS f32x4*)(q + 4); f[0] = a.x; f[1] = a.y; f[2] = a.z; f[3] = a.w; f[4] = b.x; f[5] = b.y; f[6] = b.z; f[7] = b.w; }
__device__ __forceinline__ void si_build_rows(int wid_s, KP p_, int l, int r) {
    KP p = p_; asm volatile("" : "+s"(p));
    unsigned char* ws = p->ws;
    const int tid_ = mk_tid(wid_s);
    const int tid = tid_, lane = tid & 63, wv = tid >> 6, c0 = lane * 8, h = lane >> 3;
    const GAS bf16* P = (const GAS bf16*)(ws + R_P); GAS bf16* SI = (GAS bf16*)(ws + R_SI); const GAS bf16* LW = (const GAS bf16*)(ws + WS_Y) + (size_t)r * TH * 1536;
    float w0c[8], a0c[8], kkc[8], kac[8], mur[8], muk[8], muv[8];
    ld8f((const GAS float*)p->in[I_W0] + l * 512 + c0, w0c); ld8f((const GAS float*)p->in[I_A0] + l * 512 + c0, a0c); ld8f((const GAS float*)p->in[I_KK] + l * 512 + c0, kkc); ld8f((const GAS float*)p->in[I_KA] + l * 512 + c0, kac);
    ld8f((const GAS float*)p->in[I_MU] + l * 1792 + c0, mur); ld8f((const GAS float*)p->in[I_MU] + l * 1792 + 512 + c0, muk); ld8f((const GAS float*)p->in[I_MU] + l * 1792 + 1024 + c0, muv);
    for (int row = blockIdx.x * 8 + wv; row < TH; row += gridDim.x * 8) {
        const bool first = (row & 2047) == 0;
        const GAS bf16* pr = P + (size_t)row * NP + c0; const GAS bf16* pp = pr - NP;
        const u32x4 z4 = {0u, 0u, 0u, 0u};
        const u32x4 rcw = *(const GAS u32x4*)pr, kcw = *(const GAS u32x4*)(pr + 512), vcw = *(const GAS u32x4*)(pr + 1024);
        const u32x4 rpw = first ? z4 : *(const GAS u32x4*)pp, kpw = first ? z4 : *(const GAS u32x4*)(pp + 512), vpw = first ? z4 : *(const GAS u32x4*)(pp + 1024);
        const u32x4 wlw = *(const GAS u32x4*)(LW + (size_t)row * 1536 + c0), alw = *(const GAS u32x4*)(LW + (size_t)row * 1536 + 512 + c0);
        float rc[8], kc[8], vc[8], rp[8], kp[8], vp[8], wl[8], al[8];
        unpack8(rcw, rc); unpack8(kcw, kc); unpack8(vcw, vc); unpack8(rpw, rp); unpack8(kpw, kp); unpack8(vpw, vp); unpack8(wlw, wl); unpack8(alw, al);
        float rr[8], om[8], k2[8], kk[8], ka[8], vv[8]; float ss = 0.f;
#pragma unroll
        for (int e = 0; e < 8; ++e) { rr[e] = rc[e] + (rp[e] - rc[e]) * mur[e]; const float k = kc[e] + (kp[e] - kc[e]) * muk[e]; vv[e] = vc[e] + (vp[e] - vc[e]) * muv[e];
            om[e] = 1.f - __expf(-0.6065306597126334f * fsig(w0c[e] + wl[e]));
            const float a = fsig(a0c[e] + al[e]);
            kk[e] = k * kkc[e]; ss += kk[e] * kk[e]; k2[e] = k * (1.f + (a - 1.f) * kac[e]); ka[e] = a; }
        ss = allreduce8(ss);
        const float inv = 1.f / fmaxf(sqrtf(ss), 1e-12f);
#pragma unroll
        for (int e = 0; e < 8; ++e) { kk[e] *= inv; ka[e] *= kk[e]; }
        GAS bf16* o = SI + ((size_t)((row >> 11) * 8 + h) * 2048 + (row & 2047)) * 384 + (lane & 7) * 8;
        *(GAS u32x4*)o = pack8(rr); *(GAS u32x4*)(o + 64) = pack8(om); *(GAS u32x4*)(o + 128) = pack8(k2); *(GAS u32x4*)(o + 192) = pack8(kk); *(GAS u32x4*)(o + 256) = pack8(ka); *(GAS u32x4*)(o + 320) = pack8(vv);
    }
}
__device__ __forceinline__ void rwkv_post_rows(int wid_s, KP p_, int l, int r, int dummy) {
    KP p = p_; asm volatile("" : "+s"(p));
    unsigned char* ws = p->ws;
    const int tid_ = mk_tid(wid_s);
    const int tid = tid_, lane = tid & 63, wv = tid >> 6, c0 = lane * 8, h = lane >> 3;
    const GAS bf16* P = (const GAS bf16*)(ws + R_P); const GAS bf16* SI = (const GAS bf16*)(ws + R_SI); GAS bf16* Y = (GAS bf16*)(ws + WS_Y) + (size_t)r * TH * 1536;
    float rkc[8], lng[8], lnb[8];
    ld8f((const GAS float*)p->in[I_RK] + l * 512 + c0, rkc); ld8f((const GAS float*)p->in[I_LNG] + l * 512 + c0, lng); ld8f((const GAS float*)p->in[I_LNB] + l * 512 + c0, lnb);
    for (int row = blockIdx.x * 8 + wv; row < TH; row += gridDim.x * 8) {
        const GAS bf16* si = SI + ((size_t)((row >> 11) * 8 + h) * 2048 + (row & 2047)) * 384 + (lane & 7) * 8;
        const u32x4 rw = *(const GAS u32x4*)si, kw = *(const GAS u32x4*)(si + 128), vw = *(const GAS u32x4*)(si + 320);
        const u32x4 gw = *(const GAS u32x4*)(P + (size_t)row * NP + c0);
        GAS bf16* yp = Y + (size_t)row * 1536 + c0;
        const u32x4 yw = *(const GAS u32x4*)yp;
        float rr[8], k2[8], vv[8], gg[8], y[8];
        unpack8(rw, rr); unpack8(kw, k2); unpack8(vw, vv); unpack8(gw, gg); unpack8(yw, y);
        float sy = 0.f, sb = 0.f;
#pragma unroll
        for (int e = 0; e < 8; ++e) { sy += y[e]; sb += rr[e] * k2[e] * rkc[e]; }
        const float mean = allreduce8(sy) * (1.f / 64.f); const float bonus = allreduce8(sb);
        float sv = 0.f;
#pragma unroll
        for (int e = 0; e < 8; ++e) { y[e] -= mean; sv += y[e] * y[e]; }
        const float rs = rsqrtf(allreduce8(sv) * (1.f / 64.f) + 64e-5f);
#pragma unroll
        for (int e = 0; e < 8; ++e) y[e] = (y[e] * rs * lng[e] + lnb[e] + bonus * vv[e]) * gg[e];
        if (dummy) yp = (GAS bf16*)(ws + R_P) + (size_t)row * NP + 600 + c0;
        *(GAS u32x4*)yp = pack8(y);
    }
}

__device__ __forceinline__ float gelu_tanh(float x) { const float u = 0.7978845608028654f * (x + 0.044715f * x * x * x); return x * fsig(2.f * u); }
__device__ __forceinline__ void lru_unit(int wid_s, KP p_, int l, int r, int bl, int n, float* ldsf) {
    KP p = p_; asm volatile("" : "+s"(p));
    unsigned char* ws = p->ws;
    const int tid_ = mk_tid(wid_s);
    const int tid = tid_, lane = tid & 63, wv = tid >> 6, g = lane >> 4, j = lane & 15;
    const GAS bf16* P = (const GAS bf16*)(ws + R_P) + (size_t)bl * 2048 * NP; GAS bf16* Yb = (GAS bf16*)(ws + WS_Y) + ((size_t)(r * 4 + bl) * 2048) * 1536 + 512;
    const int cg_ = n * 64 + lane;
    float* s_xc = ldsf;
    float* s_a = ldsf + 8192;
    float* s_u = ldsf + 16384;
    float* s_AH = ldsf + 24576;
    unsigned char* s_xb16 = (unsigned char*)ldsf + 102400;
    unsigned char* s_wt16 = (unsigned char*)ldsf + 120832;
    LBAR();
    for (int e = tid; e < 8192; e += 512) { const int jj = e >> 6, ii = e & 63;
        const float w = (jj < 64) ? p->in[I_WA][((size_t)l * 8 + n) * 4096 + ii * 64 + jj] : p->in[I_WX][((size_t)l * 8 + n) * 4096 + ii * 64 + (jj - 64)];
        *(bf16*)(s_wt16 + (jj * 72 + ii) * 2) = (bf16)f2bf(w); }
    const float cw0 = p->in[I_CW][(l * 4 + 0) * 512 + cg_], cw1 = p->in[I_CW][(l * 4 + 1) * 512 + cg_], cw2 = p->in[I_CW][(l * 4 + 2) * 512 + cg_], cw3 = p->in[I_CW][(l * 4 + 3) * 512 + cg_];
    const float cb = p->in[I_CB][l * 512 + cg_];
    float ba4[4], bx4[4], sp4[4];
#pragma unroll
    for (int n4 = 0; n4 < 4; ++n4) { const int c = n * 64 + 16 * n4 + j; ba4[n4] = p->in[I_BA][l * 512 + c]; bx4[n4] = p->in[I_BX][l * 512 + c];
        sp4[n4] = -8.f * 1.4426950408889634f * log1pf(__expf(-p->in[I_LAM][l * 512 + c])); }
    float hcar = 0.f;
    for (int tile = 0; tile < 16; ++tile) {
        const int t0 = tile * 128 + wv * 16;
        float xc[16]; unsigned short gbr[16];
        {
            float x3 = (t0 >= 3) ? bf2f(P[(size_t)(t0 - 3) * NP + 1792 + cg_]) : 0.f, x2 = (t0 >= 2) ? bf2f(P[(size_t)(t0 - 2) * NP + 1792 + cg_]) : 0.f, x1 = (t0 >= 1) ? bf2f(P[(size_t)(t0 - 1) * NP + 1792 + cg_]) : 0.f;
#pragma unroll
            for (int i = 0; i < 16; ++i) { const float x0 = bf2f(P[(size_t)(t0 + i) * NP + 1792 + cg_]);
                xc[i] = cw0 * x3 + cw1 * x2 + cw2 * x1 + cw3 * x0 + cb; x3 = x2; x2 = x1; x1 = x0; }
#pragma unroll
            for (int i = 0; i < 16; ++i) gbr[i] = P[(size_t)(t0 + i) * NP + 2304 + cg_];
        }
        LBAR();
#pragma unroll
        for (int i = 0; i < 16; ++i) { s_xc[(wv * 16 + i) * 64 + lane] = xc[i]; *(bf16*)(s_xb16 + ((wv * 16 + i) * 72 + lane) * 2) = (bf16)f2bf(xc[i]); }
        LBAR();
        {
            f32x4 acc[8];
            const bf16x8 a0 = *(const bf16x8*)(s_xb16 + ((16 * wv + j) * 72 + 8 * g) * 2), a1 = *(const bf16x8*)(s_xb16 + ((16 * wv + j) * 72 + 32 + 8 * g) * 2);
#pragma unroll
            for (int nn = 0; nn < 8; ++nn) { acc[nn] = (f32x4){0.f, 0.f, 0.f, 0.f};
                const bf16x8 b0 = *(const bf16x8*)(s_wt16 + ((16 * nn + j) * 72 + 8 * g) * 2), b1 = *(const bf16x8*)(s_wt16 + ((16 * nn + j) * 72 + 32 + 8 * g) * 2);
                acc[nn] = __builtin_amdgcn_mfma_f32_16x16x32_bf16(a0, b0, acc[nn], 0, 0, 0); acc[nn] = __builtin_amdgcn_mfma_f32_16x16x32_bf16(a1, b1, acc[nn], 0, 0, 0); }
#pragma unroll
            for (int n4 = 0; n4 < 4; ++n4)
#pragma unroll
                for (int rr = 0; rr < 4; ++rr) { const int tk = 16 * wv + 4 * g + rr, c = 16 * n4 + j;
                    const float rg = fsig(acc[n4][rr] + ba4[n4]), ig = fsig(acc[n4 + 4][rr] + bx4[n4]);
                    const float a = __builtin_amdgcn_exp2f(sp4[n4] * rg);
                    const float uu = __builtin_amdgcn_sqrtf(fmaxf(1.f - a * a, 0.f)) * (ig * s_xc[tk * 64 + c]);
                    s_a[tk * 64 + c] = a; s_u[tk * 64 + c] = uu; }
        }
        LBAR();
        float av[16], uv[16]; float A = 1.f, H = 0.f;
#pragma unroll
        for (int i = 0; i < 16; ++i) { av[i] = s_a[(wv * 16 + i) * 64 + lane]; uv[i] = s_u[(wv * 16 + i) * 64 + lane]; A *= av[i]; H = av[i] * H + uv[i]; }
        s_AH[(wv * 64 + lane) * 2] = A; s_AH[(wv * 64 + lane) * 2 + 1] = H;
        LBAR();
        float hin = hcar, hall = hcar;
#pragma unroll
        for (int w = 0; w < 8; ++w) { const float Aw = s_AH[(w * 64 + lane) * 2], Hw = s_AH[(w * 64 + lane) * 2 + 1]; hall = Aw * hall + Hw; if (w < wv) hin = hall; }
        hcar = hall;
        float hh = hin;
#pragma unroll
        for (int i = 0; i < 16; ++i) { hh = av[i] * hh + uv[i];
            Yb[(size_t)(t0 + i) * 1536 + cg_] = (bf16)f2bf(hh * gelu_tanh(bf2f(gbr[i]))); }
    }
    LBAR();
}

__device__ __forceinline__ void kfix_rows(int wid_s, KP p_, int l, int r) {
    KP p = p_; asm volatile("" : "+s"(p));
    unsigned char* ws = p->ws;
    const int tid_ = mk_tid(wid_s);
    const int tid = tid_, lane = tid & 63, wv = tid >> 6, h = lane >> 3, sub = lane & 7;
    const GAS bf16* P = (const GAS bf16*)(ws + R_P); GAS bf16* Km = (GAS bf16*)(ws + R_KM);
    const float* kg = p->in[I_KG] + l * 96; const int* pos = (const int*)p->in[I_POS] + r * TH;
    for (int row = blockIdx.x * 8 + wv; row < TH; row += gridDim.x * 8) {
        GAS bf16* kp = Km + (size_t)row * 768 + h * 96;
        const u32x4 w = *(const GAS u32x4*)(kp + 8 * sub);
        float nv[8] = {bflo(w.x), bfhi(w.x), bflo(w.y), bfhi(w.y), bflo(w.z), bfhi(w.z), bflo(w.w), bfhi(w.w)};
        const unsigned k1 = *(const GAS unsigned*)(P + (size_t)row * NP + 3200 + 2 * sub), k2 = *(const GAS unsigned*)(P + (size_t)row * NP + 3216 + 2 * sub);
        float x1a = bflo(k1), x1b = bfhi(k1), x2a = bflo(k2), x2b = bfhi(k2);
        float ss = x1a * x1a + x1b * x1b + x2a * x2a + x2b * x2b;
#pragma unroll
        for (int e = 0; e < 8; ++e) ss += nv[e] * nv[e];
        ss += __shfl_xor(ss, 1); ss += __shfl_xor(ss, 2); ss += __shfl_xor(ss, 4);
        const float rs = rsqrtf(ss * (1.f / 96.f) + 1e-6f);
#pragma unroll
        for (int e = 0; e < 8; ++e) nv[e] *= rs * kg[8 * sub + e];
        x1a *= rs * kg[64 + 2 * sub]; x1b *= rs * kg[65 + 2 * sub]; x2a *= rs * kg[80 + 2 * sub]; x2b *= rs * kg[81 + 2 * sub];
        const int ps = pos[row]; float ca, sa, cb, sb; rope_cs(ps, 2 * sub, ca, sa); rope_cs(ps, 2 * sub + 1, cb, sb);
        u32x4 o; o.x = pk2(nv[0], nv[1]); o.y = pk2(nv[2], nv[3]); o.z = pk2(nv[4], nv[5]); o.w = pk2(nv[6], nv[7]);
        *(GAS u32x4*)(kp + 8 * sub) = o;
        *(GAS unsigned*)(kp + 64 + 2 * sub) = pk2(x1a * ca - x2a * sa, x1b * cb - x2b * sb);
        *(GAS unsigned*)(kp + 80 + 2 * sub) = pk2(x2a * ca + x1a * sa, x2b * cb + x1b * sb);
    }
}
__device__ __forceinline__ void mkfix_rows(int wid_s, KP p_, int l) {
    KP p = p_; asm volatile("" : "+s"(p));
    unsigned char* ws = p->ws;
    const int tid_ = mk_tid(wid_s);
    const int tid = tid_, lane = tid & 63, wv = tid >> 6, h = lane >> 4, sub = lane & 15;
    bf16* mk = (bf16*)(ws + R_MK); const float* kg = p->in[I_XKG] + l * 128;
    for (int row = blockIdx.x * 8 + wv; row < 2048; row += gridDim.x * 8) {
        bf16* kp = mk + (size_t)row * 512 + h * 128 + 8 * sub;
        const u32x4 w = *(const u32x4*)kp;
        float nv[8] = {bflo(w.x), bfhi(w.x), bflo(w.y), bfhi(w.y), bflo(w.z), bfhi(w.z), bflo(w.w), bfhi(w.w)};
        float ss = 0.f;
#pragma unroll
        for (int e = 0; e < 8; ++e) ss += nv[e] * nv[e];
        ss += __shfl_xor(ss, 1); ss += __shfl_xor(ss, 2); ss += __shfl_xor(ss, 4); ss += __shfl_xor(ss, 8);
        const float rs = rsqrtf(ss * (1.f / 128.f) + 1e-6f);
#pragma unroll
        for (int e = 0; e < 8; ++e) nv[e] *= rs * kg[8 * sub + e];
        u32x4 o; o.x = pk2(nv[0], nv[1]); o.y = pk2(nv[2], nv[3]); o.z = pk2(nv[4], nv[5]); o.w = pk2(nv[6], nv[7]);
        *(u32x4*)kp = o;
    }
}
__device__ __forceinline__ void memb_rows(int wid_s, KP p_) {
    KP p = p_; asm volatile("" : "+s"(p));
    unsigned char* ws = p->ws;
    const int tid_ = mk_tid(wid_s);
    const int tid = tid_, lane = tid & 63, wv = tid >> 6;
    const float* mem = p->in[I_MEM]; bf16* memb = (bf16*)(ws + R_MEMB);
    for (int row = blockIdx.x * 8 + wv; row < 2048; row += gridDim.x * 8) {
        const f32x4* xr = (const f32x4*)(mem + (size_t)row * 1024) + lane; f32x4 v[4]; float s = 0.f;
#pragma unroll
        for (int jq = 0; jq < 4; ++jq) { v[jq] = xr[64 * jq]; s += (v[jq].x * v[jq].x + v[jq].y * v[jq].y) + (v[jq].z * v[jq].z + v[jq].w * v[jq].w); }
        const float rs = rsqrtf(wave_sum(s) * (1.f / 1024.f) + 1e-6f);
#pragma unroll
        for (int jq = 0; jq < 4; ++jq) { u32x2 w; w.x = pk2(v[jq].x * rs, v[jq].y * rs); w.y = pk2(v[jq].z * rs, v[jq].w * rs); *((u32x2*)(memb + (size_t)row * 1024) + lane + 64 * jq) = w; }
    }
}

#define XB_TMO      128
#define XB_XCNT(j)  (256  + 64 * (j))
#define XB_XSUB(j)  (1280 + 64 * (j))
#define XB_XGEN(j)  (2304 + 64 * (j))
#define XB_TOP      3328
#define XB_TOPGEN   3392
#define XCD_BAR_WORDS 3456
#define XB_SPIN_CAP (1u << 22)
__device__ __forceinline__ unsigned xb_ld(unsigned* p)              { return __hip_atomic_load(p, __ATOMIC_RELAXED, __HIP_MEMORY_SCOPE_AGENT); }
__device__ __forceinline__ unsigned xb_add(unsigned* p, unsigned v) { return __hip_atomic_fetch_add(p, v, __ATOMIC_RELAXED, __HIP_MEMORY_SCOPE_AGENT); }
__device__ __forceinline__ unsigned xb_xcc_id() { return (unsigned)__builtin_amdgcn_s_getreg((3 << 11) | 20) & 0xFu; }
#define XB_SPIN(cond, bar) do { unsigned _sp = 0; while (cond) { __builtin_amdgcn_s_sleep(1); \
    if ((++_sp & 255u) == 0u) { if (xb_ld(&(bar)[XB_TMO])) break; if (_sp > XB_SPIN_CAP) { atomicAdd(&(bar)[XB_TMO], 1u); break; } } } } while (0)
__device__ __forceinline__ void xcd_barrier_complete(unsigned* bar, unsigned x, unsigned& nloc, unsigned& nx) {
    const unsigned G = gridDim.x;
    unsigned sum, cnt, mine, sp = 0u;
    for (;;) {
        sum = 0u; cnt = 0u; mine = 0u;
#pragma unroll
        for (unsigned j = 0; j < 16; ++j) { const unsigned c = xb_ld(&bar[XB_XCNT(j)]); sum += c; cnt += (c > 0u) ? 1u : 0u; mine = (j == x) ? c : mine; }
        if (sum == G) break;
        __builtin_amdgcn_s_sleep(1);
        if ((++sp & 255u) == 0u) { if (xb_ld(&bar[XB_TMO])) break; if (sp > XB_SPIN_CAP) { atomicAdd(&bar[XB_TMO], 1u); break; } }
    }
    nloc = mine > 0u ? mine : 1u; nx = cnt > 0u ? cnt : 1u;
}
__device__ __forceinline__ void grid_barrier1(int wid_s, unsigned* bar, volatile unsigned* st) {
    asm volatile("s_waitcnt vmcnt(0)" ::: "memory");
    __syncthreads();
    if (mk_tid(wid_s) == 0) {
        const unsigned x = xb_xcc_id();
        __builtin_amdgcn_s_waitcnt(0);
        unsigned nloc = st[0], nx = st[1];
        if (nloc == 0u) { xcd_barrier_complete(bar, x, nloc, nx); st[0] = nloc; st[1] = nx; }
        const unsigned old = xb_add(&bar[XB_XSUB(x)], 1u);
        const unsigned gen = old / nloc;
        if (old + 1u == (gen + 1u) * nloc) {
            __builtin_amdgcn_fence(__ATOMIC_RELEASE, "agent");
            asm volatile("s_waitcnt vmcnt(0)" ::: "memory");
            const unsigned og = xb_add(&bar[XB_TOP], 1u);
            const unsigned tg = og / nx;
            if (og + 1u == (tg + 1u) * nx) xb_add(&bar[XB_TOPGEN], 1u);
            else XB_SPIN(xb_ld(&bar[XB_TOPGEN]) == tg, bar);
            __builtin_amdgcn_fence(__ATOMIC_ACQUIRE, "agent");
            xb_add(&bar[XB_XGEN(x)], 1u);
            asm volatile("s_waitcnt vmcnt(0)" ::: "memory");
        } else {
            XB_SPIN(xb_ld(&bar[XB_XGEN(x)]) == gen, bar);
            __builtin_amdgcn_fence(__ATOMIC_ACQUIRE, "agent");
            asm volatile("s_waitcnt vmcnt(0)" ::: "memory");
        }
    }
    __syncthreads();
}
__device__ __forceinline__ void grid_barrier(int wid_s, unsigned* bar, volatile unsigned* st) { int nb = 1 + RB(8); asm volatile("" : "+s"(nb)); for (int q = 0; q < nb; ++q) grid_barrier1(wid_s, bar, st); }
struct GateOrder {
    pg8::StaticOrder base;
    __device__ bool next(int i, pg8::Unit& u) const { if (i >= 3) return false; pg8::Unit u0; if (!base.next(0, u0)) return false; u.pm = u0.pm; u.pn = i * 4 + u0.pn; return true; }
};
template <class Epi>
__device__ __forceinline__ void run_gemm_gate(int wid_s, LAS unsigned char* lds, const bf16* A, const bf16* Bt, const Epi& E) {
    int bx_ = blockIdx.x, gx_ = gridDim.x, K = 1024, lda = 1024; asm volatile("" : "+s"(bx_), "+s"(gx_), "+s"(K), "+s"(lda));
    pg8::Gemm g{A, Bt, T, 3072, K, lda}; GateOrder S; S.base.init(T, 1024, gx_, bx_);
    if (ON(1)) pg8::gemm_phase<Epi, GateOrder>(wid_s, lds, g, S, E);
}
template <class Epi>
__device__ __forceinline__ void run_gemm(int wid_s, LAS unsigned char* lds, const bf16* A, int lda, const bf16* Bt, int M, int N, int K, const Epi& E, int shift = 0) {
    int bx_ = blockIdx.x, gx_ = gridDim.x; asm volatile("" : "+s"(bx_), "+s"(gx_), "+s"(K), "+s"(lda));
    pg8::Gemm g{A, Bt, M, N, K, lda}; pg8::StaticOrder S; S.init(M, N, gx_, (bx_ + shift) % gx_);
    if (ON(1)) pg8::gemm_phase<Epi, pg8::StaticOrder>(wid_s, lds, g, S, E);
}

__device__ __forceinline__ unsigned char* wsl_(KP p) { unsigned char* w = p->ws; asm volatile("" : "+s"(w)); return w; }
__global__ void __launch_bounds__(512, 2) fwd_kernel(Params parg) {
    KP p = (KP)__builtin_amdgcn_kernarg_segment_ptr();
    extern __shared__ __attribute__((aligned(16))) unsigned char lds_raw[];
    const int wid_s = __builtin_amdgcn_readfirstlane((int)threadIdx.x >> 6);
    LAS unsigned char* lds3 = (LAS unsigned char*)lds_raw;
    unsigned char* lds = lds_raw; float* ldsf = (float*)lds_raw;
    unsigned char* ws = p->ws;
    const int bid = blockIdx.x;
    unsigned* ctl = (unsigned*)(wsl_(p) + WS_CTL);
    bf16* xb = (bf16*)(wsl_(p) + WS_XB); float* part = (float*)(wsl_(p) + WS_PART); float* pq = (float*)(wsl_(p) + WS_PQ); float* pkv = (float*)(wsl_(p) + WS_PKV);
    bf16* Y = (bf16*)(wsl_(p) + WS_Y);
    float* xcur = p->out;
    volatile unsigned* bst = (volatile unsigned*)(lds + QIDX_OFF + 16);
    if (threadIdx.x == 0) { bst[0] = 0u; bst[1] = 0u; (void)xb_add(&ctl[1024 + XB_XCNT(xb_xcc_id())], 1u); }
    __syncthreads();

    for (int l_ = 0; l_ < 2; ++l_) {
        int l = l_; asm volatile("" : "+s"(l));
        if (l == 0) { REPLOOP(0) { if (ON(0)) phase_convert(wid_s, p, l, ldsf, bid, (int)gridDim.x);
        grid_barrier(wid_s, ctl + 1024, bst); } }
        for (int r_ = 0; r_ < 2; ++r_) {
            int r = r_; asm volatile("" : "+s"(r));
            { REPLOOP(1) { EpiP E{(bf16*)(wsl_(p) + R_P), part + (size_t)r * TH * 16, pq, pkv};
              run_gemm(wid_s, lds3, xb + (size_t)r * TH * 1024, 1024, (const bf16*)(wsl_(p) + W_IN), TH, NP, 1024, E);
              if (r == 0 && q == 0 && bid >= 160) { __syncthreads(); phase_convert_mid(wid_s, p, l, ldsf, (bid - 160) * 8 + (mk_tid(wid_s) >> 6), (int)(gridDim.x - 160) * 8); __syncthreads(); }
            grid_barrier(wid_s, ctl + 1024, bst); } }
            { REPLOOP(2) {
            if (ON(2)) lora_act_rows(wid_s, p, l, r);
            { EpiQ E{(bf16*)(wsl_(p) + R_Q), pq}; run_gemm(wid_s, lds3, (const bf16*)(wsl_(p) + R_P) + 2816, NP, (const bf16*)(wsl_(p) + W_MQ), TH, 768, 256, E); }
            { EpiKV E{(bf16*)(wsl_(p) + R_KM), (bf16*)(wsl_(p) + R_VT), pkv}; run_gemm(wid_s, lds3, (const bf16*)(wsl_(p) + R_P) + 3072, NP, (const bf16*)(wsl_(p) + W_MKV), TH, 1024, 128, E, 128); }
            grid_barrier(wid_s, ctl + 1024, bst); } }
            { REPLOOP(9) { EpiBf E{Y + (size_t)r * TH * 1536, 1536}; run_gemm(wid_s, lds3, Y + (size_t)r * TH * 1536 + 1024, 1536, (const bf16*)(wsl_(p) + W_BWA), TH, 1024, 128, E);
            grid_barrier(wid_s, ctl + 1024, bst); } }
            { REPLOOP(13) { if (ON(2)) si_build_rows(wid_s, p, l, r); } }
            if (ON(7)) kfix_rows(wid_s, p, l, r);
            grid_barrier(wid_s, ctl + 1024, bst);
            { REPLOOP(3) {
            if (ON(3) && !(q && RB(10)) && bid < 128) { const int xcd = bid & 7, idx = bid >> 3, hh = xcd * 4 + (idx >> 2), quarter = idx & 3;
                if (q == 0 || SCANMODE == 0) rwkv_scan_unit<0>(wid_s, (const bf16*)(wsl_(p) + R_SI) + (size_t)hh * 2048 * 384, Y + ((size_t)(r * 4 + (hh >> 3)) * 2048) * 1536 + (hh & 7) * 64, 1536, quarter, ldsf);
                else rwkv_scan_unit<SCANMODE>(wid_s, (const bf16*)(wsl_(p) + R_SI) + (size_t)hh * 2048 * 384, (bf16*)(wsl_(p) + R_P) + ((size_t)(hh >> 3) * 2048) * NP + 600 + (hh & 7) * 64, NP, quarter, ldsf); }
            else if (ON(4) && !(q && RB(11)) && bid >= 128 && bid < 160) { const int uu = bid - 128; lru_unit(wid_s, p, l, r, uu >> 3, uu & 7, ldsf); }
            else if (q == 0) { EpiBf E{(bf16*)(wsl_(p) + R_P), NP}; run_gemm(wid_s, lds3, (const bf16*)(wsl_(p) + WS_AG), 128, (const bf16*)(wsl_(p) + W_GUP), TH, 512, 128, E, 96); }
            {
                unsigned* ctr = ctl + q * 4 + l * 2 + r; volatile int* qidx = (volatile int*)(lds + QIDX_OFF);
                for (;;) {
                    __syncthreads();
                    if (mk_tid(wid_s) == 0) *qidx = (int)atomicAdd(ctr, 1u);
                    __syncthreads();
                    const int u = *qidx;
                    if (u >= 512 || !ON(5) || (q && RB(12))) break;
                    const int qb = 15 - (u >> 5), bh = u & 31, bl = bh >> 3, h = bh & 7;
                    attn_unit<96, 64, true, true>(wid_s, lds, (const bf16*)(wsl_(p) + R_Q) + (size_t)bl * 2048 * 768 + h * 96, 768, (const bf16*)(wsl_(p) + R_KM) + (size_t)bl * 2048 * 768 + h * 96, 768,
                        (const bf16*)(wsl_(p) + R_VT) + (size_t)(bl * 8 + h) * 64 * 2048, 2048, Y + ((size_t)(r * 4 + bl) * 2048) * 1536 + 1024 + h * 64, 1536,
                        qb * 128, 2 * qb + 2, p->in[I_QG] + l * 96, (const int*)p->in[I_POS] + (r * 4 + bl) * 2048, 0.14724444527f  );
                }
            }
            grid_barrier(wid_s, ctl + 1024, bst); } }
            { REPLOOP(16) { if (ON(6)) rwkv_post_rows(wid_s, p, l, r, q); } }
            grid_barrier(wid_s, ctl + 1024, bst);
        }
        if (ON(7)) memb_rows(wid_s, p);
        { REPLOOP(4) {
        { EpiGate E{(unsigned char*)(wsl_(p) + R_GS), part, p->in[I_BGATE] + l * 3072}; run_gemm_gate(wid_s, lds3, xb, (const bf16*)(wsl_(p) + W_GATE), E); }
        for (int n = 0; n < 3; ++n) {
            { EpiProj E{(const unsigned char*)(wsl_(p) + R_GS), (float*)(wsl_(p) + R_MS), (bf16*)(wsl_(p) + R_MG), n}; run_gemm(wid_s, lds3, Y + n * 512, 1536, (const bf16*)(wsl_(p) + W_BR) + (size_t)n * 1024 * 512, T, 1024, 512, E); }
        }
        grid_barrier(wid_s, ctl + 1024, bst); } }
        { int nw = 1 + RB(15); asm volatile("" : "+s"(nw)); for (int q = 0; q < nw; ++q) { EpiRes E{nullptr, xb, part, q + 1 < nw}; run_gemm(wid_s, lds3, (const bf16*)(wsl_(p) + R_MG), 1024, (const bf16*)(wsl_(p) + W_OUT), T, 1024, 1024, E); if (q + 1 < nw) grid_barrier(wid_s, ctl + 1024, bst); } }
        { REPLOOP(19) { EpiMemKV E{(bf16*)(wsl_(p) + R_MK), (bf16*)(wsl_(p) + R_MVT)}; run_gemm(wid_s, lds3, (const bf16*)(wsl_(p) + R_MEMB), 1024, (const bf16*)(wsl_(p) + W_XKV), 2048, 1024, 1024, E); } }
        grid_barrier(wid_s, ctl + 1024, bst);
        if (ON(7)) mkfix_rows(wid_s, p, l);
        if (bid >= 128) { __syncthreads(); phase_convert_ffn(wid_s, p, l, ldsf, (bid - 128) * 8 + (mk_tid(wid_s) >> 6), (int)(gridDim.x - 128) * 8); __syncthreads(); }
        { REPLOOP(5) { EpiXQ E{(bf16*)(wsl_(p) + R_XQ), part}; run_gemm(wid_s, lds3, xb, 1024, (const bf16*)(wsl_(p) + W_XQ), T, 512, 1024, E);
        grid_barrier(wid_s, ctl + 1024, bst); } }
        { REPLOOP(6) {
        if (ON(8)) for (int u = bid; u < 512; u += gridDim.x) { const int qb = u & 15, bh = u >> 4, b = bh >> 2, h = bh & 3;
            attn_unit<128, 128, false, false>(wid_s, lds, (const bf16*)(wsl_(p) + R_XQ) + (size_t)b * 2048 * 512 + h * 128, 512, (const bf16*)(wsl_(p) + R_MK) + (size_t)b * 256 * 512 + h * 128, 512,
                (const bf16*)(wsl_(p) + R_MVT) + (size_t)(b * 4 + h) * 128 * 256, 256, (bf16*)(wsl_(p) + R_XO) + (size_t)b * 2048 * 512 + h * 128, 512,
                qb * 128, 4, p->in[I_XQG] + l * 128, nullptr, 0.12751743082f  ); }
        grid_barrier(wid_s, ctl + 1024, bst); } }
        { int nw = 1 + RB(17); asm volatile("" : "+s"(nw)); for (int q = 0; q < nw; ++q) { EpiRes E{nullptr, xb, part, q + 1 < nw}; run_gemm(wid_s, lds3, (const bf16*)(wsl_(p) + R_XO), 512, (const bf16*)(wsl_(p) + W_XO), T, 1024, 512, E); if (q + 1 < nw) grid_barrier(wid_s, ctl + 1024, bst); } }
        grid_barrier(wid_s, ctl + 1024, bst);
        { REPLOOP(7) { EpiFFN1 E{(bf16*)(wsl_(p) + R_H), part}; run_gemm(wid_s, lds3, xb, 1024, (const bf16*)(wsl_(p) + W_13), T, 5632, 1024, E);
        if (l == 0 && q == 0 && bid >= 128) { __syncthreads(); phase_convert(wid_s, p, 1, ldsf, bid - 128, (int)gridDim.x - 128); __syncthreads(); }
        grid_barrier(wid_s, ctl + 1024, bst); } }
        { int nw = 1 + RB(18); asm volatile("" : "+s"(nw)); for (int q = 0; q < nw; ++q) { EpiRes E{l == 1 ? xcur : nullptr, xb, part, q + 1 < nw}; run_gemm(wid_s, lds3, (const bf16*)(wsl_(p) + R_H), DFF, (const bf16*)(wsl_(p) + W_2), T, 1024, DFF, E); if (q + 1 < nw) grid_barrier(wid_s, ctl + 1024, bst); } }
        grid_barrier(wid_s, ctl + 1024, bst);
    }
}

extern "C" void kernel_launch(void* const* d_in, const int* in_sizes, int n_in, void* d_out, int out_size, void* d_ws, size_t ws_size, hipStream_t stream) {
    static int grid = 0;
    if (grid == 0) {
        int dev = 0, cus = 0, per_cu = 0;
        if (n_in != 43 || ws_size < WS_END) { fprintf(stderr, "kernel_launch: unexpected n_in %d / ws %zu\n", n_in, ws_size); grid = -1; return; }
        (void)hipGetDevice(&dev);
        (void)hipDeviceGetAttribute(&cus, hipDeviceAttributeMultiprocessorCount, dev);
        (void)hipFuncSetAttribute((const void*)fwd_kernel, hipFuncAttributeMaxDynamicSharedMemorySize, LDS_BYTES);
        (void)hipOccupancyMaxActiveBlocksPerMultiprocessor(&per_cu, (const void*)fwd_kernel, 512, LDS_BYTES);
        fprintf(stderr, "cus %d per_cu %d ws %zu\n", cus, per_cu, ws_size);
        grid = cus * (per_cu >= 1 ? 1 : 0);
        if (grid <= 0) { grid = -1; return; }
    }
    if (grid < 0) return;
    Params p{};
    for (int i = 0; i < 43; ++i) p.in[i] = (const float*)d_in[i];
    p.out = (float*)d_out; p.ws = (unsigned char*)d_ws;
    (void)hipMemsetAsync((char*)d_ws + WS_CTL, 0, 32768, stream);
    void* args[] = {&p};
    hipError_t e = hipLaunchCooperativeKernel((const void*)fwd_kernel, dim3(grid), dim3(512), args, LDS_BYTES, stream);
    if (e != hipSuccess) fprintf(stderr, "cooperative launch failed: %s (grid %d)\n", hipGetErrorString(e), grid);
}
```
